# Optimizing an MI355X kernel written in HIP

```python
import math
import jax
import jax.numpy as jnp
from jax import lax
import numpy as np


D_MODEL = 4096
BATCH = 4
SEQ = 4096
DEPTH = 2

GRID_W = 64
CTX_LEN = 256
HEAD_DIM = 128
N_MIX_HEADS = D_MODEL // HEAD_DIM
HY_GROUPS = N_MIX_HEADS // 4
RET_HEADS = (N_MIX_HEADS - HY_GROUPS) // 2
NA_HEADS = N_MIX_HEADS - HY_GROUPS - RET_HEADS
HY_W = HY_GROUPS * HEAD_DIM
RET_W = RET_HEADS * HEAD_DIM
NA_W = NA_HEADS * HEAD_DIM
K_RK = 0
K_RV = K_RK + RET_W
K_NK = K_RV + RET_W
K_NV = K_NK + NA_W
KV_COLS = K_NV + NA_W
R_HY = 0
R_RQ = R_HY + 3 * HY_W
R_RG = R_RQ + RET_W
R_NQ = R_RG + RET_W
REST_COLS = R_NQ + NA_W
IN_COLS = KV_COLS + REST_COLS
N_MOD = 6
HY_ORDER = 2
HY_SHORT = 3
HY_EMB = 33
HY_BANDS = (HY_EMB - 1) // 2
HY_FILTER_HIDDEN = 64
HY_DECAY_TARGET = 1e-2
HY_SHORT_DECAY_PCT = 0.3
HY_LONG_DECAY_PCT = 1.5
HY_MAX_DECAY = math.log(HY_DECAY_TARGET) / HY_SHORT_DECAY_PCT
HY_MIN_DECAY = math.log(HY_DECAY_TARGET) / HY_LONG_DECAY_PCT
HY_FILTER_SCALE = 0.05
RET_CHUNK = 128
RET_SCALE = HEAD_DIM ** -0.5
ROPE_BASE = 10000.0
NA_KH = 8
NA_KW = 16
PEER_HEADS = 8
PEER_NKEYS = 128
PEER_N = PEER_NKEYS * PEER_NKEYS
PEER_TOPK = 16
PEER_DK = 256
PEER_BLOCK = 64
EPS = 1e-6
NEG_INF = -1e30

kernel_name = 'hybrid_hyena_retnet_natten_peer_dit'


def rmsnorm(x, g):
    xf = x.astype(jnp.float32)
    y = xf * lax.rsqrt(jnp.mean(xf * xf, axis=-1, keepdims=True) + EPS)
    return (y * g.astype(jnp.float32)).astype(x.dtype)


def head_rms(x):
    xf = x.astype(jnp.float32)
    return xf * lax.rsqrt(jnp.mean(xf * xf, axis=-1, keepdims=True) + EPS)


def modulate(h, shift, scale):
    return h * (1.0 + scale) + shift


def split_heads(x):
    return x.reshape(x.shape[:-1] + (x.shape[-1] // HEAD_DIM, HEAD_DIM))


def to_bhld(x):
    return jnp.swapaxes(x, 1, 2).astype(jnp.float32)


def axial_rope(x):
    L = x.shape[1]
    t = jnp.arange(L)
    row = (t // GRID_W).astype(jnp.float32)
    col = (t % GRID_W).astype(jnp.float32)
    quarter = x.shape[-1] // 4
    inv = ROPE_BASE ** (-jnp.arange(quarter, dtype=jnp.float32) / quarter)

    def rot(xp, pos):
        ang = pos[:, None] * inv[None, :]
        cos = jnp.cos(ang)[None, :, None, :]
        sin = jnp.sin(ang)[None, :, None, :]
        a, b = xp[..., :quarter], xp[..., quarter:]
        return jnp.concatenate([a * cos - b * sin, a * sin + b * cos], axis=-1)

    half = 2 * quarter
    return jnp.concatenate([rot(x[..., :half], row), rot(x[..., half:], col)], axis=-1).astype(x.dtype)


def short_conv(u, w, b):
    C = u.shape[-1]
    y = lax.conv_general_dilated(u, w[:, None, :].astype(u.dtype), window_strides=(1,),
                                 padding=[(HY_SHORT // 2, HY_SHORT // 2)],
                                 dimension_numbers=('NWC', 'WIO', 'NWC'),
                                 feature_group_count=C)
    return y + b.astype(u.dtype)


def hyena_filters(L, w1, b1, freq, w2, b2, w3, b3, w4):
    f32 = lambda a: a.astype(jnp.float32)
    t = jnp.linspace(0.0, 1.0, L, dtype=jnp.float32)[:, None]
    w = 2.0 * math.pi * jnp.arange(L, dtype=jnp.float32)[:, None] / L
    f = jnp.linspace(1e-4, HY_BANDS - 1, HY_BANDS, dtype=jnp.float32)[None, :]
    z = jnp.concatenate([t, jnp.cos(f * w), -jnp.sin(f * w)], axis=-1)
    h = jnp.sin(f32(freq) * (z @ f32(w1) + f32(b1)))
    h = jnp.sin(f32(freq) * (h @ f32(w2) + f32(b2)))
    h = jnp.sin(f32(freq) * (h @ f32(w3) + f32(b3)))
    k = (h @ f32(w4)).reshape(L, HY_ORDER, 2, HY_W)
    deltas = jnp.abs(jnp.linspace(HY_MIN_DECAY, HY_MAX_DECAY, HY_W, dtype=jnp.float32))
    return k * jnp.exp(-t[:, :, None, None] * deltas)


def long_conv_bidir(u, kf, kb, skip):
    L, C = u.shape[1], u.shape[2]
    filt = jnp.concatenate([kf, jnp.zeros((1, C), jnp.float32), kb[:0:-1]], axis=0)
    uf = u.astype(jnp.float32)
    U = jnp.fft.rfft(uf, n=2 * L, axis=1)
    K = jnp.fft.rfft(filt, n=2 * L, axis=0)
    y = jnp.fft.irfft(U * K[None], n=2 * L, axis=1)[:, :L]
    return (y + uf * skip.astype(jnp.float32)).astype(u.dtype)


def hyena_mixer(u, conv_w, conv_b, filt, skip):
    L = u.shape[1]
    u = short_conv(u, conv_w, conv_b)
    v, x1, x2 = jnp.split(u, 3, axis=-1)
    k = hyena_filters(L, *filt)
    z = x1 * long_conv_bidir(v, k[:, 0, 0], k[:, 0, 1], skip[0])
    z = x2 * long_conv_bidir(z, k[:, 1, 0], k[:, 1, 1], skip[1])
    return z


def ret_chunkwise(q, k, v, log_g, s0):
    B, H, L, d = q.shape
    C = RET_CHUNK
    N = L // C
    pos = jnp.arange(C, dtype=jnp.float32)
    diff = pos[:, None] - pos[None, :]
    inner_decay = jnp.where(diff >= 0, jnp.exp(log_g[:, None, None] * jnp.maximum(diff, 0.0)), 0.0)
    q_decay = jnp.exp(log_g[:, None] * (pos + 1.0))[:, :, None]
    k_decay = jnp.exp(log_g[:, None] * (C - 1.0 - pos))[:, :, None]
    chunk_decay = jnp.exp(log_g * C)[:, None, None]

    def chunks(a):
        return jnp.moveaxis(a.reshape(B, H, N, C, d), 2, 0)

    def step(S, qkv):
        qn, kn, vn = qkv
        a = jnp.einsum('bhid,bhjd->bhij', qn, kn) * inner_decay
        o = jnp.einsum('bhij,bhje->bhie', a, vn) + jnp.einsum('bhid,bhde->bhie', qn * q_decay, S)
        S = S * chunk_decay + jnp.einsum('bhjd,bhje->bhde', kn * k_decay, vn)
        return S, o

    _, o = lax.scan(step, s0, (chunks(q), chunks(k), chunks(v)))
    return jnp.moveaxis(o, 0, 2).reshape(B, H, L, d)


def ret_final_state(k, v, log_g, reverse):
    L = k.shape[2]
    pos = jnp.arange(L, dtype=jnp.float32)
    expo = pos if reverse else (L - 1.0 - pos)
    w = jnp.exp(log_g[:, None] * expo)
    return jnp.einsum('bhld,bhle->bhde', k * w[None, :, :, None], v)


def retention_bidir(q, k, v, log_f, log_b, s_f, s_b):
    fwd = ret_chunkwise(q, k, v, log_f, s_f)
    bwd = jnp.flip(ret_chunkwise(jnp.flip(q, 2), jnp.flip(k, 2), jnp.flip(v, 2), log_b, s_b), 2)
    return fwd + bwd


def na_latent(q, k, v, kc, vc, rpb):
    B, L, H, d = q.shape
    rows = L // GRID_W
    kh = min(NA_KH, rows)
    kw = NA_KW
    scale = d ** -0.5
    col = jnp.arange(GRID_W)
    cstart = jnp.clip(col - kw // 2, 0, GRID_W - kw)
    cmask = (col[None, :] >= cstart[:, None]) & (col[None, :] < cstart[:, None] + kw)
    cidx = jnp.clip(col[None, :] - col[:, None] + kw - 1, 0, 2 * kw - 2)
    rpb_c = rpb[:, :, cidx]
    kg = k.reshape(B, rows, GRID_W, H, d)
    vg = v.reshape(B, rows, GRID_W, H, d)
    qg = q.reshape(B, rows, GRID_W, H, d)

    def row_block(args):
        r, q_r = args
        start = jnp.clip(r - kh // 2, 0, rows - kh)
        k_b = lax.dynamic_slice_in_dim(kg, start, kh, axis=1)
        v_b = lax.dynamic_slice_in_dim(vg, start, kh, axis=1)
        ridx = start + jnp.arange(kh) - r + NA_KH - 1
        bias = jnp.transpose(rpb_c[:, ridx], (0, 2, 1, 3)).astype(jnp.float32)
        s_loc = jnp.einsum('bqhd,bikhd->bhqik', q_r, k_b).astype(jnp.float32) * scale + bias[None]
        s_loc = jnp.where(cmask[None, None, :, None, :], s_loc, NEG_INF).reshape(B, H, GRID_W, kh * GRID_W)
        s_ctx = jnp.einsum('bqhd,bchd->bhqc', q_r, kc).astype(jnp.float32) * scale
        p = jax.nn.softmax(jnp.concatenate([s_loc, s_ctx], axis=-1), axis=-1)
        p_loc = p[..., :kh * GRID_W].reshape(B, H, GRID_W, kh, GRID_W).astype(v.dtype)
        p_ctx = p[..., kh * GRID_W:].astype(v.dtype)
        return (jnp.einsum('bhqik,bikhd->bqhd', p_loc, v_b)
                + jnp.einsum('bhqc,bchd->bqhd', p_ctx, vc))

    out = lax.map(row_block, (jnp.arange(rows), jnp.moveaxis(qg, 1, 0)))
    return jnp.moveaxis(out, 0, 1).reshape(B, L, H, d)


def ctx_attention(q, k, v):
    s = jnp.einsum('bqhd,bkhd->bhqk', q, k).astype(jnp.float32) * q.shape[-1] ** -0.5
    p = jax.nn.softmax(s, axis=-1).astype(v.dtype)
    return jnp.einsum('bhqk,bkhd->bqhd', p, v)


def peer(h, w_q, sub_keys, exp_u, exp_v):
    B, L, D = h.shape
    tok = h.reshape(-1, PEER_BLOCK, D)
    K = PEER_TOPK

    def block(xb):
        T = xb.shape[0]
        q = (xb @ w_q).reshape(T, PEER_HEADS, 2, PEER_DK // 2)
        s = jnp.einsum('thpk,hpnk->thpn', q, sub_keys).astype(jnp.float32)
        top_s, top_i = lax.top_k(s, K)
        cand_s = (top_s[:, :, 0, :, None] + top_s[:, :, 1, None, :]).reshape(T, PEER_HEADS, K * K)
        cand_i = (top_i[:, :, 0, :, None] * PEER_NKEYS + top_i[:, :, 1, None, :]).reshape(T, PEER_HEADS, K * K)
        best_s, best_pos = lax.top_k(cand_s, K)
        e = jnp.take_along_axis(cand_i, best_pos, axis=-1)
        g = jax.nn.softmax(best_s, axis=-1).astype(xb.dtype)
        act = jax.nn.gelu(jnp.einsum('thkd,td->thk', exp_u[e], xb)) * g
        return jnp.einsum('thk,thkd->td', act, exp_v[e])

    return lax.map(block, tok).reshape(B, L, D)


def mixer(kv, rest, p, log_f, log_b, s_f, s_b, nk_c, nv_c, latent):
    B, L, _ = kv.shape
    hy = hyena_mixer(rest[..., R_HY:R_RQ], p['hy_conv_w'], p['hy_conv_b'], p['hy_f'], p['hy_skip'])
    rq = split_heads(rest[..., R_RQ:R_RG])
    rk = split_heads(kv[..., K_RK:K_RV]) * RET_SCALE
    rv = split_heads(kv[..., K_RV:K_NK])
    if latent:
        rq = axial_rope(rq)
        rk = axial_rope(rk)
    ro = retention_bidir(to_bhld(rq), to_bhld(rk), to_bhld(rv), log_f, log_b, s_f, s_b)
    ro = head_rms(jnp.swapaxes(ro, 1, 2)).reshape(B, L, RET_W).astype(kv.dtype)
    ro = ro * jax.nn.silu(rest[..., R_RG:R_NQ])
    nq = rmsnorm(split_heads(rest[..., R_NQ:]), p['q_norm'])
    if latent:
        nk = rmsnorm(split_heads(kv[..., K_NK:K_NV]), p['k_norm'])
        nv = split_heads(kv[..., K_NV:])
        no = na_latent(nq, nk, nv, nk_c, nv_c, p['na_rpb'])
    else:
        no = ctx_attention(nq, nk_c, nv_c)
    return jnp.concatenate([hy, ro, no.reshape(B, L, NA_W)], axis=-1) @ p['w_out']


def layer(xl, xc, mod_l, mod_c, p, last):
    sa_l, ca_l, ga_l, sf_l, cf_l, gf_l = jnp.split(mod_l, N_MOD, axis=-1)
    mod_c_parts = jnp.split(mod_c, mod_c.shape[-1] // D_MODEL, axis=-1)
    sa_c, ca_c = mod_c_parts[0], mod_c_parts[1]
    log_f = -jnp.exp(p['ret_decay'][0].astype(jnp.float32))
    log_b = -jnp.exp(p['ret_decay'][1].astype(jnp.float32))
    w_in = p['w_in']
    hc = modulate(rmsnorm(xc, p['norm_mix']), sa_c, ca_c)
    kv_c = hc @ w_in[:, :KV_COLS]
    rk_c = to_bhld(split_heads(kv_c[..., K_RK:K_RV]) * RET_SCALE)
    rv_c = to_bhld(split_heads(kv_c[..., K_RV:K_NK]))
    s_f = ret_final_state(rk_c, rv_c, log_f, False)
    s_b = ret_final_state(rk_c, rv_c, log_b, True)
    nk_c = rmsnorm(split_heads(kv_c[..., K_NK:K_NV]), p['k_norm'])
    nv_c = split_heads(kv_c[..., K_NV:])
    hl = modulate(rmsnorm(xl, p['norm_mix']), sa_l, ca_l)
    y_l = mixer(hl @ w_in[:, :KV_COLS], hl @ w_in[:, KV_COLS:], p, log_f, log_b, s_f, s_b, nk_c, nv_c, True)
    xl = xl + ga_l * y_l
    hf_l = modulate(rmsnorm(xl, p['norm_ffn']), sf_l, cf_l)
    xl = xl + gf_l * peer(hf_l, p['peer_wq'], p['peer_keys'], p['peer_u'], p['peer_v'])
    if last:
        return xl, None
    ga_c, sf_c, cf_c, gf_c = mod_c_parts[2], mod_c_parts[3], mod_c_parts[4], mod_c_parts[5]
    zeros = jnp.zeros_like(s_f)
    y_c = mixer(kv_c, hc @ w_in[:, KV_COLS:], p, log_f, log_b, zeros, zeros, nk_c, nv_c, False)
    xc = xc + ga_c * y_c
    hf_c = modulate(rmsnorm(xc, p['norm_ffn']), sf_c, cf_c)
    xc = xc + gf_c * peer(hf_c, p['peer_wq'], p['peer_keys'], p['peer_u'], p['peer_v'])
    return xl, xc


def setup_inputs(seed: int = 0) -> dict:
    key = jax.random.key(seed)
    ks = jax.random.split(key, 32)
    D = D_MODEL

    def nrm(k, shape, s):
        return jax.random.normal(k, shape, jnp.float32) * s

    a0 = jnp.asarray(np.log(-np.log1p(-(2.0 ** (-5.0 - np.arange(RET_HEADS))))), dtype=jnp.float32)
    return {
        'x': nrm(ks[0], (BATCH, SEQ, D), 1.0),
        'c': nrm(ks[1], (BATCH, D), 1.0),
        'ctx': nrm(ks[2], (BATCH, CTX_LEN, D), 1.0),
        'c_ctx': nrm(ks[3], (D,), 1.0),
        'w_mod': nrm(ks[4], (DEPTH, D, N_MOD * D), D ** -0.5),
        'b_mod': nrm(ks[5], (DEPTH, N_MOD * D), 0.02),
        'norm_mix': 1.0 + nrm(ks[6], (DEPTH, D), 0.02),
        'w_in': nrm(ks[7], (DEPTH, D, IN_COLS), D ** -0.5),
        'hy_conv_w': nrm(ks[8], (DEPTH, HY_SHORT, 3 * HY_W), HY_SHORT ** -0.5),
        'hy_conv_b': nrm(ks[9], (DEPTH, 3 * HY_W), 0.02),
        'hy_f_w1': nrm(ks[10], (DEPTH, HY_EMB, HY_FILTER_HIDDEN), HY_EMB ** -0.5),
        'hy_f_b1': nrm(ks[11], (DEPTH, HY_FILTER_HIDDEN), 0.1),
        'hy_f_freq': 1.0 + nrm(ks[12], (DEPTH, HY_FILTER_HIDDEN), 0.02),
        'hy_f_w2': nrm(ks[13], (DEPTH, HY_FILTER_HIDDEN, HY_FILTER_HIDDEN), HY_FILTER_HIDDEN ** -0.5),
        'hy_f_b2': nrm(ks[14], (DEPTH, HY_FILTER_HIDDEN), 0.1),
        'hy_f_w3': nrm(ks[15], (DEPTH, HY_FILTER_HIDDEN, HY_FILTER_HIDDEN), HY_FILTER_HIDDEN ** -0.5),
        'hy_f_b3': nrm(ks[16], (DEPTH, HY_FILTER_HIDDEN), 0.1),
        'hy_f_w4': nrm(ks[17], (DEPTH, HY_FILTER_HIDDEN, HY_ORDER * 2 * HY_W), HY_FILTER_HIDDEN ** -0.5 * HY_FILTER_SCALE),
        'hy_skip': nrm(ks[18], (DEPTH, HY_ORDER, HY_W), 0.5),
        'ret_decay': a0 + nrm(ks[19], (DEPTH, 2, RET_HEADS), 0.05),
        'na_rpb': nrm(ks[20], (DEPTH, NA_HEADS, 2 * NA_KH - 1, 2 * NA_KW - 1), 0.1),
        'q_norm': 1.0 + nrm(ks[21], (DEPTH, HEAD_DIM), 0.02),
        'k_norm': 1.0 + nrm(ks[22], (DEPTH, HEAD_DIM), 0.02),
        'w_out': nrm(ks[23], (DEPTH, D, D), D ** -0.5),
        'norm_ffn': 1.0 + nrm(ks[24], (DEPTH, D), 0.02),
        'peer_wq': nrm(ks[25], (DEPTH, D, PEER_HEADS * PEER_DK), D ** -0.5),
        'peer_keys': nrm(ks[26], (DEPTH, PEER_HEADS, 2, PEER_NKEYS, PEER_DK // 2), (PEER_DK // 2) ** -0.5),
        'peer_u': nrm(ks[27], (DEPTH, PEER_N, D), D ** -0.5),
        'peer_v': nrm(ks[28], (DEPTH, PEER_N, D), 1.0),
    }


def reference(x, c, ctx, c_ctx, w_mod, b_mod, norm_mix, w_in, hy_conv_w, hy_conv_b,
              hy_f_w1, hy_f_b1, hy_f_freq, hy_f_w2, hy_f_b2, hy_f_w3, hy_f_b3, hy_f_w4,
              hy_skip, ret_decay, na_rpb, q_norm, k_norm, w_out, norm_ffn,
              peer_wq, peer_keys, peer_u, peer_v):
    xl, xc = x, ctx
    sc = jax.nn.silu(c)
    scc = jax.nn.silu(c_ctx)
    for l in range(DEPTH):
        last = l == DEPTH - 1
        p = {
            'norm_mix': norm_mix[l], 'w_in': w_in[l],
            'hy_conv_w': hy_conv_w[l], 'hy_conv_b': hy_conv_b[l],
            'hy_f': (hy_f_w1[l], hy_f_b1[l], hy_f_freq[l], hy_f_w2[l], hy_f_b2[l],
                     hy_f_w3[l], hy_f_b3[l], hy_f_w4[l]),
            'hy_skip': hy_skip[l], 'ret_decay': ret_decay[l], 'na_rpb': na_rpb[l],
            'q_norm': q_norm[l], 'k_norm': k_norm[l], 'w_out': w_out[l],
            'norm_ffn': norm_ffn[l], 'peer_wq': peer_wq[l], 'peer_keys': peer_keys[l],
            'peer_u': peer_u[l], 'peer_v': peer_v[l],
        }
        mod_l = (sc @ w_mod[l] + b_mod[l])[:, None, :]
        n_ctx = 2 if last else N_MOD
        mod_c = (scc @ w_mod[l][:, :n_ctx * D_MODEL] + b_mod[l][:n_ctx * D_MODEL])[None, None, :]
        xl, xc = layer(xl, xc, mod_l, mod_c, p, last)
    return xl
```

```cpp
#include <hip/hip_runtime.h>
#include <cstdio>
#include <cstdint>

#ifndef MK_ONE_LAUNCH
#define MK_ONE_LAUNCH 0
#endif

typedef unsigned short bf16_t;
typedef short bf16x8_t __attribute__((ext_vector_type(8)));
typedef float f32x4_t __attribute__((ext_vector_type(4)));
typedef float v4f __attribute__((ext_vector_type(4)));
typedef float v2f __attribute__((ext_vector_type(2)));
typedef unsigned v4u __attribute__((ext_vector_type(4)));
typedef unsigned v2u __attribute__((ext_vector_type(2)));
__device__ __forceinline__ v4f make_v4f(float a, float b, float c, float d) { return (v4f){a, b, c, d}; }
__device__ __forceinline__ v2f make_v2f(float a, float b) { return (v2f){a, b}; }
__device__ __forceinline__ v4u make_v4u(unsigned a, unsigned b, unsigned c, unsigned d) { return (v4u){a, b, c, d}; }
__device__ __forceinline__ v2u make_v2u(unsigned a, unsigned b) { return (v2u){a, b}; }

constexpr int D = 4096, NB = 4, SEQ = 4096, TL = NB * SEQ, CTXL = 256, TC = NB * CTXL, MT = TL + TC;
constexpr int INC = 13824;
constexpr int C_RK = 0, C_RV = 1536, C_NK = 3072, C_NV = 4608, C_HY = 6144, C_RQ = 9216, C_RG = 10752, C_NQ = 12288;
constexpr int M_HY = 0, M_RO = 1024, M_NO = 2560;
constexpr int NMOD = 6 * D;
constexpr int PQ = 2048;
constexpr float EPS = 1e-6f;

constexpr size_t al256(size_t x) { return (x + 255) & ~(size_t)255; }
constexpr size_t WS_CTL  = 0;
constexpr size_t CTL_BYTES = 65536;
constexpr size_t WS_MOD  = WS_CTL + CTL_BYTES;
constexpr size_t WS_KT   = al256(WS_MOD + (size_t)2 * 5 * NMOD * 4);
constexpr size_t WS_KTC  = al256(WS_KT + (size_t)2 * 4096 * 4096 * 4);
constexpr size_t WS_WIN  = al256(WS_KTC + (size_t)4096 * 256 * 4);
constexpr size_t WS_WOUT = al256(WS_WIN + (size_t)2 * INC * D * 2);
constexpr size_t WS_WQ   = al256(WS_WOUT + (size_t)2 * D * D * 2);
constexpr size_t WS_H    = al256(WS_WQ + (size_t)2 * PQ * D * 2);
constexpr size_t WS_PROJ = al256(WS_H + (size_t)MT * D * 2);
constexpr size_t WS_MIX  = al256(WS_PROJ + (size_t)MT * INC * 2);
constexpr size_t WS_XC   = al256(WS_MIX + (size_t)MT * D * 2);
constexpr size_t WS_Q    = al256(WS_XC + (size_t)TC * D * 4);
constexpr size_t WS_IDX  = al256(WS_Q + (size_t)MT * PQ * 4);
constexpr size_t WS_GATE = al256(WS_IDX + (size_t)MT * 128 * 4);
constexpr size_t WS_OF   = al256(WS_GATE + (size_t)MT * 128 * 4);
constexpr size_t WS_UB   = al256(WS_OF + (size_t)MT * 1536 * 4);
constexpr size_t WS_VB   = al256(WS_UB + (size_t)2 * 16384 * D * 2);
constexpr size_t WS_END  = al256(WS_VB + (size_t)2 * 16384 * D * 2);

constexpr int CW_BAR = 0;
constexpr int CW_QUEUE = 4096;

constexpr int LDS_BYTES = 156 * 1024;
constexpr int MISC_OFF = LDS_BYTES - 1024;
constexpr int NTHREADS = 512;

struct Args { const float* in[29]; float* out; unsigned char* ws; int ph_lo, ph_hi; };
#define KARG __attribute__((address_space(4)))
#define ARGS_REF const KARG Args&

__device__ __forceinline__ int fresh_tid() { int t = (int)threadIdx.x; asm volatile("" : "+v"(t)); return t; }
__device__ __forceinline__ float bf2f(bf16_t b) { return __uint_as_float(((unsigned)b) << 16); }
__device__ __forceinline__ bf16_t f2bf(float f) { unsigned u = __float_as_uint(f); u += 0x7FFFu + ((u >> 16) & 1u); return (bf16_t)(u >> 16); }
__device__ __forceinline__ unsigned pack2bf(float lo, float hi) { return (unsigned)f2bf(lo) | ((unsigned)f2bf(hi) << 16); }
__device__ __forceinline__ float bflo(unsigned w) { return __uint_as_float(w << 16); }
__device__ __forceinline__ float bfhi(unsigned w) { return __uint_as_float(w & 0xffff0000u); }
__device__ __forceinline__ float wave_sum(float v) {
#pragma unroll
    for (int o = 32; o >= 1; o >>= 1) v += __shfl_xor(v, o);
    return v;
}
__device__ __forceinline__ float wave_max(float v) {
#pragma unroll
    for (int o = 32; o >= 1; o >>= 1) v = fmaxf(v, __shfl_xor(v, o));
    return v;
}
__device__ __forceinline__ float sin_turns(float t) { return __builtin_amdgcn_sinf(t - floorf(t)); }
__device__ __forceinline__ float cos_turns(float t) { return __builtin_amdgcn_cosf(t - floorf(t)); }
__device__ __forceinline__ float sin_rad(float x) { return sin_turns(x * 0.15915494309189535f); }
__device__ __forceinline__ float silu_f(float x) { return x / (1.0f + __expf(-x)); }
__device__ __forceinline__ float gelu_tanh_f(float x) {
    const float u = 0.7978845608028654f * (x + 0.044715f * x * x * x);
    const float th = 1.0f - 2.0f / (__expf(2.0f * u) + 1.0f);
    return 0.5f * x * (1.0f + th);
}
__device__ __forceinline__ int clampi(int x, int lo, int hi) { return x < lo ? lo : (x > hi ? hi : x); }

#define XB_TMO      128
#define XB_XCNT(j)  (256  + 64 * (j))
#define XB_XSUB(j)  (1280 + 64 * (j))
#define XB_XGEN(j)  (2304 + 64 * (j))
#define XB_TOP      3328
#define XB_TOPGEN   3392
#define XCD_BAR_WORDS 3456
#define XB_SPIN_CAP (1u << 21)
#define LAS __attribute__((address_space(3)))

__device__ __forceinline__ unsigned xb_ld(unsigned* p)              { return __hip_atomic_load(p, __ATOMIC_RELAXED, __HIP_MEMORY_SCOPE_AGENT); }
__device__ __forceinline__ unsigned xb_add(unsigned* p, unsigned v) { return __hip_atomic_fetch_add(p, v, __ATOMIC_RELAXED, __HIP_MEMORY_SCOPE_AGENT); }
__device__ __forceinline__ unsigned xb_xcc_id() { return (unsigned)__builtin_amdgcn_s_getreg((3 << 11) | 20) & 0xFu; }
#define XB_SPIN(cond, bar) do { unsigned _sp = 0; while (cond) { __builtin_amdgcn_s_sleep(1); \
    if ((++_sp & 255u) == 0u) { if (xb_ld(&(bar)[XB_TMO])) break; if (_sp > XB_SPIN_CAP) { atomicAdd(&(bar)[XB_TMO], 1u); break; } } } } while (0)

struct XcdBarrier {
    unsigned* bar; unsigned x;
    volatile LAS unsigned* st;
};

__device__ __forceinline__ XcdBarrier xcd_barrier_post(unsigned* bar, volatile LAS unsigned* st) {
    XcdBarrier b; b.bar = bar; b.x = xb_xcc_id(); b.st = st;
    if (threadIdx.x == 0) (void)xb_add(&bar[XB_XCNT(b.x)], 1u);
    return b;
}
__device__ __forceinline__ void xcd_barrier_complete(unsigned* bar, unsigned x, unsigned& nloc, unsigned& nx) {
    const unsigned G = gridDim.x * gridDim.y * gridDim.z;
    unsigned sum, cnt, mine, sp = 0u;
    for (;;) {
        sum = 0u; cnt = 0u; mine = 0u;
#pragma unroll
        for (unsigned j = 0; j < 16; ++j) { const unsigned c = xb_ld(&bar[XB_XCNT(j)]); sum += c; cnt += (c > 0u) ? 1u : 0u; mine = (j == x) ? c : mine; }
        if (sum == G) break;
        __builtin_amdgcn_s_sleep(1);
        if ((++sp & 255u) == 0u) { if (xb_ld(&bar[XB_TMO])) break; if (sp > XB_SPIN_CAP) { atomicAdd(&bar[XB_TMO], 1u); break; } }
    }
    nloc = mine > 0u ? mine : 1u; nx = cnt > 0u ? cnt : 1u;
}

__device__ __forceinline__ void xcd_barrier(const XcdBarrier& b) {
    asm volatile("s_waitcnt vmcnt(0)" ::: "memory");
    __syncthreads();
    if (threadIdx.x == 0) {
        unsigned* bar = b.bar;
        __builtin_amdgcn_s_waitcnt(0);
        unsigned nloc = b.st[0], nx = b.st[1];
        if (nloc == 0u) { xcd_barrier_complete(bar, b.x, nloc, nx); b.st[0] = nloc; b.st[1] = nx; }
        const unsigned old = xb_add(&bar[XB_XSUB(b.x)], 1u);
        const unsigned gen = old / nloc;
        if (old + 1u == (gen + 1u) * nloc) {
            __builtin_amdgcn_fence(__ATOMIC_RELEASE, "agent");
            asm volatile("s_waitcnt vmcnt(0)" ::: "memory");
            const unsigned og = xb_add(&bar[XB_TOP], 1u);
            const unsigned tg = og / nx;
            if (og + 1u == (tg + 1u) * nx) xb_add(&bar[XB_TOPGEN], 1u);
            else XB_SPIN(xb_ld(&bar[XB_TOPGEN]) == tg, bar);
            __builtin_amdgcn_fence(__ATOMIC_ACQUIRE, "agent");
            xb_add(&bar[XB_XGEN(b.x)], 1u);
            asm volatile("s_waitcnt vmcnt(0)" ::: "memory");
        } else {
            XB_SPIN(xb_ld(&bar[XB_XGEN(b.x)]) == gen, bar);
            __builtin_amdgcn_fence(__ATOMIC_ACQUIRE, "agent");
            asm volatile("s_waitcnt vmcnt(0)" ::: "memory");
        }
    }
    __syncthreads();
}
namespace pg8 {
#define PG8_LAS __attribute__((address_space(3)))
typedef unsigned short bf16_t;
typedef short bf16x8 __attribute__((ext_vector_type(8)));
typedef float f32x4 __attribute__((ext_vector_type(4)));
typedef unsigned u32x4 __attribute__((ext_vector_type(4)));
constexpr int BM = 256, BK = 64, HALF = 128, HTB = HALF * BK * 2  , STAGE_BYTES = 8 * HTB, NXCD = 8, WGM = 8;

__host__ __device__ __forceinline__ int lds_byte(int r, int c) { const int st = (r >> 4) * 2 + (c >> 5), rr = r & 15, cc = c & 31, ob = rr * 64 + cc * 2; return st * 1024 + (ob ^ (((ob >> 9) & 1) << 5)); }
__host__ __device__ __forceinline__ void stage_rc(int b, int& R, int& C) { const int st = b / 1024, sb = b % 1024, swz = sb ^ (((sb >> 9) & 1) << 5); R = (st >> 1) * 16 + swz / 64; C = (st & 1) * 32 + (swz % 64) / 2; }
__host__ __device__ __forceinline__ int perm32(int rho) { const int n = rho >> 4, i = rho & 15; return 8 * (i >> 2) + 4 * n + (i & 3); }

struct Unit { int pm, pn; };
struct Gemm { const bf16_t* A; const bf16_t* Bt; int M, N, K; };

struct StaticOrder {
    int nM, nN, nwg, G, c;
    __host__ __device__ void init(int M, int N, int G_, int c_) { nM = M / BM; nN = N / BM; nwg = nM * nN; G = G_; c = c_; }
    __host__ __device__ bool next(int i, Unit& u) const {
        const long L = (long)i * G + c; if (L >= nwg) return false;
        int wgid = (int)L; { const int q = nwg / NXCD, r = nwg % NXCD, xcd = wgid % NXCD, off = wgid / NXCD; wgid = (xcd < r ? xcd * (q + 1) : r * (q + 1) + (xcd - r) * q) + off; }
        const int nig = WGM * nN, gid = wgid / nig, fm = gid * WGM, gsz = (nM - fm) < WGM ? (nM - fm) : WGM;
        u.pm = fm + ((wgid % nig) % gsz); u.pn = (wgid % nig) / gsz; return true;
    }
    __device__ __forceinline__ void a_ready(const Unit&) const {}
    __device__ __forceinline__ void done(const Unit&) const {}
};
struct CountedOrder : StaticOrder {
    const unsigned* ready; unsigned need; unsigned* tmo;
    __device__ __forceinline__ void a_ready(const Unit& u) const {
        if (threadIdx.x < 64) {
            const unsigned long long t0 = __builtin_amdgcn_s_memrealtime(); unsigned polls = 0;
            while ((unsigned)__builtin_amdgcn_readfirstlane(__hip_atomic_load(ready + 64 * u.pm, __ATOMIC_RELAXED, __HIP_MEMORY_SCOPE_AGENT)) < need) {
                if ((++polls & 255u) == 0u && __builtin_amdgcn_readfirstlane(__hip_atomic_load(tmo, __ATOMIC_RELAXED, __HIP_MEMORY_SCOPE_AGENT)) != 0u) break;
                if (__builtin_amdgcn_s_memrealtime() - t0 > 2000000ull) {
                    if (threadIdx.x == 0) { unsigned expect = 0u; __hip_atomic_compare_exchange_strong(tmo + 1, &expect, 0x600u | (unsigned)(u.pm & 0xff), __ATOMIC_RELAXED, __ATOMIC_RELAXED, __HIP_MEMORY_SCOPE_AGENT); __hip_atomic_store(tmo, 1u, __ATOMIC_RELAXED, __HIP_MEMORY_SCOPE_AGENT); }
                    break; }
                __builtin_amdgcn_s_sleep(2); }
            __builtin_amdgcn_fence(__ATOMIC_ACQUIRE, "agent");
            asm volatile("s_waitcnt vmcnt(0)" ::: "memory");
        }
#if !defined(BROKEN_HOOK_NO_BARRIER)
        asm volatile("" ::: "memory"); __builtin_amdgcn_s_barrier(); asm volatile("" ::: "memory");
#endif
    }
};

__device__ __forceinline__ unsigned cvt_pk_bf16(float lo, float hi) { unsigned r; asm volatile("v_cvt_pk_bf16_f32 %0, %1, %2" : "=v"(r) : "v"(lo), "v"(hi)); return r; }
typedef float f32x2 __attribute__((ext_vector_type(2)));
__device__ __forceinline__ f32x2 gelu_pk(f32x2 v) {
    const f32x2 av = __builtin_elementwise_abs(v), d = av * 0.2316418882f + 1.0f;
    f32x2 t; t.x = __builtin_amdgcn_rcpf(d.x); t.y = __builtin_amdgcn_rcpf(d.y);
    f32x2 q = t * 0.5307027145f + (-0.7265760135f); q = q * t + 0.7107068705f; q = q * t + (-0.142248368f); q = q * t + 0.127414796f; q = q * t;
    const f32x2 s = (v * v) * (-0.72134752044f);
    f32x2 e; e.x = __builtin_amdgcn_exp2f(s.x); e.y = __builtin_amdgcn_exp2f(s.y);
    const f32x2 m = v * (q * e), r = v - m;
    f32x2 o; o.x = v.x < 0.f ? m.x : r.x; o.y = v.y < 0.f ? m.y : r.y; return o;
}

struct EpiF32 {
    static constexpr bool PERM = false, AFTER_DRAIN = false;
    float* C; int ldc; const float* bias;
    __device__ __forceinline__ void operator()(const f32x4 (&acc)[2][2][4][2], const Unit& u, int wr, int wc, int fr, int fq) const {
        const int row0 = u.pm * BM + wr * 64 + fr, col0 = u.pn * BM + wc * 32 + 4 * fq;
        f32x4 bv[2][2];
#pragma unroll
        for (int bj = 0; bj < 2; ++bj)
#pragma unroll
            for (int n = 0; n < 2; ++n) bv[bj][n] = bias ? *(const f32x4*)(bias + col0 + bj * HALF + n * 16) : (f32x4){0.f, 0.f, 0.f, 0.f};
#pragma unroll
        for (int ai = 0; ai < 2; ++ai)
#pragma unroll
            for (int m = 0; m < 4; ++m) { float* rowp = C + (size_t)(row0 + ai * HALF + m * 16) * ldc + col0;
#pragma unroll
                for (int bj = 0; bj < 2; ++bj)
#pragma unroll
                    for (int n = 0; n < 2; ++n) *(f32x4*)(rowp + bj * HALF + n * 16) = acc[ai][bj][m][n] + bv[bj][n]; }
    }
};
template <int ACT  > struct EpiBf16 {
    static constexpr bool PERM = true, AFTER_DRAIN = false;
    bf16_t* O; int ldc; const float* bias; int split_cols; size_t split_stride;
    __device__ __forceinline__ void operator()(const f32x4 (&acc)[2][2][4][2], const Unit& u, int wr, int wc, int fr, int fq) const {
        const int row0 = u.pm * BM + wr * 64 + fr; int colt = u.pn * BM; bf16_t* base = O;
        if (split_cols) { const int t = colt / split_cols; base += (size_t)t * split_stride; colt -= t * split_cols; }
        const int col0 = colt + wc * 32 + 8 * fq, bcol0 = u.pn * BM + wc * 32 + 8 * fq;
        f32x4 bv[2][2];
#pragma unroll
        for (int bj = 0; bj < 2; ++bj)
#pragma unroll
            for (int n = 0; n < 2; ++n) bv[bj][n] = bias ? *(const f32x4*)(bias + bcol0 + bj * HALF + 4 * n) : (f32x4){0.f, 0.f, 0.f, 0.f};
#pragma unroll
        for (int ai = 0; ai < 2; ++ai)
#pragma unroll
            for (int m = 0; m < 4; ++m) { bf16_t* rowp = base + (size_t)(row0 + ai * HALF + m * 16) * ldc + col0;
#pragma unroll
                for (int bj = 0; bj < 2; ++bj) { f32x4 v0 = acc[ai][bj][m][0] + bv[bj][0], v1 = acc[ai][bj][m][1] + bv[bj][1];
                    if (ACT == 1) { f32x2 a = gelu_pk((f32x2){v0[0], v0[1]}), b = gelu_pk((f32x2){v0[2], v0[3]}), c = gelu_pk((f32x2){v1[0], v1[1]}), d = gelu_pk((f32x2){v1[2], v1[3]});
                        v0 = (f32x4){a.x, a.y, b.x, b.y}; v1 = (f32x4){c.x, c.y, d.x, d.y}; }
                    if (ACT == 2) {
#pragma unroll
                        for (int j = 0; j < 4; ++j) { v0[j] = 0.5f * v0[j] * (1.0f + erff(v0[j] * 0.70710678f)); v1[j] = 0.5f * v1[j] * (1.0f + erff(v1[j] * 0.70710678f)); } }
                    u32x4 w; w.x = cvt_pk_bf16(v0[0], v0[1]); w.y = cvt_pk_bf16(v0[2], v0[3]); w.z = cvt_pk_bf16(v1[0], v1[1]); w.w = cvt_pk_bf16(v1[2], v1[3]);
                    *(u32x4*)(rowp + bj * HALF) = w; } }
    }
};

struct PanelStats {
    unsigned* xbuf;
    unsigned* cnt;
    unsigned* tmo;
    int ntn; float eps;
    unsigned code;
    __device__ __forceinline__ bool run(const f32x4 (&v)[2][2][4][2], const Unit& u, int wr, int wc, int fr, int fq, PG8_LAS unsigned char* lds, int wid, int lane) const {
        typedef float f32x2v __attribute__((ext_vector_type(2)));
        PG8_LAS f32x2v* P = (PG8_LAS f32x2v*)lds;
        PG8_LAS f32x2v* S = (PG8_LAS f32x2v*)(lds + 8192);
        PG8_LAS unsigned* flag = (PG8_LAS unsigned*)(lds + 8192 + 2048);
#pragma unroll
        for (int ai = 0; ai < 2; ++ai)
#pragma unroll
            for (int m = 0; m < 4; ++m) {
                float s = 0.f;
#pragma unroll
                for (int bj = 0; bj < 2; ++bj)
#pragma unroll
                    for (int n = 0; n < 2; ++n) { const f32x4 x = v[ai][bj][m][n]; s += (x[0] + x[1]) + (x[2] + x[3]); }
                s += __shfl_xor(s, 16); s += __shfl_xor(s, 32);
                const float mw = s * (1.0f / 64.0f); float q = 0.f;
#pragma unroll
                for (int bj = 0; bj < 2; ++bj)
#pragma unroll
                    for (int n = 0; n < 2; ++n) { const f32x4 d = v[ai][bj][m][n] - mw; q += (d[0] * d[0] + d[1] * d[1]) + (d[2] * d[2] + d[3] * d[3]); }
                q += __shfl_xor(q, 16); q += __shfl_xor(q, 32);
                if (fq == 0) P[(ai * HALF + wr * 64 + m * 16 + fr) * 4 + wc] = (f32x2v){mw, q};
            }
        asm volatile("s_waitcnt lgkmcnt(0)" ::: "memory"); __builtin_amdgcn_s_barrier(); asm volatile("" ::: "memory");
#if defined(BROKEN_NO_WAIT)
        if (blockIdx.x >= 64) { const long long t0 = clock64(); while (clock64() - t0 < 60000) __builtin_amdgcn_s_sleep(8); }
#endif
        const int row = wid * 32 + (lane & 31);
        if (lane < 32) {
            const f32x2v a = P[row * 4 + 0], b = P[row * 4 + 1], c = P[row * 4 + 2], d = P[row * 4 + 3];
            const float mt = (a.x + b.x + c.x + d.x) * 0.25f;
            const float da = a.x - mt, db = b.x - mt, dc = c.x - mt, dd = d.x - mt;
            const float m2 = (a.y + b.y) + (c.y + d.y) + 64.0f * ((da * da + db * db) + (dc * dc + dd * dd));
            unsigned long long* slot = (unsigned long long*)xbuf + ((size_t)(u.pm * BM + row) * 4 + u.pn);
            __hip_atomic_store(slot, ((unsigned long long)__float_as_uint(m2) << 32) | __float_as_uint(mt), __ATOMIC_RELAXED, __HIP_MEMORY_SCOPE_AGENT);
        }
        asm volatile("s_waitcnt vmcnt(0)" ::: "memory");
        if (lane == 0) __hip_atomic_fetch_add(cnt + 64 * u.pm, 1u, __ATOMIC_RELAXED, __HIP_MEMORY_SCOPE_AGENT);
        if (wid == 0) {
            bool dead = false; const unsigned long long t0 = __builtin_amdgcn_s_memrealtime(); const unsigned want = 8u * (unsigned)ntn;
            for (;;) {
#if defined(BROKEN_NO_WAIT)
                break;
#endif
                if ((unsigned)__builtin_amdgcn_readfirstlane(__hip_atomic_load(cnt + 64 * u.pm, __ATOMIC_RELAXED, __HIP_MEMORY_SCOPE_AGENT)) >= want) break;
                if (__builtin_amdgcn_s_memrealtime() - t0 > 2000000ull) {
                    if (lane == 0) { unsigned expect = 0u; __hip_atomic_compare_exchange_strong(tmo + 1, &expect, code | (unsigned)(u.pm & 0xff), __ATOMIC_RELAXED, __ATOMIC_RELAXED, __HIP_MEMORY_SCOPE_AGENT);
                                     __hip_atomic_store(tmo, 1u, __ATOMIC_RELAXED, __HIP_MEMORY_SCOPE_AGENT); }
                    dead = true; break; }
                __builtin_amdgcn_s_sleep(2);
            }
            __builtin_amdgcn_fence(__ATOMIC_ACQUIRE, "agent");
            if (lane == 0) flag[0] = dead ? 1u : 0u;
        }
        asm volatile("s_waitcnt vmcnt(0) lgkmcnt(0)" ::: "memory"); __builtin_amdgcn_s_barrier(); asm volatile("" ::: "memory");
        const bool bad = flag[0] != 0u;
        if (lane < 32) {
            const unsigned long long* slot = (const unsigned long long*)xbuf + (size_t)(u.pm * BM + row) * 4; float mt[4], m2[4]; float ms = 0.f;
#pragma unroll
            for (int t = 0; t < 4; ++t) { if (t < ntn) { const unsigned long long w = __hip_atomic_load(slot + t, __ATOMIC_RELAXED, __HIP_MEMORY_SCOPE_AGENT); mt[t] = __uint_as_float((unsigned)w); m2[t] = __uint_as_float((unsigned)(w >> 32)); } else { mt[t] = 0.f; m2[t] = 0.f; } ms += mt[t]; }
            const float mean = ms / (float)ntn; float q = 0.f;
#pragma unroll
            for (int t = 0; t < 4; ++t) if (t < ntn) { const float dm = mt[t] - mean; q += m2[t] + 256.0f * dm * dm; }
            S[row] = (f32x2v){mean, 1.0f / sqrtf(q / (256.0f * (float)ntn) + eps)};
        }
        asm volatile("s_waitcnt lgkmcnt(0)" ::: "memory"); __builtin_amdgcn_s_barrier(); asm volatile("" ::: "memory");
        return bad;
    }
};
struct EpiLnRes {
    static constexpr bool PERM = false, AFTER_DRAIN = true;
    const float* base; float* out; int ldc; const float* bias; PanelStats st; unsigned poison;
    __device__ __forceinline__ void refuse(size_t i0, size_t stride, int M, int N) const { const float q = __builtin_nanf(""); for (size_t i = i0; i < (size_t)M * N; i += stride) out[(i / N) * ldc + i % N] = q;
        if (i0 == 0) { unsigned expect = 0u; __hip_atomic_compare_exchange_strong(st.tmo + 1, &expect, 0x7f0u, __ATOMIC_RELAXED, __ATOMIC_RELAXED, __HIP_MEMORY_SCOPE_AGENT); __hip_atomic_store(st.tmo, 1u, __ATOMIC_RELAXED, __HIP_MEMORY_SCOPE_AGENT); } }
    __device__ __forceinline__ void fused(f32x4 (&acc)[2][2][4][2], const Unit& u, int wr, int wc, int fr, int fq, PG8_LAS unsigned char* lds, int wid, int lane) const {
        typedef float f32x2v __attribute__((ext_vector_type(2)));
        const PG8_LAS f32x2v* S = (const PG8_LAS f32x2v*)(lds + 8192);
        const int col0 = u.pn * BM + wc * 32 + 4 * fq;
#pragma unroll
        for (int bj = 0; bj < 2; ++bj)
#pragma unroll
            for (int n = 0; n < 2; ++n) { const f32x4 bv = bias ? *(const f32x4*)(bias + col0 + bj * HALF + n * 16) : (f32x4){0.f, 0.f, 0.f, 0.f};
#pragma unroll
                for (int ai = 0; ai < 2; ++ai)
#pragma unroll
                    for (int m = 0; m < 4; ++m) acc[ai][bj][m][n] += bv; }
        const bool bad = st.run(acc, u, wr, wc, fr, fq, lds, wid, lane) || poison != 0u;
        const float qnan = __builtin_nanf("");
#pragma unroll
        for (int ai = 0; ai < 2; ++ai)
#pragma unroll
            for (int m = 0; m < 4; ++m) { const int r = ai * HALF + wr * 64 + m * 16 + fr; const f32x2v sr = S[r]; const size_t off = (size_t)(u.pm * BM + r) * ldc + col0;
#pragma unroll
                for (int bj = 0; bj < 2; ++bj)
#pragma unroll
                    for (int n = 0; n < 2; ++n) { const f32x4 bs = *(const f32x4*)(base + off + bj * HALF + n * 16); f32x4 o = bs + (acc[ai][bj][m][n] - sr.x) * sr.y;
                        if (bad) o = (f32x4){qnan, qnan, qnan, qnan}; *(f32x4*)(out + off + bj * HALF + n * 16) = o; }
                asm volatile("" ::: "memory"); }
    }
};
struct EpiLnResLn {
    static constexpr bool PERM = false, AFTER_DRAIN = true;
    const float* base; float* out; bf16_t* xn; int ldc; const float* bias; PanelStats st1, st2; unsigned poison;
    __device__ __forceinline__ void refuse(size_t i0, size_t stride, int M, int N) const { const float q = __builtin_nanf(""); for (size_t i = i0; i < (size_t)M * N; i += stride) { const size_t o = (i / N) * ldc + i % N; out[o] = q; xn[o] = (bf16_t)0x7fc0u; }
        if (i0 == 0) { unsigned expect = 0u; __hip_atomic_compare_exchange_strong(st1.tmo + 1, &expect, 0x7f0u, __ATOMIC_RELAXED, __ATOMIC_RELAXED, __HIP_MEMORY_SCOPE_AGENT); __hip_atomic_store(st1.tmo, 1u, __ATOMIC_RELAXED, __HIP_MEMORY_SCOPE_AGENT); } }
    __device__ __forceinline__ void fused(f32x4 (&acc)[2][2][4][2], const Unit& u, int wr, int wc, int fr, int fq, PG8_LAS unsigned char* lds, int wid, int lane) const {
        typedef float f32x2v __attribute__((ext_vector_type(2))); typedef unsigned u32x2v __attribute__((ext_vector_type(2)));
        const PG8_LAS f32x2v* S = (const PG8_LAS f32x2v*)(lds + 8192);
        const int col0 = u.pn * BM + wc * 32 + 4 * fq;
#pragma unroll
        for (int bj = 0; bj < 2; ++bj)
#pragma unroll
            for (int n = 0; n < 2; ++n) { const f32x4 bv = bias ? *(const f32x4*)(bias + col0 + bj * HALF + n * 16) : (f32x4){0.f, 0.f, 0.f, 0.f};
#pragma unroll
                for (int ai = 0; ai < 2; ++ai)
#pragma unroll
                    for (int m = 0; m < 4; ++m) acc[ai][bj][m][n] += bv; }
        bool bad = st1.run(acc, u, wr, wc, fr, fq, lds, wid, lane) || poison != 0u;
        const float qnan = __builtin_nanf("");
#pragma unroll
        for (int ai = 0; ai < 2; ++ai)
#pragma unroll
            for (int m = 0; m < 4; ++m) { const int r = ai * HALF + wr * 64 + m * 16 + fr; const f32x2v sr = S[r]; const size_t off = (size_t)(u.pm * BM + r) * ldc + col0;
#pragma unroll
                for (int bj = 0; bj < 2; ++bj)
#pragma unroll
                    for (int n = 0; n < 2; ++n) { const f32x4 bs = *(const f32x4*)(base + off + bj * HALF + n * 16); acc[ai][bj][m][n] = bs + (acc[ai][bj][m][n] - sr.x) * sr.y; }
                asm volatile("" : "+v"(acc[ai][0][m][0]), "+v"(acc[ai][0][m][1]), "+v"(acc[ai][1][m][0]), "+v"(acc[ai][1][m][1]));
                if (m & 1) asm volatile("" ::: "memory"); }
        const bool bad1 = bad;
        bad = st2.run(acc, u, wr, wc, fr, fq, lds, wid, lane) || bad;
#pragma unroll
        for (int ai = 0; ai < 2; ++ai)
#pragma unroll
            for (int m = 0; m < 4; ++m) { const int r = ai * HALF + wr * 64 + m * 16 + fr; const f32x2v sr = S[r]; const size_t off = (size_t)(u.pm * BM + r) * ldc + col0;
#pragma unroll
                for (int bj = 0; bj < 2; ++bj)
#pragma unroll
                    for (int n = 0; n < 2; ++n) { const f32x4 x1 = acc[ai][bj][m][n]; *(f32x4*)(out + off + bj * HALF + n * 16) = bad1 ? (f32x4){qnan, qnan, qnan, qnan} : x1;
                        const f32x4 o = (x1 - sr.x) * sr.y; u32x2v w; w.x = cvt_pk_bf16(o[0], o[1]); w.y = cvt_pk_bf16(o[2], o[3]);
                        if (bad) { w.x = 0x7fc07fc0u; w.y = 0x7fc07fc0u; } *(u32x2v*)(xn + off + bj * HALF + n * 16) = w; }
                asm volatile("" ::: "memory"); }
    }
};

template <class Epi, class Sched, bool STAMP = false>
__device__ __forceinline__ void gemm_phase(PG8_LAS unsigned char* lds, const Gemm g, const Sched& S, const Epi& E, unsigned long long* stamps) {
    const int tid = fresh_tid(), wid = __builtin_amdgcn_readfirstlane(tid >> 6), lane = tid & 63, wr = wid >> 2, wc = wid & 3, fr = lane & 15, fq = lane >> 4;
    const int K = g.K, nt = K / BK;
    int ts_lo = 0, ts_hi = 0, nts = 0; const unsigned long long rt_entry = STAMP ? (unsigned long long)wall_clock64() : 0ull;
#define PG8_STAMP() do { if (STAMP && wid == 0 && nts < 64) { const unsigned long long _c = (unsigned long long)clock64(); \
        ts_lo = (lane == nts) ? (int)(unsigned)_c : ts_lo; ts_hi = (lane == nts) ? (int)(unsigned)(_c >> 32) : ts_hi; ++nts; } } while (0)
    PG8_STAMP();
    unsigned voffA[2], voffB[2];
#pragma unroll
    for (int i = 0; i < 2; ++i) { int R, C; stage_rc(tid * 16 + i * 8192, R, C); const int Rb = Epi::PERM ? ((R & ~31) + perm32(R & 31)) : R;
        voffA[i] = (unsigned)(R * K + C) * 2u; voffB[i] = (unsigned)(Rb * K + C) * 2u; }
    const size_t kstep = (size_t)(BK * 2);
    const size_t hstep = (size_t)HALF * K * 2;
    const size_t tstep = 2 * hstep;
    const unsigned ldsw = (unsigned)wid * 1024u;
    const int aoff = lds_byte(wr * 64 + fr, fq * 8), boff = lds_byte(wc * 32 + fr, fq * 8);
#define PG8_SA(b, h) (((b) * 2 + (h)) * HTB)
#define PG8_SB(b, h) ((4 + (b) * 2 + (h)) * HTB)
#define PG8_STAGE(bufoff, gbase, voff) do { _Pragma("unroll") for (int _i = 0; _i < 2; ++_i) \
        __builtin_amdgcn_global_load_lds((const unsigned*)((const char*)(gbase) + (voff)[_i]), (PG8_LAS unsigned*)(lds + (bufoff) + ldsw + _i * 8192), 16, 0, 0); } while (0)
#define PG8_LDA(dst, b, h) do { _Pragma("unroll") for (int m = 0; m < 4; ++m) _Pragma("unroll") for (int k = 0; k < 2; ++k) dst[m][k] = *(const PG8_LAS bf16x8*)(lds + PG8_SA(b, h) + aoff + m * 2048 + k * 1024); } while (0)
#define PG8_LDB(dst, b, h) do { _Pragma("unroll") for (int n = 0; n < 2; ++n) _Pragma("unroll") for (int k = 0; k < 2; ++k) dst[n][k] = *(const PG8_LAS bf16x8*)(lds + PG8_SB(b, h) + boff + n * 2048 + k * 1024); } while (0)
#define PG8_MMA(ai, bj, At, Bt) do { __builtin_amdgcn_s_setprio(1); _Pragma("unroll") for (int m = 0; m < 4; ++m) _Pragma("unroll") for (int n = 0; n < 2; ++n) _Pragma("unroll") for (int k = 0; k < 2; ++k) \
        acc[ai][bj][m][n] = __builtin_amdgcn_mfma_f32_16x16x32_bf16(Bt[n][k], At[m][k], acc[ai][bj][m][n], 0, 0, 0); __builtin_amdgcn_s_setprio(0); } while (0)
#define PG8_WAIT_V(n) asm volatile("s_waitcnt vmcnt(" #n ")" ::: "memory")
#define PG8_WAIT_L(n) asm volatile("s_waitcnt lgkmcnt(" #n ")" ::: "memory")
#define PG8_BAR __builtin_amdgcn_s_barrier()
#define PG8_SCHED __builtin_amdgcn_sched_barrier(0)
    Unit cur, nxt; int ui = 0;
    if (!S.next(0, cur)) return;
    f32x4 acc[2][2][4][2];
#pragma unroll
    for (int a = 0; a < 2; ++a)
#pragma unroll
        for (int b = 0; b < 2; ++b)
#pragma unroll
            for (int m = 0; m < 4; ++m)
#pragma unroll
                for (int n = 0; n < 2; ++n) acc[a][b][m][n] = (f32x4){0.f, 0.f, 0.f, 0.f};
    bf16x8 At[4][2], B0[2][2], B1[2][2];
    const char* cA = (const char*)g.A + (size_t)cur.pm * tstep; const char* cB = (const char*)g.Bt + (size_t)cur.pn * tstep;
    S.a_ready(cur);
    PG8_STAGE(PG8_SB(0, 0), cB, voffB); PG8_STAGE(PG8_SA(0, 0), cA, voffA); PG8_STAGE(PG8_SB(0, 1), cB + hstep, voffB); PG8_STAGE(PG8_SA(0, 1), cA + hstep, voffA);
    if (wr == 1) PG8_BAR;
    PG8_WAIT_V(4); PG8_BAR;
    PG8_STAGE(PG8_SB(1, 0), cB + kstep, voffB); PG8_STAGE(PG8_SA(1, 0), cA + kstep, voffA); PG8_STAGE(PG8_SB(1, 1), cB + hstep + kstep, voffB);
    PG8_WAIT_V(6); PG8_BAR;
    PG8_STAMP();
    for (;;) {
        const bool has_next = S.next(ui + 1, nxt);
        const char* nA = has_next ? (const char*)g.A + (size_t)nxt.pm * tstep : cA; const char* nB = has_next ? (const char*)g.Bt + (size_t)nxt.pn * tstep : cB;
        for (int t = 0; t < nt; t += 2) {
            const bool last = (t == nt - 2);
            const char* a1 = cA + (size_t)(t + 1) * kstep;
            const char* a2 = last ? nA : cA + (size_t)(t + 2) * kstep; const char* b2 = last ? nB : cB + (size_t)(t + 2) * kstep;
            const char* a3 = a2 + kstep; const char* b3 = b2 + kstep;
            if (last && has_next) S.a_ready(nxt);
            PG8_LDB(B0, 0, 0); PG8_SCHED; PG8_LDA(At, 0, 0); PG8_STAGE(PG8_SA(1, 1), a1 + hstep, voffA);
            PG8_WAIT_L(8); PG8_BAR; PG8_WAIT_L(0); PG8_MMA(0, 0, At, B0); PG8_BAR; PG8_SCHED;
            PG8_LDB(B1, 0, 1); PG8_STAGE(PG8_SB(0, 0), b2, voffB);
            PG8_BAR; PG8_WAIT_L(0); PG8_MMA(0, 1, At, B1); PG8_BAR;
            PG8_LDA(At, 0, 1); PG8_STAGE(PG8_SA(0, 0), a2, voffA);
            PG8_BAR; PG8_WAIT_L(0); PG8_MMA(1, 0, At, B0); PG8_BAR; PG8_SCHED;
            PG8_STAGE(PG8_SB(0, 1), b2 + hstep, voffB);
            PG8_WAIT_V(6); PG8_BAR; PG8_MMA(1, 1, At, B1); PG8_BAR;
            PG8_LDB(B0, 1, 0); PG8_SCHED; PG8_LDA(At, 1, 0); PG8_STAGE(PG8_SA(0, 1), a2 + hstep, voffA);
            PG8_WAIT_L(8); PG8_BAR; PG8_WAIT_L(0); PG8_MMA(0, 0, At, B0); PG8_BAR; PG8_SCHED;
            PG8_LDB(B1, 1, 1); PG8_STAGE(PG8_SB(1, 0), b3, voffB);
            PG8_BAR; PG8_WAIT_L(0); PG8_MMA(0, 1, At, B1); PG8_BAR;
            PG8_LDA(At, 1, 1); PG8_STAGE(PG8_SA(1, 0), a3, voffA);
            PG8_BAR; PG8_WAIT_L(0); PG8_MMA(1, 0, At, B0); PG8_BAR; PG8_SCHED;
            PG8_STAGE(PG8_SB(1, 1), b3 + hstep, voffB);
            PG8_WAIT_V(6); PG8_BAR; PG8_MMA(1, 1, At, B1); PG8_BAR;
        }
        PG8_STAMP();
        if constexpr (!Epi::AFTER_DRAIN) { E(acc, cur, wr, wc, fr, fq); S.done(cur); }
        PG8_STAMP();
        if (!has_next) break;
#pragma unroll
        for (int a = 0; a < 2; ++a)
#pragma unroll
            for (int b = 0; b < 2; ++b)
#pragma unroll
                for (int m = 0; m < 4; ++m)
#pragma unroll
                    for (int n = 0; n < 2; ++n) acc[a][b][m][n] = (f32x4){0.f, 0.f, 0.f, 0.f};
        cur = nxt; cA = nA; cB = nB; ++ui;
    }
    PG8_WAIT_V(0);
    if (wr == 0) PG8_BAR;
    PG8_BAR;
    if constexpr (Epi::AFTER_DRAIN) { E.fused(acc, cur, wr, wc, fr, fq, lds, wid, lane); S.done(cur); }
    PG8_STAMP();
    if (STAMP && wid == 0) { stamps[lane] = lane < nts ? (((unsigned long long)(unsigned)ts_hi << 32) | (unsigned)ts_lo) : 0ull;
        if (lane == 62) stamps[62] = rt_entry; if (lane == 63) stamps[63] = (unsigned long long)wall_clock64(); }
#undef PG8_STAMP
#undef PG8_SA
#undef PG8_SB
#undef PG8_STAGE
#undef PG8_LDA
#undef PG8_LDB
#undef PG8_MMA
#undef PG8_WAIT_V
#undef PG8_WAIT_L
#undef PG8_BAR
#undef PG8_SCHED
}
}

constexpr float HY_MIN_DECAY = -3.0701134573253944f;
constexpr float HY_MAX_DECAY = -15.350567286626972f;
constexpr float RET_SCALE = 0.08838834764831845f;

__device__ __forceinline__ void p0_mod_item(ARGS_REF a, int item, LAS unsigned char* lds) {
    const int tid = fresh_tid(), lane = tid & 63, wave = tid >> 6;
    const int l = item / 192, n0 = (item % 192) * 128;
    LAS float* sc = (LAS float*)lds;
    LAS float* red = (LAS float*)(lds + 81920);
    const float* c = a.in[1]; const float* cc = a.in[3];
    for (int i = tid; i < 5 * 4096; i += NTHREADS) { const int r = i >> 12, k = i & 4095; const float x = r < 4 ? c[r * 4096 + k] : cc[k]; sc[i] = silu_f(x); }
    __syncthreads();
    float acc[5][2];
#pragma unroll
    for (int r = 0; r < 5; ++r) { acc[r][0] = 0.f; acc[r][1] = 0.f; }
    const float* W = a.in[4] + (size_t)l * 4096 * NMOD + n0 + 2 * lane;
#pragma unroll 8
    for (int k = wave; k < 4096; k += 8) {
        const v2f w = *(const v2f*)(W + (size_t)k * NMOD);
#pragma unroll
        for (int r = 0; r < 5; ++r) { const float s = sc[r * 4096 + k]; acc[r][0] += s * w.x; acc[r][1] += s * w.y; }
    }
#pragma unroll
    for (int r = 0; r < 5; ++r) { red[(wave * 5 + r) * 128 + 2 * lane] = acc[r][0]; red[(wave * 5 + r) * 128 + 2 * lane + 1] = acc[r][1]; }
    __syncthreads();
    float* MOD = (float*)(a.ws + WS_MOD);
    for (int i = tid; i < 640; i += NTHREADS) {
        const int r = i >> 7, n = i & 127; float s = 0.f;
#pragma unroll
        for (int w = 0; w < 8; ++w) s += red[(w * 5 + r) * 128 + n];
        MOD[(size_t)(l * 5 + r) * NMOD + n0 + n] = s + a.in[5][(size_t)l * NMOD + n0 + n];
    }
    __syncthreads();
}

__device__ __forceinline__ void p0_filter_item(ARGS_REF a, int item, LAS unsigned char* lds) {
    const int tid = fresh_tid(), lane = tid & 63, wave = tid >> 6;
    const bool ctx = item >= 128; const int l = ctx ? 0 : item / 64; const int L = ctx ? 256 : 4096; const int t0 = (ctx ? item - 128 : item % 64) * 64;
    LAS float* z = (LAS float*)lds;
    LAS float* h1 = z + 64 * 33;
    LAS float* h2 = h1 + 64 * 64;
    const float* w1 = a.in[10] + l * 33 * 64; const float* b1 = a.in[11] + l * 64; const float* fq = a.in[12] + l * 64;
    const float* w2 = a.in[13] + l * 4096; const float* b2 = a.in[14] + l * 64; const float* w3 = a.in[15] + l * 4096; const float* b3 = a.in[16] + l * 64;
    const float* w4 = a.in[17] + (size_t)l * 64 * 4096;
    for (int i = tid; i < 64 * 33; i += NTHREADS) {
        const int tl = i / 33, j = i - tl * 33; const int t = t0 + tl; float val;
        if (j == 0) val = (float)t / (float)(L - 1);
        else { const int bi = (j - 1) & 15; const float f = 1e-4f + (float)bi * ((15.0f - 1e-4f) / 15.0f); const float turns = f * (float)t / (float)L;
               val = (j <= 16) ? cos_turns(turns) : -sin_turns(turns); }
        z[i] = val;
    }
    __syncthreads();
    const float frq = fq[lane];
#pragma unroll 1
    for (int i = 0; i < 8; ++i) { const int tl = wave + 8 * i; float s = b1[lane]; for (int q = 0; q < 33; ++q) s += z[tl * 33 + q] * w1[q * 64 + lane]; h1[tl * 64 + lane] = sin_rad(frq * s); }
    __syncthreads();
#pragma unroll 1
    for (int i = 0; i < 8; ++i) { const int tl = wave + 8 * i; float s = b2[lane]; for (int q = 0; q < 64; ++q) s += h1[tl * 64 + q] * w2[q * 64 + lane]; h2[tl * 64 + lane] = sin_rad(frq * s); }
    __syncthreads();
#pragma unroll 1
    for (int i = 0; i < 8; ++i) { const int tl = wave + 8 * i; float s = b3[lane]; for (int q = 0; q < 64; ++q) s += h2[tl * 64 + q] * w3[q * 64 + lane]; h1[tl * 64 + lane] = sin_rad(frq * s); }
    __syncthreads();
    float* KT = ctx ? (float*)(a.ws + WS_KTC) : (float*)(a.ws + WS_KT) + (size_t)l * 4096 * 4096;
#pragma unroll 1
    for (int ci = 0; ci < 8; ++ci) {
        const int col = tid + 512 * ci; const int c = col & 1023;
        float w[64];
#pragma unroll
        for (int j = 0; j < 64; ++j) w[j] = w4[j * 4096 + col];
        const float delta = fabsf(HY_MIN_DECAY + (HY_MAX_DECAY - HY_MIN_DECAY) * ((float)c / 1023.0f));
#pragma unroll 1
        for (int tl = 0; tl < 64; ++tl) {
            float s = 0.f;
#pragma unroll
            for (int j4 = 0; j4 < 16; ++j4) { const v4f hv = *(const LAS v4f*)(h1 + tl * 64 + j4 * 4); s += hv.x * w[j4 * 4] + hv.y * w[j4 * 4 + 1] + hv.z * w[j4 * 4 + 2] + hv.w * w[j4 * 4 + 3]; }
            const float tt = (float)(t0 + tl) / (float)(L - 1);
            KT[(size_t)col * L + t0 + tl] = s * __expf(-tt * delta);
        }
    }
    __syncthreads();
}

__device__ __forceinline__ void p0_tr_tile(const float* src, int N, bf16_t* dst, int k0, int n0, LAS unsigned char* lds) {
    const int tid = fresh_tid();
    LAS float* T = (LAS float*)lds;
#pragma unroll
    for (int i = 0; i < 4; ++i) {
        const int idx = tid + 512 * i; const int r = idx >> 5, c4 = idx & 31;
        const v4f v = *(const v4f*)(src + (size_t)(k0 + r) * N + n0 + c4 * 4);
        LAS float* p = T + r * 129 + c4 * 4; p[0] = v.x; p[1] = v.y; p[2] = v.z; p[3] = v.w;
    }
    __syncthreads();
    {
        const int n = tid >> 2, kc = (tid & 3) * 16; unsigned w[8];
#pragma unroll
        for (int j = 0; j < 8; ++j) w[j] = pack2bf(T[(kc + 2 * j) * 129 + n], T[(kc + 2 * j + 1) * 129 + n]);
        bf16_t* d = dst + (size_t)(n0 + n) * 4096 + k0 + kc;
        *(v4u*)d = make_v4u(w[0], w[1], w[2], w[3]); *(v4u*)(d + 8) = make_v4u(w[4], w[5], w[6], w[7]);
    }
    __syncthreads();
}

__device__ __forceinline__ void p0_prologue(ARGS_REF a, LAS unsigned char* lds) {
    const int tid = fresh_tid(); const int G = gridDim.x, bx = blockIdx.x;
    for (int it = bx; it < 384; it += G) p0_mod_item(a, it, lds);
    for (int it = bx; it < 132; it += G) p0_filter_item(a, it, lds);
    for (int it = bx; it < 2 * 9984; it += G) {
        const int l = it / 9984; int j = it - l * 9984;
        if (j < 6912) p0_tr_tile(a.in[7] + (size_t)l * 4096 * INC, INC, (bf16_t*)(a.ws + WS_WIN) + (size_t)l * INC * 4096, (j / 108) * 64, (j % 108) * 128, lds);
        else if (j < 8960) { j -= 6912; p0_tr_tile(a.in[23] + (size_t)l * 4096 * 4096, 4096, (bf16_t*)(a.ws + WS_WOUT) + (size_t)l * 4096 * 4096, (j / 32) * 64, (j % 32) * 128, lds); }
        else { j -= 8960; p0_tr_tile(a.in[25] + (size_t)l * 4096 * PQ, PQ, (bf16_t*)(a.ws + WS_WQ) + (size_t)l * PQ * 4096, (j / 16) * 64, (j % 16) * 128, lds); }
    }
    {
        const v4f* su = (const v4f*)a.in[27]; const v4f* sv = (const v4f*)a.in[28];
        v2u* du = (v2u*)(a.ws + WS_UB); v2u* dv = (v2u*)(a.ws + WS_VB);
        const size_t n4 = (size_t)2 * 16384 * 4096 / 4;
        for (size_t i = (size_t)bx * NTHREADS + tid; i < n4; i += (size_t)G * NTHREADS) {
            v4f x = su[i]; du[i] = make_v2u(pack2bf(x.x, x.y), pack2bf(x.z, x.w));
            x = sv[i]; dv[i] = make_v2u(pack2bf(x.x, x.y), pack2bf(x.z, x.w));
        }
    }
}

__device__ __forceinline__ void norm_phase(ARGS_REF a, int l, int which, int nrows) {
    const int tid = fresh_tid(), lane = tid & 63, wave = tid >> 6;
    const float* MOD = (const float*)(a.ws + WS_MOD);
    bf16_t* H = (bf16_t*)(a.ws + WS_H);
    const float* g = (which ? a.in[24] : a.in[6]) + l * 4096;
    const bool first = (l == 0 && which == 0);
    for (int row = blockIdx.x * 8 + wave; row < nrows; row += gridDim.x * 8) {
        const float* src; int r;
        if (row < TL) { src = (first ? a.in[0] : (const float*)a.out) + (size_t)row * 4096; r = row >> 12; }
        else { src = (first ? a.in[2] : (const float*)(a.ws + WS_XC)) + (size_t)(row - TL) * 4096; r = 4; }
        const float* shift = MOD + (size_t)(l * 5 + r) * NMOD + (which ? 3 : 0) * 4096; const float* scale = shift + 4096;
        v4f v[16]; float ss = 0.f;
#pragma unroll
        for (int i = 0; i < 16; ++i) { v[i] = ((const v4f*)src)[i * 64 + lane]; ss += v[i].x * v[i].x + v[i].y * v[i].y + v[i].z * v[i].z + v[i].w * v[i].w; }
        ss = wave_sum(ss);
        const float rs = rsqrtf(ss * (1.0f / 4096.0f) + EPS);
#pragma unroll
        for (int i = 0; i < 16; ++i) {
            const int j = (i * 64 + lane) * 4;
            const v4f gg = *(const v4f*)(g + j), sh = *(const v4f*)(shift + j), scl = *(const v4f*)(scale + j);
            const float o0 = v[i].x * rs * gg.x * (1.0f + scl.x) + sh.x, o1 = v[i].y * rs * gg.y * (1.0f + scl.y) + sh.y;
            const float o2 = v[i].z * rs * gg.z * (1.0f + scl.z) + sh.z, o3 = v[i].w * rs * gg.w * (1.0f + scl.w) + sh.w;
            *(v2u*)(H + (size_t)row * 4096 + j) = make_v2u(pack2bf(o0, o1), pack2bf(o2, o3));
        }
    }
}

struct EpiRes {
    static constexpr bool PERM = false, AFTER_DRAIN = false;
    const float* baseL; const float* baseC; float* outL; float* outC; const float* gate;
    __device__ __forceinline__ void operator()(const pg8::f32x4 (&acc)[2][2][4][2], const pg8::Unit& u, int wr, int wc, int fr, int fq) const {
        const int row0 = u.pm * 256 + wr * 64 + fr, col0 = u.pn * 256 + wc * 32 + 4 * fq;
#pragma unroll
        for (int ai = 0; ai < 2; ++ai)
#pragma unroll
            for (int m = 0; m < 4; ++m) {
                const int row = row0 + ai * 128 + m * 16;
                const float* bp; float* op; int r;
                if (row < TL) { bp = baseL + (size_t)row * 4096; op = outL + (size_t)row * 4096; r = row >> 12; }
                else { bp = baseC + (size_t)(row - TL) * 4096; op = outC + (size_t)(row - TL) * 4096; r = 4; }
                const float* gp = gate + (size_t)r * NMOD;
#pragma unroll
                for (int bj = 0; bj < 2; ++bj)
#pragma unroll
                    for (int n = 0; n < 2; ++n) {
                        const int col = col0 + bj * 128 + n * 16;
                        const pg8::f32x4 gv = *(const pg8::f32x4*)(gp + col), bv = *(const pg8::f32x4*)(bp + col);
                        *(pg8::f32x4*)(op + col) = bv + gv * acc[ai][bj][m][n];
                    }
            }
    }
};

template <int NTN, int PER, int K, int LDA, int LDB>
__device__ __forceinline__ void mma_lds(const LAS bf16_t* A, const LAS bf16_t* Bt, f32x4_t (&acc)[PER], int wave, int fr, int fq) {
#pragma unroll
    for (int i = 0; i < PER; ++i) {
        const int tt = wave + 8 * i, tm = tt / NTN, tn = tt % NTN;
        const LAS bf16_t* ap = A + (tm * 16 + fr) * LDA + fq * 8; const LAS bf16_t* bp = Bt + (tn * 16 + fr) * LDB + fq * 8;
#pragma unroll
        for (int k0 = 0; k0 < K; k0 += 32) {
            const bf16x8_t av = *(const LAS bf16x8_t*)(ap + k0); const bf16x8_t bv = *(const LAS bf16x8_t*)(bp + k0);
            acc[i] = __builtin_amdgcn_mfma_f32_16x16x32_bf16(av, bv, acc[i], 0, 0, 0);
        }
        __builtin_amdgcn_sched_barrier(0);
    }
}

__device__ __forceinline__ void ret_load_kv(const bf16_t* P, int r0, int pos0, int h, bool do_rope, int dir, float lg,
                                            LAS bf16_t* Ks, LAS bf16_t* Ktd, LAS bf16_t* Vt, const LAS v2f* rope, bool write_ks) {
    const int tid = fresh_tid();
#pragma unroll
    for (int it = 0; it < 2; ++it) {
        const int task = tid + 512 * it; const int t = task >> 4, half = (task >> 3) & 1, i0 = (task & 7) * 4;
        const bf16_t* src = P + (size_t)(r0 + t) * INC + C_RK + h * 128 + half * 64 + i0;
        const v2u wa = *(const v2u*)src; const v2u wb = *(const v2u*)(src + 32);
        const float av[4] = {bflo(wa.x) * RET_SCALE, bfhi(wa.x) * RET_SCALE, bflo(wa.y) * RET_SCALE, bfhi(wa.y) * RET_SCALE};
        const float bv[4] = {bflo(wb.x) * RET_SCALE, bfhi(wb.x) * RET_SCALE, bflo(wb.y) * RET_SCALE, bfhi(wb.y) * RET_SCALE};
        float oa[4], ob[4];
        if (do_rope) {
            const int pos = half ? ((pos0 + t) & 63) : ((pos0 + t) >> 6);
#pragma unroll
            for (int q = 0; q < 4; ++q) { const v2f cs = rope[pos * 32 + i0 + q]; oa[q] = av[q] * cs.x - bv[q] * cs.y; ob[q] = av[q] * cs.y + bv[q] * cs.x; }
        } else {
#pragma unroll
            for (int q = 0; q < 4; ++q) { oa[q] = av[q]; ob[q] = bv[q]; }
        }
        if (write_ks) {
            *(LAS v2u*)(Ks + t * 136 + half * 64 + i0) = make_v2u(pack2bf(oa[0], oa[1]), pack2bf(oa[2], oa[3]));
            *(LAS v2u*)(Ks + t * 136 + half * 64 + 32 + i0) = make_v2u(pack2bf(ob[0], ob[1]), pack2bf(ob[2], ob[3]));
        }
        const float kd = __expf(lg * (float)(dir ? t : 63 - t));
#pragma unroll
        for (int q = 0; q < 4; ++q) { Ktd[(half * 64 + i0 + q) * 72 + t] = f2bf(oa[q] * kd); Ktd[(half * 64 + 32 + i0 + q) * 72 + t] = f2bf(ob[q] * kd); }
    }
    {
        const int s = tid >> 3, e0 = (tid & 7) * 16;
        const bf16_t* src = P + (size_t)(r0 + s) * INC + C_RV + h * 128 + e0;
        const v4u w0 = *(const v4u*)src, w1 = *(const v4u*)(src + 8);
        const unsigned ww[8] = {w0.x, w0.y, w0.z, w0.w, w1.x, w1.y, w1.z, w1.w};
#pragma unroll
        for (int q = 0; q < 8; ++q) { Vt[(e0 + 2 * q) * 72 + s] = (bf16_t)(ww[q] & 0xffffu); Vt[(e0 + 2 * q + 1) * 72 + s] = (bf16_t)(ww[q] >> 16); }
    }
}

__device__ __forceinline__ void ret_item(ARGS_REF a, int l, int b, int h, bool cstream, LAS unsigned char* lds) {
    const int tid = fresh_tid(), lane = tid & 63, wave = tid >> 6, fr = lane & 15, fq = lane >> 4;
    LAS bf16_t* Qs  = (LAS bf16_t*)(lds);
    LAS bf16_t* Ks  = (LAS bf16_t*)(lds + 17408);
    LAS float*  Of  = (LAS float*)(lds);
    LAS bf16_t* Ktd = (LAS bf16_t*)(lds + 34816);
    LAS bf16_t* Vt  = (LAS bf16_t*)(lds + 53248);
    LAS bf16_t* St  = (LAS bf16_t*)(lds + 71680);
    LAS float*  Af  = (LAS float*)(lds + 106496);
    LAS bf16_t* Pb  = (LAS bf16_t*)(lds + 123904);
    LAS v2f* rope = (LAS v2f*)(lds + 133120);
    const bf16_t* P = (const bf16_t*)(a.ws + WS_PROJ);
    float* OF = (float*)(a.ws + WS_OF);
    bf16_t* MIX = (bf16_t*)(a.ws + WS_MIX);
    const int L = cstream ? 256 : 4096, row0 = cstream ? TL + b * 256 : b * 4096, NCH = L / 64, crow0 = TL + b * 256;
    __syncthreads();
    for (int i = tid; i < 2048; i += NTHREADS) {
        const int pos = i >> 5, fi = i & 31; const float inv = exp2f(-(float)fi * (13.287712379549449f / 32.0f));
        const float turns = ((float)pos * inv) * 0.15915494309189535f;
        rope[i] = make_v2f(cos_turns(turns), sin_turns(turns));
    }
    f32x4_t Sacc[8];
#pragma unroll 1
    for (int dir = 0; dir < 2; ++dir) {
        const float lg = -__expf(a.in[19][(l * 2 + dir) * 12 + h]);
        const float cdec = __expf(lg * 64.0f);
#pragma unroll
        for (int i = 0; i < 8; ++i) Sacc[i] = (f32x4_t){0.f, 0.f, 0.f, 0.f};
        if (!cstream) {
#pragma unroll 1
            for (int cc = 0; cc < 4; ++cc) {
                const int ch = dir ? 3 - cc : cc;
                __syncthreads();
                ret_load_kv(P, crow0 + ch * 64, 0, h, false, dir, lg, Ks, Ktd, Vt, rope, false);
                __syncthreads();
#pragma unroll
                for (int i = 0; i < 8; ++i) Sacc[i] *= cdec;
                mma_lds<8, 8, 64, 72, 72>(Ktd, Vt, Sacc, wave, fr, fq);
            }
        }
        __syncthreads();
#pragma unroll
        for (int i = 0; i < 8; ++i)
            *(LAS v2u*)(St + (wave * 16 + fr) * 136 + i * 16 + fq * 4) = make_v2u(pack2bf(Sacc[i][0], Sacc[i][1]), pack2bf(Sacc[i][2], Sacc[i][3]));
#pragma unroll 1
        for (int cc = 0; cc < NCH; ++cc) {
            const int ch = dir ? NCH - 1 - cc : cc; const int r0 = row0 + ch * 64, pos0 = ch * 64;
            __syncthreads();
#pragma unroll
            for (int it = 0; it < 2; ++it) {
                const int task = tid + 512 * it; const int t = task >> 4, half = (task >> 3) & 1, i0 = (task & 7) * 4;
                const bf16_t* src = P + (size_t)(r0 + t) * INC + C_RQ + h * 128 + half * 64 + i0;
                const v2u wa = *(const v2u*)src; const v2u wb = *(const v2u*)(src + 32);
                const float av[4] = {bflo(wa.x), bfhi(wa.x), bflo(wa.y), bfhi(wa.y)}; const float bv[4] = {bflo(wb.x), bfhi(wb.x), bflo(wb.y), bfhi(wb.y)};
                float oa[4], ob[4];
                if (!cstream) {
                    const int pos = half ? ((pos0 + t) & 63) : ((pos0 + t) >> 6);
#pragma unroll
                    for (int q = 0; q < 4; ++q) { const v2f cs = rope[pos * 32 + i0 + q]; oa[q] = av[q] * cs.x - bv[q] * cs.y; ob[q] = av[q] * cs.y + bv[q] * cs.x; }
                } else {
#pragma unroll
                    for (int q = 0; q < 4; ++q) { oa[q] = av[q]; ob[q] = bv[q]; }
                }
                *(LAS v2u*)(Qs + t * 136 + half * 64 + i0) = make_v2u(pack2bf(oa[0], oa[1]), pack2bf(oa[2], oa[3]));
                *(LAS v2u*)(Qs + t * 136 + half * 64 + 32 + i0) = make_v2u(pack2bf(ob[0], ob[1]), pack2bf(ob[2], ob[3]));
            }
            ret_load_kv(P, r0, pos0, h, !cstream, dir, lg, Ks, Ktd, Vt, rope, true);
            __syncthreads();
            {
                f32x4_t sa[2] = {(f32x4_t){0.f, 0.f, 0.f, 0.f}, (f32x4_t){0.f, 0.f, 0.f, 0.f}};
                mma_lds<4, 2, 128, 136, 136>(Qs, Ks, sa, wave, fr, fq);
#pragma unroll
                for (int i = 0; i < 2; ++i) { const int tt = wave + 8 * i, tm = tt >> 2, tn = tt & 3;
#pragma unroll
                    for (int r = 0; r < 4; ++r) Af[(tm * 16 + fq * 4 + r) * 68 + tn * 16 + fr] = sa[i][r]; }
            }
            __syncthreads();
            for (int i = tid; i < 4096; i += NTHREADS) {
                const int ii = i >> 6, jj = i & 63; const int dd = dir ? jj - ii : ii - jj;
                const float val = dd >= 0 ? Af[ii * 68 + jj] * __expf(lg * (float)dd) : 0.f;
                Pb[ii * 72 + jj] = f2bf(val);
            }
            __syncthreads();
            f32x4_t o1[4];
#pragma unroll
            for (int i = 0; i < 4; ++i) o1[i] = (f32x4_t){0.f, 0.f, 0.f, 0.f};
            mma_lds<8, 4, 128, 136, 136>(Qs, St, o1, wave, fr, fq);
#pragma unroll
            for (int i = 0; i < 4; ++i) {
                const int tt = wave + 8 * i, tm = tt >> 3;
#pragma unroll
                for (int r = 0; r < 4; ++r) { const int il = tm * 16 + fq * 4 + r; o1[i][r] *= __expf(lg * (float)(dir ? 64 - il : il + 1)); }
            }
            mma_lds<8, 4, 64, 72, 72>(Pb, Vt, o1, wave, fr, fq);
#pragma unroll
            for (int i = 0; i < 8; ++i) Sacc[i] *= cdec;
            mma_lds<8, 8, 64, 72, 72>(Ktd, Vt, Sacc, wave, fr, fq);
            __syncthreads();
#pragma unroll
            for (int i = 0; i < 8; ++i)
                *(LAS v2u*)(St + (wave * 16 + fr) * 136 + i * 16 + fq * 4) = make_v2u(pack2bf(Sacc[i][0], Sacc[i][1]), pack2bf(Sacc[i][2], Sacc[i][3]));
#pragma unroll
            for (int i = 0; i < 4; ++i) {
                const int tt = wave + 8 * i, tm = tt >> 3, tn = tt & 7;
#pragma unroll
                for (int r = 0; r < 4; ++r) {
                    const int il = tm * 16 + fq * 4 + r, e = tn * 16 + fr;
                    const float val = o1[i][r];
                    const size_t oidx = (size_t)(r0 + il) * 1536 + h * 128 + e;
                    if (dir == 0) OF[oidx] = val; else Of[il * 132 + e] = val + OF[oidx];
                }
            }
            if (dir == 1) {
                __syncthreads();
#pragma unroll 1
                for (int rr = 0; rr < 8; ++rr) {
                    const int il = wave * 8 + rr; const float x0 = Of[il * 132 + lane], x1 = Of[il * 132 + lane + 64];
                    const float ss = wave_sum(x0 * x0 + x1 * x1); const float rs = rsqrtf(ss * (1.0f / 128.0f) + EPS);
                    const bf16_t* gp = P + (size_t)(r0 + il) * INC + C_RG + h * 128;
                    const float g0 = bf2f(gp[lane]), g1 = bf2f(gp[lane + 64]);
                    bf16_t* mp = MIX + (size_t)(r0 + il) * 4096 + M_RO + h * 128;
                    mp[lane] = f2bf(x0 * rs * silu_f(g0)); mp[lane + 64] = f2bf(x1 * rs * silu_f(g1));
                }
            }
        }
        __threadfence();
    }
    __syncthreads();
}

__device__ __forceinline__ void hy_conv8(const LAS float* U, const LAS float* G, int L, float (&y)[8]) {
    const int tb = 8 * fresh_tid();
#pragma unroll
    for (int j = 0; j < 8; ++j) y[j] = 0.f;
    if (tb < L) {
#pragma unroll 2
        for (int s0 = 0; s0 < L; s0 += 4) {
            const int base = tb - s0 + L;
            const v4f g0 = *(const LAS v4f*)(G + base - 4), g1 = *(const LAS v4f*)(G + base), g2 = *(const LAS v4f*)(G + base + 4);
            const v4f u = *(const LAS v4f*)(U + s0);
            const float g[12] = {g0.x, g0.y, g0.z, g0.w, g1.x, g1.y, g1.z, g1.w, g2.x, g2.y, g2.z, g2.w};
            const float uu[4] = {u.x, u.y, u.z, u.w};
#pragma unroll
            for (int j = 0; j < 8; ++j)
#pragma unroll
                for (int i = 0; i < 4; ++i) y[j] += g[4 + j - i] * uu[i];
        }
    }
}
__device__ __forceinline__ void hyena_item(ARGS_REF a, int l, int c, int b, bool cstream, LAS unsigned char* lds) {
    const int tid = fresh_tid();
    const int L = cstream ? 256 : 4096, row0 = cstream ? TL + b * 256 : b * 4096;
    LAS float* sv = (LAS float*)lds; LAS float* sx1 = sv + L; LAS float* sx2 = sx1 + L; LAS float* sz = sx2 + L; LAS float* G0 = sz + L; LAS float* G1 = G0 + 2 * L;
    const bf16_t* P = (const bf16_t*)(a.ws + WS_PROJ);
    bf16_t* MIX = (bf16_t*)(a.ws + WS_MIX);
    const float* cw = a.in[8] + l * 3 * 3072; const float* cb = a.in[9] + l * 3072;
    const float* K = cstream ? (const float*)(a.ws + WS_KTC) : (const float*)(a.ws + WS_KT) + (size_t)l * 4096 * 4096;
    __syncthreads();
    for (int t = tid; t < L; t += NTHREADS) {
#pragma unroll
        for (int which = 0; which < 3; ++which) {
            const int chn = which * 1024 + c; float acc = cb[chn];
#pragma unroll
            for (int i = 0; i < 3; ++i) { const int tt = t + i - 1; if (tt >= 0 && tt < L) acc += cw[i * 3072 + chn] * bf2f(P[(size_t)(row0 + tt) * INC + C_HY + chn]); }
            (which == 0 ? sv : (which == 1 ? sx1 : sx2))[t] = acc;
        }
    }
    for (int i = tid; i < 2 * L; i += NTHREADS) {
        const int d = i - L;
        const size_t cf0 = (size_t)(0 * 1024 + c) * L, cb0 = (size_t)(1 * 1024 + c) * L, cf1 = (size_t)(2 * 1024 + c) * L, cb1 = (size_t)(3 * 1024 + c) * L;
        float v0 = 0.f, v1 = 0.f;
        if (d >= 0) { v0 = K[cf0 + d]; v1 = K[cf1 + d]; } else if (d > -L) { v0 = K[cb0 - d]; v1 = K[cb1 - d]; }
        G0[i] = v0; G1[i] = v1;
    }
    __syncthreads();
    const float skip0 = a.in[18][(l * 2 + 0) * 1024 + c], skip1 = a.in[18][(l * 2 + 1) * 1024 + c];
    float y[8];
    hy_conv8(sv, G0, L, y);
    if (8 * tid < L) {
#pragma unroll
        for (int j = 0; j < 8; ++j) { const int t = 8 * tid + j; sz[t] = sx1[t] * (y[j] + skip0 * sv[t]); }
    }
    __syncthreads();
    hy_conv8(sz, G1, L, y);
    if (8 * tid < L) {
#pragma unroll
        for (int j = 0; j < 8; ++j) { const int t = 8 * tid + j; MIX[(size_t)(row0 + t) * 4096 + M_HY + c] = f2bf(sx2[t] * (y[j] + skip1 * sz[t])); }
    }
    __syncthreads();
}

__device__ __forceinline__ float na_dot128(const LAS float* q, const LAS bf16_t* k) {
    float s = 0.f;
#pragma unroll
    for (int d8 = 0; d8 < 16; ++d8) {
        const v4u w = *(const LAS v4u*)(k + d8 * 8); const v4f q0 = *(const LAS v4f*)(q + d8 * 8), q1 = *(const LAS v4f*)(q + d8 * 8 + 4);
        s += q0.x * bflo(w.x) + q0.y * bfhi(w.x) + q0.z * bflo(w.y) + q0.w * bfhi(w.y) + q1.x * bflo(w.z) + q1.y * bfhi(w.z) + q1.z * bflo(w.w) + q1.w * bfhi(w.w);
    }
    return s;
}
__device__ __forceinline__ void na_item(ARGS_REF a, int l, int b, int h, int r, bool cstream, LAS unsigned char* lds) {
    const int tid = fresh_tid(), lane = tid & 63, wave = tid >> 6;
    LAS float* Qs = (LAS float*)lds;
    LAS float* Sc = Qs + 64 * 132;
    LAS bf16_t* Kb = (LAS bf16_t*)(Sc + 64 * 388);
    LAS float* rk = (LAS float*)(Kb + 64 * 136);
    const bf16_t* P = (const bf16_t*)(a.ws + WS_PROJ);
    bf16_t* MIX = (bf16_t*)(a.ws + WS_MIX);
    const int qrow0 = cstream ? TL + b * 256 + r * 64 : b * 4096 + r * 64;
    const float* gq = a.in[21] + l * 128; const float* gk = a.in[22] + l * 128;
    const float* rpb = a.in[20] + (size_t)(l * 12 + h) * 15 * 31;
    const int nloc = cstream ? 0 : 8, start = clampi(r - 4, 0, 56), ntiles = nloc + 4, nk = nloc * 16 + 256;
    __syncthreads();
#pragma unroll 1
    for (int qq = 0; qq < 8; ++qq) {
        const int q = wave * 8 + qq; const bf16_t* p = P + (size_t)(qrow0 + q) * INC + C_NQ + h * 128;
        const float x0 = bf2f(p[lane]), x1 = bf2f(p[lane + 64]);
        const float ss = wave_sum(x0 * x0 + x1 * x1); const float rs = rsqrtf(ss * (1.0f / 128.0f) + EPS);
        Qs[q * 132 + lane] = x0 * rs * gq[lane] * gk[lane] * RET_SCALE; Qs[q * 132 + lane + 64] = x1 * rs * gq[lane + 64] * gk[lane + 64] * RET_SCALE;
    }
#pragma unroll 1
    for (int kt = 0; kt < ntiles; ++kt) {
        const bool local = kt < nloc; const int krow0 = local ? b * 4096 + (start + kt) * 64 : TL + b * 256 + (kt - nloc) * 64;
        __syncthreads();
#pragma unroll
        for (int i = 0; i < 2; ++i) { const int idx = tid + 512 * i; const int kr = idx >> 4, c8 = idx & 15;
            *(LAS v4u*)(Kb + kr * 136 + c8 * 8) = *(const v4u*)(P + (size_t)(krow0 + kr) * INC + C_NK + h * 128 + c8 * 8); }
        __syncthreads();
#pragma unroll 1
        for (int kk = 0; kk < 8; ++kk) { const int key = wave * 8 + kk; const float x0 = bf2f(Kb[key * 136 + lane]), x1 = bf2f(Kb[key * 136 + lane + 64]);
            const float ss = wave_sum(x0 * x0 + x1 * x1); if (lane == 0) rk[key] = rsqrtf(ss * (1.0f / 128.0f) + EPS); }
        __syncthreads();
        if (local) {
#pragma unroll 1
            for (int i = 0; i < 2; ++i) {
                const int p = tid + 512 * i; const int q = p >> 4, j = p & 15; const int cs = clampi(q - 8, 0, 48), kc = cs + j;
                const float dot = na_dot128(Qs + q * 132, Kb + kc * 136);
                const int ridx = start + kt - r + 7, cidx = clampi(kc - q + 15, 0, 30);
                Sc[q * 388 + kt * 16 + j] = dot * rk[kc] + rpb[ridx * 31 + cidx];
            }
        } else {
#pragma unroll 1
            for (int i = 0; i < 8; ++i) {
                const int p = tid + 512 * i; const int q = p >> 6, kc = p & 63;
                const float dot = na_dot128(Qs + q * 132, Kb + kc * 136);
                Sc[q * 388 + nloc * 16 + (kt - nloc) * 64 + kc] = dot * rk[kc];
            }
        }
    }
    __syncthreads();
#pragma unroll 1
    for (int qq = 0; qq < 8; ++qq) {
        const int q = wave * 8 + qq; float m = -3.0e38f;
        for (int k = lane; k < nk; k += 64) m = fmaxf(m, Sc[q * 388 + k]);
        m = wave_max(m); float s = 0.f;
        for (int k = lane; k < nk; k += 64) { const float e = __expf(Sc[q * 388 + k] - m); Sc[q * 388 + k] = e; s += e; }
        s = wave_sum(s); const float inv = 1.0f / s;
        for (int k = lane; k < nk; k += 64) Sc[q * 388 + k] *= inv;
    }
    const int q = tid >> 3, e0 = (tid & 7) * 16;
    float acc[16];
#pragma unroll
    for (int e = 0; e < 16; ++e) acc[e] = 0.f;
#pragma unroll 1
    for (int kt = 0; kt < ntiles; ++kt) {
        const bool local = kt < nloc; const int krow0 = local ? b * 4096 + (start + kt) * 64 : TL + b * 256 + (kt - nloc) * 64;
        __syncthreads();
#pragma unroll
        for (int i = 0; i < 2; ++i) { const int idx = tid + 512 * i; const int kr = idx >> 4, c8 = idx & 15;
            *(LAS v4u*)(Kb + kr * 136 + c8 * 8) = *(const v4u*)(P + (size_t)(krow0 + kr) * INC + C_NV + h * 128 + c8 * 8); }
        __syncthreads();
        const int cnt = local ? 16 : 64; const int kc0 = local ? clampi(q - 8, 0, 48) : 0; const int sbase = local ? kt * 16 : nloc * 16 + (kt - nloc) * 64;
#pragma unroll 1
        for (int j = 0; j < cnt; ++j) {
            const float p = Sc[q * 388 + sbase + j]; const LAS bf16_t* vp = Kb + (kc0 + j) * 136 + e0;
            const v4u w0 = *(const LAS v4u*)vp, w1 = *(const LAS v4u*)(vp + 8);
            acc[0] += p * bflo(w0.x); acc[1] += p * bfhi(w0.x); acc[2] += p * bflo(w0.y); acc[3] += p * bfhi(w0.y);
            acc[4] += p * bflo(w0.z); acc[5] += p * bfhi(w0.z); acc[6] += p * bflo(w0.w); acc[7] += p * bfhi(w0.w);
            acc[8] += p * bflo(w1.x); acc[9] += p * bfhi(w1.x); acc[10] += p * bflo(w1.y); acc[11] += p * bfhi(w1.y);
            acc[12] += p * bflo(w1.z); acc[13] += p * bfhi(w1.z); acc[14] += p * bflo(w1.w); acc[15] += p * bfhi(w1.w);
        }
    }
    {
        bf16_t* mp = MIX + (size_t)(qrow0 + q) * 4096 + M_NO + h * 128 + e0;
        *(v4u*)mp = make_v4u(pack2bf(acc[0], acc[1]), pack2bf(acc[2], acc[3]), pack2bf(acc[4], acc[5]), pack2bf(acc[6], acc[7]));
        *(v4u*)(mp + 8) = make_v4u(pack2bf(acc[8], acc[9]), pack2bf(acc[10], acc[11]), pack2bf(acc[12], acc[13]), pack2bf(acc[14], acc[15]));
    }
    __syncthreads();
}

__device__ __forceinline__ void mixer_phase(ARGS_REF a, int l, LAS unsigned char* lds, unsigned* qctr) {
    volatile LAS int* slot = (volatile LAS int*)(lds + MISC_OFF + 64);
    const int n_ret = (l == 0) ? 96 : 48, n_hy = (l == 0) ? 8192 : 4096, n_na = (l == 0) ? 3072 + 192 : 3072;
    const int total = n_ret + n_hy + n_na;
    for (;;) {
        __syncthreads();
        if (fresh_tid() == 0) *slot = (int)atomicAdd(qctr, 1u);
        __syncthreads();
        int it = *slot;
        if (it >= total) break;
#ifndef NO_RET
        if (it < n_ret) { const bool cs = it >= 48; const int j = cs ? it - 48 : it; ret_item(a, l, j / 12, j % 12, cs, lds); continue; }
#endif
        it -= n_ret;
#ifndef NO_HY
        if (it < n_hy) { const bool cs = it >= 4096; const int j = cs ? it - 4096 : it; hyena_item(a, l, j >> 2, j & 3, cs, lds); continue; }
#endif
        it -= n_hy;
#ifndef NO_NA
        if (it < 3072) { na_item(a, l, it / 768, (it / 64) % 12, it & 63, false, lds); continue; }
        it -= 3072;
        na_item(a, l, it / 48, (it / 4) % 12, it & 3, true, lds);
#endif
    }
}

__device__ __forceinline__ void peer_select_item(ARGS_REF a, int l, int tile, int h, LAS unsigned char* lds) {
    const int tid = fresh_tid(), lane = tid & 63, wave = tid >> 6;
    LAS float* Ksm = (LAS float*)lds;
    LAS float* Qt = Ksm + 128 * 129;
    LAS float* Ss = Qt + 32 * 257;
    LAS float* tops = Ss + 64 * 129;
    LAS int* topi = (LAS int*)(tops + 64 * 16);
    const float* Qb = (const float*)(a.ws + WS_Q);
    int* IDX = (int*)(a.ws + WS_IDX); float* GATE = (float*)(a.ws + WS_GATE);
    const int row0 = tile * 32;
    __syncthreads();
    for (int i = tid; i < 32 * 256; i += NTHREADS) { const int t = i >> 8, j = i & 255; Qt[t * 257 + j] = Qb[(size_t)(row0 + t) * PQ + h * 256 + j]; }
#pragma unroll 1
    for (int p = 0; p < 2; ++p) {
        __syncthreads();
        const float* kp = a.in[26] + (size_t)(((l * 8 + h) * 2 + p) * 128) * 128;
        for (int i = tid; i < 128 * 128; i += NTHREADS) { const int n = i >> 7, k = i & 127; Ksm[n * 129 + k] = kp[i]; }
        __syncthreads();
        const int t = tid >> 4;
#pragma unroll 1
        for (int i = 0; i < 8; ++i) {
            const int n = (tid & 15) + 16 * i; float s = 0.f;
#pragma unroll 8
            for (int k = 0; k < 128; ++k) s += Qt[t * 257 + p * 128 + k] * Ksm[n * 129 + k];
            Ss[(t * 2 + p) * 129 + n] = s;
        }
    }
    __syncthreads();
#pragma unroll 1
    for (int rr = 0; rr < 8; ++rr) {
        const int row = wave * 8 + rr; float v0 = Ss[row * 129 + lane], v1 = Ss[row * 129 + lane + 64];
#pragma unroll 1
        for (int k = 0; k < 16; ++k) {
            float bv = v0; int bi = lane; if (v1 > bv) { bv = v1; bi = lane + 64; }
#pragma unroll
            for (int o = 32; o >= 1; o >>= 1) { const float ov = __shfl_xor(bv, o); const int oi = __shfl_xor(bi, o); if (ov > bv || (ov == bv && oi < bi)) { bv = ov; bi = oi; } }
            if (lane == 0) { tops[row * 16 + k] = bv; topi[row * 16 + k] = bi; }
            if (bi == lane) v0 = -3.0e38f;
            if (bi == lane + 64) v1 = -3.0e38f;
        }
    }
    __syncthreads();
#pragma unroll 1
    for (int tt = 0; tt < 4; ++tt) {
        const int t = wave * 4 + tt; const int r0 = (t * 2) * 16, r1 = (t * 2 + 1) * 16;
        float cv[4];
#pragma unroll
        for (int j = 0; j < 4; ++j) { const int ci = lane * 4 + j; cv[j] = tops[r0 + (ci >> 4)] + tops[r1 + (ci & 15)]; }
        float myv = -3.0e38f; int myi = 0; float vmax = 0.f;
#pragma unroll 1
        for (int k = 0; k < 16; ++k) {
            float bv = cv[0]; int bi = lane * 4;
#pragma unroll
            for (int j = 1; j < 4; ++j) if (cv[j] > bv) { bv = cv[j]; bi = lane * 4 + j; }
#pragma unroll
            for (int o = 32; o >= 1; o >>= 1) { const float ov = __shfl_xor(bv, o); const int oi = __shfl_xor(bi, o); if (ov > bv || (ov == bv && oi < bi)) { bv = ov; bi = oi; } }
            if (k == 0) vmax = bv;
            if (lane == k) { myv = bv; myi = bi; }
#pragma unroll
            for (int j = 0; j < 4; ++j) if (bi == lane * 4 + j) cv[j] = -3.0e38f;
        }
        const float e = lane < 16 ? __expf(myv - vmax) : 0.f;
        const float s = wave_sum(e);
        if (lane < 16) {
            const int eid = topi[r0 + (myi >> 4)] * 128 + topi[r1 + (myi & 15)];
            const size_t o = ((size_t)(row0 + t) * 8 + h) * 16 + lane;
            IDX[o] = eid; GATE[o] = e / s;
        }
    }
    __syncthreads();
}

__device__ __forceinline__ void peer_apply_token(ARGS_REF a, int l, int row, LAS unsigned char* lds) {
    const int tid = fresh_tid(), lane = tid & 63, wave = tid >> 6;
    LAS float* red = (LAS float*)lds;
    const bf16_t* H = (const bf16_t*)(a.ws + WS_H);
    const bf16_t* Ub = (const bf16_t*)(a.ws + WS_UB) + (size_t)l * 16384 * 4096;
    const bf16_t* Vb = (const bf16_t*)(a.ws + WS_VB) + (size_t)l * 16384 * 4096;
    const int* IDX = (const int*)(a.ws + WS_IDX); const float* GATE = (const float*)(a.ws + WS_GATE);
    float hf[64], out[64];
    {
        const bf16_t* hp = H + (size_t)row * 4096;
#pragma unroll
        for (int j = 0; j < 8; ++j) {
            const v4u w = *(const v4u*)(hp + (j * 64 + lane) * 8);
            hf[j * 8 + 0] = bflo(w.x); hf[j * 8 + 1] = bfhi(w.x); hf[j * 8 + 2] = bflo(w.y); hf[j * 8 + 3] = bfhi(w.y);
            hf[j * 8 + 4] = bflo(w.z); hf[j * 8 + 5] = bfhi(w.z); hf[j * 8 + 6] = bflo(w.w); hf[j * 8 + 7] = bfhi(w.w);
        }
    }
#pragma unroll
    for (int j = 0; j < 64; ++j) out[j] = 0.f;
#pragma unroll 1
    for (int i = 0; i < 16; ++i) {
        const int k = wave * 16 + i;
        const int e = __builtin_amdgcn_readfirstlane(IDX[(size_t)row * 128 + k]);
        const float g = __uint_as_float(__builtin_amdgcn_readfirstlane(__float_as_uint(GATE[(size_t)row * 128 + k])));
        const bf16_t* up = Ub + (size_t)e * 4096; const bf16_t* vp = Vb + (size_t)e * 4096;
        float s = 0.f;
#pragma unroll
        for (int j = 0; j < 8; ++j) {
            const v4u w = *(const v4u*)(up + (j * 64 + lane) * 8);
            s += hf[j * 8 + 0] * bflo(w.x) + hf[j * 8 + 1] * bfhi(w.x) + hf[j * 8 + 2] * bflo(w.y) + hf[j * 8 + 3] * bfhi(w.y)
               + hf[j * 8 + 4] * bflo(w.z) + hf[j * 8 + 5] * bfhi(w.z) + hf[j * 8 + 6] * bflo(w.w) + hf[j * 8 + 7] * bfhi(w.w);
        }
        s = wave_sum(s);
        const float act = gelu_tanh_f(s) * g;
#pragma unroll
        for (int j = 0; j < 8; ++j) {
            const v4u w = *(const v4u*)(vp + (j * 64 + lane) * 8);
            out[j * 8 + 0] += act * bflo(w.x); out[j * 8 + 1] += act * bfhi(w.x); out[j * 8 + 2] += act * bflo(w.y); out[j * 8 + 3] += act * bfhi(w.y);
            out[j * 8 + 4] += act * bflo(w.z); out[j * 8 + 5] += act * bfhi(w.z); out[j * 8 + 6] += act * bflo(w.w); out[j * 8 + 7] += act * bfhi(w.w);
        }
    }
    __syncthreads();
#pragma unroll
    for (int j = 0; j < 8; ++j) {
        LAS float* rp = red + wave * 4096 + (j * 64 + lane) * 8;
        *(LAS v4f*)rp = make_v4f(out[j * 8 + 0], out[j * 8 + 1], out[j * 8 + 2], out[j * 8 + 3]);
        *(LAS v4f*)(rp + 4) = make_v4f(out[j * 8 + 4], out[j * 8 + 5], out[j * 8 + 6], out[j * 8 + 7]);
    }
    __syncthreads();
    {
        v4f s0 = make_v4f(0.f, 0.f, 0.f, 0.f), s1 = s0;
#pragma unroll
        for (int w = 0; w < 8; ++w) {
            const v4f x0 = *(const LAS v4f*)(red + w * 4096 + tid * 8), x1 = *(const LAS v4f*)(red + w * 4096 + tid * 8 + 4);
            s0.x += x0.x; s0.y += x0.y; s0.z += x0.z; s0.w += x0.w; s1.x += x1.x; s1.y += x1.y; s1.z += x1.z; s1.w += x1.w;
        }
        const int r = row < TL ? (row >> 12) : 4;
        const float* gf = (const float*)(a.ws + WS_MOD) + (size_t)(l * 5 + r) * NMOD + 5 * 4096 + tid * 8;
        float* xp = (row < TL ? a.out + (size_t)row * 4096 : (float*)(a.ws + WS_XC) + (size_t)(row - TL) * 4096) + tid * 8;
        const v4f g0 = *(const v4f*)gf, g1 = *(const v4f*)(gf + 4);
        v4f x0 = *(v4f*)xp, x1 = *(v4f*)(xp + 4);
        x0.x += g0.x * s0.x; x0.y += g0.y * s0.y; x0.z += g0.z * s0.z; x0.w += g0.w * s0.w;
        x1.x += g1.x * s1.x; x1.y += g1.y * s1.y; x1.z += g1.z * s1.z; x1.w += g1.w * s1.w;
        *(v4f*)xp = x0; *(v4f*)(xp + 4) = x1;
    }
}

constexpr int N_PHASES = 17;
__global__ void __launch_bounds__(NTHREADS, 2) fwd_kernel(Args a) {
    extern __shared__ __attribute__((aligned(16))) unsigned char lds_raw[];
    LAS unsigned char* lds = (LAS unsigned char*)lds_raw;
    const int tid = threadIdx.x;
    const KARG Args* ap0 = (const KARG Args*)__builtin_amdgcn_kernarg_segment_ptr();
#define FRESH(name) const KARG Args* name = ap0; asm volatile("" : "+s"(name))
    const int lo = ap0->ph_lo, hi = ap0->ph_hi;
    unsigned* ctl = (unsigned*)(ap0->ws + WS_CTL);
    const bool fused = (hi - lo) > 1;
    if (tid < 64) ((LAS unsigned*)(lds + MISC_OFF))[tid] = 0u;
    __syncthreads();
    XcdBarrier bar; bar.bar = ctl + CW_BAR; bar.x = 0; bar.st = (volatile LAS unsigned*)(lds + MISC_OFF);
    if (fused) bar = xcd_barrier_post(ctl + CW_BAR, (volatile LAS unsigned*)(lds + MISC_OFF));
#define IN(k) (lo <= (k) && (k) < hi)
#if defined(ONLY)
#define EN(x) ((ONLY) == (x))
#elif defined(DISABLE)
#define EN(x) (!(((DISABLE) >> (x)) & 1))
#else
#define EN(x) 1
#endif
#define SEAM(k) do { if (IN(k) && IN((k) + 1)) xcd_barrier(bar); } while (0)

    if (EN(0) && IN(0)) { FRESH(ap); p0_prologue(*ap, lds); }
    SEAM(0);
#pragma unroll 1
    for (int l = 0; l < 2; ++l) {
        const int pb = 1 + 8 * l;
        const int nrows = (l == 0) ? MT : TL;
        if (EN(1) && IN(pb + 0)) { FRESH(ap); norm_phase(*ap, l, 0, MT); }
        SEAM(pb + 0);
        if (EN(2) && IN(pb + 1)) {
            FRESH(ap); ARGS_REF a = *ap;
            pg8::Gemm g{(const bf16_t*)(a.ws + WS_H), (const bf16_t*)(a.ws + WS_WIN) + (size_t)l * INC * 4096, MT, INC, D};
            pg8::StaticOrder S; S.init(MT, INC, (int)gridDim.x, (int)blockIdx.x);
            pg8::EpiBf16<0> E{(bf16_t*)(a.ws + WS_PROJ), INC, nullptr, 0, 0};
            pg8::gemm_phase<pg8::EpiBf16<0>, pg8::StaticOrder, false>(lds, g, S, E, nullptr);
        }
        SEAM(pb + 1);
        if (EN(3) && IN(pb + 2)) { FRESH(ap); mixer_phase(*ap, l, lds, (unsigned*)(ap->ws + WS_CTL) + CW_QUEUE + 64 * l); }
        SEAM(pb + 2);
        if (EN(4) && IN(pb + 3)) {
            FRESH(ap); ARGS_REF a = *ap;
            pg8::Gemm g{(const bf16_t*)(a.ws + WS_MIX), (const bf16_t*)(a.ws + WS_WOUT) + (size_t)l * D * D, nrows, D, D};
            pg8::StaticOrder S; S.init(nrows, D, (int)gridDim.x, (int)blockIdx.x);
            EpiRes E{l == 0 ? a.in[0] : (const float*)a.out, l == 0 ? a.in[2] : (const float*)(a.ws + WS_XC), a.out, (float*)(a.ws + WS_XC),
                     (const float*)(a.ws + WS_MOD) + (size_t)l * 5 * NMOD + 2 * 4096};
            pg8::gemm_phase<EpiRes, pg8::StaticOrder, false>(lds, g, S, E, nullptr);
        }
        SEAM(pb + 3);
        if (EN(1) && IN(pb + 4)) { FRESH(ap); norm_phase(*ap, l, 1, nrows); }
        SEAM(pb + 4);
        if (EN(5) && IN(pb + 5)) {
            FRESH(ap); ARGS_REF a = *ap;
            pg8::Gemm g{(const bf16_t*)(a.ws + WS_H), (const bf16_t*)(a.ws + WS_WQ) + (size_t)l * PQ * D, nrows, PQ, D};
            pg8::StaticOrder S; S.init(nrows, PQ, (int)gridDim.x, (int)blockIdx.x);
            pg8::EpiF32 E{(float*)(a.ws + WS_Q), PQ, nullptr};
            pg8::gemm_phase<pg8::EpiF32, pg8::StaticOrder, false>(lds, g, S, E, nullptr);
        }
        SEAM(pb + 5);
        if (EN(6) && IN(pb + 6)) { const int nit = (nrows / 32) * 8; for (int it = blockIdx.x; it < nit; it += gridDim.x) { FRESH(ap); peer_select_item(*ap, l, it >> 3, it & 7, lds); } }
        SEAM(pb + 6);
        if (EN(7) && IN(pb + 7)) { for (int row = blockIdx.x; row < nrows; row += gridDim.x) { FRESH(ap); peer_apply_token(*ap, l, row, lds); } }
        SEAM(pb + 7);
    }
#undef IN
#undef SEAM
}

extern "C" void kernel_launch(void* const* d_in, const int* in_sizes, int n_in, void* d_out, int out_size, void* d_ws, size_t ws_size, hipStream_t stream) {
    static int grid = 0;
    if (grid == 0) {
        if (n_in != 29 || out_size != TL * D || ws_size < WS_END) {
            fprintf(stderr, "kernel_launch: expected 29 inputs, out %d floats, ws >= %zu bytes; got n_in %d out %d ws %zu; nothing launched\n", TL * D, (size_t)WS_END, n_in, out_size, ws_size);
            grid = -1; return;
        }
        int dev = 0, cus = 0, per_cu = 0;
        if (hipGetDevice(&dev) != hipSuccess || hipDeviceGetAttribute(&cus, hipDeviceAttributeMultiprocessorCount, dev) != hipSuccess) { fprintf(stderr, "kernel_launch: device query failed\n"); grid = -1; return; }
        if (hipFuncSetAttribute((const void*)fwd_kernel, hipFuncAttributeMaxDynamicSharedMemorySize, LDS_BYTES) != hipSuccess) { fprintf(stderr, "kernel_launch: hipFuncSetAttribute failed\n"); grid = -1; return; }
        if (hipOccupancyMaxActiveBlocksPerMultiprocessor(&per_cu, (const void*)fwd_kernel, NTHREADS, LDS_BYTES) != hipSuccess || per_cu < 1)
            fprintf(stderr, "kernel_launch: note: occupancy query reports %d workgroups per CU\n", per_cu);
        (void)hipGetLastError();
        grid = cus;
    }
    if (grid < 0) return;
    if (hipMemsetAsync((char*)d_ws + WS_CTL, 0, CTL_BYTES, stream) != hipSuccess) { fprintf(stderr, "kernel_launch: memset failed\n"); return; }
    Args a{};
    for (int i = 0; i < 29; ++i) a.in[i] = (const float*)d_in[i];
    a.out = (float*)d_out; a.ws = (unsigned char*)d_ws;
#if MK_ONE_LAUNCH
    a.ph_lo = 0; a.ph_hi = N_PHASES;
    hipLaunchKernelGGL(fwd_kernel, dim3(grid), dim3(NTHREADS), LDS_BYTES, stream, a);
#else
    for (int p = 0; p < N_PHASES; ++p) { a.ph_lo = p; a.ph_hi = p + 1; hipLaunchKernelGGL(fwd_kernel, dim3(grid), dim3(NTHREADS), LDS_BYTES, stream, a); }
#endif
    const hipError_t le = hipPeekAtLastError();
    if (le != hipSuccess) fprintf(stderr, "kernel_launch: launch failed: %s\n", hipGetErrorName(le));
}
```

```cpp
#include <hip/hip_runtime.h>
#include <cstdio>
#include <cstdint>

#ifndef MK_ONE_LAUNCH
#define MK_ONE_LAUNCH 1
#endif

typedef unsigned short bf16_t;
typedef short bf16x8_t __attribute__((ext_vector_type(8)));
typedef float f32x4_t __attribute__((ext_vector_type(4)));
typedef float v4f __attribute__((ext_vector_type(4)));
typedef float v2f __attribute__((ext_vector_type(2)));
typedef unsigned v4u __attribute__((ext_vector_type(4)));
typedef unsigned v2u __attribute__((ext_vector_type(2)));
__device__ __forceinline__ v4f make_v4f(float a, float b, float c, float d) { return (v4f){a, b, c, d}; }
__device__ __forceinline__ v2f make_v2f(float a, float b) { return (v2f){a, b}; }
__device__ __forceinline__ v4u make_v4u(unsigned a, unsigned b, unsigned c, unsigned d) { return (v4u){a, b, c, d}; }
__device__ __forceinline__ v2u make_v2u(unsigned a, unsigned b) { return (v2u){a, b}; }

constexpr int D = 4096, NB = 4, SEQ = 4096, TL = NB * SEQ, CTXL = 256, TC = NB * CTXL, MT = TL + TC;
constexpr int INC = 13824;
constexpr int C_RK = 0, C_RV = 1536, C_NK = 3072, C_NV = 4608, C_HY = 6144, C_RQ = 9216, C_RG = 10752, C_NQ = 12288;
constexpr int M_HY = 0, M_RO = 1024, M_NO = 2560;
constexpr int NMOD = 6 * D;
constexpr int PQ = 2048;
constexpr int PN = 16384;
constexpr float EPS = 1e-6f;
constexpr float A8_SCALE = 16.0f;
constexpr float W8_SCALE = 64.0f;
constexpr float U8_SCALE = 64.0f;

constexpr size_t al256(size_t x) { return (x + 255) & ~(size_t)255; }
constexpr size_t WS_CTL  = 0;
constexpr size_t CTL_BYTES = 65536;
constexpr size_t WS_MOD  = WS_CTL + CTL_BYTES;
constexpr size_t WS_KT   = al256(WS_MOD + (size_t)2 * 5 * NMOD * 4);
constexpr size_t WS_KTC  = al256(WS_KT + (size_t)2 * 4096 * 4096 * 4);
constexpr size_t WS_WIN  = al256(WS_KTC + (size_t)4096 * 256 * 4);
constexpr size_t WS_WOUT = al256(WS_WIN + (size_t)2 * INC * D * 2);
constexpr size_t WS_WQ   = al256(WS_WOUT + (size_t)2 * D * D * 2);
constexpr size_t WS_H    = al256(WS_WQ + (size_t)2 * PQ * D * 2);
constexpr size_t WS_PROJ = al256(WS_H + (size_t)MT * D * 2);
constexpr size_t WS_MIX  = al256(WS_PROJ + (size_t)MT * INC * 2);
constexpr size_t WS_XC   = al256(WS_MIX + (size_t)MT * D * 2);
constexpr size_t WS_Q    = al256(WS_XC + (size_t)TC * D * 4);
constexpr size_t WS_OF   = al256(WS_Q + (size_t)MT * PQ * 4);
constexpr size_t WS_UB   = al256(WS_OF + (size_t)2 * MT * 1536 * 4);
constexpr size_t WS_VT   = al256(WS_UB + (size_t)2 * 16384 * D);
constexpr size_t WS_GA   = al256(WS_VT + (size_t)2 * 16384 * D);
constexpr size_t WS_UT   = al256(WS_GA + (size_t)MT * 16384 * 2);
constexpr size_t WS_HF8  = al256(WS_UT + (size_t)3072 * MT * 2);
constexpr size_t WS_GA8  = al256(WS_HF8 + (size_t)MT * D);
constexpr size_t WS_KHL  = al256(WS_GA8 + (size_t)MT * 16384);
constexpr size_t WS_PART = al256(WS_KHL + (size_t)2 * 8 * 2 * 2 * 128 * 128 * 2);
constexpr size_t WS_END  = al256(WS_PART + (size_t)4 * TC * D * 4);

constexpr int CW_BAR = 0;
constexpr int CW_QUEUE = 4096;
constexpr int CW_RET = 8192;

constexpr int LDS_BYTES = 156 * 1024;
constexpr int MISC_OFF = LDS_BYTES - 1024;
constexpr int NTHREADS = 512;

struct Args { const float* in[29]; float* out; unsigned char* ws; int ph_lo, ph_hi; };
#define KARG __attribute__((address_space(4)))
#define ARGS_REF const KARG Args&

__device__ __forceinline__ int fresh_tid() { int t = (int)threadIdx.x; asm volatile("" : "+v"(t)); return t; }
__device__ __forceinline__ float bf2f(bf16_t b) { return __uint_as_float(((unsigned)b) << 16); }
__device__ __forceinline__ unsigned pack2bf(float lo, float hi) { unsigned r; asm volatile("v_cvt_pk_bf16_f32 %0, %1, %2" : "=v"(r) : "v"(lo), "v"(hi)); return r; }
__device__ __forceinline__ unsigned pack4fp8(float a, float b, float c, float d) { int w = 0; w = __builtin_amdgcn_cvt_pk_fp8_f32(a, b, w, false); w = __builtin_amdgcn_cvt_pk_fp8_f32(c, d, w, true); return (unsigned)w; }
__device__ __forceinline__ unsigned char f2fp8(float f) { return (unsigned char)(__builtin_amdgcn_cvt_pk_fp8_f32(f, 0.0f, 0, false) & 0xff); }
__device__ __forceinline__ bf16_t f2bf(float f) { return (bf16_t)(pack2bf(f, 0.0f) & 0xffffu); }
__device__ __forceinline__ float bflo(unsigned w) { return __uint_as_float(w << 16); }
__device__ __forceinline__ float bfhi(unsigned w) { return __uint_as_float(w & 0xffff0000u); }
#define WAVE_DPP(v, ctrl) __int_as_float(__builtin_amdgcn_update_dpp(0, __float_as_int(v), (ctrl), 0xf, 0xf, true))
__device__ __forceinline__ float wave_sum(float v) {
    v += WAVE_DPP(v, 0xB1); v += WAVE_DPP(v, 0x4E); v += WAVE_DPP(v, 0x141); v += WAVE_DPP(v, 0x140);
    const float r0 = __int_as_float(__builtin_amdgcn_readlane(__float_as_int(v), 0)), r1 = __int_as_float(__builtin_amdgcn_readlane(__float_as_int(v), 16));
    const float r2 = __int_as_float(__builtin_amdgcn_readlane(__float_as_int(v), 32)), r3 = __int_as_float(__builtin_amdgcn_readlane(__float_as_int(v), 48));
    return (r0 + r1) + (r2 + r3);
}
__device__ __forceinline__ float wave_max(float v) {
    v = fmaxf(v, WAVE_DPP(v, 0xB1)); v = fmaxf(v, WAVE_DPP(v, 0x4E)); v = fmaxf(v, WAVE_DPP(v, 0x141)); v = fmaxf(v, WAVE_DPP(v, 0x140));
    const float r0 = __int_as_float(__builtin_amdgcn_readlane(__float_as_int(v), 0)), r1 = __int_as_float(__builtin_amdgcn_readlane(__float_as_int(v), 16));
    const float r2 = __int_as_float(__builtin_amdgcn_readlane(__float_as_int(v), 32)), r3 = __int_as_float(__builtin_amdgcn_readlane(__float_as_int(v), 48));
    return fmaxf(fmaxf(r0, r1), fmaxf(r2, r3));
}
__device__ __forceinline__ float sin_turns(float t) { return __builtin_amdgcn_sinf(t - floorf(t)); }
__device__ __forceinline__ float cos_turns(float t) { return __builtin_amdgcn_cosf(t - floorf(t)); }
__device__ __forceinline__ float sin_rad(float x) { return sin_turns(x * 0.15915494309189535f); }
__device__ __forceinline__ float silu_f(float x) { return x / (1.0f + __expf(-x)); }
__device__ __forceinline__ float gelu_tanh_f(float x) {
    const float u = 0.7978845608028654f * (x + 0.044715f * x * x * x);
    const float th = 1.0f - 2.0f / (__expf(2.0f * u) + 1.0f);
    return 0.5f * x * (1.0f + th);
}
__device__ __forceinline__ int clampi(int x, int lo, int hi) { return x < lo ? lo : (x > hi ? hi : x); }

#define XB_TMO      128
#define XB_XCNT(j)  (256  + 64 * (j))
#define XB_XSUB(j)  (1280 + 64 * (j))
#define XB_XGEN(j)  (2304 + 64 * (j))
#define XB_TOP      3328
#define XB_TOPGEN   3392
#define XCD_BAR_WORDS 3456
#define XB_SPIN_CAP (1u << 21)
#define LAS __attribute__((address_space(3)))

__device__ __forceinline__ unsigned xb_ld(unsigned* p)              { return __hip_atomic_load(p, __ATOMIC_RELAXED, __HIP_MEMORY_SCOPE_AGENT); }
__device__ __forceinline__ unsigned xb_add(unsigned* p, unsigned v) { return __hip_atomic_fetch_add(p, v, __ATOMIC_RELAXED, __HIP_MEMORY_SCOPE_AGENT); }
__device__ __forceinline__ unsigned xb_xcc_id() { return (unsigned)__builtin_amdgcn_s_getreg((3 << 11) | 20) & 0xFu; }
#define XB_SPIN(cond, bar) do { unsigned _sp = 0; while (cond) { __builtin_amdgcn_s_sleep(1); \
    if ((++_sp & 255u) == 0u) { if (xb_ld(&(bar)[XB_TMO])) break; if (_sp > XB_SPIN_CAP) { atomicAdd(&(bar)[XB_TMO], 1u); break; } } } } while (0)

struct XcdBarrier {
    unsigned* bar; unsigned x;
    volatile LAS unsigned* st;
};

__device__ __forceinline__ XcdBarrier xcd_barrier_post(unsigned* bar, volatile LAS unsigned* st) {
    XcdBarrier b; b.bar = bar; b.x = xb_xcc_id(); b.st = st;
    if (threadIdx.x == 0) (void)xb_add(&bar[XB_XCNT(b.x)], 1u);
    return b;
}
__device__ __forceinline__ void xcd_barrier_complete(unsigned* bar, unsigned x, unsigned& nloc, unsigned& nx) {
    const unsigned G = gridDim.x * gridDim.y * gridDim.z;
    unsigned sum, cnt, mine, sp = 0u;
    for (;;) {
        sum = 0u; cnt = 0u; mine = 0u;
#pragma unroll
        for (unsigned j = 0; j < 16; ++j) { const unsigned c = xb_ld(&bar[XB_XCNT(j)]); sum += c; cnt += (c > 0u) ? 1u : 0u; mine = (j == x) ? c : mine; }
        if (sum == G) break;
        __builtin_amdgcn_s_sleep(1);
        if ((++sp & 255u) == 0u) { if (xb_ld(&bar[XB_TMO])) break; if (sp > XB_SPIN_CAP) { atomicAdd(&bar[XB_TMO], 1u); break; } }
    }
    nloc = mine > 0u ? mine : 1u; nx = cnt > 0u ? cnt : 1u;
}

__device__ __forceinline__ void xcd_barrier(const XcdBarrier& b) {
    asm volatile("s_waitcnt vmcnt(0)" ::: "memory");
    __syncthreads();
    if (threadIdx.x == 0) {
        unsigned* bar = b.bar;
        __builtin_amdgcn_s_waitcnt(0);
        unsigned nloc = b.st[0], nx = b.st[1];
        if (nloc == 0u) { xcd_barrier_complete(bar, b.x, nloc, nx); b.st[0] = nloc; b.st[1] = nx; }
        const unsigned old = xb_add(&bar[XB_XSUB(b.x)], 1u);
        const unsigned gen = old / nloc;
        if (old + 1u == (gen + 1u) * nloc) {
            __builtin_amdgcn_fence(__ATOMIC_RELEASE, "agent");
            asm volatile("s_waitcnt vmcnt(0)" ::: "memory");
            const unsigned og = xb_add(&bar[XB_TOP], 1u);
            const unsigned tg = og / nx;
            if (og + 1u == (tg + 1u) * nx) xb_add(&bar[XB_TOPGEN], 1u);
            else XB_SPIN(xb_ld(&bar[XB_TOPGEN]) == tg, bar);
            __builtin_amdgcn_fence(__ATOMIC_ACQUIRE, "agent");
            xb_add(&bar[XB_XGEN(b.x)], 1u);
            asm volatile("s_waitcnt vmcnt(0)" ::: "memory");
        } else {
            XB_SPIN(xb_ld(&bar[XB_XGEN(b.x)]) == gen, bar);
            __builtin_amdgcn_fence(__ATOMIC_ACQUIRE, "agent");
            asm volatile("s_waitcnt vmcnt(0)" ::: "memory");
        }
    }
    __syncthreads();
}
namespace pg8 {
#define PG8_LAS __attribute__((address_space(3)))
typedef unsigned short bf16_t;
typedef short bf16x8 __attribute__((ext_vector_type(8)));
typedef float f32x4 __attribute__((ext_vector_type(4)));
typedef unsigned u32x4 __attribute__((ext_vector_type(4)));
constexpr int BM = 256, BK = 64, HALF = 128, HTB = HALF * BK * 2  , STAGE_BYTES = 8 * HTB, NXCD = 8, WGM = 8;

__host__ __device__ __forceinline__ int lds_byte(int r, int c) { const int st = (r >> 4) * 2 + (c >> 5), rr = r & 15, cc = c & 31, ob = rr * 64 + cc * 2; return st * 1024 + (ob ^ (((ob >> 9) & 1) << 5)); }
__host__ __device__ __forceinline__ void stage_rc(int b, int& R, int& C) { const int st = b / 1024, sb = b % 1024, swz = sb ^ (((sb >> 9) & 1) << 5); R = (st >> 1) * 16 + swz / 64; C = (st & 1) * 32 + (swz % 64) / 2; }
__host__ __device__ __forceinline__ int perm32(int rho) { const int n = rho >> 4, i = rho & 15; return 8 * (i >> 2) + 4 * n + (i & 3); }

struct Unit { int pm, pn, kb; };
struct Gemm { const bf16_t* A; const bf16_t* Bt; int M, N, K, ld; };

struct StaticOrder {
    int nM, nN, nwg, G, c, W;
    __host__ __device__ void init(int M, int N, int G_, int c_, int W_ = 4) { nM = M / BM; nN = N / BM; nwg = nM * nN; G = G_; c = c_; W = W_; }
    __host__ __device__ bool next(int i, Unit& u) const {
        const long L = (long)i * G + c; if (L >= nwg) return false;
        int wgid = (int)L; { const int q = nwg / NXCD, r = nwg % NXCD, xcd = wgid % NXCD, off = wgid / NXCD; wgid = (xcd < r ? xcd * (q + 1) : r * (q + 1) + (xcd - r) * q) + off; }
        const int nig = W * nN, gid = wgid / nig, fm = gid * W, gsz = (nM - fm) < W ? (nM - fm) : W;
        u.pm = fm + ((wgid % nig) % gsz); u.pn = (wgid % nig) / gsz; u.kb = 0; return true;
    }
    __device__ __forceinline__ void a_ready(const Unit&) const {}
    __device__ __forceinline__ void done(const Unit&) const {}
};
struct CountedOrder : StaticOrder {
    const unsigned* ready; unsigned need; unsigned* tmo;
    __device__ __forceinline__ void a_ready(const Unit& u) const {
        if (threadIdx.x < 64) {
            const unsigned long long t0 = __builtin_amdgcn_s_memrealtime(); unsigned polls = 0;
            while ((unsigned)__builtin_amdgcn_readfirstlane(__hip_atomic_load(ready + 64 * u.pm, __ATOMIC_RELAXED, __HIP_MEMORY_SCOPE_AGENT)) < need) {
                if ((++polls & 255u) == 0u && __builtin_amdgcn_readfirstlane(__hip_atomic_load(tmo, __ATOMIC_RELAXED, __HIP_MEMORY_SCOPE_AGENT)) != 0u) break;
                if (__builtin_amdgcn_s_memrealtime() - t0 > 2000000ull) {
                    if (threadIdx.x == 0) { unsigned expect = 0u; __hip_atomic_compare_exchange_strong(tmo + 1, &expect, 0x600u | (unsigned)(u.pm & 0xff), __ATOMIC_RELAXED, __ATOMIC_RELAXED, __HIP_MEMORY_SCOPE_AGENT); __hip_atomic_store(tmo, 1u, __ATOMIC_RELAXED, __HIP_MEMORY_SCOPE_AGENT); }
                    break; }
                __builtin_amdgcn_s_sleep(2); }
            __builtin_amdgcn_fence(__ATOMIC_ACQUIRE, "agent");
            asm volatile("s_waitcnt vmcnt(0)" ::: "memory");
        }
#if !defined(BROKEN_HOOK_NO_BARRIER)
        asm volatile("" ::: "memory"); __builtin_amdgcn_s_barrier(); asm volatile("" ::: "memory");
#endif
    }
};

struct TwoPartOrder {
    StaticOrder base; int ncol2, n2;
    __host__ __device__ void init(int M1, int M2, int N, int ncol2_, int G_, int c_, int W_ = 4) { base.init(M1, N, G_, c_, W_); ncol2 = ncol2_; n2 = (M2 / BM) * ncol2_; }
    __host__ __device__ bool next(int i, Unit& u) const {
        if (base.next(i, u)) return true;
        const long L = (long)i * base.G + base.c - base.nwg; if (L >= n2) return false;
        const int li = (int)L; u.pm = base.nM + (li & 3); u.pn = li >> 2;
        u.kb = 0; return true;
    }
    __device__ __forceinline__ void a_ready(const Unit&) const {}
    __device__ __forceinline__ void done(const Unit&) const {}
};
struct SplitKOrder {
    int nN, S, kpb, tot, G, c;
    __host__ __device__ void init(int M, int N, int S_, int kpb_, int G_, int c_) { nN = N / BM; S = S_; kpb = kpb_; tot = (M / BM) * nN * S_; G = G_; c = c_; }
    __host__ __device__ bool next(int i, Unit& u) const { const long L = (long)i * G + c; if (L >= tot) return false; const int l = (int)L, s = l % S, t = l / S; u.pn = t % nN; u.pm = t / nN; u.kb = s * kpb; return true; }
    __device__ __forceinline__ void a_ready(const Unit&) const {}
    __device__ __forceinline__ void done(const Unit&) const {}
};

__device__ __forceinline__ unsigned cvt_pk_bf16(float lo, float hi) { unsigned r; asm volatile("v_cvt_pk_bf16_f32 %0, %1, %2" : "=v"(r) : "v"(lo), "v"(hi)); return r; }
typedef float f32x2 __attribute__((ext_vector_type(2)));
__device__ __forceinline__ f32x2 gelu_pk(f32x2 v) {
    const f32x2 av = __builtin_elementwise_abs(v), d = av * 0.2316418882f + 1.0f;
    f32x2 t; t.x = __builtin_amdgcn_rcpf(d.x); t.y = __builtin_amdgcn_rcpf(d.y);
    f32x2 q = t * 0.5307027145f + (-0.7265760135f); q = q * t + 0.7107068705f; q = q * t + (-0.142248368f); q = q * t + 0.127414796f; q = q * t;
    const f32x2 s = (v * v) * (-0.72134752044f);
    f32x2 e; e.x = __builtin_amdgcn_exp2f(s.x); e.y = __builtin_amdgcn_exp2f(s.y);
    const f32x2 m = v * (q * e), r = v - m;
    f32x2 o; o.x = v.x < 0.f ? m.x : r.x; o.y = v.y < 0.f ? m.y : r.y; return o;
}

struct EpiF32 {
    static constexpr bool PERM = false, AFTER_DRAIN = false;
    float* C; int ldc; const float* bias;
    __device__ __forceinline__ void operator()(const f32x4 (&acc)[2][2][4][2], const Unit& u, int wr, int wc, int fr, int fq) const {
        const int row0 = u.pm * BM + wr * 64 + fr, col0 = u.pn * BM + wc * 32 + 4 * fq;
        f32x4 bv[2][2];
#pragma unroll
        for (int bj = 0; bj < 2; ++bj)
#pragma unroll
            for (int n = 0; n < 2; ++n) bv[bj][n] = bias ? *(const f32x4*)(bias + col0 + bj * HALF + n * 16) : (f32x4){0.f, 0.f, 0.f, 0.f};
#pragma unroll
        for (int ai = 0; ai < 2; ++ai)
#pragma unroll
            for (int m = 0; m < 4; ++m) { float* rowp = C + (size_t)(row0 + ai * HALF + m * 16) * ldc + col0;
#pragma unroll
                for (int bj = 0; bj < 2; ++bj)
#pragma unroll
                    for (int n = 0; n < 2; ++n) *(f32x4*)(rowp + bj * HALF + n * 16) = acc[ai][bj][m][n] + bv[bj][n]; }
    }
};
template <int ACT  > struct EpiBf16 {
    static constexpr bool PERM = true, AFTER_DRAIN = false;
    bf16_t* O; int ldc; const float* bias; int split_cols; size_t split_stride;
    __device__ __forceinline__ void operator()(const f32x4 (&acc)[2][2][4][2], const Unit& u, int wr, int wc, int fr, int fq) const {
        const int row0 = u.pm * BM + wr * 64 + fr; int colt = u.pn * BM; bf16_t* base = O;
        if (split_cols) { const int t = colt / split_cols; base += (size_t)t * split_stride; colt -= t * split_cols; }
        const int col0 = colt + wc * 32 + 8 * fq, bcol0 = u.pn * BM + wc * 32 + 8 * fq;
        f32x4 bv[2][2];
#pragma unroll
        for (int bj = 0; bj < 2; ++bj)
#pragma unroll
            for (int n = 0; n < 2; ++n) bv[bj][n] = bias ? *(const f32x4*)(bias + bcol0 + bj * HALF + 4 * n) : (f32x4){0.f, 0.f, 0.f, 0.f};
#pragma unroll
        for (int ai = 0; ai < 2; ++ai)
#pragma unroll
            for (int m = 0; m < 4; ++m) { bf16_t* rowp = base + (size_t)(row0 + ai * HALF + m * 16) * ldc + col0;
#pragma unroll
                for (int bj = 0; bj < 2; ++bj) { f32x4 v0 = acc[ai][bj][m][0] + bv[bj][0], v1 = acc[ai][bj][m][1] + bv[bj][1];
                    if (ACT == 1) { f32x2 a = gelu_pk((f32x2){v0[0], v0[1]}), b = gelu_pk((f32x2){v0[2], v0[3]}), c = gelu_pk((f32x2){v1[0], v1[1]}), d = gelu_pk((f32x2){v1[2], v1[3]});
                        v0 = (f32x4){a.x, a.y, b.x, b.y}; v1 = (f32x4){c.x, c.y, d.x, d.y}; }
                    if (ACT == 2) {
#pragma unroll
                        for (int j = 0; j < 4; ++j) { v0[j] = 0.5f * v0[j] * (1.0f + erff(v0[j] * 0.70710678f)); v1[j] = 0.5f * v1[j] * (1.0f + erff(v1[j] * 0.70710678f)); } }
                    u32x4 w; w.x = cvt_pk_bf16(v0[0], v0[1]); w.y = cvt_pk_bf16(v0[2], v0[3]); w.z = cvt_pk_bf16(v1[0], v1[1]); w.w = cvt_pk_bf16(v1[2], v1[3]);
                    *(u32x4*)(rowp + bj * HALF) = w; } }
    }
};

struct PanelStats {
    unsigned* xbuf;
    unsigned* cnt;
    unsigned* tmo;
    int ntn; float eps;
    unsigned code;
    __device__ __forceinline__ bool run(const f32x4 (&v)[2][2][4][2], const Unit& u, int wr, int wc, int fr, int fq, PG8_LAS unsigned char* lds, int wid, int lane) const {
        typedef float f32x2v __attribute__((ext_vector_type(2)));
        PG8_LAS f32x2v* P = (PG8_LAS f32x2v*)lds;
        PG8_LAS f32x2v* S = (PG8_LAS f32x2v*)(lds + 8192);
        PG8_LAS unsigned* flag = (PG8_LAS unsigned*)(lds + 8192 + 2048);
#pragma unroll
        for (int ai = 0; ai < 2; ++ai)
#pragma unroll
            for (int m = 0; m < 4; ++m) {
                float s = 0.f;
#pragma unroll
                for (int bj = 0; bj < 2; ++bj)
#pragma unroll
                    for (int n = 0; n < 2; ++n) { const f32x4 x = v[ai][bj][m][n]; s += (x[0] + x[1]) + (x[2] + x[3]); }
                s += __shfl_xor(s, 16); s += __shfl_xor(s, 32);
                const float mw = s * (1.0f / 64.0f); float q = 0.f;
#pragma unroll
                for (int bj = 0; bj < 2; ++bj)
#pragma unroll
                    for (int n = 0; n < 2; ++n) { const f32x4 d = v[ai][bj][m][n] - mw; q += (d[0] * d[0] + d[1] * d[1]) + (d[2] * d[2] + d[3] * d[3]); }
                q += __shfl_xor(q, 16); q += __shfl_xor(q, 32);
                if (fq == 0) P[(ai * HALF + wr * 64 + m * 16 + fr) * 4 + wc] = (f32x2v){mw, q};
            }
        asm volatile("s_waitcnt lgkmcnt(0)" ::: "memory"); __builtin_amdgcn_s_barrier(); asm volatile("" ::: "memory");
#if defined(BROKEN_NO_WAIT)
        if (blockIdx.x >= 64) { const long long t0 = clock64(); while (clock64() - t0 < 60000) __builtin_amdgcn_s_sleep(8); }
#endif
        const int row = wid * 32 + (lane & 31);
        if (lane < 32) {
            const f32x2v a = P[row * 4 + 0], b = P[row * 4 + 1], c = P[row * 4 + 2], d = P[row * 4 + 3];
            const float mt = (a.x + b.x + c.x + d.x) * 0.25f;
            const float da = a.x - mt, db = b.x - mt, dc = c.x - mt, dd = d.x - mt;
            const float m2 = (a.y + b.y) + (c.y + d.y) + 64.0f * ((da * da + db * db) + (dc * dc + dd * dd));
            unsigned long long* slot = (unsigned long long*)xbuf + ((size_t)(u.pm * BM + row) * 4 + u.pn);
            __hip_atomic_store(slot, ((unsigned long long)__float_as_uint(m2) << 32) | __float_as_uint(mt), __ATOMIC_RELAXED, __HIP_MEMORY_SCOPE_AGENT);
        }
        asm volatile("s_waitcnt vmcnt(0)" ::: "memory");
        if (lane == 0) __hip_atomic_fetch_add(cnt + 64 * u.pm, 1u, __ATOMIC_RELAXED, __HIP_MEMORY_SCOPE_AGENT);
        if (wid == 0) {
            bool dead = false; const unsigned long long t0 = __builtin_amdgcn_s_memrealtime(); const unsigned want = 8u * (unsigned)ntn;
            for (;;) {
#if defined(BROKEN_NO_WAIT)
                break;
#endif
                if ((unsigned)__builtin_amdgcn_readfirstlane(__hip_atomic_load(cnt + 64 * u.pm, __ATOMIC_RELAXED, __HIP_MEMORY_SCOPE_AGENT)) >= want) break;
                if (__builtin_amdgcn_s_memrealtime() - t0 > 2000000ull) {
                    if (lane == 0) { unsigned expect = 0u; __hip_atomic_compare_exchange_strong(tmo + 1, &expect, code | (unsigned)(u.pm & 0xff), __ATOMIC_RELAXED, __ATOMIC_RELAXED, __HIP_MEMORY_SCOPE_AGENT);
                                     __hip_atomic_store(tmo, 1u, __ATOMIC_RELAXED, __HIP_MEMORY_SCOPE_AGENT); }
                    dead = true; break; }
                __builtin_amdgcn_s_sleep(2);
            }
            __builtin_amdgcn_fence(__ATOMIC_ACQUIRE, "agent");
            if (lane == 0) flag[0] = dead ? 1u : 0u;
        }
        asm volatile("s_waitcnt vmcnt(0) lgkmcnt(0)" ::: "memory"); __builtin_amdgcn_s_barrier(); asm volatile("" ::: "memory");
        const bool bad = flag[0] != 0u;
        if (lane < 32) {
            const unsigned long long* slot = (const unsigned long long*)xbuf + (size_t)(u.pm * BM + row) * 4; float mt[4], m2[4]; float ms = 0.f;
#pragma unroll
            for (int t = 0; t < 4; ++t) { if (t < ntn) { const unsigned long long w = __hip_atomic_load(slot + t, __ATOMIC_RELAXED, __HIP_MEMORY_SCOPE_AGENT); mt[t] = __uint_as_float((unsigned)w); m2[t] = __uint_as_float((unsigned)(w >> 32)); } else { mt[t] = 0.f; m2[t] = 0.f; } ms += mt[t]; }
            const float mean = ms / (float)ntn; float q = 0.f;
#pragma unroll
            for (int t = 0; t < 4; ++t) if (t < ntn) { const float dm = mt[t] - mean; q += m2[t] + 256.0f * dm * dm; }
            S[row] = (f32x2v){mean, 1.0f / sqrtf(q / (256.0f * (float)ntn) + eps)};
        }
        asm volatile("s_waitcnt lgkmcnt(0)" ::: "memory"); __builtin_amdgcn_s_barrier(); asm volatile("" ::: "memory");
        return bad;
    }
};
struct EpiLnRes {
    static constexpr bool PERM = false, AFTER_DRAIN = true;
    const float* base; float* out; int ldc; const float* bias; PanelStats st; unsigned poison;
    __device__ __forceinline__ void refuse(size_t i0, size_t stride, int M, int N) const { const float q = __builtin_nanf(""); for (size_t i = i0; i < (size_t)M * N; i += stride) out[(i / N) * ldc + i % N] = q;
        if (i0 == 0) { unsigned expect = 0u; __hip_atomic_compare_exchange_strong(st.tmo + 1, &expect, 0x7f0u, __ATOMIC_RELAXED, __ATOMIC_RELAXED, __HIP_MEMORY_SCOPE_AGENT); __hip_atomic_store(st.tmo, 1u, __ATOMIC_RELAXED, __HIP_MEMORY_SCOPE_AGENT); } }
    __device__ __forceinline__ void fused(f32x4 (&acc)[2][2][4][2], const Unit& u, int wr, int wc, int fr, int fq, PG8_LAS unsigned char* lds, int wid, int lane) const {
        typedef float f32x2v __attribute__((ext_vector_type(2)));
        const PG8_LAS f32x2v* S = (const PG8_LAS f32x2v*)(lds + 8192);
        const int col0 = u.pn * BM + wc * 32 + 4 * fq;
#pragma unroll
        for (int bj = 0; bj < 2; ++bj)
#pragma unroll
            for (int n = 0; n < 2; ++n) { const f32x4 bv = bias ? *(const f32x4*)(bias + col0 + bj * HALF + n * 16) : (f32x4){0.f, 0.f, 0.f, 0.f};
#pragma unroll
                for (int ai = 0; ai < 2; ++ai)
#pragma unroll
                    for (int m = 0; m < 4; ++m) acc[ai][bj][m][n] += bv; }
        const bool bad = st.run(acc, u, wr, wc, fr, fq, lds, wid, lane) || poison != 0u;
        const float qnan = __builtin_nanf("");
#pragma unroll
        for (int ai = 0; ai < 2; ++ai)
#pragma unroll
            for (int m = 0; m < 4; ++m) { const int r = ai * HALF + wr * 64 + m * 16 + fr; const f32x2v sr = S[r]; const size_t off = (size_t)(u.pm * BM + r) * ldc + col0;
#pragma unroll
                for (int bj = 0; bj < 2; ++bj)
#pragma unroll
                    for (int n = 0; n < 2; ++n) { const f32x4 bs = *(const f32x4*)(base + off + bj * HALF + n * 16); f32x4 o = bs + (acc[ai][bj][m][n] - sr.x) * sr.y;
                        if (bad) o = (f32x4){qnan, qnan, qnan, qnan}; *(f32x4*)(out + off + bj * HALF + n * 16) = o; }
                asm volatile("" ::: "memory"); }
    }
};
struct EpiLnResLn {
    static constexpr bool PERM = false, AFTER_DRAIN = true;
    const float* base; float* out; bf16_t* xn; int ldc; const float* bias; PanelStats st1, st2; unsigned poison;
    __device__ __forceinline__ void refuse(size_t i0, size_t stride, int M, int N) const { const float q = __builtin_nanf(""); for (size_t i = i0; i < (size_t)M * N; i += stride) { const size_t o = (i / N) * ldc + i % N; out[o] = q; xn[o] = (bf16_t)0x7fc0u; }
        if (i0 == 0) { unsigned expect = 0u; __hip_atomic_compare_exchange_strong(st1.tmo + 1, &expect, 0x7f0u, __ATOMIC_RELAXED, __ATOMIC_RELAXED, __HIP_MEMORY_SCOPE_AGENT); __hip_atomic_store(st1.tmo, 1u, __ATOMIC_RELAXED, __HIP_MEMORY_SCOPE_AGENT); } }
    __device__ __forceinline__ void fused(f32x4 (&acc)[2][2][4][2], const Unit& u, int wr, int wc, int fr, int fq, PG8_LAS unsigned char* lds, int wid, int lane) const {
        typedef float f32x2v __attribute__((ext_vector_type(2))); typedef unsigned u32x2v __attribute__((ext_vector_type(2)));
        const PG8_LAS f32x2v* S = (const PG8_LAS f32x2v*)(lds + 8192);
        const int col0 = u.pn * BM + wc * 32 + 4 * fq;
#pragma unroll
        for (int bj = 0; bj < 2; ++bj)
#pragma unroll
            for (int n = 0; n < 2; ++n) { const f32x4 bv = bias ? *(const f32x4*)(bias + col0 + bj * HALF + n * 16) : (f32x4){0.f, 0.f, 0.f, 0.f};
#pragma unroll
                for (int ai = 0; ai < 2; ++ai)
#pragma unroll
                    for (int m = 0; m < 4; ++m) acc[ai][bj][m][n] += bv; }
        bool bad = st1.run(acc, u, wr, wc, fr, fq, lds, wid, lane) || poison != 0u;
        const float qnan = __builtin_nanf("");
#pragma unroll
        for (int ai = 0; ai < 2; ++ai)
#pragma unroll
            for (int m = 0; m < 4; ++m) { const int r = ai * HALF + wr * 64 + m * 16 + fr; const f32x2v sr = S[r]; const size_t off = (size_t)(u.pm * BM + r) * ldc + col0;
#pragma unroll
                for (int bj = 0; bj < 2; ++bj)
#pragma unroll
                    for (int n = 0; n < 2; ++n) { const f32x4 bs = *(const f32x4*)(base + off + bj * HALF + n * 16); acc[ai][bj][m][n] = bs + (acc[ai][bj][m][n] - sr.x) * sr.y; }
                asm volatile("" : "+v"(acc[ai][0][m][0]), "+v"(acc[ai][0][m][1]), "+v"(acc[ai][1][m][0]), "+v"(acc[ai][1][m][1]));
                if (m & 1) asm volatile("" ::: "memory"); }
        const bool bad1 = bad;
        bad = st2.run(acc, u, wr, wc, fr, fq, lds, wid, lane) || bad;
#pragma unroll
        for (int ai = 0; ai < 2; ++ai)
#pragma unroll
            for (int m = 0; m < 4; ++m) { const int r = ai * HALF + wr * 64 + m * 16 + fr; const f32x2v sr = S[r]; const size_t off = (size_t)(u.pm * BM + r) * ldc + col0;
#pragma unroll
                for (int bj = 0; bj < 2; ++bj)
#pragma unroll
                    for (int n = 0; n < 2; ++n) { const f32x4 x1 = acc[ai][bj][m][n]; *(f32x4*)(out + off + bj * HALF + n * 16) = bad1 ? (f32x4){qnan, qnan, qnan, qnan} : x1;
                        const f32x4 o = (x1 - sr.x) * sr.y; u32x2v w; w.x = cvt_pk_bf16(o[0], o[1]); w.y = cvt_pk_bf16(o[2], o[3]);
                        if (bad) { w.x = 0x7fc07fc0u; w.y = 0x7fc07fc0u; } *(u32x2v*)(xn + off + bj * HALF + n * 16) = w; }
                asm volatile("" ::: "memory"); }
    }
};

template <class Epi, class Sched, bool STAMP = false, bool FP8 = false, bool ALIGN_EPI = true, bool SP2 = true>
__device__ __forceinline__ void gemm_phase(PG8_LAS unsigned char* lds, const Gemm g, const Sched& S, const Epi& E, unsigned long long* stamps) {
    const int tid = fresh_tid(), wid = __builtin_amdgcn_readfirstlane(tid >> 6), lane = tid & 63, wr = wid >> 2, wc = wid & 3, fr = lane & 15, fq = lane >> 4;
    const int K = g.K, nt = K / BK, LD = g.ld ? g.ld : K;
    int ts_lo = 0, ts_hi = 0, nts = 0; const unsigned long long rt_entry = STAMP ? (unsigned long long)wall_clock64() : 0ull;
#define PG8_STAMP() do { if (STAMP && wid == 0 && nts < 64) { const unsigned long long _c = (unsigned long long)clock64(); \
        ts_lo = (lane == nts) ? (int)(unsigned)_c : ts_lo; ts_hi = (lane == nts) ? (int)(unsigned)(_c >> 32) : ts_hi; ++nts; } } while (0)
    PG8_STAMP();
    unsigned voffA[2], voffB[2];
#pragma unroll
    for (int i = 0; i < 2; ++i) { int R, C; stage_rc(tid * 16 + i * 8192, R, C); const int Rb = Epi::PERM ? ((R & ~31) + perm32(R & 31)) : R;
        voffA[i] = (unsigned)(R * LD + C) * 2u; voffB[i] = (unsigned)(Rb * LD + C) * 2u; }
    const size_t kstep = (size_t)(BK * 2);
    const size_t hstep = (size_t)HALF * LD * 2;
    const size_t tstep = 2 * hstep;
    const unsigned ldsw = (unsigned)wid * 1024u;
    const int aoff = lds_byte(wr * 64 + fr, fq * 8), boff = lds_byte(wc * 32 + fr, fq * 8);
#define PG8_SA(b, h) (((b) * 2 + (h)) * HTB)
#define PG8_SB(b, h) ((4 + (b) * 2 + (h)) * HTB)
#define PG8_STAGE(bufoff, gbase, voff) do { _Pragma("unroll") for (int _i = 0; _i < 2; ++_i) \
        __builtin_amdgcn_global_load_lds((const unsigned*)((const char*)(gbase) + (voff)[_i]), (PG8_LAS unsigned*)(lds + (bufoff) + ldsw + _i * 8192), 16, 0, 0); } while (0)
#define PG8_LDA(dst, b, h) do { if constexpr (FP8) { _Pragma("unroll") for (int m = 0; m < 4; ++m) { const i32x4v lo_ = *(const PG8_LAS i32x4v*)(lds + PG8_SA(b, h) + aoff + m * 2048), hi_ = *(const PG8_LAS i32x4v*)(lds + PG8_SA(b, h) + aoff + m * 2048 + 1024); dst##8[m] = __builtin_shufflevector(lo_, hi_, 0, 1, 2, 3, 4, 5, 6, 7); } } \
        else { _Pragma("unroll") for (int m = 0; m < 4; ++m) _Pragma("unroll") for (int k = 0; k < 2; ++k) dst[m][k] = *(const PG8_LAS bf16x8*)(lds + PG8_SA(b, h) + aoff + m * 2048 + k * 1024); } } while (0)
#define PG8_LDB(dst, b, h) do { if constexpr (FP8) { _Pragma("unroll") for (int n = 0; n < 2; ++n) { const i32x4v lo_ = *(const PG8_LAS i32x4v*)(lds + PG8_SB(b, h) + boff + n * 2048), hi_ = *(const PG8_LAS i32x4v*)(lds + PG8_SB(b, h) + boff + n * 2048 + 1024); dst##8[n] = __builtin_shufflevector(lo_, hi_, 0, 1, 2, 3, 4, 5, 6, 7); } } \
        else { _Pragma("unroll") for (int n = 0; n < 2; ++n) _Pragma("unroll") for (int k = 0; k < 2; ++k) dst[n][k] = *(const PG8_LAS bf16x8*)(lds + PG8_SB(b, h) + boff + n * 2048 + k * 1024); } } while (0)
#define PG8_MMA(ai, bj, At, Bt) do { __builtin_amdgcn_s_setprio(1); _Pragma("unroll") for (int m = 0; m < 4; ++m) _Pragma("unroll") for (int n = 0; n < 2; ++n) { \
        if constexpr (FP8) asm volatile("v_mfma_scale_f32_16x16x128_f8f6f4 %0, %1, %2, %0, %3, %3 op_sel_hi:[0,0,0]" : "+v"(acc[ai][bj][m][n]) : "v"(Bt##8[n]), "v"(At##8[m]), "v"(fp8_unit_scale)); \
        else { _Pragma("unroll") for (int k = 0; k < 2; ++k) acc[ai][bj][m][n] = __builtin_amdgcn_mfma_f32_16x16x32_bf16(Bt[n][k], At[m][k], acc[ai][bj][m][n], 0, 0, 0); } } \
        __builtin_amdgcn_s_setprio(0); } while (0)
#define PG8_WAIT_V(n) asm volatile("s_waitcnt vmcnt(" #n ")" ::: "memory")
#define PG8_WAIT_L(n) asm volatile("s_waitcnt lgkmcnt(" #n ")" ::: "memory")
#define PG8_BAR __builtin_amdgcn_s_barrier()
#define PG8_SCHED __builtin_amdgcn_sched_barrier(0)
    Unit cur, nxt; int ui = 0;
    if (!S.next(0, cur)) return;
    f32x4 acc[2][2][4][2];
#pragma unroll
    for (int a = 0; a < 2; ++a)
#pragma unroll
        for (int b = 0; b < 2; ++b)
#pragma unroll
            for (int m = 0; m < 4; ++m)
#pragma unroll
                for (int n = 0; n < 2; ++n) acc[a][b][m][n] = (f32x4){0.f, 0.f, 0.f, 0.f};
    typedef int i32x4v __attribute__((ext_vector_type(4))); typedef int i32x8v __attribute__((ext_vector_type(8)));
    int fp8_unit_scale = 0x7f7f7f7f; asm volatile("" : "+v"(fp8_unit_scale));
    bf16x8 At[4][2], B0[2][2], B1[2][2]; i32x8v At8[4], B08[2], B18[2];
    const char* cA = (const char*)g.A + (size_t)cur.pm * tstep + cur.kb; const char* cB = (const char*)g.Bt + (size_t)cur.pn * tstep + cur.kb;
    S.a_ready(cur);
    if constexpr (SP2) {
        PG8_STAGE(PG8_SB(0, 0), cB, voffB); PG8_STAGE(PG8_SB(0, 1), cB + hstep, voffB); PG8_STAGE(PG8_SA(0, 0), cA, voffA); PG8_STAGE(PG8_SA(0, 1), cA + hstep, voffA);
        if (wr == 1) PG8_BAR;
        PG8_WAIT_V(2); PG8_BAR;
        PG8_STAGE(PG8_SB(1, 0), cB + kstep, voffB); PG8_STAGE(PG8_SA(1, 0), cA + kstep, voffA); PG8_STAGE(PG8_SB(1, 1), cB + hstep + kstep, voffB);
        PG8_WAIT_V(6); PG8_BAR;
    } else {
        PG8_STAGE(PG8_SB(0, 0), cB, voffB); PG8_STAGE(PG8_SA(0, 0), cA, voffA); PG8_STAGE(PG8_SB(0, 1), cB + hstep, voffB); PG8_STAGE(PG8_SA(0, 1), cA + hstep, voffA);
        if (wr == 1) PG8_BAR;
        PG8_WAIT_V(4); PG8_BAR;
        PG8_STAGE(PG8_SB(1, 0), cB + kstep, voffB); PG8_STAGE(PG8_SA(1, 0), cA + kstep, voffA); PG8_STAGE(PG8_SB(1, 1), cB + hstep + kstep, voffB);
        PG8_WAIT_V(6); PG8_BAR;
    }
    PG8_STAMP();
    for (;;) {
        const bool has_next = S.next(ui + 1, nxt);
        const char* nA = has_next ? (const char*)g.A + (size_t)nxt.pm * tstep + nxt.kb : cA; const char* nB = has_next ? (const char*)g.Bt + (size_t)nxt.pn * tstep + nxt.kb : cB;
        for (int t = 0; t < nt; t += 2) {
            const bool last = (t == nt - 2);
            const char* a1 = cA + (size_t)(t + 1) * kstep;
            const char* a2 = last ? nA : cA + (size_t)(t + 2) * kstep; const char* b2 = last ? nB : cB + (size_t)(t + 2) * kstep;
            const char* a3 = a2 + kstep; const char* b3 = b2 + kstep;
            if (last && has_next) S.a_ready(nxt);
            if constexpr (SP2) {
            PG8_LDB(B0, 0, 0); PG8_LDB(B1, 0, 1); PG8_SCHED; PG8_LDA(At, 0, 0); PG8_STAGE(PG8_SA(1, 1), a1 + hstep, voffA);
            PG8_WAIT_V(8); PG8_WAIT_L(0); PG8_BAR; PG8_MMA(0, 0, At, B0); PG8_MMA(0, 1, At, B1); PG8_BAR; PG8_SCHED;
            PG8_LDA(At, 0, 1); PG8_STAGE(PG8_SB(0, 0), b2, voffB); PG8_STAGE(PG8_SB(0, 1), b2 + hstep, voffB); PG8_STAGE(PG8_SA(0, 0), a2, voffA);
            PG8_WAIT_V(8); PG8_WAIT_L(0); PG8_BAR; PG8_MMA(1, 0, At, B0); PG8_MMA(1, 1, At, B1); PG8_BAR; PG8_SCHED;
            PG8_LDB(B0, 1, 0); PG8_LDB(B1, 1, 1); PG8_SCHED; PG8_LDA(At, 1, 0); PG8_STAGE(PG8_SA(0, 1), a2 + hstep, voffA);
            PG8_WAIT_V(8); PG8_WAIT_L(0); PG8_BAR; PG8_MMA(0, 0, At, B0); PG8_MMA(0, 1, At, B1); PG8_BAR; PG8_SCHED;
            PG8_LDA(At, 1, 1); PG8_STAGE(PG8_SB(1, 0), b3, voffB); PG8_STAGE(PG8_SB(1, 1), b3 + hstep, voffB); PG8_STAGE(PG8_SA(1, 0), a3, voffA);
            PG8_WAIT_V(8); PG8_WAIT_L(0); PG8_BAR; PG8_MMA(1, 0, At, B0); PG8_MMA(1, 1, At, B1); PG8_BAR; PG8_SCHED;
            } else {
            PG8_LDB(B0, 0, 0); PG8_SCHED; PG8_LDA(At, 0, 0); PG8_STAGE(PG8_SA(1, 1), a1 + hstep, voffA);
            PG8_WAIT_L(8); PG8_BAR; PG8_WAIT_L(0); PG8_MMA(0, 0, At, B0); PG8_BAR; PG8_SCHED;
            PG8_LDB(B1, 0, 1); PG8_STAGE(PG8_SB(0, 0), b2, voffB);
            PG8_BAR; PG8_WAIT_L(0); PG8_MMA(0, 1, At, B1); PG8_BAR;
            PG8_LDA(At, 0, 1); PG8_STAGE(PG8_SA(0, 0), a2, voffA);
            PG8_BAR; PG8_WAIT_L(0); PG8_MMA(1, 0, At, B0); PG8_BAR; PG8_SCHED;
            PG8_STAGE(PG8_SB(0, 1), b2 + hstep, voffB);
            PG8_WAIT_V(6); PG8_BAR; PG8_MMA(1, 1, At, B1); PG8_BAR;
            PG8_LDB(B0, 1, 0); PG8_SCHED; PG8_LDA(At, 1, 0); PG8_STAGE(PG8_SA(0, 1), a2 + hstep, voffA);
            PG8_WAIT_L(8); PG8_BAR; PG8_WAIT_L(0); PG8_MMA(0, 0, At, B0); PG8_BAR; PG8_SCHED;
            PG8_LDB(B1, 1, 1); PG8_STAGE(PG8_SB(1, 0), b3, voffB);
            PG8_BAR; PG8_WAIT_L(0); PG8_MMA(0, 1, At, B1); PG8_BAR;
            PG8_LDA(At, 1, 1); PG8_STAGE(PG8_SA(1, 0), a3, voffA);
            PG8_BAR; PG8_WAIT_L(0); PG8_MMA(1, 0, At, B0); PG8_BAR; PG8_SCHED;
            PG8_STAGE(PG8_SB(1, 1), b3 + hstep, voffB);
            PG8_WAIT_V(6); PG8_BAR; PG8_MMA(1, 1, At, B1); PG8_BAR;
            }
        }
        PG8_STAMP();
        if constexpr (ALIGN_EPI) { if (wr == 0) PG8_BAR; }
        if constexpr (FP8) asm volatile("s_nop 15\n\ts_nop 15" ::: "memory");
        if constexpr (!Epi::AFTER_DRAIN) { E(acc, cur, wr, wc, fr, fq); S.done(cur); }
        PG8_STAMP();
        if (!has_next) break;
#pragma unroll
        for (int a = 0; a < 2; ++a)
#pragma unroll
            for (int b = 0; b < 2; ++b)
#pragma unroll
                for (int m = 0; m < 4; ++m)
#pragma unroll
                    for (int n = 0; n < 2; ++n) acc[a][b][m][n] = (f32x4){0.f, 0.f, 0.f, 0.f};
        cur = nxt; cA = nA; cB = nB; ++ui;
        if constexpr (ALIGN_EPI) { if (wr == 1) PG8_BAR; }
    }
    PG8_WAIT_V(0);
    if constexpr (!ALIGN_EPI) { if (wr == 0) PG8_BAR; }
    PG8_BAR;
    if constexpr (Epi::AFTER_DRAIN) { E.fused(acc, cur, wr, wc, fr, fq, lds, wid, lane); S.done(cur); }
    PG8_STAMP();
    if (STAMP && wid == 0) { stamps[lane] = lane < nts ? (((unsigned long long)(unsigned)ts_hi << 32) | (unsigned)ts_lo) : 0ull;
        if (lane == 62) stamps[62] = rt_entry; if (lane == 63) stamps[63] = (unsigned long long)wall_clock64(); }
#undef PG8_STAMP
#undef PG8_SA
#undef PG8_SB
#undef PG8_STAGE
#undef PG8_LDA
#undef PG8_LDB
#undef PG8_MMA
#undef PG8_WAIT_V
#undef PG8_WAIT_L
#undef PG8_BAR
#undef PG8_SCHED
}
}

constexpr float HY_MIN_DECAY = -3.0701134573253944f;
constexpr float HY_MAX_DECAY = -15.350567286626972f;
constexpr float RET_SCALE = 0.08838834764831845f;

__device__ __forceinline__ void p0_mod_item(ARGS_REF a, int item, LAS unsigned char* lds) {
    const int tid = fresh_tid(), lane = tid & 63, wave = tid >> 6;
    const int l = item / 192, n0 = (item % 192) * 128;
    LAS float* sc = (LAS float*)lds;
    LAS float* red = (LAS float*)(lds + 81920);
    const float* c = a.in[1]; const float* cc = a.in[3];
    for (int i = tid; i < 5 * 4096; i += NTHREADS) { const int r = i >> 12, k = i & 4095; const float x = r < 4 ? c[r * 4096 + k] : cc[k]; sc[i] = silu_f(x); }
    __syncthreads();
    float acc[5][2];
#pragma unroll
    for (int r = 0; r < 5; ++r) { acc[r][0] = 0.f; acc[r][1] = 0.f; }
    const float* W = a.in[4] + (size_t)l * 4096 * NMOD + n0 + 2 * lane;
#pragma unroll 8
    for (int k = wave; k < 4096; k += 8) {
        const v2f w = *(const v2f*)(W + (size_t)k * NMOD);
#pragma unroll
        for (int r = 0; r < 5; ++r) { const float s = sc[r * 4096 + k]; acc[r][0] += s * w.x; acc[r][1] += s * w.y; }
    }
#pragma unroll
    for (int r = 0; r < 5; ++r) { red[(wave * 5 + r) * 128 + 2 * lane] = acc[r][0]; red[(wave * 5 + r) * 128 + 2 * lane + 1] = acc[r][1]; }
    __syncthreads();
    float* MOD = (float*)(a.ws + WS_MOD);
    for (int i = tid; i < 640; i += NTHREADS) {
        const int r = i >> 7, n = i & 127; float s = 0.f;
#pragma unroll
        for (int w = 0; w < 8; ++w) s += red[(w * 5 + r) * 128 + n];
        MOD[(size_t)(l * 5 + r) * NMOD + n0 + n] = s + a.in[5][(size_t)l * NMOD + n0 + n];
    }
    __syncthreads();
}

__device__ __forceinline__ void p0_filter_item(ARGS_REF a, int item, LAS unsigned char* lds) {
    const int tid = fresh_tid(), lane = tid & 63, wave = tid >> 6;
    const bool ctx = item >= 128; const int l = ctx ? 0 : item / 64; const int L = ctx ? 256 : 4096; const int t0 = (ctx ? item - 128 : item % 64) * 64;
    LAS float* z = (LAS float*)lds;
    LAS float* h1 = z + 64 * 33;
    LAS float* h2 = h1 + 64 * 64;
    const float* w1 = a.in[10] + l * 33 * 64; const float* b1 = a.in[11] + l * 64; const float* fq = a.in[12] + l * 64;
    const float* w2 = a.in[13] + l * 4096; const float* b2 = a.in[14] + l * 64; const float* w3 = a.in[15] + l * 4096; const float* b3 = a.in[16] + l * 64;
    const float* w4 = a.in[17] + (size_t)l * 64 * 4096;
    for (int i = tid; i < 64 * 33; i += NTHREADS) {
        const int tl = i / 33, j = i - tl * 33; const int t = t0 + tl; float val;
        if (j == 0) val = (float)t / (float)(L - 1);
        else { const int bi = (j - 1) & 15; const float f = 1e-4f + (float)bi * ((15.0f - 1e-4f) / 15.0f); const float turns = f * (float)t / (float)L;
               val = (j <= 16) ? cos_turns(turns) : -sin_turns(turns); }
        z[i] = val;
    }
    __syncthreads();
    const float frq = fq[lane];
#pragma unroll 1
    for (int i = 0; i < 8; ++i) { const int tl = wave + 8 * i; float s = b1[lane]; for (int q = 0; q < 33; ++q) s += z[tl * 33 + q] * w1[q * 64 + lane]; h1[tl * 64 + lane] = sin_rad(frq * s); }
    __syncthreads();
#pragma unroll 1
    for (int i = 0; i < 8; ++i) { const int tl = wave + 8 * i; float s = b2[lane]; for (int q = 0; q < 64; ++q) s += h1[tl * 64 + q] * w2[q * 64 + lane]; h2[tl * 64 + lane] = sin_rad(frq * s); }
    __syncthreads();
#pragma unroll 1
    for (int i = 0; i < 8; ++i) { const int tl = wave + 8 * i; float s = b3[lane]; for (int q = 0; q < 64; ++q) s += h2[tl * 64 + q] * w3[q * 64 + lane]; h1[tl * 64 + lane] = sin_rad(frq * s); }
    __syncthreads();
    float* KT = ctx ? (float*)(a.ws + WS_KTC) : (float*)(a.ws + WS_KT) + (size_t)l * 4096 * 4096;
#pragma unroll 1
    for (int ci = 0; ci < 8; ++ci) {
        const int col = tid + 512 * ci; const int c = col & 1023;
        float w[64];
#pragma unroll
        for (int j = 0; j < 64; ++j) w[j] = w4[j * 4096 + col];
        const float delta = fabsf(HY_MIN_DECAY + (HY_MAX_DECAY - HY_MIN_DECAY) * ((float)c / 1023.0f));
#pragma unroll 1
        for (int tl = 0; tl < 64; ++tl) {
            float s = 0.f;
#pragma unroll
            for (int j4 = 0; j4 < 16; ++j4) { const v4f hv = *(const LAS v4f*)(h1 + tl * 64 + j4 * 4); s += hv.x * w[j4 * 4] + hv.y * w[j4 * 4 + 1] + hv.z * w[j4 * 4 + 2] + hv.w * w[j4 * 4 + 3]; }
            const float tt = (float)(t0 + tl) / (float)(L - 1);
            KT[(size_t)col * L + t0 + tl] = s * __expf(-tt * delta);
        }
    }
    __syncthreads();
}

__device__ __forceinline__ void p0_tr_tile(const float* src, int N, bf16_t* dst, int KD, int k0, int n0, LAS unsigned char* lds) {
    const int tid = fresh_tid();
    LAS float* T = (LAS float*)lds;
#pragma unroll
    for (int i = 0; i < 4; ++i) {
        const int idx = tid + 512 * i; const int r = idx >> 5, c4 = idx & 31;
        const v4f v = *(const v4f*)(src + (size_t)(k0 + r) * N + n0 + c4 * 4);
        LAS float* p = T + r * 129 + c4 * 4; p[0] = v.x; p[1] = v.y; p[2] = v.z; p[3] = v.w;
    }
    __syncthreads();
    {
        const int n = tid >> 2, kc = (tid & 3) * 16; unsigned w[8];
#pragma unroll
        for (int j = 0; j < 8; ++j) w[j] = pack2bf(T[(kc + 2 * j) * 129 + n], T[(kc + 2 * j + 1) * 129 + n]);
        bf16_t* d = dst + (size_t)(n0 + n) * KD + k0 + kc;
        *(v4u*)d = make_v4u(w[0], w[1], w[2], w[3]); *(v4u*)(d + 8) = make_v4u(w[4], w[5], w[6], w[7]);
    }
    __syncthreads();
}

__device__ __forceinline__ void p0_tr_tile_fp8(const float* src, int N, unsigned char* dst, int KD, int k0, int n0, LAS unsigned char* lds) {
    const int tid = fresh_tid();
    LAS float* T = (LAS float*)lds;
#pragma unroll
    for (int i = 0; i < 4; ++i) {
        const int idx = tid + 512 * i; const int r = idx >> 5, c4 = idx & 31;
        const v4f v = *(const v4f*)(src + (size_t)(k0 + r) * N + n0 + c4 * 4);
        LAS float* p = T + r * 129 + c4 * 4; p[0] = v.x; p[1] = v.y; p[2] = v.z; p[3] = v.w;
    }
    __syncthreads();
    {
        const int n = tid >> 2, kc = (tid & 3) * 16; unsigned w[4];
#pragma unroll
        for (int j = 0; j < 4; ++j) w[j] = pack4fp8(T[(kc + 4 * j) * 129 + n], T[(kc + 4 * j + 1) * 129 + n], T[(kc + 4 * j + 2) * 129 + n], T[(kc + 4 * j + 3) * 129 + n]);
        *(v4u*)(dst + (size_t)(n0 + n) * KD + k0 + kc) = make_v4u(w[0], w[1], w[2], w[3]);
    }
    __syncthreads();
}

struct TrDesc { const float* src; unsigned char* dst; int N, KD, k0, n0, fp8; };
__device__ __forceinline__ TrDesc p0_tile_desc(ARGS_REF a, int idx) {
    TrDesc d;
    if (idx < 2 * 9984) {
        const int l = idx / 9984; int j = idx - l * 9984; d.fp8 = 0; d.KD = 4096;
        if (j < 6912) { d.src = a.in[7] + (size_t)l * 4096 * INC; d.N = INC; d.dst = a.ws + WS_WIN + (size_t)l * INC * 4096 * 2; d.k0 = (j / 108) * 64; d.n0 = (j % 108) * 128; }
        else if (j < 8960) { j -= 6912; d.src = a.in[23] + (size_t)l * 4096 * 4096; d.N = 4096; d.dst = a.ws + WS_WOUT + (size_t)l * 4096 * 4096 * 2; d.k0 = (j / 32) * 64; d.n0 = (j % 32) * 128; }
        else { j -= 8960; d.src = a.in[25] + (size_t)l * 4096 * PQ; d.N = PQ; d.dst = a.ws + WS_WQ + (size_t)l * PQ * 4096 * 2; d.k0 = (j / 16) * 64; d.n0 = (j % 16) * 128; }
    } else {
        idx -= 2 * 9984; const int l = idx >> 13, j = idx & 8191; d.fp8 = 1; d.KD = PN;
        d.src = a.in[28] + (size_t)l * PN * 4096; d.N = 4096; d.dst = a.ws + WS_VT + (size_t)l * PN * 4096; d.k0 = (j >> 5) * 64; d.n0 = (j & 31) * 128;
    }
    return d;
}
__device__ __forceinline__ void p0_tile_load(const TrDesc& d, int tid, v4f (&r)[4]) {
#pragma unroll
    for (int i = 0; i < 4; ++i) { const int idx = tid + 512 * i; const int rr = idx >> 5, c4 = idx & 31; r[i] = *(const v4f*)(d.src + (size_t)(d.k0 + rr) * d.N + d.n0 + c4 * 4); }
}
__device__ __forceinline__ void p0_prologue(ARGS_REF a, LAS unsigned char* lds, int pmode = 0) {
    const int tid = fresh_tid(); const int G = gridDim.x, bx = blockIdx.x;
    if (pmode == 0 || pmode == 1) for (int it = bx; it < 384; it += G) p0_mod_item(a, it, lds);
    if (pmode == 0 || pmode == 2) for (int it = G - 1 - bx; it < 132; it += G) p0_filter_item(a, it, lds);
    if (pmode == 1 || pmode == 2) return;
    {
        constexpr int NP = (2 * 9984 + 16384) / 2;
        LAS float* T = (LAS float*)lds;
        volatile LAS int* slot = (volatile LAS int*)(lds + MISC_OFF + 64);
        unsigned* ctr = (unsigned*)(a.ws + WS_CTL) + CW_QUEUE + 64 * 40;
        v4f r[2][4], rn[2][4];
        int cur = bx, nxt = bx + G;
        TrDesc d0 = p0_tile_desc(a, cur < NP ? 2 * cur : 0), d1 = p0_tile_desc(a, cur < NP ? 2 * cur + 1 : 1);
        if (cur < NP) { p0_tile_load(d0, tid, r[0]); p0_tile_load(d1, tid, r[1]); }
#pragma unroll 1
        while (cur < NP) {
            TrDesc dn0 = d0, dn1 = d1;
            if (nxt < NP) { dn0 = p0_tile_desc(a, 2 * nxt); dn1 = p0_tile_desc(a, 2 * nxt + 1); p0_tile_load(dn0, tid, rn[0]); p0_tile_load(dn1, tid, rn[1]); }
            if (tid == 0) *slot = 2 * G + (int)atomicAdd(ctr, 1u);
#pragma unroll
            for (int h = 0; h < 2; ++h)
#pragma unroll
                for (int i = 0; i < 4; ++i) { const int idx = tid + 512 * i; const int rr = idx >> 5, c4 = idx & 31; LAS float* p = T + h * (64 * 129) + rr * 129 + c4 * 4; p[0] = r[h][i].x; p[1] = r[h][i].y; p[2] = r[h][i].z; p[3] = r[h][i].w; }
            __syncthreads();
            const int nn = __builtin_amdgcn_readfirstlane(*slot);
#pragma unroll
            for (int h = 0; h < 2; ++h) {
                const TrDesc& d = h ? d1 : d0; const LAS float* Th = T + h * (64 * 129);
                const int n = tid >> 2, kc = (tid & 3) * 16;
                if (d.fp8) {
                    unsigned w[4];
#pragma unroll
                    for (int j = 0; j < 4; ++j) w[j] = pack4fp8(Th[(kc + 4 * j) * 129 + n], Th[(kc + 4 * j + 1) * 129 + n], Th[(kc + 4 * j + 2) * 129 + n], Th[(kc + 4 * j + 3) * 129 + n]);
                    *(v4u*)(d.dst + (size_t)(d.n0 + n) * d.KD + d.k0 + kc) = make_v4u(w[0], w[1], w[2], w[3]);
                } else {
                    unsigned w[8];
#pragma unroll
                    for (int j = 0; j < 8; ++j) w[j] = pack2bf(Th[(kc + 2 * j) * 129 + n], Th[(kc + 2 * j + 1) * 129 + n]);
                    bf16_t* dd = (bf16_t*)d.dst + (size_t)(d.n0 + n) * d.KD + d.k0 + kc;
                    *(v4u*)dd = make_v4u(w[0], w[1], w[2], w[3]); *(v4u*)(dd + 8) = make_v4u(w[4], w[5], w[6], w[7]);
                }
            }
            __syncthreads();
#pragma unroll
            for (int h = 0; h < 2; ++h)
#pragma unroll
                for (int i = 0; i < 4; ++i) r[h][i] = rn[h][i];
            d0 = dn0; d1 = dn1; cur = nxt; nxt = nn;
        }
    }
    for (int it = bx; it < 32; it += G) {
        const float* kp = a.in[26] + (size_t)it * 128 * 128; bf16_t* kh = (bf16_t*)(a.ws + WS_KHL) + (size_t)it * 2 * 128 * 128; bf16_t* kl = kh + 128 * 128;
#pragma unroll
        for (int i = 0; i < 8; ++i) {
            const int idx4 = tid + 512 * i; const v4f x = *(const v4f*)(kp + idx4 * 4);
            const unsigned h01 = pack2bf(x.x, x.y), h23 = pack2bf(x.z, x.w);
            *(v2u*)(kh + idx4 * 4) = make_v2u(h01, h23);
            *(v2u*)(kl + idx4 * 4) = make_v2u(pack2bf(x.x - bflo(h01), x.y - bfhi(h01)), pack2bf(x.z - bflo(h23), x.w - bfhi(h23)));
        }
    }
    {
        const v4f* su = (const v4f*)a.in[27]; unsigned* du = (unsigned*)(a.ws + WS_UB);
        const size_t n4 = (size_t)2 * PN * 4096 / 4, stride = (size_t)G * NTHREADS;
        for (size_t i0 = (size_t)bx * NTHREADS + tid; i0 < n4; i0 += 8 * stride) {
            v4f x[8];
#pragma unroll
            for (int u = 0; u < 8; ++u) { const size_t i = i0 + u * stride; x[u] = su[i < n4 ? i : i0]; }
#pragma unroll
            for (int u = 0; u < 8; ++u) { const size_t i = i0 + u * stride; if (i < n4) du[i] = pack4fp8(x[u].x * U8_SCALE, x[u].y * U8_SCALE, x[u].z * U8_SCALE, x[u].w * U8_SCALE); }
        }
    }
}

__device__ __forceinline__ void norm_phase(ARGS_REF a, int l, int which, int nrows, int tmode = 0, const float* tgate = nullptr, float tsc = 1.0f) {
    const int tid = fresh_tid(), lane = tid & 63, wave = tid >> 6;
    const float* MOD = (const float*)(a.ws + WS_MOD);
    bf16_t* H = (bf16_t*)(a.ws + WS_H);
    const float* g = (which ? a.in[24] : a.in[6]) + l * 4096;
    const bool first = (l == 0 && which == 0);
    for (int row = blockIdx.x * 8 + wave; row < nrows; row += gridDim.x * 8) {
        const float* src; int r;
        if (row < TL) { src = (first ? a.in[0] : (const float*)a.out) + (size_t)row * 4096; r = row >> 12; }
        else { src = ((first || tmode == 1) ? a.in[2] : (const float*)(a.ws + WS_XC)) + (size_t)(row - TL) * 4096; r = 4; }
        const float* shift = MOD + (size_t)(l * 5 + r) * NMOD + (which ? 3 : 0) * 4096; const float* scale = shift + 4096;
        v4f v[16]; float ss = 0.f;
#pragma unroll
        for (int i = 0; i < 16; ++i) { v[i] = ((const v4f*)src)[i * 64 + lane]; ss += v[i].x * v[i].x + v[i].y * v[i].y + v[i].z * v[i].z + v[i].w * v[i].w; }
        if (tmode != 0 && row >= TL) {
            const float* part = (const float*)(a.ws + WS_PART) + (size_t)(row - TL) * 4096; ss = 0.f;
#pragma unroll
            for (int i = 0; i < 16; ++i) {
                const int j = (i * 64 + lane) * 4;
                v4f ps = *(const v4f*)(part + j);
#pragma unroll
                for (int s = 1; s < 4; ++s) ps += *(const v4f*)(part + (size_t)s * TC * 4096 + j);
                v[i] += *(const v4f*)(tgate + j) * tsc * ps;
                ss += v[i].x * v[i].x + v[i].y * v[i].y + v[i].z * v[i].z + v[i].w * v[i].w;
                if (tmode == 1) *(v4f*)((float*)(a.ws + WS_XC) + (size_t)(row - TL) * 4096 + j) = v[i];
            }
        }
        ss = wave_sum(ss);
        const float rs = rsqrtf(ss * (1.0f / 4096.0f) + EPS);
#pragma unroll
        for (int i = 0; i < 16; ++i) {
            const int j = (i * 64 + lane) * 4;
            const v4f gg = *(const v4f*)(g + j), sh = *(const v4f*)(shift + j), scl = *(const v4f*)(scale + j);
            const float o0 = v[i].x * rs * gg.x * (1.0f + scl.x) + sh.x, o1 = v[i].y * rs * gg.y * (1.0f + scl.y) + sh.y;
            const float o2 = v[i].z * rs * gg.z * (1.0f + scl.z) + sh.z, o3 = v[i].w * rs * gg.w * (1.0f + scl.w) + sh.w;
            *(v2u*)(H + (size_t)row * 4096 + j) = make_v2u(pack2bf(o0, o1), pack2bf(o2, o3));
            if (which) *(unsigned*)(a.ws + WS_HF8 + (size_t)row * 4096 + j) = pack4fp8(o0, o1, o2, o3);
        }
    }
}

struct EpiRes {
    static constexpr bool PERM = false, AFTER_DRAIN = false;
    const float* baseL; const float* baseC; float* outL; float* outC; const float* gate; float sc;
    __device__ __forceinline__ void operator()(const pg8::f32x4 (&acc)[2][2][4][2], const pg8::Unit& u, int wr, int wc, int fr, int fq) const {
        const int urow = u.pm * 256, row0 = urow + wr * 64 + fr, col0 = u.pn * 256 + wc * 32 + 4 * fq;
        const int r = urow < TL ? (urow >> 12) : 4;
        const float* bp0 = urow < TL ? baseL + (size_t)row0 * 4096 : baseC + (size_t)(row0 - TL) * 4096;
        float* op0 = urow < TL ? outL + (size_t)row0 * 4096 : outC + (size_t)(row0 - TL) * 4096;
        pg8::f32x4 gv[2][2];
#pragma unroll
        for (int bj = 0; bj < 2; ++bj)
#pragma unroll
            for (int n = 0; n < 2; ++n) gv[bj][n] = *(const pg8::f32x4*)(gate + (size_t)r * NMOD + col0 + bj * 128 + n * 16) * sc;
#pragma unroll
        for (int ai = 0; ai < 2; ++ai)
#pragma unroll
            for (int m2 = 0; m2 < 2; ++m2) {
                pg8::f32x4 bv[2][2][2];
#pragma unroll
                for (int mm = 0; mm < 2; ++mm)
#pragma unroll
                    for (int bj = 0; bj < 2; ++bj)
#pragma unroll
                        for (int n = 0; n < 2; ++n) bv[mm][bj][n] = *(const pg8::f32x4*)(bp0 + (size_t)(ai * 128 + (2 * m2 + mm) * 16) * 4096 + col0 + bj * 128 + n * 16);
                __builtin_amdgcn_sched_barrier(0);
#pragma unroll
                for (int mm = 0; mm < 2; ++mm)
#pragma unroll
                    for (int bj = 0; bj < 2; ++bj)
#pragma unroll
                        for (int n = 0; n < 2; ++n)
                            *(pg8::f32x4*)(op0 + (size_t)(ai * 128 + (2 * m2 + mm) * 16) * 4096 + col0 + bj * 128 + n * 16) = bv[mm][bj][n] + gv[bj][n] * acc[ai][bj][2 * m2 + mm][n];
                __builtin_amdgcn_sched_barrier(0);
            }
    }
};

struct EpiPart {
    static constexpr bool PERM = false, AFTER_DRAIN = false;
    float* P; int ldc, rows, kpb;
    __device__ __forceinline__ void operator()(const pg8::f32x4 (&acc)[2][2][4][2], const pg8::Unit& u, int wr, int wc, int fr, int fq) const {
        float* base = P + (size_t)(u.kb / kpb) * rows * ldc + (size_t)(u.pm * 256 + wr * 64 + fr) * ldc + u.pn * 256 + wc * 32 + 4 * fq;
#pragma unroll
        for (int ai = 0; ai < 2; ++ai)
#pragma unroll
            for (int m = 0; m < 4; ++m)
#pragma unroll
                for (int bj = 0; bj < 2; ++bj)
#pragma unroll
                    for (int n = 0; n < 2; ++n) *(pg8::f32x4*)(base + (size_t)(ai * 128 + m * 16) * ldc + bj * 128 + n * 16) = acc[ai][bj][m][n];
    }
};

struct EpiProj {
    static constexpr bool PERM = true, AFTER_DRAIN = false;
    bf16_t* O; bf16_t* UT;
    __device__ __forceinline__ void operator()(const pg8::f32x4 (&acc)[2][2][4][2], const pg8::Unit& u, int wr, int wc, int fr, int fq) const {
        const int row0 = u.pm * 256 + wr * 64 + fr, colt = u.pn * 256, col0 = colt + wc * 32 + 8 * fq;
        if (colt >= C_HY && colt < C_HY + 3072) {
#pragma unroll
            for (int ai = 0; ai < 2; ++ai)
#pragma unroll
                for (int m = 0; m < 4; ++m) {
                    const int row = row0 + ai * 128 + m * 16;
#pragma unroll
                    for (int bj = 0; bj < 2; ++bj) {
                        const pg8::f32x4 v0 = acc[ai][bj][m][0], v1 = acc[ai][bj][m][1];
                        const unsigned o = (unsigned)(col0 + bj * 128 - C_HY) * (unsigned)MT + (unsigned)row;
                        const unsigned w0 = pack2bf(v0[0], v0[1]), w1 = pack2bf(v0[2], v0[3]), w2 = pack2bf(v1[0], v1[1]), w3 = pack2bf(v1[2], v1[3]);
                        UT[o] = (bf16_t)(w0 & 0xffffu); UT[o + (unsigned)MT] = (bf16_t)(w0 >> 16); UT[o + 2u * (unsigned)MT] = (bf16_t)(w1 & 0xffffu); UT[o + 3u * (unsigned)MT] = (bf16_t)(w1 >> 16);
                        UT[o + 4u * (unsigned)MT] = (bf16_t)(w2 & 0xffffu); UT[o + 5u * (unsigned)MT] = (bf16_t)(w2 >> 16); UT[o + 6u * (unsigned)MT] = (bf16_t)(w3 & 0xffffu); UT[o + 7u * (unsigned)MT] = (bf16_t)(w3 >> 16);
                        __builtin_amdgcn_sched_barrier(0);
                    }
                }
        } else {
#pragma unroll
            for (int ai = 0; ai < 2; ++ai)
#pragma unroll
                for (int m = 0; m < 4; ++m) {
                    bf16_t* rowp = O + (size_t)(row0 + ai * 128 + m * 16) * INC + col0;
#pragma unroll
                    for (int bj = 0; bj < 2; ++bj) {
                        const pg8::f32x4 v0 = acc[ai][bj][m][0], v1 = acc[ai][bj][m][1];
                        *(v4u*)(rowp + bj * 128) = make_v4u(pack2bf(v0[0], v0[1]), pack2bf(v0[2], v0[3]), pack2bf(v1[0], v1[1]), pack2bf(v1[2], v1[3]));
                    }
                }
        }
    }
};

template <int NTN, int PER, int K, int LDA, int LDB, bool SWA = false, bool SWB = false>
__device__ __forceinline__ void mma_lds(const LAS bf16_t* A, const LAS bf16_t* Bt, f32x4_t (&acc)[PER], int wave, int fr, int fq) {
#pragma unroll
    for (int i = 0; i < PER; ++i) {
        const int tt = wave + 8 * i, tm = tt / NTN, tn = tt % NTN;
        const LAS bf16_t* ap = A + (tm * 16 + fr) * LDA + (SWA ? 0 : fq * 8); const LAS bf16_t* bp = Bt + (tn * 16 + fr) * LDB + (SWB ? 0 : fq * 8);
#pragma unroll
        for (int k0 = 0; k0 < K; k0 += 32) {
            const bf16x8_t av = *(const LAS bf16x8_t*)(ap + (SWA ? 8 * (fq ^ (tm & 3)) : 0) + k0);
            const bf16x8_t bv = *(const LAS bf16x8_t*)(bp + (SWB ? 8 * (fq ^ (tn & 3)) : 0) + k0);
            acc[i] = __builtin_amdgcn_mfma_f32_16x16x32_bf16(av, bv, acc[i], 0, 0, 0);
        }
        __builtin_amdgcn_sched_barrier(0);
    }
}

struct RetRaw { v2u qa[2], qb[2]; v2u ka[4], kb[4]; v2u vv[4]; };
__device__ __forceinline__ void ret_fetch(const bf16_t* P, int r0, int h, bool need_q, int tid, RetRaw& R) {
    if (need_q) {
#pragma unroll
        for (int it = 0; it < 2; ++it) {
            const int task = tid + 512 * it; const int t = task >> 4, half = (task >> 3) & 1, i0 = (task & 7) * 4;
            const bf16_t* src = P + (size_t)(r0 + t) * INC + C_RQ + h * 128 + half * 64 + i0;
            R.qa[it] = *(const v2u*)src; R.qb[it] = *(const v2u*)(src + 32);
        }
    }
    {
        const int s4 = tid >> 5, half = (tid >> 4) & 1, iq = (tid >> 1) & 7;
        const bf16_t* src = P + (size_t)(r0 + 4 * s4) * INC + C_RK + h * 128 + half * 64 + 4 * iq;
#pragma unroll
        for (int j = 0; j < 4; ++j) { R.ka[j] = *(const v2u*)(src + (size_t)j * INC); R.kb[j] = *(const v2u*)(src + (size_t)j * INC + 32); }
    }
    {
        const int s4 = tid >> 5, e4 = tid & 31;
        const bf16_t* src = P + (size_t)(r0 + 4 * s4) * INC + C_RV + h * 128 + 4 * e4;
#pragma unroll
        for (int j = 0; j < 4; ++j) R.vv[j] = *(const v2u*)(src + (size_t)j * INC);
    }
}
__device__ __forceinline__ void ret_stage(const RetRaw& R, int pos0, bool need_q, bool do_rope, int dir, float lg, int tid,
                                          LAS bf16_t* Qs, LAS bf16_t* Ks, LAS bf16_t* Ktd, LAS bf16_t* Vt, const LAS v2f* rope) {
    if (need_q) {
#pragma unroll
        for (int it = 0; it < 2; ++it) {
            const int task = tid + 512 * it; const int t = task >> 4, half = (task >> 3) & 1, i0 = (task & 7) * 4;
            const v2u wa = R.qa[it], wb = R.qb[it];
            const float av[4] = {bflo(wa.x), bfhi(wa.x), bflo(wa.y), bfhi(wa.y)}; const float bv[4] = {bflo(wb.x), bfhi(wb.x), bflo(wb.y), bfhi(wb.y)};
            float oa[4], ob[4];
            if (do_rope) {
                const int pos = half ? ((pos0 + t) & 63) : ((pos0 + t) >> 6);
#pragma unroll
                for (int q = 0; q < 4; ++q) { const v2f cs = rope[pos * 32 + i0 + q]; oa[q] = av[q] * cs.x - bv[q] * cs.y; ob[q] = av[q] * cs.y + bv[q] * cs.x; }
            } else {
#pragma unroll
                for (int q = 0; q < 4; ++q) { oa[q] = av[q]; ob[q] = bv[q]; }
            }
            *(LAS v2u*)(Qs + t * 136 + half * 64 + i0) = make_v2u(pack2bf(oa[0], oa[1]), pack2bf(oa[2], oa[3]));
            *(LAS v2u*)(Qs + t * 136 + half * 64 + 32 + i0) = make_v2u(pack2bf(ob[0], ob[1]), pack2bf(ob[2], ob[3]));
        }
    }
    {
        const int s4 = tid >> 5, half = (tid >> 4) & 1, iq = (tid >> 1) & 7, ab = tid & 1;
        float o[4][4];
#pragma unroll
        for (int j = 0; j < 4; ++j) {
            const int t = 4 * s4 + j; const v2u wa = R.ka[j], wb = R.kb[j];
            const float av[4] = {bflo(wa.x) * RET_SCALE, bfhi(wa.x) * RET_SCALE, bflo(wa.y) * RET_SCALE, bfhi(wa.y) * RET_SCALE};
            const float bv[4] = {bflo(wb.x) * RET_SCALE, bfhi(wb.x) * RET_SCALE, bflo(wb.y) * RET_SCALE, bfhi(wb.y) * RET_SCALE};
            if (do_rope) {
                const int pos = half ? ((pos0 + t) & 63) : ((pos0 + t) >> 6);
#pragma unroll
                for (int q = 0; q < 4; ++q) { const v2f cs = rope[pos * 32 + 4 * iq + q]; o[j][q] = ab ? (av[q] * cs.y + bv[q] * cs.x) : (av[q] * cs.x - bv[q] * cs.y); }
            } else {
#pragma unroll
                for (int q = 0; q < 4; ++q) o[j][q] = ab ? bv[q] : av[q];
            }
            if (need_q) *(LAS v2u*)(Ks + t * 136 + half * 64 + ab * 32 + 4 * iq) = make_v2u(pack2bf(o[j][0], o[j][1]), pack2bf(o[j][2], o[j][3]));
        }
        float kd[4];
#pragma unroll
        for (int j = 0; j < 4; ++j) { const int t = 4 * s4 + j; kd[j] = __expf(lg * (float)(dir ? t : 63 - t)); }
#pragma unroll
        for (int q = 0; q < 4; ++q)
            *(LAS v2u*)(Ktd + (half * 64 + ab * 32 + 4 * iq + q) * 72 + 4 * s4) = make_v2u(pack2bf(o[0][q] * kd[0], o[1][q] * kd[1]), pack2bf(o[2][q] * kd[2], o[3][q] * kd[3]));
    }
    {
        const int s4 = tid >> 5, e4 = tid & 31;
        const unsigned r0x = R.vv[0].x, r0y = R.vv[0].y, r1x = R.vv[1].x, r1y = R.vv[1].y, r2x = R.vv[2].x, r2y = R.vv[2].y, r3x = R.vv[3].x, r3y = R.vv[3].y;
        *(LAS v2u*)(Vt + (4 * e4 + 0) * 72 + 8 * ((s4 >> 1) ^ ((e4 >> 2) & 3)) + 4 * (s4 & 1)) = make_v2u((r0x & 0xffffu) | (r1x << 16), (r2x & 0xffffu) | (r3x << 16));
        *(LAS v2u*)(Vt + (4 * e4 + 1) * 72 + 8 * ((s4 >> 1) ^ ((e4 >> 2) & 3)) + 4 * (s4 & 1)) = make_v2u((r0x >> 16) | (r1x & 0xffff0000u), (r2x >> 16) | (r3x & 0xffff0000u));
        *(LAS v2u*)(Vt + (4 * e4 + 2) * 72 + 8 * ((s4 >> 1) ^ ((e4 >> 2) & 3)) + 4 * (s4 & 1)) = make_v2u((r0y & 0xffffu) | (r1y << 16), (r2y & 0xffffu) | (r3y << 16));
        *(LAS v2u*)(Vt + (4 * e4 + 3) * 72 + 8 * ((s4 >> 1) ^ ((e4 >> 2) & 3)) + 4 * (s4 & 1)) = make_v2u((r0y >> 16) | (r1y & 0xffff0000u), (r2y >> 16) | (r3y & 0xffff0000u));
    }
}

__device__ __forceinline__ void ret_item(ARGS_REF a, int l, int b, int h, int dir, bool cstream, LAS unsigned char* lds) {
    const int tid = fresh_tid(), lane = tid & 63, wave = tid >> 6, fr = lane & 15, fq = lane >> 4;
    LAS bf16_t* Qs  = (LAS bf16_t*)(lds);
    LAS bf16_t* Ks  = (LAS bf16_t*)(lds + 17408);
    LAS bf16_t* Ktd = (LAS bf16_t*)(lds + 34816);
    LAS bf16_t* Vt  = (LAS bf16_t*)(lds + 53248);
    LAS bf16_t* St  = (LAS bf16_t*)(lds + 71680);
    LAS float*  Af  = (LAS float*)(lds + 106496);
    LAS bf16_t* Pb  = (LAS bf16_t*)(lds + 123904);
    LAS v2f* rope = (LAS v2f*)(lds + 133120);
    volatile LAS int* slot = (volatile LAS int*)(lds + MISC_OFF + 128);
    const bf16_t* P = (const bf16_t*)(a.ws + WS_PROJ);
    float* OFd = (float*)(a.ws + WS_OF) + (size_t)dir * MT * 1536;
    const int L = cstream ? 256 : 4096, row0 = cstream ? TL + b * 256 : b * 4096, NCH = L / 64, crow0 = TL + b * 256;
    const int n_init = cstream ? 0 : 4, n_steps = n_init + NCH;
    __syncthreads();
    for (int i = tid; i < 2048; i += NTHREADS) {
        const int pos = i >> 5, fi = i & 31; const float inv = exp2f(-(float)fi * (13.287712379549449f / 32.0f));
        const float turns = ((float)pos * inv) * 0.15915494309189535f;
        rope[i] = make_v2f(cos_turns(turns), sin_turns(turns));
    }
    const float lg = -__expf(a.in[19][(l * 2 + dir) * 12 + h]);
    const float cdec = __expf(lg * 64.0f);
    f32x4_t Sacc[8];
#pragma unroll
    for (int i = 0; i < 8; ++i) Sacc[i] = (f32x4_t){0.f, 0.f, 0.f, 0.f};
#pragma unroll
    for (int i = 0; i < 8; ++i) *(LAS v2u*)(St + (wave * 16 + fr) * 136 + i * 16 + fq * 4) = make_v2u(0u, 0u);
    RetRaw R;
    {
        const bool init = 0 < n_init; const int ch = init ? (dir ? 3 : 0) : (dir ? NCH - 1 : 0);
        ret_fetch(P, init ? crow0 + ch * 64 : row0 + ch * 64, h, !init, tid, R);
    }
#pragma unroll 1
    for (int st = 0; st < n_steps; ++st) {
        const bool init = st < n_init; const int cc = init ? st : st - n_init;
        const int ch = init ? (dir ? 3 - cc : cc) : (dir ? NCH - 1 - cc : cc);
        const int r0 = init ? crow0 + ch * 64 : row0 + ch * 64, pos0 = ch * 64;
        __syncthreads();
        ret_stage(R, pos0, !init, !init && !cstream, dir, lg, tid, Qs, Ks, Ktd, Vt, rope);
        if (st + 1 < n_steps) {
            const bool ninit = st + 1 < n_init; const int ncc = ninit ? st + 1 : st + 1 - n_init;
            const int nch = ninit ? (dir ? 3 - ncc : ncc) : (dir ? NCH - 1 - ncc : ncc);
            ret_fetch(P, ninit ? crow0 + nch * 64 : row0 + nch * 64, h, !ninit, tid, R);
        }
        __syncthreads();
        if (init) {
#pragma unroll
            for (int i = 0; i < 8; ++i) Sacc[i] *= cdec;
            mma_lds<8, 8, 64, 72, 72, false, true>(Ktd, Vt, Sacc, wave, fr, fq);
            if (st + 1 == n_init) {
                __syncthreads();
#pragma unroll
                for (int i = 0; i < 8; ++i)
                    *(LAS v2u*)(St + (wave * 16 + fr) * 136 + i * 16 + fq * 4) = make_v2u(pack2bf(Sacc[i][0], Sacc[i][1]), pack2bf(Sacc[i][2], Sacc[i][3]));
            }
            continue;
        }
        {
            f32x4_t sa[2] = {(f32x4_t){0.f, 0.f, 0.f, 0.f}, (f32x4_t){0.f, 0.f, 0.f, 0.f}};
            mma_lds<4, 2, 128, 136, 136>(Qs, Ks, sa, wave, fr, fq);
#pragma unroll
            for (int i = 0; i < 2; ++i) { const int tt = wave + 8 * i, tm = tt >> 2, tn = tt & 3;
#pragma unroll
                for (int r = 0; r < 4; ++r) Af[(tm * 16 + fq * 4 + r) * 68 + tn * 16 + fr] = sa[i][r]; }
        }
        __syncthreads();
        for (int i = tid; i < 4096; i += NTHREADS) {
            const int ii = i >> 6, jj = i & 63; const int dd = dir ? jj - ii : ii - jj;
            const float val = dd >= 0 ? Af[ii * 68 + jj] * __expf(lg * (float)dd) : 0.f;
            Pb[ii * 72 + jj] = f2bf(val);
        }
        __syncthreads();
        f32x4_t o1[4];
#pragma unroll
        for (int i = 0; i < 4; ++i) o1[i] = (f32x4_t){0.f, 0.f, 0.f, 0.f};
        mma_lds<8, 4, 128, 136, 136>(Qs, St, o1, wave, fr, fq);
#pragma unroll
        for (int i = 0; i < 4; ++i) {
            const int tt = wave + 8 * i, tm = tt >> 3;
#pragma unroll
            for (int r = 0; r < 4; ++r) { const int il = tm * 16 + fq * 4 + r; o1[i][r] *= __expf(lg * (float)(dir ? 64 - il : il + 1)); }
        }
        mma_lds<8, 4, 64, 72, 72, false, true>(Pb, Vt, o1, wave, fr, fq);
#pragma unroll
        for (int i = 0; i < 8; ++i) Sacc[i] *= cdec;
        mma_lds<8, 8, 64, 72, 72, false, true>(Ktd, Vt, Sacc, wave, fr, fq);
        __syncthreads();
#pragma unroll
        for (int i = 0; i < 8; ++i)
            *(LAS v2u*)(St + (wave * 16 + fr) * 136 + i * 16 + fq * 4) = make_v2u(pack2bf(Sacc[i][0], Sacc[i][1]), pack2bf(Sacc[i][2], Sacc[i][3]));
#pragma unroll
        for (int i = 0; i < 4; ++i) {
            const int tt = wave + 8 * i, tm = tt >> 3, tn = tt & 7;
#pragma unroll
            for (int r = 0; r < 4; ++r) {
                const int il = tm * 16 + fq * 4 + r, e = tn * 16 + fr;
                __hip_atomic_store(OFd + (size_t)(r0 + il) * 1536 + h * 128 + e, o1[i][r], __ATOMIC_RELAXED, __HIP_MEMORY_SCOPE_AGENT);
            }
        }
    }
    asm volatile("s_waitcnt vmcnt(0)" ::: "memory");
    __syncthreads();
    if (tid == 0) {
        unsigned* cnt = (unsigned*)(a.ws + WS_CTL) + CW_RET + ((l * 2 + (cstream ? 1 : 0)) * 48 + b * 12 + h);
        *slot = (int)__hip_atomic_fetch_add(cnt, 1u, __ATOMIC_RELAXED, __HIP_MEMORY_SCOPE_AGENT);
    }
    __syncthreads();
    if (*slot == 1) {
        __builtin_amdgcn_fence(__ATOMIC_ACQUIRE, "agent");
        const float* OF0 = (const float*)(a.ws + WS_OF); const float* OF1 = OF0 + (size_t)MT * 1536;
        bf16_t* MIX = (bf16_t*)(a.ws + WS_MIX);
#pragma unroll 2
        for (int t = wave; t < L; t += 8) {
            const size_t row = (size_t)(row0 + t);
            const v2f x0 = *(const v2f*)(OF0 + row * 1536 + h * 128 + 2 * lane), x1 = *(const v2f*)(OF1 + row * 1536 + h * 128 + 2 * lane);
            const float y0 = x0.x + x1.x, y1 = x0.y + x1.y;
            const float ss = wave_sum(y0 * y0 + y1 * y1); const float rs = rsqrtf(ss * (1.0f / 128.0f) + EPS);
            const unsigned gw = *(const unsigned*)(P + row * INC + C_RG + h * 128 + 2 * lane);
            *(unsigned*)(MIX + row * 4096 + M_RO + h * 128 + 2 * lane) = pack2bf(y0 * rs * silu_f(bflo(gw)), y1 * rs * silu_f(bfhi(gw)));
        }
    }
    __syncthreads();
}

__device__ __forceinline__ void hy_conv8(const LAS float* U, const LAS float* G, int L, float (&y)[8]) {
    const int tb = 8 * fresh_tid();
#pragma unroll
    for (int j = 0; j < 8; ++j) y[j] = 0.f;
    if (tb < L) {
#pragma unroll 2
        for (int s0 = 0; s0 < L; s0 += 4) {
            const int base = tb - s0 + L;
            const v4f g0 = *(const LAS v4f*)(G + base - 4), g1 = *(const LAS v4f*)(G + base), g2 = *(const LAS v4f*)(G + base + 4);
            const v4f u = *(const LAS v4f*)(U + s0);
            const float g[12] = {g0.x, g0.y, g0.z, g0.w, g1.x, g1.y, g1.z, g1.w, g2.x, g2.y, g2.z, g2.w};
            const float uu[4] = {u.x, u.y, u.z, u.w};
#pragma unroll
            for (int j = 0; j < 8; ++j)
#pragma unroll
                for (int i = 0; i < 4; ++i) y[j] += g[4 + j - i] * uu[i];
        }
    }
}
__device__ __forceinline__ void hyena_item(ARGS_REF a, int l, int c, int b, bool cstream, LAS unsigned char* lds) {
    const int tid = fresh_tid();
    const int L = cstream ? 256 : 4096, row0 = cstream ? TL + b * 256 : b * 4096;
    LAS float* sv = (LAS float*)lds; LAS float* sx1 = sv + L; LAS float* sx2 = sx1 + L; LAS float* sz = sx2 + L; LAS float* G0 = sz + L; LAS float* G1 = G0 + 2 * L;
    const bf16_t* UT = (const bf16_t*)(a.ws + WS_UT);
    bf16_t* MIX = (bf16_t*)(a.ws + WS_MIX);
    const float* cw = a.in[8] + l * 3 * 3072; const float* cb = a.in[9] + l * 3072;
    const float* K = cstream ? (const float*)(a.ws + WS_KTC) : (const float*)(a.ws + WS_KT) + (size_t)l * 4096 * 4096;
    __syncthreads();
    for (int t = tid; t < L; t += NTHREADS) {
#pragma unroll
        for (int which = 0; which < 3; ++which) {
            const int chn = which * 1024 + c; float acc = cb[chn];
#pragma unroll
            for (int i = 0; i < 3; ++i) { const int tt = t + i - 1; if (tt >= 0 && tt < L) acc += cw[i * 3072 + chn] * bf2f(UT[(size_t)chn * MT + row0 + tt]); }
            (which == 0 ? sv : (which == 1 ? sx1 : sx2))[t] = acc;
        }
    }
    for (int i = tid; i < 2 * L; i += NTHREADS) {
        const int d = i - L;
        const size_t cf0 = (size_t)(0 * 1024 + c) * L, cb0 = (size_t)(1 * 1024 + c) * L, cf1 = (size_t)(2 * 1024 + c) * L, cb1 = (size_t)(3 * 1024 + c) * L;
        float v0 = 0.f, v1 = 0.f;
        if (d >= 0) { v0 = K[cf0 + d]; v1 = K[cf1 + d]; } else if (d > -L) { v0 = K[cb0 - d]; v1 = K[cb1 - d]; }
        G0[i] = v0; G1[i] = v1;
    }
    __syncthreads();
    const float skip0 = a.in[18][(l * 2 + 0) * 1024 + c], skip1 = a.in[18][(l * 2 + 1) * 1024 + c];
    float y[8];
    hy_conv8(sv, G0, L, y);
    if (8 * tid < L) {
#pragma unroll
        for (int j = 0; j < 8; ++j) { const int t = 8 * tid + j; sz[t] = sx1[t] * (y[j] + skip0 * sv[t]); }
    }
    __syncthreads();
    hy_conv8(sz, G1, L, y);
    if (8 * tid < L) {
#pragma unroll
        for (int j = 0; j < 8; ++j) { const int t = 8 * tid + j; MIX[(size_t)(row0 + t) * 4096 + M_HY + c] = f2bf(sx2[t] * (y[j] + skip1 * sz[t])); }
    }
    __syncthreads();
}


#define HY_DEV __device__ __forceinline__
#define HY_LDS LAS
__device__ __forceinline__ float hy_cos_turns(float t) { return __builtin_amdgcn_cosf(t); }
__device__ __forceinline__ float hy_sin_turns(float t) { return __builtin_amdgcn_sinf(t); }

#define HY_CPX_DEFINED
typedef float cpx __attribute__((ext_vector_type(2)));
__device__ __forceinline__ cpx cmk(float x, float y) { return (cpx){x, y}; }
#ifndef HY_CPX_DEFINED
struct __attribute__((aligned(8))) cpx { float x, y; };
HY_DEV cpx cmk(float x, float y) { cpx r; r.x = x; r.y = y; return r; }
#endif
HY_DEV cpx cadd(cpx a, cpx b) { return cmk(a.x + b.x, a.y + b.y); }
HY_DEV cpx csub(cpx a, cpx b) { return cmk(a.x - b.x, a.y - b.y); }
HY_DEV cpx cmul(cpx a, cpx b) { return cmk(a.x * b.x - a.y * b.y, a.x * b.y + a.y * b.x); }
HY_DEV cpx cmuli(cpx a, bool inv) { return inv ? cmk(-a.y, a.x) : cmk(a.y, -a.x); }
constexpr int HY_N = 8192, HY_BUFN = 8192 + 256;
HY_DEV int hy_pad(int p) { return p + (p >> 5); }
HY_DEV int hy_freq(int p) { return (p >> 9) | (((p >> 5) & 15) << 4) | (((p >> 1) & 15) << 8) | ((p & 1) << 12); }
HY_DEV int hy_pos(int w) { return ((w & 15) << 9) | (((w >> 4) & 15) << 5) | (((w >> 8) & 15) << 1) | (w >> 12); }

template <bool INV> HY_DEV void dft16(cpx (&x)[16]) {
    const float C1 = 0.92387953251128674f, S1 = 0.38268343236508977f, R2 = 0.70710678118654752f;
    cpx u[4][4];
#pragma unroll
    for (int b = 0; b < 4; ++b) {
        const cpx t0 = cadd(x[b], x[8 + b]), t1 = csub(x[b], x[8 + b]), t2 = cadd(x[4 + b], x[12 + b]), t3 = cmuli(csub(x[4 + b], x[12 + b]), INV);
        u[b][0] = cadd(t0, t2); u[b][2] = csub(t0, t2); u[b][1] = cadd(t1, t3); u[b][3] = csub(t1, t3);
    }
    const float sg = INV ? 1.0f : -1.0f;
    u[1][1] = cmul(u[1][1], cmk(C1, sg * S1));  u[1][2] = cmul(u[1][2], cmk(R2, sg * R2));  u[1][3] = cmul(u[1][3], cmk(S1, sg * C1));
    u[2][1] = cmul(u[2][1], cmk(R2, sg * R2));  u[2][2] = cmuli(u[2][2], INV);              u[2][3] = cmul(u[2][3], cmk(-R2, sg * R2));
    u[3][1] = cmul(u[3][1], cmk(S1, sg * C1));  u[3][2] = cmul(u[3][2], cmk(-R2, sg * R2)); u[3][3] = cmul(u[3][3], cmk(-C1, -sg * S1));
#pragma unroll
    for (int c = 0; c < 4; ++c) {
        const cpx t0 = cadd(u[0][c], u[2][c]), t1 = csub(u[0][c], u[2][c]), t2 = cadd(u[1][c], u[3][c]), t3 = cmuli(csub(u[1][c], u[3][c]), INV);
        x[c] = cadd(t0, t2); x[c + 8] = csub(t0, t2); x[c + 4] = cadd(t1, t3); x[c + 12] = csub(t1, t3);
    }
}
template <bool INV> HY_DEV void hy_twiddle(cpx (&x)[16], int j, int n) {
    const float turns = (float)j / (float)n;
    const cpx w1 = cmk(hy_cos_turns(turns), INV ? hy_sin_turns(turns) : -hy_sin_turns(turns));
    cpx w = w1;
#pragma unroll
    for (int q = 1; q < 16; ++q) { x[q] = cmul(x[q], w); w = cmul(w, w1); }
}
template <bool LOAD> HY_DEV void hy_fwd16(int tid, int n, HY_LDS cpx* Z, cpx (&x)[16]) {
    const int m = n >> 4, blk = tid / m, j = tid - blk * m, base = blk * n + j;
    const int bp = hy_pad(base), S = m + (m >> 5);
    if (LOAD) {
#pragma unroll
        for (int k = 0; k < 16; ++k) x[k] = Z[bp + k * S];
    }
    dft16<false>(x);
    hy_twiddle<false>(x, j, n);
#pragma unroll
    for (int q = 0; q < 16; ++q) Z[bp + q * S] = x[q];
}
template <bool STORE> HY_DEV void hy_inv16(int tid, int n, HY_LDS cpx* Z, cpx (&x)[16]) {
    const int m = n >> 4, blk = tid / m, j = tid - blk * m, base = blk * n + j;
    const int bp = hy_pad(base), S = m + (m >> 5);
#pragma unroll
    for (int q = 0; q < 16; ++q) x[q] = Z[bp + q * S];
    hy_twiddle<true>(x, j, n);
    dft16<true>(x);
    if (STORE) {
#pragma unroll
        for (int k = 0; k < 16; ++k) Z[bp + k * S] = x[k];
    }
}
HY_DEV void hy_fwd2(int tid, HY_LDS cpx* Z) {
#pragma unroll
    for (int i = 0; i < 8; ++i) { const int pp = 16 * tid + (tid >> 1) + 2 * i; const cpx a = Z[pp], b = Z[pp + 1]; Z[pp] = cadd(a, b); Z[pp + 1] = csub(a, b); }
}
HY_DEV cpx hy_kfilter(const HY_LDS cpx* F, int p, int order) {
    const int w = hy_freq(p); const cpx A = F[hy_pad(p)], B = F[hy_pad(hy_pos((HY_N - w) & (HY_N - 1)))];
    return order == 0 ? cmk(0.5f * (A.x + B.x), 0.5f * (A.y - B.y)) : cmk(0.5f * (A.y + B.y), -0.5f * (A.x - B.x));
}
HY_DEV void hy_mid(int tid, HY_LDS cpx* Z, const HY_LDS cpx* F, int order, float scale) {
    const int wl = (tid >> 5) | (((tid >> 1) & 15) << 4), nl = (256 - wl) & 255;
    const int posb = ((nl & 15) << 9) | ((nl >> 4) << 5), bbase = posb + (posb >> 5), ch = (wl == 0 ? 32 : 31) - 8 * (tid & 1);
#pragma unroll
    for (int i = 0; i < 8; ++i) {
        const int p0 = 16 * tid + 2 * i, pp = p0 + (tid >> 1); const cpx a = Z[pp], b = Z[pp + 1];
        const int nh0 = (ch - i) & 31, nh1 = (ch - i - 16) & 31;
        const cpx A0 = F[pp], B0 = F[bbase + (((nh0 & 15) << 1) | (nh0 >> 4))], A1 = F[pp + 1], B1 = F[bbase + (((nh1 & 15) << 1) | (nh1 >> 4))];
        cpx k0 = order == 0 ? cmk(0.5f * (A0.x + B0.x), 0.5f * (A0.y - B0.y)) : cmk(0.5f * (A0.y + B0.y), -0.5f * (A0.x - B0.x));
        cpx k1 = order == 0 ? cmk(0.5f * (A1.x + B1.x), 0.5f * (A1.y - B1.y)) : cmk(0.5f * (A1.y + B1.y), -0.5f * (A1.x - B1.x));
        k0.x *= scale; k0.y *= scale; k1.x *= scale; k1.y *= scale;
        const cpx y0 = cmul(cadd(a, b), k0), y1 = cmul(csub(a, b), k1);
        Z[pp] = cadd(y0, y1); Z[pp + 1] = csub(y0, y1);
    }
}
__device__ __forceinline__ void hy_conv_fft(LAS cpx* Z, const LAS cpx* F, int order, cpx (&x)[16], int pmode = 0) {
    if (pmode == 1) return;
    hy_fwd16<false>(fresh_tid(), 8192, Z, x); __syncthreads();
    hy_fwd16<true>(fresh_tid(), 512, Z, x); __syncthreads();
    hy_fwd16<true>(fresh_tid(), 32, Z, x); __syncthreads();
    hy_mid(fresh_tid(), Z, F, order, 1.0f / 8192.0f); __syncthreads();
    hy_inv16<true>(fresh_tid(), 32, Z, x); __syncthreads();
    hy_inv16<true>(fresh_tid(), 512, Z, x); __syncthreads();
    hy_inv16<false>(fresh_tid(), 8192, Z, x);
}
__device__ __forceinline__ void hy_load_short(const bf16_t* U0, const bf16_t* U1, float w0, float w1, float w2, float bias, int tid, cpx (&o)[8]) {
    const int lane = tid & 63, tb = tid - lane;
    unsigned c0[8], c1[8], e0[8], e1[8];
#pragma unroll
    for (int k = 0; k < 8; ++k) {
        const int t = tid + 512 * k, ter = (lane < 32) ? (tb + 512 * k - 1) : (tb + 512 * k + 64), te = ter < 0 ? 0 : (ter > 4095 ? 4095 : ter);
        c0[k] = U0[t]; c1[k] = U1[t]; e0[k] = U0[te]; e1[k] = U1[te];
    }
#pragma unroll
    for (int k = 0; k < 8; ++k) {
        const int ter = (lane < 32) ? (tb + 512 * k - 1) : (tb + 512 * k + 64); const bool ev = (ter >= 0) && (ter <= 4095);
        const unsigned m0 = ev ? e0[k] : 0u, m1 = ev ? e1[k] : 0u;
        const unsigned l0 = (unsigned)__builtin_amdgcn_update_dpp((int)m0, (int)c0[k], 0x138, 0xf, 0xf, false), r0 = (unsigned)__builtin_amdgcn_update_dpp((int)m0, (int)c0[k], 0x130, 0xf, 0xf, false);
        const unsigned l1 = (unsigned)__builtin_amdgcn_update_dpp((int)m1, (int)c1[k], 0x138, 0xf, 0xf, false), r1 = (unsigned)__builtin_amdgcn_update_dpp((int)m1, (int)c1[k], 0x130, 0xf, 0xf, false);
        o[k] = cmk(bias + w0 * bf2f((bf16_t)l0) + w1 * bf2f((bf16_t)c0[k]) + w2 * bf2f((bf16_t)r0), bias + w0 * bf2f((bf16_t)l1) + w1 * bf2f((bf16_t)c1[k]) + w2 * bf2f((bf16_t)r1));
    }
}
__device__ __forceinline__ void hyena_fft_item(ARGS_REF a, int l, int c4, LAS unsigned char* lds, int pmode = 0) {
    LAS cpx* F = (LAS cpx*)lds; LAS cpx* Z = F + HY_BUFN;
    const bf16_t* UT = (const bf16_t*)(a.ws + WS_UT);
    bf16_t* MIX = (bf16_t*)(a.ws + WS_MIX);
    const float* cw = a.in[8] + l * 3 * 3072; const float* cb = a.in[9] + l * 3072;
    const float* K = (const float*)(a.ws + WS_KT) + (size_t)l * 4096 * 4096;
    unsigned olo[2][8][2], ohi[2][8][2];
#pragma unroll
    for (int i = 0; i < 2; ++i)
#pragma unroll
        for (int k = 0; k < 8; ++k) { olo[i][k][0] = 0u; olo[i][k][1] = 0u; ohi[i][k][0] = 0u; ohi[i][k][1] = 0u; }
#pragma unroll 1
    for (int ci = 0; ci < 4; ++ci) {
        const int c = 4 * c4 + ci;
        const float skip0 = a.in[18][(l * 2 + 0) * 1024 + c], skip1 = a.in[18][(l * 2 + 1) * 1024 + c];
        __syncthreads();
        cpx x[16];
        {
            const int tid = fresh_tid();
            const float* kf0 = K + (size_t)(0 * 1024 + c) * 4096; const float* kb0 = K + (size_t)(1 * 1024 + c) * 4096;
            const float* kf1 = K + (size_t)(2 * 1024 + c) * 4096; const float* kb1 = K + (size_t)(3 * 1024 + c) * 4096;
#pragma unroll
            for (int k = 0; k < 8; ++k) x[k] = cmk(kf0[tid + 512 * k], kf1[tid + 512 * k]);
#pragma unroll
            for (int k = 8; k < 16; ++k) { const int i = tid + 512 * k; const int ii = (i == 4096) ? 1 : 8192 - i; const cpx v = cmk(kb0[ii], kb1[ii]); x[k] = (i == 4096) ? cmk(0.f, 0.f) : v; }
            hy_fwd16<false>(fresh_tid(), 8192, F, x); __syncthreads();
            hy_fwd16<true>(fresh_tid(), 512, F, x); __syncthreads();
            hy_fwd16<true>(fresh_tid(), 32, F, x); __syncthreads();
            hy_fwd2(fresh_tid(), F); __syncthreads();
        }
#pragma unroll
        for (int bp = 0; bp < 2; ++bp) {
            const int rb0 = (2 * bp) * 4096, rb1 = (2 * bp + 1) * 4096;
            unsigned vvp[8], z1p[8];
            {
                cpx vv[8];
                const int chn = c; hy_load_short(UT + (size_t)chn * MT + rb0, UT + (size_t)chn * MT + rb1, cw[chn], cw[3072 + chn], cw[2 * 3072 + chn], cb[chn], fresh_tid(), vv);
#pragma unroll
                for (int k = 0; k < 8; ++k) { x[k] = vv[k]; x[k + 8] = cmk(0.f, 0.f); vvp[k] = pack2bf(vv[k].x, vv[k].y); }
            }
            hy_conv_fft(Z, F, 0, x, pmode);
            {
                cpx x1v[8];
                const int chn = 1024 + c; hy_load_short(UT + (size_t)chn * MT + rb0, UT + (size_t)chn * MT + rb1, cw[chn], cw[3072 + chn], cw[2 * 3072 + chn], cb[chn], fresh_tid(), x1v);
#pragma unroll
                for (int k = 0; k < 8; ++k) {
                    const cpx z = cmk(x1v[k].x * (x[k].x + skip0 * bflo(vvp[k])), x1v[k].y * (x[k].y + skip0 * bfhi(vvp[k])));
                    x[k] = z; x[k + 8] = cmk(0.f, 0.f); z1p[k] = pack2bf(z.x, z.y);
                }
            }
            __syncthreads();
            hy_conv_fft(Z, F, 1, x, pmode);
            {
                cpx x2v[8];
                const int chn = 2048 + c; hy_load_short(UT + (size_t)chn * MT + rb0, UT + (size_t)chn * MT + rb1, cw[chn], cw[3072 + chn], cw[2 * 3072 + chn], cb[chn], fresh_tid(), x2v);
                const unsigned sh = (ci & 1) ? 16u : 0u;
#pragma unroll
                for (int k = 0; k < 8; ++k) {
                    const unsigned w0 = (unsigned)f2bf(x2v[k].x * (x[k].x + skip1 * bflo(z1p[k]))) << sh, w1 = (unsigned)f2bf(x2v[k].y * (x[k].y + skip1 * bfhi(z1p[k]))) << sh;
                    if (ci < 2) { olo[bp][k][0] |= w0; olo[bp][k][1] |= w1; } else { ohi[bp][k][0] |= w0; ohi[bp][k][1] |= w1; }
                }
            }
            __syncthreads();
        }
    }
    if (pmode == 0 || pmode == 3) {
        const int tid = fresh_tid();
#pragma unroll
        for (int bp = 0; bp < 2; ++bp)
#pragma unroll
            for (int k = 0; k < 8; ++k) {
                const int t = tid + 512 * k;
                *(v2u*)(MIX + (size_t)((2 * bp) * 4096 + t) * 4096 + M_HY + 4 * c4) = make_v2u(olo[bp][k][0], ohi[bp][k][0]);
                *(v2u*)(MIX + (size_t)((2 * bp + 1) * 4096 + t) * 4096 + M_HY + 4 * c4) = make_v2u(olo[bp][k][1], ohi[bp][k][1]);
            }
    }
}

__device__ __forceinline__ void hy_ctx_conv2(const LAS float* U, const LAS float* G, int t2, float (&y)[2]) {
    y[0] = 0.f; y[1] = 0.f;
#pragma unroll 4
    for (int s0 = 0; s0 < 256; s0 += 4) {
        const int base = t2 - s0 + 256; const v4f u = *(const LAS v4f*)(U + s0);
        const float g0 = G[base - 3], g1 = G[base - 2], g2 = G[base - 1], g3 = G[base], g4 = G[base + 1];
        y[0] += g3 * u.x + g2 * u.y + g1 * u.z + g0 * u.w;
        y[1] += g4 * u.x + g3 * u.y + g2 * u.z + g1 * u.w;
    }
}
__device__ __forceinline__ void hyena_ctx_item(ARGS_REF a, int l, int c, LAS unsigned char* lds) {
    const int tid = fresh_tid();
    LAS float* G0 = (LAS float*)lds; LAS float* G1 = G0 + 512;
    LAS float* sv = G1 + 512; LAS float* sx1 = sv + 1024; LAS float* sx2 = sx1 + 1024; LAS float* sz = sx2 + 1024;
    const bf16_t* UT = (const bf16_t*)(a.ws + WS_UT);
    bf16_t* MIX = (bf16_t*)(a.ws + WS_MIX);
    const float* cw = a.in[8] + l * 3 * 3072; const float* cb = a.in[9] + l * 3072;
    const float* K = (const float*)(a.ws + WS_KTC);
    __syncthreads();
#pragma unroll
    for (int i = 0; i < 2; ++i) {
        const int idx = tid + 512 * i; const int b = idx >> 8, t = idx & 255, tm = t > 0 ? t - 1 : 0, tp = t < 255 ? t + 1 : 255;
        const float m0 = t > 0 ? 1.f : 0.f, m2 = t < 255 ? 1.f : 0.f;
#pragma unroll
        for (int which = 0; which < 3; ++which) {
            const int chn = which * 1024 + c; const bf16_t* U = UT + (size_t)chn * MT + TL + b * 256;
            const float val = cb[chn] + cw[chn] * m0 * bf2f(U[tm]) + cw[3072 + chn] * bf2f(U[t]) + cw[2 * 3072 + chn] * m2 * bf2f(U[tp]);
            (which == 0 ? sv : (which == 1 ? sx1 : sx2))[idx] = val;
        }
    }
    {
        const int d = tid - 256, dd = d >= 0 ? d : -d, ok = (d > -256) ? 1 : 0;
        const float f0 = K[(size_t)(0 * 1024 + c) * 256 + dd], b0 = K[(size_t)(1 * 1024 + c) * 256 + dd], f1 = K[(size_t)(2 * 1024 + c) * 256 + dd], b1 = K[(size_t)(3 * 1024 + c) * 256 + dd];
        G0[tid] = ok ? (d >= 0 ? f0 : b0) : 0.f; G1[tid] = ok ? (d >= 0 ? f1 : b1) : 0.f;
    }
    __syncthreads();
    const float skip0 = a.in[18][(l * 2 + 0) * 1024 + c], skip1 = a.in[18][(l * 2 + 1) * 1024 + c];
    const int b = tid >> 7, t2 = (tid & 127) * 2;
    float y[2];
    hy_ctx_conv2(sv + b * 256, G0, t2, y);
    sz[b * 256 + t2] = sx1[b * 256 + t2] * (y[0] + skip0 * sv[b * 256 + t2]); sz[b * 256 + t2 + 1] = sx1[b * 256 + t2 + 1] * (y[1] + skip0 * sv[b * 256 + t2 + 1]);
    __syncthreads();
    hy_ctx_conv2(sz + b * 256, G1, t2, y);
    MIX[(size_t)(TL + b * 256 + t2) * 4096 + M_HY + c] = f2bf(sx2[b * 256 + t2] * (y[0] + skip1 * sz[b * 256 + t2]));
    MIX[(size_t)(TL + b * 256 + t2 + 1) * 4096 + M_HY + c] = f2bf(sx2[b * 256 + t2 + 1] * (y[1] + skip1 * sz[b * 256 + t2 + 1]));
    __syncthreads();
}

struct NaRaw { v4u k[4]; v2u v[2][4]; };
__device__ __forceinline__ void na_fetch(const bf16_t* P, int krow0, int h, int tid, NaRaw& R) {
#pragma unroll
    for (int i = 0; i < 4; ++i) { const int idx = tid + 512 * i; const int kr = idx >> 4, c8 = idx & 15; R.k[i] = *(const v4u*)(P + (size_t)(krow0 + kr) * INC + C_NK + h * 128 + c8 * 8); }
#pragma unroll
    for (int it = 0; it < 2; ++it) {
        const int task = tid + 512 * it; const int s4 = task >> 5, e4 = task & 31;
        const bf16_t* src = P + (size_t)(krow0 + 4 * s4) * INC + C_NV + h * 128 + 4 * e4;
#pragma unroll
        for (int j = 0; j < 4; ++j) R.v[it][j] = *(const v2u*)(src + (size_t)j * INC);
    }
}
__device__ __forceinline__ void na_stage(const NaRaw& R, int tid, LAS bf16_t* Kb, LAS bf16_t* Vt) {
#pragma unroll
    for (int i = 0; i < 4; ++i) { const int idx = tid + 512 * i; const int kr = idx >> 4, c8 = idx & 15; *(LAS v4u*)(Kb + kr * 136 + c8 * 8) = R.k[i]; }
#pragma unroll
    for (int it = 0; it < 2; ++it) {
        const int task = tid + 512 * it; const int s4 = task >> 5, e4 = task & 31, sw = s4 ^ (e4 >> 2);
        const unsigned r0x = R.v[it][0].x, r0y = R.v[it][0].y, r1x = R.v[it][1].x, r1y = R.v[it][1].y, r2x = R.v[it][2].x, r2y = R.v[it][2].y, r3x = R.v[it][3].x, r3y = R.v[it][3].y;
        *(LAS v2u*)(Vt + (4 * e4 + 0) * 136 + 4 * sw) = make_v2u((r0x & 0xffffu) | (r1x << 16), (r2x & 0xffffu) | (r3x << 16));
        *(LAS v2u*)(Vt + (4 * e4 + 1) * 136 + 4 * sw) = make_v2u((r0x >> 16) | (r1x & 0xffff0000u), (r2x >> 16) | (r3x & 0xffff0000u));
        *(LAS v2u*)(Vt + (4 * e4 + 2) * 136 + 4 * sw) = make_v2u((r0y & 0xffffu) | (r1y << 16), (r2y & 0xffffu) | (r3y << 16));
        *(LAS v2u*)(Vt + (4 * e4 + 3) * 136 + 4 * sw) = make_v2u((r0y >> 16) | (r1y & 0xffff0000u), (r2y >> 16) | (r3y & 0xffff0000u));
    }
}
__device__ __forceinline__ void na_item(ARGS_REF a, int l, int b, int h, int r, bool cstream, LAS unsigned char* lds, int pmode = 0) {
    const int tid = fresh_tid(), lane = tid & 63, wave = tid >> 6, fr = lane & 15, fq = lane >> 4;
    LAS bf16_t* Qs = (LAS bf16_t*)lds;
    LAS bf16_t* Kb = (LAS bf16_t*)(lds + 17408);
    LAS bf16_t* Vt = (LAS bf16_t*)(lds + 52224);
    LAS float*  Sf = (LAS float*)(lds + 87040);
    LAS bf16_t* Pb = (LAS bf16_t*)(lds + 120832);
    LAS float*  rk = (LAS float*)(lds + 138240);
    LAS float*  st_m = rk + 128;
    LAS float*  st_l = st_m + 64;
    LAS float*  st_a = st_l + 64;
    LAS float*  rpbs = st_a + 64;
    const bf16_t* P = (const bf16_t*)(a.ws + WS_PROJ);
    bf16_t* MIX = (bf16_t*)(a.ws + WS_MIX);
    const int qrow0 = cstream ? TL + b * 256 + r * 64 : b * 4096 + r * 64;
    const float* gq = a.in[21] + l * 128; const float* gk = a.in[22] + l * 128;
    const float* rpb = a.in[20] + (size_t)(l * 12 + h) * 15 * 31;
    const int nloc = cstream ? 0 : 4, start = clampi(r - 4, 0, 56), nsteps = nloc + 2;
    NaRaw R;
    na_fetch(P, cstream ? TL + b * 256 : b * 4096 + start * 64, h, tid, R);
    __syncthreads();
#pragma unroll 1
    for (int qq = 0; qq < 8; ++qq) {
        const int q = wave * 8 + qq; const bf16_t* p = P + (size_t)(qrow0 + q) * INC + C_NQ + h * 128;
        const unsigned w = *(const unsigned*)(p + 2 * lane); const float x0 = bflo(w), x1 = bfhi(w);
        const float ss = wave_sum(x0 * x0 + x1 * x1); const float rs = rsqrtf(ss * (1.0f / 128.0f) + EPS) * RET_SCALE;
        *(LAS unsigned*)(Qs + q * 136 + 2 * lane) = pack2bf(x0 * rs * gq[2 * lane] * gk[2 * lane], x1 * rs * gq[2 * lane + 1] * gk[2 * lane + 1]);
    }
    if (tid < 64) { st_m[tid] = -1.0e30f; st_l[tid] = 0.f; }
    if (tid < 465) rpbs[tid] = rpb[tid];
    f32x4_t O[4];
#pragma unroll
    for (int i = 0; i < 4; ++i) O[i] = (f32x4_t){0.f, 0.f, 0.f, 0.f};
#pragma unroll 1
    for (int st = 0; st < nsteps; ++st) {
        const bool local = st < nloc;
        __syncthreads();
        na_stage(R, tid, Kb, Vt);
        if (st + 1 < nsteps) { const bool nl = st + 1 < nloc; na_fetch(P, nl ? b * 4096 + (start + 2 * (st + 1)) * 64 : TL + b * 256 + (st + 1 - nloc) * 128, h, tid, R); }
        __syncthreads();
        if (pmode == 4) continue;
        {
            const int key = tid >> 2, part = tid & 3; float ss = 0.f;
#pragma unroll
            for (int i = 0; i < 4; ++i) { const v4u w = *(const LAS v4u*)(Kb + key * 136 + part * 32 + i * 8);
                ss += bflo(w.x) * bflo(w.x) + bfhi(w.x) * bfhi(w.x) + bflo(w.y) * bflo(w.y) + bfhi(w.y) * bfhi(w.y) + bflo(w.z) * bflo(w.z) + bfhi(w.z) * bfhi(w.z) + bflo(w.w) * bflo(w.w) + bfhi(w.w) * bfhi(w.w); }
            ss += WAVE_DPP(ss, 0xB1); ss += WAVE_DPP(ss, 0x4E);
            if (part == 0) rk[key] = rsqrtf(ss * (1.0f / 128.0f) + EPS);
            f32x4_t sa[4];
#pragma unroll
            for (int i = 0; i < 4; ++i) sa[i] = (f32x4_t){0.f, 0.f, 0.f, 0.f};
            mma_lds<8, 4, 128, 136, 136>(Qs, Kb, sa, wave, fr, fq);
#pragma unroll
            for (int i = 0; i < 4; ++i)
#pragma unroll
                for (int rr = 0; rr < 4; ++rr) Sf[(i * 16 + fq * 4 + rr) * 132 + wave * 16 + fr] = sa[i][rr];
        }
        __syncthreads();
        if (pmode == 5) continue;
        {
            const int q = tid >> 3, part = tid & 7, col0 = part * 16;
            float s[16]; float mx = -1.0e30f;
            if (local) {
                const int cs = clampi(q - 8, 0, 48), kc0 = (part & 3) * 16, ridx = start + 2 * st + (part >> 2) - r + 7;
#pragma unroll
                for (int j4 = 0; j4 < 4; ++j4) {
                    const v4f sv = *(const LAS v4f*)(Sf + q * 132 + col0 + 4 * j4), kv = *(const LAS v4f*)(rk + col0 + 4 * j4);
#pragma unroll
                    for (int jj = 0; jj < 4; ++jj) {
                        const int kc = kc0 + 4 * j4 + jj; const bool ok = (kc >= cs) && (kc < cs + 16);
                        const float v = sv[jj] * kv[jj] + rpbs[ridx * 31 + clampi(kc - q + 15, 0, 30)];
                        s[4 * j4 + jj] = ok ? v : -1.0e30f; mx = fmaxf(mx, s[4 * j4 + jj]);
                    }
                }
            } else {
#pragma unroll
                for (int j4 = 0; j4 < 4; ++j4) {
                    const v4f sv = *(const LAS v4f*)(Sf + q * 132 + col0 + 4 * j4), kv = *(const LAS v4f*)(rk + col0 + 4 * j4);
#pragma unroll
                    for (int jj = 0; jj < 4; ++jj) { s[4 * j4 + jj] = sv[jj] * kv[jj]; mx = fmaxf(mx, s[4 * j4 + jj]); }
                }
            }
            mx = fmaxf(mx, WAVE_DPP(mx, 0xB1)); mx = fmaxf(mx, WAVE_DPP(mx, 0x4E)); mx = fmaxf(mx, WAVE_DPP(mx, 0x141));
            const float mo = st_m[q], mn = fmaxf(mo, mx);
            float sum = 0.f; unsigned pw[8];
#pragma unroll
            for (int j2 = 0; j2 < 8; ++j2) { const float p0 = __expf(s[2 * j2] - mn), p1 = __expf(s[2 * j2 + 1] - mn); sum += p0 + p1; pw[j2] = pack2bf(p0, p1); }
            *(LAS v4u*)(Pb + q * 136 + col0) = make_v4u(pw[0], pw[1], pw[2], pw[3]); *(LAS v4u*)(Pb + q * 136 + col0 + 8) = make_v4u(pw[4], pw[5], pw[6], pw[7]);
            sum += WAVE_DPP(sum, 0xB1); sum += WAVE_DPP(sum, 0x4E); sum += WAVE_DPP(sum, 0x141);
            const float al = __expf(mo - mn);
            if (part == 0) { st_m[q] = mn; st_l[q] = st_l[q] * al + sum; st_a[q] = al; }
        }
        __syncthreads();
        if (pmode == 6) continue;
#pragma unroll
        for (int i = 0; i < 4; ++i)
#pragma unroll
            for (int rr = 0; rr < 4; ++rr) O[i][rr] *= st_a[i * 16 + fq * 4 + rr];
        mma_lds<8, 4, 128, 136, 136>(Pb, Vt, O, wave, fr, fq);
    }
    __syncthreads();
    if (pmode >= 4) return;
#pragma unroll
    for (int i = 0; i < 4; ++i)
#pragma unroll
        for (int rr = 0; rr < 4; ++rr) { const int q = i * 16 + fq * 4 + rr; MIX[(size_t)(qrow0 + q) * 4096 + M_NO + h * 128 + wave * 16 + fr] = f2bf(O[i][rr] / st_l[q]); }
    __syncthreads();
}

__device__ __forceinline__ void na2_fetch(const bf16_t* P, int rowA, int rowB, int h, int tid, NaRaw& R) {
#pragma unroll
    for (int i = 0; i < 4; ++i) { const int idx = tid + 512 * i; const int kr = idx >> 4, c8 = idx & 15; const int row = kr < 64 ? rowA + kr : rowB + kr - 64;
        R.k[i] = *(const v4u*)(P + (size_t)row * INC + C_NK + h * 128 + c8 * 8); }
#pragma unroll
    for (int it = 0; it < 2; ++it) {
        const int task = tid + 512 * it; const int s4 = task >> 5, e4 = task & 31; const int r0 = 4 * s4, row = r0 < 64 ? rowA + r0 : rowB + r0 - 64;
        const bf16_t* src = P + (size_t)row * INC + C_NV + h * 128 + 4 * e4;
#pragma unroll
        for (int j = 0; j < 4; ++j) R.v[it][j] = *(const v2u*)(src + (size_t)j * INC);
    }
}
__device__ __forceinline__ void na2_item(ARGS_REF a, int l, int b, int h, int rp, bool cstream, LAS unsigned char* lds, int namode = 0) {
    const int tid = fresh_tid(), lane = tid & 63, wave = tid >> 6, fr = lane & 15, fq = lane >> 4;
    LAS bf16_t* Qs = (LAS bf16_t*)lds;
    LAS bf16_t* Kb = (LAS bf16_t*)(lds + 34816);
    LAS bf16_t* Vt = (LAS bf16_t*)(lds + 69632);
    LAS float*  rk = (LAS float*)(lds + 104448);
    LAS float*  rpbs = rk + 128;
    LAS float*  alx = rpbs + 480;
    const bf16_t* P = (const bf16_t*)(a.ws + WS_PROJ);
    bf16_t* MIX = (bf16_t*)(a.ws + WS_MIX);
    const float* gqp = a.in[21] + l * 128; const float* gkp = a.in[22] + l * 128;
    const float* rpb = a.in[20] + (size_t)(l * 12 + h) * 15 * 31;
    const int r0 = 2 * rp, start0 = clampi(r0 - 4, 0, 56), start1 = clampi(r0 - 3, 0, 56);
    const int nloc = cstream ? 0 : ((start1 + 9 - start0) >> 1), nsteps = nloc + 2;
    const int qb0 = cstream ? TL + b * 256 + rp * 128 + 16 * wave : b * 4096 + r0 * 64 + 8 * wave;
#define NA2_QTOK(j) (cstream ? qb0 + (j) : qb0 + ((j) >> 3) * 64 + ((j) & 7))
    const int rq = r0 + (fr >> 3), startq = (fr < 8) ? start0 : start1, qcol = 8 * wave + (fr & 7), cs = clampi(qcol - 8, 0, 48);
    const int wu = __builtin_amdgcn_readfirstlane(wave), tlo = wu <= 2 ? 0 : (wu <= 4 ? 1 : 2);
#define NA2_ROWA(s) ((s) < nloc ? b * 4096 + (start0 + 2 * (s) < 63 ? start0 + 2 * (s) : 63) * 64 : TL + b * 256 + ((s) - nloc) * 128)
#define NA2_ROWB(s) ((s) < nloc ? b * 4096 + (start0 + 2 * (s) + 1 < 63 ? start0 + 2 * (s) + 1 : 63) * 64 : TL + b * 256 + ((s) - nloc) * 128 + 64)
    NaRaw R;
    na2_fetch(P, NA2_ROWA(0), NA2_ROWB(0), h, tid, R);
    __syncthreads();
    if (tid < 465) rpbs[tid] = rpb[tid];
    {
        const v4f g0 = *(const v4f*)(gqp + 8 * fr), g1 = *(const v4f*)(gqp + 8 * fr + 4), k0 = *(const v4f*)(gkp + 8 * fr), k1 = *(const v4f*)(gkp + 8 * fr + 4);
#pragma unroll
        for (int it = 0; it < 4; ++it) {
            const int j = it * 4 + fq; const v4u w = *(const v4u*)(P + (size_t)NA2_QTOK(j) * INC + C_NQ + h * 128 + 8 * fr);
            const float x0 = bflo(w.x), x1 = bfhi(w.x), x2 = bflo(w.y), x3 = bfhi(w.y), x4 = bflo(w.z), x5 = bfhi(w.z), x6 = bflo(w.w), x7 = bfhi(w.w);
            float ss = (x0 * x0 + x1 * x1) + (x2 * x2 + x3 * x3) + (x4 * x4 + x5 * x5) + (x6 * x6 + x7 * x7);
            ss += WAVE_DPP(ss, 0xB1); ss += WAVE_DPP(ss, 0x4E); ss += WAVE_DPP(ss, 0x141); ss += WAVE_DPP(ss, 0x140);
            const float rs = rsqrtf(ss * (1.0f / 128.0f) + EPS) * RET_SCALE;
            *(LAS v4u*)(Qs + (16 * wave + j) * 136 + 8 * fr) = make_v4u(pack2bf(x0 * rs * g0.x * k0.x, x1 * rs * g0.y * k0.y), pack2bf(x2 * rs * g0.z * k0.z, x3 * rs * g0.w * k0.w),
                                                                          pack2bf(x4 * rs * g1.x * k1.x, x5 * rs * g1.y * k1.y), pack2bf(x6 * rs * g1.z * k1.z, x7 * rs * g1.w * k1.w));
        }
    }
    bf16x8_t qf[4];
#pragma unroll
    for (int ks = 0; ks < 4; ++ks) qf[ks] = *(const LAS bf16x8_t*)(Qs + (16 * wave + fr) * 136 + 8 * fq + 32 * ks);
    float m_run = -1.0e30f, l_run = 0.f;
    f32x4_t O[8];
#pragma unroll
    for (int i = 0; i < 8; ++i) O[i] = (f32x4_t){0.f, 0.f, 0.f, 0.f};
#pragma unroll 1
    for (int st = 0; st < nsteps; ++st) {
        const bool local = st < nloc; const int kra = start0 + 2 * st;
        __syncthreads();
        na_stage(R, tid, Kb, Vt);
#pragma unroll
        for (int i = 0; i < 4; ++i) {
            const v4u w = R.k[i];
            float ss = (bflo(w.x) * bflo(w.x) + bfhi(w.x) * bfhi(w.x)) + (bflo(w.y) * bflo(w.y) + bfhi(w.y) * bfhi(w.y)) + (bflo(w.z) * bflo(w.z) + bfhi(w.z) * bfhi(w.z)) + (bflo(w.w) * bflo(w.w) + bfhi(w.w) * bfhi(w.w));
            ss += WAVE_DPP(ss, 0xB1); ss += WAVE_DPP(ss, 0x4E); ss += WAVE_DPP(ss, 0x141); ss += WAVE_DPP(ss, 0x140);
            if (fr == 0) rk[(tid + 512 * i) >> 4] = rsqrtf(ss * (1.0f / 128.0f) + EPS);
        }
        if (st + 1 < nsteps && namode != 1) na2_fetch(P, NA2_ROWA(st + 1), NA2_ROWB(st + 1), h, tid, R);
        __syncthreads();
        if (namode == 3) continue;
        if (local) {
        f32x4_t sa[4];
#pragma unroll
        for (int u = 0; u < 4; ++u) {
            const int t = 4 * (u >> 1) + tlo + (u & 1);
            sa[u] = (f32x4_t){0.f, 0.f, 0.f, 0.f};
#pragma unroll
            for (int ks = 0; ks < 4; ++ks) sa[u] = __builtin_amdgcn_mfma_f32_16x16x32_bf16(*(const LAS bf16x8_t*)(Kb + (16 * t + fr) * 136 + 8 * fq + 32 * ks), qf[ks], sa[u], 0, 0, 0);
        }
        float mx = -1.0e30f;
#pragma unroll
        for (int u = 0; u < 4; ++u) {
            const int t = 4 * (u >> 1) + tlo + (u & 1);
            const v4f kv = *(const LAS v4f*)(rk + 16 * t + 4 * fq);
#pragma unroll
            for (int rr = 0; rr < 4; ++rr) {
                float v = sa[u][rr] * kv[rr];
                const int kr = kra + (u >> 1), kc = 16 * (tlo + (u & 1)) + 4 * fq + rr;
                const bool ok = (kr >= startq) && (kr <= startq + 7) && (kc >= cs) && (kc < cs + 16);
                v += rpbs[clampi(kr - rq + 7, 0, 14) * 31 + clampi(kc - qcol + 15, 0, 30)];
                v = ok ? v : -1.0e30f; sa[u][rr] = v; mx = fmaxf(mx, v);
            }
        }
        mx = fmaxf(mx, __shfl_xor(mx, 16)); mx = fmaxf(mx, __shfl_xor(mx, 32));
        const float mn = fmaxf(m_run, mx), al = __expf(m_run - mn); m_run = mn;
        float sum = 0.f; bf16x8_t pf[2];
#pragma unroll
        for (int s2 = 0; s2 < 2; ++s2) {
            const float p0 = __expf(sa[2 * s2][0] - mn), p1 = __expf(sa[2 * s2][1] - mn), p2 = __expf(sa[2 * s2][2] - mn), p3 = __expf(sa[2 * s2][3] - mn);
            const float p4 = __expf(sa[2 * s2 + 1][0] - mn), p5 = __expf(sa[2 * s2 + 1][1] - mn), p6 = __expf(sa[2 * s2 + 1][2] - mn), p7 = __expf(sa[2 * s2 + 1][3] - mn);
            sum += ((p0 + p1) + (p2 + p3)) + ((p4 + p5) + (p6 + p7));
            pf[s2] = __builtin_bit_cast(bf16x8_t, make_v4u(pack2bf(p0, p1), pack2bf(p2, p3), pack2bf(p4, p5), pack2bf(p6, p7)));
        }
        sum += __shfl_xor(sum, 16); sum += __shfl_xor(sum, 32);
        l_run = l_run * al + sum;
        if (fq == 0) alx[wave * 16 + fr] = al;
        const v4f a4 = *(const LAS v4f*)(alx + wave * 16 + 4 * fq);
#pragma unroll
        for (int te = 0; te < 8; ++te) {
#pragma unroll
            for (int rr = 0; rr < 4; ++rr) O[te][rr] *= a4[rr];
#pragma unroll
            for (int s2 = 0; s2 < 2; ++s2) {
                const v2u lo = *(const LAS v2u*)(Vt + (16 * te + fr) * 136 + 64 * s2 + 4 * ((4 * tlo + fq) ^ te)), hi = *(const LAS v2u*)(Vt + (16 * te + fr) * 136 + 64 * s2 + 4 * ((4 * tlo + 4 + fq) ^ te));
                O[te] = __builtin_amdgcn_mfma_f32_16x16x32_bf16(pf[s2], __builtin_bit_cast(bf16x8_t, make_v4u(lo.x, lo.y, hi.x, hi.y)), O[te], 0, 0, 0);
            }
        }
        } else {
        f32x4_t sa[8];
#pragma unroll
        for (int t = 0; t < 8; ++t) {
            sa[t] = (f32x4_t){0.f, 0.f, 0.f, 0.f};
#pragma unroll
            for (int ks = 0; ks < 4; ++ks) sa[t] = __builtin_amdgcn_mfma_f32_16x16x32_bf16(*(const LAS bf16x8_t*)(Kb + (16 * t + fr) * 136 + 8 * fq + 32 * ks), qf[ks], sa[t], 0, 0, 0);
        }
        float mx = -1.0e30f;
#pragma unroll
        for (int t = 0; t < 8; ++t) {
            const v4f kv = *(const LAS v4f*)(rk + 16 * t + 4 * fq);
#pragma unroll
            for (int rr = 0; rr < 4; ++rr) {
                const float v = sa[t][rr] * kv[rr];
                sa[t][rr] = v; mx = fmaxf(mx, v);
            }
        }
        mx = fmaxf(mx, __shfl_xor(mx, 16)); mx = fmaxf(mx, __shfl_xor(mx, 32));
        const float mn = fmaxf(m_run, mx), al = __expf(m_run - mn); m_run = mn;
        float sum = 0.f; bf16x8_t pf[4];
#pragma unroll
        for (int s4 = 0; s4 < 4; ++s4) {
            const float p0 = __expf(sa[2 * s4][0] - mn), p1 = __expf(sa[2 * s4][1] - mn), p2 = __expf(sa[2 * s4][2] - mn), p3 = __expf(sa[2 * s4][3] - mn);
            const float p4 = __expf(sa[2 * s4 + 1][0] - mn), p5 = __expf(sa[2 * s4 + 1][1] - mn), p6 = __expf(sa[2 * s4 + 1][2] - mn), p7 = __expf(sa[2 * s4 + 1][3] - mn);
            sum += ((p0 + p1) + (p2 + p3)) + ((p4 + p5) + (p6 + p7));
            pf[s4] = __builtin_bit_cast(bf16x8_t, make_v4u(pack2bf(p0, p1), pack2bf(p2, p3), pack2bf(p4, p5), pack2bf(p6, p7)));
        }
        sum += __shfl_xor(sum, 16); sum += __shfl_xor(sum, 32);
        l_run = l_run * al + sum;
        if (fq == 0) alx[wave * 16 + fr] = al;
        const v4f a4 = *(const LAS v4f*)(alx + wave * 16 + 4 * fq);
#pragma unroll
        for (int te = 0; te < 8; ++te) {
#pragma unroll
            for (int rr = 0; rr < 4; ++rr) O[te][rr] *= a4[rr];
#pragma unroll
            for (int s4 = 0; s4 < 4; ++s4) {
                const v2u lo = *(const LAS v2u*)(Vt + (16 * te + fr) * 136 + 32 * s4 + 4 * (fq ^ te)), hi = *(const LAS v2u*)(Vt + (16 * te + fr) * 136 + 32 * s4 + 4 * ((4 + fq) ^ te));
                O[te] = __builtin_amdgcn_mfma_f32_16x16x32_bf16(pf[s4], __builtin_bit_cast(bf16x8_t, make_v4u(lo.x, lo.y, hi.x, hi.y)), O[te], 0, 0, 0);
            }
        }

        }
    }
    if (fq == 0) alx[wave * 16 + fr] = l_run;
    {
        const v4f l4 = *(const LAS v4f*)(alx + wave * 16 + 4 * fq);
#pragma unroll
        for (int te = 0; te < 8; ++te)
#pragma unroll
            for (int rr = 0; rr < 4; ++rr) MIX[(size_t)NA2_QTOK(4 * fq + rr) * 4096 + M_NO + h * 128 + 16 * te + fr] = f2bf(O[te][rr] / l4[rr]);
    }
#undef NA2_ROWA
#undef NA2_ROWB
#undef NA2_QTOK
}

__device__ __forceinline__ void mixer_phase(ARGS_REF a, int l, LAS unsigned char* lds, unsigned* qctr, unsigned* nactr, int cls_mask = 7, int pmode = 0, int namode = 0) {
    volatile LAS int* slot = (volatile LAS int*)(lds + MISC_OFF + 64);
    const int n_ret = (l == 0) ? 192 : 96, n_hy = (l == 0) ? 256 + 1024 : 256;
    const int n_zero = (l == 0) ? MT / 32 : 0;
    const int total = n_ret + n_hy + n_zero;
    for (;;) {
        __syncthreads();
        if (fresh_tid() == 0) *slot = (int)atomicAdd(qctr, 1u);
        __syncthreads();
        int it = *slot;
        if (it >= total) break;
#ifndef NO_RET
        if (it < n_ret) { if (!(cls_mask & 1)) continue; const bool cs = it >= 96; const int j = cs ? it - 96 : it; ret_item(a, l, (j >> 1) / 12, (j >> 1) % 12, j & 1, cs, lds); continue; }
#endif
        it -= n_ret;
#ifndef NO_HY
        if (it < n_hy) { if (!(cls_mask & 2)) continue; if (it < 256) hyena_fft_item(a, l, it, lds, pmode); else { if (pmode) continue; hyena_ctx_item(a, l, it - 256, lds); } continue; }
#endif
        it -= n_hy;
        if (!(cls_mask & 4) || pmode) continue;
        {
            v4u* zp = (v4u*)(a.ws + WS_GA + (size_t)it * 32 * PN * 2); const v4u z = make_v4u(0u, 0u, 0u, 0u); const int t_ = fresh_tid();
#pragma unroll 8
            for (int i = 0; i < 128; ++i) zp[i * NTHREADS + t_] = z;
        }
    }
#ifndef NO_NA
    if (!(cls_mask & 4) || pmode) return;
    const int x0 = (int)(xb_xcc_id() & 7u), len = 192 + ((l == 0) ? 12 : 0);
#pragma unroll 1
    for (int k = 0; k < 8; ++k) {
        const int x = (x0 + k) & 7;
        for (;;) {
            __syncthreads();
            if (fresh_tid() == 0) *slot = (int)atomicAdd(nactr + 64 * x, 1u);
            __syncthreads();
            const int idx = *slot;
            if (idx >= len) break;
            const bool cs = idx >= 192; const int j = cs ? idx - 192 : idx;
            const int g = x + 8 * (cs ? (j >> 1) : (j >> 5)), rp = cs ? (j & 1) : (j & 31);
            na2_item(a, l, g / 12, g % 12, rp, cs, lds, namode);
        }
    }
#endif
}

__device__ __forceinline__ unsigned mono_key(float x) { const unsigned u = __float_as_uint(x); return (u & 0x80000000u) ? ~u : (u | 0x80000000u); }
__device__ __forceinline__ int lanes_below(unsigned long long m) { return (int)__builtin_amdgcn_mbcnt_hi((unsigned)(m >> 32), __builtin_amdgcn_mbcnt_lo((unsigned)m, 0u)); }
struct SelRaw { v4u kh[4], kl[4]; v4f q[2]; };
__device__ __forceinline__ void sel_fetch(ARGS_REF a, int l, int tile, int h, int p, int tid, SelRaw& R) {
    const bf16_t* kh = (const bf16_t*)(a.ws + WS_KHL) + (size_t)((l * 8 + h) * 2 + p) * 2 * 128 * 128; const bf16_t* kl = kh + 128 * 128;
    const float* Qb = (const float*)(a.ws + WS_Q);
    const int row0 = tile * 32;
#pragma unroll
    for (int i = 0; i < 4; ++i) { const int idx8 = tid + 512 * i; R.kh[i] = *(const v4u*)(kh + idx8 * 8); R.kl[i] = *(const v4u*)(kl + idx8 * 8); }
#pragma unroll
    for (int i = 0; i < 2; ++i) {
        const int idx4 = tid + 512 * i; const int t = idx4 >> 5, k4 = (idx4 & 31) * 4;
        v4f x;
        if (row0 < TL || l != 0) x = *(const v4f*)(Qb + (size_t)(row0 + t) * PQ + h * 256 + p * 128 + k4);
        else {
            const float* pp = (const float*)(a.ws + WS_PART) + (size_t)(row0 - TL + t) * PQ + h * 256 + p * 128 + k4;
            x = *(const v4f*)pp;
#pragma unroll
            for (int s = 1; s < 8; ++s) x += *(const v4f*)(pp + (size_t)s * TC * PQ);
        }
        R.q[i] = x;
    }
}
__device__ __forceinline__ void sel_stage(const SelRaw& R, int tid, LAS bf16_t* Qh, LAS bf16_t* Ql, LAS bf16_t* Kh, LAS bf16_t* Kl) {
#pragma unroll
    for (int i = 0; i < 4; ++i) { const int idx8 = tid + 512 * i; const int n = idx8 >> 4, k8 = (idx8 & 15) * 8; *(LAS v4u*)(Kh + n * 136 + k8) = R.kh[i]; *(LAS v4u*)(Kl + n * 136 + k8) = R.kl[i]; }
#pragma unroll
    for (int i = 0; i < 2; ++i) {
        const int idx4 = tid + 512 * i; const int t = idx4 >> 5, k4 = (idx4 & 31) * 4; const v4f x = R.q[i];
        const unsigned h01 = pack2bf(x.x, x.y), h23 = pack2bf(x.z, x.w);
        *(LAS v2u*)(Qh + t * 136 + k4) = make_v2u(h01, h23);
        *(LAS v2u*)(Ql + t * 136 + k4) = make_v2u(pack2bf(x.x - bflo(h01), x.y - bfhi(h01)), pack2bf(x.z - bflo(h23), x.w - bfhi(h23)));
    }
}
__device__ __forceinline__ void peer_select_phase(ARGS_REF a, int l, int nrows, LAS unsigned char* lds) {
    const int nit = (nrows / 32) * 8, G = gridDim.x;
    if ((int)blockIdx.x >= nit) return;
    SelRaw R;
    sel_fetch(a, l, (int)blockIdx.x >> 3, (int)blockIdx.x & 7, 0, fresh_tid(), R);
#pragma unroll 1
    for (int it = blockIdx.x; it < nit; it += G) {
    const int tile = it >> 3, h = it & 7;
    const int tid = fresh_tid(), lane = tid & 63, wave = tid >> 6, fr = lane & 15, fq = lane >> 4;
    LAS bf16_t* Qh = (LAS bf16_t*)lds;
    LAS bf16_t* Ql = Qh + 32 * 136;
    LAS bf16_t* Kh = Ql + 32 * 136;
    LAS bf16_t* Kl = Kh + 128 * 136;
    LAS float* Ss = (LAS float*)(Kl + 128 * 136);
    LAS float* tops = Ss + 64 * 129;
    LAS int* topi = (LAS int*)(tops + 64 * 16);
    LAS float* GL = (LAS float*)(topi + 64 * 16);
    LAS int* EL = (LAS int*)(GL + 32 * 16);
    const float* Qb = (const float*)(a.ws + WS_Q);
    unsigned* GA32 = (unsigned*)(a.ws + WS_GA);
    const int row0 = tile * 32;
#pragma unroll 1
    for (int p = 0; p < 2; ++p) {
        __syncthreads();
        sel_stage(R, tid, Qh, Ql, Kh, Kl);
        if (p == 0) sel_fetch(a, l, tile, h, 1, tid, R);
        else if (it + G < nit) sel_fetch(a, l, (it + G) >> 3, (it + G) & 7, 0, tid, R);
        __syncthreads();
        f32x4_t sa[2] = {(f32x4_t){0.f, 0.f, 0.f, 0.f}, (f32x4_t){0.f, 0.f, 0.f, 0.f}};
        mma_lds<8, 2, 128, 136, 136>(Ql, Kh, sa, wave, fr, fq);
        mma_lds<8, 2, 128, 136, 136>(Qh, Kl, sa, wave, fr, fq);
        mma_lds<8, 2, 128, 136, 136>(Qh, Kh, sa, wave, fr, fq);
#pragma unroll
        for (int i = 0; i < 2; ++i)
#pragma unroll
            for (int r = 0; r < 4; ++r) Ss[((i * 16 + fq * 4 + r) * 2 + p) * 129 + wave * 16 + fr] = sa[i][r];
    }
    __syncthreads();
    {
        float v0[8], v1[8]; unsigned k0[8], k1[8], T[8]; int ex[8];
#pragma unroll
        for (int rr = 0; rr < 8; ++rr) {
            const int row = wave * 8 + rr; v0[rr] = Ss[row * 129 + lane]; v1[rr] = Ss[row * 129 + lane + 64];
            k0[rr] = (mono_key(v0[rr]) & ~127u) | (unsigned)(127 - lane); k1[rr] = (mono_key(v1[rr]) & ~127u) | (unsigned)(63 - lane); T[rr] = 0u; ex[rr] = 0;
        }
#pragma unroll 1
        for (int bit = 31; bit >= 0; --bit) {
            int fin = 1;
#pragma unroll
            for (int g = 0; g < 2; ++g) {
                unsigned c[4]; unsigned long long ma[4], mb[4]; int cnt[4];
#pragma unroll
                for (int rr = 0; rr < 4; ++rr) c[rr] = T[4 * g + rr] | (1u << bit);
#pragma unroll
                for (int rr = 0; rr < 4; ++rr) { ma[rr] = __ballot(k0[4 * g + rr] >= c[rr]); mb[rr] = __ballot(k1[4 * g + rr] >= c[rr]); }
                __builtin_amdgcn_sched_barrier(0);
#pragma unroll
                for (int rr = 0; rr < 4; ++rr) cnt[rr] = __popcll(ma[rr]) + __popcll(mb[rr]);
                __builtin_amdgcn_sched_barrier(0);
#pragma unroll
                for (int rr = 0; rr < 4; ++rr) { T[4 * g + rr] = cnt[rr] >= 16 ? c[rr] : T[4 * g + rr]; ex[4 * g + rr] |= (cnt[rr] == 16) ? 1 : 0; fin &= ex[4 * g + rr]; }
                __builtin_amdgcn_sched_barrier(0);
            }
            if (fin) break;
        }
#pragma unroll
        for (int rr = 0; rr < 8; ++rr) {
            const int row = wave * 8 + rr; const bool s0 = k0[rr] >= T[rr], s1 = k1[rr] >= T[rr];
            const unsigned long long m0 = __ballot(s0), m1 = __ballot(s1);
            const int p0 = lanes_below(m0), p1 = __popcll(m0) + lanes_below(m1);
            if (s0 && p0 < 16) { tops[row * 16 + p0] = v0[rr]; topi[row * 16 + p0] = lane; }
            if (s1 && p1 < 16) { tops[row * 16 + p1] = v1[rr]; topi[row * 16 + p1] = lane + 64; }
        }
    }
    __syncthreads();
    {
        float cv[4][4]; unsigned ck[4][4], T[4]; int exb[4];
#pragma unroll
        for (int tt = 0; tt < 4; ++tt) {
            const int t = wave * 4 + tt; const int r0 = (t * 2) * 16, r1 = (t * 2 + 1) * 16;
#pragma unroll
            for (int j = 0; j < 4; ++j) { const int ci = lane * 4 + j; cv[tt][j] = tops[r0 + (ci >> 4)] + tops[r1 + (ci & 15)]; ck[tt][j] = (mono_key(cv[tt][j]) & ~255u) | (unsigned)(255 - ci); }
            T[tt] = 0u; exb[tt] = 0;
        }
#pragma unroll 1
        for (int bit = 31; bit >= 0; --bit) {
            int fin = 1;
#pragma unroll
            for (int g = 0; g < 2; ++g) {
                unsigned c[2]; unsigned long long mm[2][4]; int cnt[2];
#pragma unroll
                for (int tt = 0; tt < 2; ++tt) c[tt] = T[2 * g + tt] | (1u << bit);
#pragma unroll
                for (int tt = 0; tt < 2; ++tt)
#pragma unroll
                    for (int j = 0; j < 4; ++j) mm[tt][j] = __ballot(ck[2 * g + tt][j] >= c[tt]);
                __builtin_amdgcn_sched_barrier(0);
#pragma unroll
                for (int tt = 0; tt < 2; ++tt) cnt[tt] = (__popcll(mm[tt][0]) + __popcll(mm[tt][1])) + (__popcll(mm[tt][2]) + __popcll(mm[tt][3]));
                __builtin_amdgcn_sched_barrier(0);
#pragma unroll
                for (int tt = 0; tt < 2; ++tt) { T[2 * g + tt] = cnt[tt] >= 16 ? c[tt] : T[2 * g + tt]; exb[2 * g + tt] |= (cnt[tt] == 16) ? 1 : 0; fin &= exb[2 * g + tt]; }
                __builtin_amdgcn_sched_barrier(0);
            }
            if (fin) break;
        }
#pragma unroll
        for (int tt = 0; tt < 4; ++tt) {
            const int t = wave * 4 + tt; const int r0 = (t * 2) * 16, r1 = (t * 2 + 1) * 16; int base = 0;
#pragma unroll
            for (int j = 0; j < 4; ++j) {
                const bool sel = ck[tt][j] >= T[tt]; const unsigned long long m = __ballot(sel); const int pos = base + lanes_below(m); base += __popcll(m);
                if (sel && pos < 16) { const int ci = lane * 4 + j; EL[t * 16 + pos] = topi[r0 + (ci >> 4)] * 128 + topi[r1 + (ci & 15)]; GL[t * 16 + pos] = cv[tt][j]; }
            }
        }
        {
            const int t = wave * 4 + fq; const float sv = GL[t * 16 + fr]; const int eid = EL[t * 16 + fr];
            float m = sv;
#pragma unroll
            for (int o = 8; o >= 1; o >>= 1) m = fmaxf(m, __shfl_xor(m, o));
            const float e = __expf(sv - m); float s = e;
#pragma unroll
            for (int o = 8; o >= 1; o >>= 1) s += __shfl_xor(s, o);
            const unsigned gb = (unsigned)f2bf(e / s);
            typedef short s2v __attribute__((ext_vector_type(2)));
            const s2v val = __builtin_bit_cast(s2v, (eid & 1) ? (gb << 16) : gb);
            __builtin_amdgcn_global_atomic_fadd_v2bf16((__attribute__((address_space(1))) s2v*)(GA32 + (((size_t)(row0 + t) * PN + eid) >> 1)), val);
        }
    }
    }
}

struct EpiGate {
    static constexpr bool PERM = true, AFTER_DRAIN = false;
    bf16_t* GM; unsigned char* GA8; int ldc; float sc;
    __device__ __forceinline__ void operator()(const pg8::f32x4 (&acc)[2][2][4][2], const pg8::Unit& u, int wr, int wc, int fr, int fq) const {
        const int row0 = u.pm * 256 + wr * 64 + fr, col0 = u.pn * 256 + wc * 32 + 8 * fq;
#pragma unroll
        for (int ai = 0; ai < 2; ++ai) {
            v4u gm[4][2];
#pragma unroll
            for (int m = 0; m < 4; ++m)
#pragma unroll
                for (int bj = 0; bj < 2; ++bj) gm[m][bj] = *(const v4u*)(GM + (size_t)(row0 + ai * 128 + m * 16) * ldc + col0 + bj * 128);
            __builtin_amdgcn_sched_barrier(0);
#pragma unroll
            for (int m = 0; m < 4; ++m) {
                const size_t ro = (size_t)(row0 + ai * 128 + m * 16) * ldc + col0;
#pragma unroll
                for (int bj = 0; bj < 2; ++bj) {
                    const v4u g = gm[m][bj];
                    v2u w = make_v2u(0u, 0u);
                    if ((g.x | g.y | g.z | g.w) != 0u) {
                        const pg8::f32x4 v0 = acc[ai][bj][m][0] * sc, v1 = acc[ai][bj][m][1] * sc;
                        w.x = pack4fp8(A8_SCALE * bflo(g.x) * gelu_tanh_f(v0[0]), A8_SCALE * bfhi(g.x) * gelu_tanh_f(v0[1]), A8_SCALE * bflo(g.y) * gelu_tanh_f(v0[2]), A8_SCALE * bfhi(g.y) * gelu_tanh_f(v0[3]));
                        w.y = pack4fp8(A8_SCALE * bflo(g.z) * gelu_tanh_f(v1[0]), A8_SCALE * bfhi(g.z) * gelu_tanh_f(v1[1]), A8_SCALE * bflo(g.w) * gelu_tanh_f(v1[2]), A8_SCALE * bfhi(g.w) * gelu_tanh_f(v1[3]));
                        *(v4u*)(GM + ro + bj * 128) = make_v4u(0u, 0u, 0u, 0u);
                    }
                    *(v2u*)(GA8 + ro + bj * 128) = w;
                }
            }
        }
    }
};

constexpr int N_PHASES = 19;
__global__ void __launch_bounds__(NTHREADS, 2) fwd_kernel(Args a) {
    extern __shared__ __attribute__((aligned(16))) unsigned char lds_raw[];
    LAS unsigned char* lds = (LAS unsigned char*)lds_raw;
    const int tid = threadIdx.x;
    const KARG Args* ap0 = (const KARG Args*)__builtin_amdgcn_kernarg_segment_ptr();
#define FRESH(name) const KARG Args* name = ap0; asm volatile("" : "+s"(name))
    const int lo = ap0->ph_lo, hi = ap0->ph_hi;
    unsigned* ctl = (unsigned*)(ap0->ws + WS_CTL);
    const bool fused = (hi - lo) > 1;
    if (tid < 64) ((LAS unsigned*)(lds + MISC_OFF))[tid] = 0u;
    __syncthreads();
    XcdBarrier bar; bar.bar = ctl + CW_BAR; bar.x = 0; bar.st = (volatile LAS unsigned*)(lds + MISC_OFF);
    if (fused) bar = xcd_barrier_post(ctl + CW_BAR, (volatile LAS unsigned*)(lds + MISC_OFF));
#define IN(k) (lo <= (k) && (k) < hi)
#if defined(ONLY)
#define EN(x) ((ONLY) == (x))
#elif defined(DISABLE)
#define EN(x) (!(((DISABLE) >> (x)) & 1))
#else
#define EN(x) 1
#endif
#ifndef DUP
#define DUP 0
#endif
#ifndef DUPMIX
#define DUPMIX 7
#endif
#ifndef SELMODE
#define SELMODE 0
#endif
#ifndef NAMODE
#define NAMODE 0
#endif
#ifndef HYMODE
#define HYMODE 0
#endif
#ifndef P0MODE
#define P0MODE 0
#endif
#ifndef WGM_IN
#define WGM_IN 8
#endif
#ifndef WGM_OUT
#define WGM_OUT 4
#endif
#ifndef WGM_Q
#define WGM_Q 4
#endif
#ifndef WGM_P1
#define WGM_P1 4
#endif
#ifndef WGM_P2
#define WGM_P2 4
#endif
#define NREP(x) ((((DUP) >> (x)) & 1) ? 2 : 1)
#define REPBAR(x) do { if (rep + 1 < NREP(x)) xcd_barrier(bar); } while (0)
#define SEAM(k) do { if (IN(k) && IN((k) + 1)) xcd_barrier(bar); } while (0)

    if (EN(0) && IN(0)) for (int rep = 0; rep < NREP(0); ++rep) { FRESH(ap); p0_prologue(*ap, lds, rep ? P0MODE : 0); REPBAR(0); }
    SEAM(0);
#pragma unroll 1
    for (int l = 0; l < 2; ++l) {
        const int pb = 1 + 9 * l;
        const int nrows = (l == 0) ? MT : TL;
        if (EN(1) && IN(pb + 0)) for (int rep = 0; rep < NREP(1); ++rep) { FRESH(ap); if (l == 1) norm_phase(*ap, l, 0, MT, 2, (const float*)(ap->ws + WS_MOD) + (size_t)4 * NMOD + 5 * 4096, 1.0f / A8_SCALE); else norm_phase(*ap, l, 0, MT); REPBAR(1); }
        SEAM(pb + 0);
        if (EN(2) && IN(pb + 1)) for (int rep = 0; rep < NREP(2); ++rep) {
            FRESH(ap); ARGS_REF a = *ap;
            pg8::Gemm g{(const bf16_t*)(a.ws + WS_H), (const bf16_t*)(a.ws + WS_WIN) + (size_t)l * INC * 4096, MT, INC, D};
            pg8::TwoPartOrder S; S.init(TL, TC, INC, l == 0 ? INC / 256 : 6144 / 256, (int)gridDim.x, (int)blockIdx.x, WGM_IN);
            EpiProj E{(bf16_t*)(a.ws + WS_PROJ), (bf16_t*)(a.ws + WS_UT)};
            pg8::gemm_phase<EpiProj, pg8::TwoPartOrder, false>(lds, g, S, E, nullptr);
            REPBAR(2);
        }
        SEAM(pb + 1);
        if (EN(3) && IN(pb + 2)) for (int rep = 0; rep < NREP(3); ++rep) { FRESH(ap); mixer_phase(*ap, l, lds, (unsigned*)(ap->ws + WS_CTL) + CW_QUEUE + 64 * (l + 2 * rep), (unsigned*)(ap->ws + WS_CTL) + CW_QUEUE + 64 * (8 + 8 * (l + 2 * rep)), (NREP(3) == 2 && rep == 0) ? DUPMIX : 7, (NREP(3) == 2 && rep == 0) ? HYMODE : 0, (NREP(3) == 2 && rep == 0) ? NAMODE : 0); REPBAR(3); }
        SEAM(pb + 2);
        if (EN(4) && IN(pb + 3)) {
            FRESH(ap); ARGS_REF a = *ap;
            {
                pg8::Gemm g{(const bf16_t*)(a.ws + WS_MIX), (const bf16_t*)(a.ws + WS_WOUT) + (size_t)l * D * D, TL, D, D};
                pg8::StaticOrder S; S.init(TL, D, (int)gridDim.x, (int)blockIdx.x, WGM_OUT);
                EpiRes E{l == 0 ? a.in[0] : (const float*)a.out, (const float*)(a.ws + WS_XC), a.out, (float*)(a.ws + WS_XC), (const float*)(a.ws + WS_MOD) + (size_t)l * 5 * NMOD + 2 * 4096, 1.0f};
                pg8::gemm_phase<EpiRes, pg8::StaticOrder, false>(lds, g, S, E, nullptr);
            }
            if (l == 0) {
                pg8::Gemm g{(const bf16_t*)(a.ws + WS_MIX) + (size_t)TL * D, (const bf16_t*)(a.ws + WS_WOUT), TC, D, D / 4, D};
                pg8::SplitKOrder S; S.init(TC, D, 4, (D / 4) * 2, (int)gridDim.x, (int)blockIdx.x);
                EpiPart E{(float*)(a.ws + WS_PART), D, TC, (D / 4) * 2};
                pg8::gemm_phase<EpiPart, pg8::SplitKOrder, false>(lds, g, S, E, nullptr);
            }
        }
        SEAM(pb + 3);
        if (EN(1) && IN(pb + 4)) for (int rep = 0; rep < NREP(1); ++rep) { FRESH(ap); if (l == 0) norm_phase(*ap, l, 1, nrows, 1, (const float*)(ap->ws + WS_MOD) + (size_t)4 * NMOD + 2 * 4096, 1.0f); else norm_phase(*ap, l, 1, nrows); REPBAR(1); }
        SEAM(pb + 4);
        if (EN(5) && IN(pb + 5)) {
            FRESH(ap); ARGS_REF a = *ap;
            {
                pg8::Gemm g{(const bf16_t*)(a.ws + WS_H), (const bf16_t*)(a.ws + WS_WQ) + (size_t)l * PQ * D, TL, PQ, D};
                pg8::StaticOrder S; S.init(TL, PQ, (int)gridDim.x, (int)blockIdx.x, WGM_Q);
                pg8::EpiF32 E{(float*)(a.ws + WS_Q), PQ, nullptr};
                pg8::gemm_phase<pg8::EpiF32, pg8::StaticOrder, false>(lds, g, S, E, nullptr);
            }
            if (l == 0) {
                pg8::Gemm g{(const bf16_t*)(a.ws + WS_H) + (size_t)TL * D, (const bf16_t*)(a.ws + WS_WQ), TC, PQ, D / 8, D};
                pg8::SplitKOrder S; S.init(TC, PQ, 8, (D / 8) * 2, (int)gridDim.x, (int)blockIdx.x);
                EpiPart E{(float*)(a.ws + WS_PART), PQ, TC, (D / 8) * 2};
                pg8::gemm_phase<EpiPart, pg8::SplitKOrder, false>(lds, g, S, E, nullptr);
            }
        }
        SEAM(pb + 5);
        if (EN(6) && IN(pb + 6)) for (int rep = 0; rep < NREP(6); ++rep) { FRESH(ap); peer_select_phase(*ap, l, nrows, lds); REPBAR(6); }
        SEAM(pb + 6);
        if (EN(7) && IN(pb + 7)) for (int rep = 0; rep < NREP(7); ++rep) {
            FRESH(ap); ARGS_REF a = *ap;
            pg8::Gemm g{(const bf16_t*)(a.ws + WS_HF8), (const bf16_t*)(a.ws + WS_UB + (size_t)l * PN * D), nrows, PN, D / 2};
            pg8::StaticOrder S; S.init(nrows, PN, (int)gridDim.x, (int)blockIdx.x, WGM_P1);
            EpiGate E{(bf16_t*)(a.ws + WS_GA), a.ws + WS_GA8, PN, 1.0f / U8_SCALE};
            pg8::gemm_phase<EpiGate, pg8::StaticOrder, false, true>(lds, g, S, E, nullptr);
            REPBAR(7);
        }
        SEAM(pb + 7);
        if (EN(8) && IN(pb + 8)) {
            FRESH(ap); ARGS_REF a = *ap;
            {
                pg8::Gemm g{(const bf16_t*)(a.ws + WS_GA8), (const bf16_t*)(a.ws + WS_VT + (size_t)l * PN * D), TL, D, PN / 2};
                pg8::StaticOrder S; S.init(TL, D, (int)gridDim.x, (int)blockIdx.x, WGM_P2);
                EpiRes E{(const float*)a.out, (const float*)(a.ws + WS_XC), a.out, (float*)(a.ws + WS_XC), (const float*)(a.ws + WS_MOD) + (size_t)l * 5 * NMOD + 5 * 4096, 1.0f / A8_SCALE};
                pg8::gemm_phase<EpiRes, pg8::StaticOrder, false, true>(lds, g, S, E, nullptr);
            }
            if (l == 0) {
                pg8::Gemm g{(const bf16_t*)(a.ws + WS_GA8 + (size_t)TL * PN), (const bf16_t*)(a.ws + WS_VT), TC, D, PN / 8, PN / 2};
                pg8::SplitKOrder S; S.init(TC, D, 4, PN / 4, (int)gridDim.x, (int)blockIdx.x);
                EpiPart E{(float*)(a.ws + WS_PART), D, TC, PN / 4};
                pg8::gemm_phase<EpiPart, pg8::SplitKOrder, false, true>(lds, g, S, E, nullptr);
            }
        }
        SEAM(pb + 8);
    }
#undef IN
#undef SEAM
}

extern "C" void kernel_launch(void* const* d_in, const int* in_sizes, int n_in, void* d_out, int out_size, void* d_ws, size_t ws_size, hipStream_t stream) {
    static int grid = 0;
    if (grid == 0) {
        if (n_in != 29 || out_size != TL * D || ws_size < WS_END) {
            fprintf(stderr, "kernel_launch: expected 29 inputs, out %d floats, ws >= %zu bytes; got n_in %d out %d ws %zu; nothing launched\n", TL * D, (size_t)WS_END, n_in, out_size, ws_size);
            grid = -1; return;
        }
        int dev = 0, cus = 0, per_cu = 0;
        if (hipGetDevice(&dev) != hipSuccess || hipDeviceGetAttribute(&cus, hipDeviceAttributeMultiprocessorCount, dev) != hipSuccess) { fprintf(stderr, "kernel_launch: device query failed\n"); grid = -1; return; }
        if (hipFuncSetAttribute((const void*)fwd_kernel, hipFuncAttributeMaxDynamicSharedMemorySize, LDS_BYTES) != hipSuccess) { fprintf(stderr, "kernel_launch: hipFuncSetAttribute failed\n"); grid = -1; return; }
        if (hipOccupancyMaxActiveBlocksPerMultiprocessor(&per_cu, (const void*)fwd_kernel, NTHREADS, LDS_BYTES) != hipSuccess || per_cu < 1)
            fprintf(stderr, "kernel_launch: note: occupancy query reports %d workgroups per CU\n", per_cu);
        (void)hipGetLastError();
        grid = cus;
    }
    if (grid < 0) return;
    if (hipMemsetAsync((char*)d_ws + WS_CTL, 0, CTL_BYTES, stream) != hipSuccess) { fprintf(stderr, "kernel_launch: memset failed\n"); return; }
    Args a{};
    for (int i = 0; i < 29; ++i) a.in[i] = (const float*)d_in[i];
    a.out = (float*)d_out; a.ws = (unsigned char*)d_ws;
#if MK_ONE_LAUNCH
    a.ph_lo = 0; a.ph_hi = N_PHASES;
    hipLaunchKernelGGL(fwd_kernel, dim3(grid), dim3(NTHREADS), LDS_BYTES, stream, a);
#else
    for (int p = 0; p < N_PHASES; ++p) { a.ph_lo = p; a.ph_hi = p + 1; hipLaunchKernelGGL(fwd_kernel, dim3(grid), dim3(NTHREADS), LDS_BYTES, stream, a); }
#endif
    const hipError_t le = hipPeekAtLastError();
    if (le != hipSuccess) fprintf(stderr, "kernel_launch: launch failed: %s\n", hipGetErrorName(le));
}
```

```cpp
#include <hip/hip_runtime.h>
#include <cstdio>
#include <cstdint>

#ifndef MK_ONE_LAUNCH
#define MK_ONE_LAUNCH 1
#endif

typedef unsigned short bf16_t;
typedef short bf16x8_t __attribute__((ext_vector_type(8)));
typedef float f32x4_t __attribute__((ext_vector_type(4)));
typedef float v4f __attribute__((ext_vector_type(4)));
typedef float v2f __attribute__((ext_vector_type(2)));
typedef unsigned v4u __attribute__((ext_vector_type(4)));
typedef unsigned v2u __attribute__((ext_vector_type(2)));
__device__ __forceinline__ v4f make_v4f(float a, float b, float c, float d) { return (v4f){a, b, c, d}; }
__device__ __forceinline__ v2f make_v2f(float a, float b) { return (v2f){a, b}; }
__device__ __forceinline__ v4u make_v4u(unsigned a, unsigned b, unsigned c, unsigned d) { return (v4u){a, b, c, d}; }
__device__ __forceinline__ v2u make_v2u(unsigned a, unsigned b) { return (v2u){a, b}; }

constexpr int D = 4096, NB = 4, SEQ = 4096, TL = NB * SEQ, CTXL = 256, TC = NB * CTXL, MT = TL + TC;
constexpr int INC = 13824;
constexpr int C_RK = 0, C_RV = 1536, C_NK = 3072, C_NV = 4608, C_HY = 6144, C_RQ = 9216, C_RG = 10752, C_NQ = 12288;
constexpr int M_HY = 0, M_RO = 1024, M_NO = 2560;
constexpr int NMOD = 6 * D;
constexpr int PQ = 2048;
constexpr int PN = 16384;
constexpr float EPS = 1e-6f;
constexpr float A8_SCALE = 16.0f;
constexpr float W8_SCALE = 64.0f;
constexpr float U8_SCALE = 64.0f;

constexpr size_t al256(size_t x) { return (x + 255) & ~(size_t)255; }
constexpr size_t WS_CTL  = 0;
constexpr size_t CTL_BYTES = 65536;
constexpr size_t WS_MOD  = WS_CTL + CTL_BYTES;
constexpr size_t WS_KT   = al256(WS_MOD + (size_t)2 * 5 * NMOD * 4);
constexpr size_t WS_KTC  = al256(WS_KT + (size_t)2 * 4096 * 4096 * 4);
constexpr size_t WS_WIN  = al256(WS_KTC + (size_t)4096 * 256 * 4);
constexpr size_t WS_WOUT = al256(WS_WIN + (size_t)2 * INC * D * 2);
constexpr size_t WS_WQ   = al256(WS_WOUT + (size_t)2 * D * D * 2);
constexpr size_t WS_H    = al256(WS_WQ + (size_t)2 * PQ * D * 2);
constexpr size_t WS_PROJ = al256(WS_H + (size_t)MT * D * 2);
constexpr size_t WS_MIX  = al256(WS_PROJ + (size_t)MT * INC * 2);
constexpr size_t WS_XC   = al256(WS_MIX + (size_t)MT * D * 2);
constexpr size_t WS_Q    = al256(WS_XC + (size_t)TC * D * 4);
constexpr size_t WS_OF   = al256(WS_Q + (size_t)MT * PQ * 4);
constexpr size_t WS_UB   = al256(WS_OF + (size_t)2 * MT * 1536 * 4);
constexpr size_t WS_VT   = al256(WS_UB + (size_t)2 * 16384 * D);
constexpr size_t WS_GA   = al256(WS_VT + (size_t)2 * 16384 * D);
constexpr size_t WS_UT   = al256(WS_GA + (size_t)MT * 16384 * 2);
constexpr size_t WS_HF8  = al256(WS_UT + (size_t)3072 * MT * 2);
constexpr size_t WS_GA8  = al256(WS_HF8 + (size_t)MT * D);
constexpr size_t WS_KHL  = al256(WS_GA8 + (size_t)MT * 16384);
constexpr size_t WS_PART = al256(WS_KHL + (size_t)2 * 8 * 2 * 2 * 128 * 128 * 2);
constexpr size_t WS_END  = al256(WS_PART + (size_t)4 * TC * D * 4);

constexpr int CW_BAR = 0;
constexpr int CW_QUEUE = 4096;
constexpr int CW_RET = 8192;

constexpr int LDS_BYTES = 156 * 1024;
constexpr int MISC_OFF = LDS_BYTES - 1024;
constexpr int NTHREADS = 512;

struct Args { const float* in[29]; float* out; unsigned char* ws; int ph_lo, ph_hi; };
#define KARG __attribute__((address_space(4)))
#define ARGS_REF const KARG Args&

__device__ __forceinline__ int fresh_tid() { int t = (int)threadIdx.x; asm volatile("" : "+v"(t)); return t; }
__device__ __forceinline__ float bf2f(bf16_t b) { return __uint_as_float(((unsigned)b) << 16); }
__device__ __forceinline__ unsigned pack2bf(float lo, float hi) { unsigned r; asm volatile("v_cvt_pk_bf16_f32 %0, %1, %2" : "=v"(r) : "v"(lo), "v"(hi)); return r; }
__device__ __forceinline__ unsigned pack4fp8(float a, float b, float c, float d) { int w = 0; w = __builtin_amdgcn_cvt_pk_fp8_f32(a, b, w, false); w = __builtin_amdgcn_cvt_pk_fp8_f32(c, d, w, true); return (unsigned)w; }
__device__ __forceinline__ unsigned char f2fp8(float f) { return (unsigned char)(__builtin_amdgcn_cvt_pk_fp8_f32(f, 0.0f, 0, false) & 0xff); }
__device__ __forceinline__ bf16_t f2bf(float f) { return (bf16_t)(pack2bf(f, 0.0f) & 0xffffu); }
__device__ __forceinline__ float bflo(unsigned w) { return __uint_as_float(w << 16); }
__device__ __forceinline__ float bfhi(unsigned w) { return __uint_as_float(w & 0xffff0000u); }
#define WAVE_DPP(v, ctrl) __int_as_float(__builtin_amdgcn_update_dpp(0, __float_as_int(v), (ctrl), 0xf, 0xf, true))
__device__ __forceinline__ float wave_sum(float v) {
    v += WAVE_DPP(v, 0xB1); v += WAVE_DPP(v, 0x4E); v += WAVE_DPP(v, 0x141); v += WAVE_DPP(v, 0x140);
    const float r0 = __int_as_float(__builtin_amdgcn_readlane(__float_as_int(v), 0)), r1 = __int_as_float(__builtin_amdgcn_readlane(__float_as_int(v), 16));
    const float r2 = __int_as_float(__builtin_amdgcn_readlane(__float_as_int(v), 32)), r3 = __int_as_float(__builtin_amdgcn_readlane(__float_as_int(v), 48));
    return (r0 + r1) + (r2 + r3);
}
__device__ __forceinline__ float wave_max(float v) {
    v = fmaxf(v, WAVE_DPP(v, 0xB1)); v = fmaxf(v, WAVE_DPP(v, 0x4E)); v = fmaxf(v, WAVE_DPP(v, 0x141)); v = fmaxf(v, WAVE_DPP(v, 0x140));
    const float r0 = __int_as_float(__builtin_amdgcn_readlane(__float_as_int(v), 0)), r1 = __int_as_float(__builtin_amdgcn_readlane(__float_as_int(v), 16));
    const float r2 = __int_as_float(__builtin_amdgcn_readlane(__float_as_int(v), 32)), r3 = __int_as_float(__builtin_amdgcn_readlane(__float_as_int(v), 48));
    return fmaxf(fmaxf(r0, r1), fmaxf(r2, r3));
}
__device__ __forceinline__ float sin_turns(float t) { return __builtin_amdgcn_sinf(t - floorf(t)); }
__device__ __forceinline__ float cos_turns(float t) { return __builtin_amdgcn_cosf(t - floorf(t)); }
__device__ __forceinline__ float sin_rad(float x) { return sin_turns(x * 0.15915494309189535f); }
__device__ __forceinline__ float silu_f(float x) { return x / (1.0f + __expf(-x)); }
__device__ __forceinline__ float gelu_tanh_f(float x) {
    const float u = 0.7978845608028654f * (x + 0.044715f * x * x * x);
    const float th = 1.0f - 2.0f / (__expf(2.0f * u) + 1.0f);
    return 0.5f * x * (1.0f + th);
}
__device__ __forceinline__ int clampi(int x, int lo, int hi) { return x < lo ? lo : (x > hi ? hi : x); }

#define XB_TMO      128
#define XB_XCNT(j)  (256  + 64 * (j))
#define XB_XSUB(j)  (1280 + 64 * (j))
#define XB_XGEN(j)  (2304 + 64 * (j))
#define XB_TOP      3328
#define XB_TOPGEN   3392
#define XCD_BAR_WORDS 3456
#define XB_SPIN_CAP (1u << 21)
#define LAS __attribute__((address_space(3)))

__device__ __forceinline__ unsigned xb_ld(unsigned* p)              { return __hip_atomic_load(p, __ATOMIC_RELAXED, __HIP_MEMORY_SCOPE_AGENT); }
__device__ __forceinline__ unsigned xb_add(unsigned* p, unsigned v) { return __hip_atomic_fetch_add(p, v, __ATOMIC_RELAXED, __HIP_MEMORY_SCOPE_AGENT); }
__device__ __forceinline__ unsigned xb_xcc_id() { return (unsigned)__builtin_amdgcn_s_getreg((3 << 11) | 20) & 0xFu; }
#define XB_SPIN(cond, bar) do { unsigned _sp = 0; while (cond) { __builtin_amdgcn_s_sleep(1); \
    if ((++_sp & 255u) == 0u) { if (xb_ld(&(bar)[XB_TMO])) break; if (_sp > XB_SPIN_CAP) { atomicAdd(&(bar)[XB_TMO], 1u); break; } } } } while (0)

struct XcdBarrier {
    unsigned* bar; unsigned x;
    volatile LAS unsigned* st;
};

__device__ __forceinline__ XcdBarrier xcd_barrier_post(unsigned* bar, volatile LAS unsigned* st) {
    XcdBarrier b; b.bar = bar; b.x = xb_xcc_id(); b.st = st;
    if (threadIdx.x == 0) (void)xb_add(&bar[XB_XCNT(b.x)], 1u);
    return b;
}
__device__ __forceinline__ void xcd_barrier_complete(unsigned* bar, unsigned x, unsigned& nloc, unsigned& nx) {
    const unsigned G = gridDim.x * gridDim.y * gridDim.z;
    unsigned sum, cnt, mine, sp = 0u;
    for (;;) {
        sum = 0u; cnt = 0u; mine = 0u;
#pragma unroll
        for (unsigned j = 0; j < 16; ++j) { const unsigned c = xb_ld(&bar[XB_XCNT(j)]); sum += c; cnt += (c > 0u) ? 1u : 0u; mine = (j == x) ? c : mine; }
        if (sum == G) break;
        __builtin_amdgcn_s_sleep(1);
        if ((++sp & 255u) == 0u) { if (xb_ld(&bar[XB_TMO])) break; if (sp > XB_SPIN_CAP) { atomicAdd(&bar[XB_TMO], 1u); break; } }
    }
    nloc = mine > 0u ? mine : 1u; nx = cnt > 0u ? cnt : 1u;
}

__device__ __forceinline__ void xcd_barrier(const XcdBarrier& b) {
    asm volatile("s_waitcnt vmcnt(0)" ::: "memory");
    __syncthreads();
    if (threadIdx.x == 0) {
        unsigned* bar = b.bar;
        __builtin_amdgcn_s_waitcnt(0);
        unsigned nloc = b.st[0], nx = b.st[1];
        if (nloc == 0u) { xcd_barrier_complete(bar, b.x, nloc, nx); b.st[0] = nloc; b.st[1] = nx; }
        const unsigned old = xb_add(&bar[XB_XSUB(b.x)], 1u);
        const unsigned gen = old / nloc;
        if (old + 1u == (gen + 1u) * nloc) {
            __builtin_amdgcn_fence(__ATOMIC_RELEASE, "agent");
            asm volatile("s_waitcnt vmcnt(0)" ::: "memory");
            const unsigned og = xb_add(&bar[XB_TOP], 1u);
            const unsigned tg = og / nx;
            if (og + 1u == (tg + 1u) * nx) xb_add(&bar[XB_TOPGEN], 1u);
            else XB_SPIN(xb_ld(&bar[XB_TOPGEN]) == tg, bar);
            __builtin_amdgcn_fence(__ATOMIC_ACQUIRE, "agent");
            xb_add(&bar[XB_XGEN(b.x)], 1u);
            asm volatile("s_waitcnt vmcnt(0)" ::: "memory");
        } else {
            XB_SPIN(xb_ld(&bar[XB_XGEN(b.x)]) == gen, bar);
            __builtin_amdgcn_fence(__ATOMIC_ACQUIRE, "agent");
            asm volatile("s_waitcnt vmcnt(0)" ::: "memory");
        }
    }
    __syncthreads();
}
namespace pg8 {
#define PG8_LAS __attribute__((address_space(3)))
typedef unsigned short bf16_t;
typedef short bf16x8 __attribute__((ext_vector_type(8)));
typedef float f32x4 __attribute__((ext_vector_type(4)));
typedef unsigned u32x4 __attribute__((ext_vector_type(4)));
constexpr int BM = 256, BK = 64, HALF = 128, HTB = HALF * BK * 2  , STAGE_BYTES = 8 * HTB, NXCD = 8, WGM = 8;

__host__ __device__ __forceinline__ int lds_byte(int r, int c) { const int st = (r >> 4) * 2 + (c >> 5), rr = r & 15, cc = c & 31, ob = rr * 64 + cc * 2; return st * 1024 + (ob ^ (((ob >> 9) & 1) << 5)); }
__host__ __device__ __forceinline__ void stage_rc(int b, int& R, int& C) { const int st = b / 1024, sb = b % 1024, swz = sb ^ (((sb >> 9) & 1) << 5); R = (st >> 1) * 16 + swz / 64; C = (st & 1) * 32 + (swz % 64) / 2; }
__host__ __device__ __forceinline__ int perm32(int rho) { const int n = rho >> 4, i = rho & 15; return 8 * (i >> 2) + 4 * n + (i & 3); }

struct Unit { int pm, pn, kb; };
struct Gemm { const bf16_t* A; const bf16_t* Bt; int M, N, K, ld; };

struct StaticOrder {
    int nM, nN, nwg, G, c, W;
    __host__ __device__ void init(int M, int N, int G_, int c_, int W_ = 4) { nM = M / BM; nN = N / BM; nwg = nM * nN; G = G_; c = c_; W = W_; }
    __host__ __device__ bool next(int i, Unit& u) const {
        const long L = (long)i * G + c; if (L >= nwg) return false;
        int wgid = (int)L; { const int q = nwg / NXCD, r = nwg % NXCD, xcd = wgid % NXCD, off = wgid / NXCD; wgid = (xcd < r ? xcd * (q + 1) : r * (q + 1) + (xcd - r) * q) + off; }
        const int nig = W * nN, gid = wgid / nig, fm = gid * W, gsz = (nM - fm) < W ? (nM - fm) : W;
        u.pm = fm + ((wgid % nig) % gsz); u.pn = (wgid % nig) / gsz; u.kb = 0; return true;
    }
    __device__ __forceinline__ void a_ready(const Unit&) const {}
    __device__ __forceinline__ void done(const Unit&) const {}
};
struct CountedOrder : StaticOrder {
    const unsigned* ready; unsigned need; unsigned* tmo;
    __device__ __forceinline__ void a_ready(const Unit& u) const {
        if (threadIdx.x < 64) {
            const unsigned long long t0 = __builtin_amdgcn_s_memrealtime(); unsigned polls = 0;
            while ((unsigned)__builtin_amdgcn_readfirstlane(__hip_atomic_load(ready + 64 * u.pm, __ATOMIC_RELAXED, __HIP_MEMORY_SCOPE_AGENT)) < need) {
                if ((++polls & 255u) == 0u && __builtin_amdgcn_readfirstlane(__hip_atomic_load(tmo, __ATOMIC_RELAXED, __HIP_MEMORY_SCOPE_AGENT)) != 0u) break;
                if (__builtin_amdgcn_s_memrealtime() - t0 > 2000000ull) {
                    if (threadIdx.x == 0) { unsigned expect = 0u; __hip_atomic_compare_exchange_strong(tmo + 1, &expect, 0x600u | (unsigned)(u.pm & 0xff), __ATOMIC_RELAXED, __ATOMIC_RELAXED, __HIP_MEMORY_SCOPE_AGENT); __hip_atomic_store(tmo, 1u, __ATOMIC_RELAXED, __HIP_MEMORY_SCOPE_AGENT); }
                    break; }
                __builtin_amdgcn_s_sleep(2); }
            __builtin_amdgcn_fence(__ATOMIC_ACQUIRE, "agent");
            asm volatile("s_waitcnt vmcnt(0)" ::: "memory");
        }
#if !defined(BROKEN_HOOK_NO_BARRIER)
        asm volatile("" ::: "memory"); __builtin_amdgcn_s_barrier(); asm volatile("" ::: "memory");
#endif
    }
};

struct TwoPartOrder {
    StaticOrder base; int ncol2, n2;
    __host__ __device__ void init(int M1, int M2, int N, int ncol2_, int G_, int c_, int W_ = 4) { base.init(M1, N, G_, c_, W_); ncol2 = ncol2_; n2 = (M2 / BM) * ncol2_; }
    __host__ __device__ bool next(int i, Unit& u) const {
        if (base.next(i, u)) return true;
        const long L = (long)i * base.G + base.c - base.nwg; if (L >= n2) return false;
        const int li = (int)L; u.pm = base.nM + (li & 3); u.pn = li >> 2;
        u.kb = 0; return true;
    }
    __device__ __forceinline__ void a_ready(const Unit&) const {}
    __device__ __forceinline__ void done(const Unit&) const {}
};
struct SplitKOrder {
    int nN, S, kpb, tot, G, c;
    __host__ __device__ void init(int M, int N, int S_, int kpb_, int G_, int c_) { nN = N / BM; S = S_; kpb = kpb_; tot = (M / BM) * nN * S_; G = G_; c = c_; }
    __host__ __device__ bool next(int i, Unit& u) const { const long L = (long)i * G + c; if (L >= tot) return false; const int l = (int)L, s = l % S, t = l / S; u.pn = t % nN; u.pm = t / nN; u.kb = s * kpb; return true; }
    __device__ __forceinline__ void a_ready(const Unit&) const {}
    __device__ __forceinline__ void done(const Unit&) const {}
};

__device__ __forceinline__ unsigned cvt_pk_bf16(float lo, float hi) { unsigned r; asm volatile("v_cvt_pk_bf16_f32 %0, %1, %2" : "=v"(r) : "v"(lo), "v"(hi)); return r; }
typedef float f32x2 __attribute__((ext_vector_type(2)));
__device__ __forceinline__ f32x2 gelu_pk(f32x2 v) {
    const f32x2 av = __builtin_elementwise_abs(v), d = av * 0.2316418882f + 1.0f;
    f32x2 t; t.x = __builtin_amdgcn_rcpf(d.x); t.y = __builtin_amdgcn_rcpf(d.y);
    f32x2 q = t * 0.5307027145f + (-0.7265760135f); q = q * t + 0.7107068705f; q = q * t + (-0.142248368f); q = q * t + 0.127414796f; q = q * t;
    const f32x2 s = (v * v) * (-0.72134752044f);
    f32x2 e; e.x = __builtin_amdgcn_exp2f(s.x); e.y = __builtin_amdgcn_exp2f(s.y);
    const f32x2 m = v * (q * e), r = v - m;
    f32x2 o; o.x = v.x < 0.f ? m.x : r.x; o.y = v.y < 0.f ? m.y : r.y; return o;
}

struct EpiF32 {
    static constexpr bool PERM = false, AFTER_DRAIN = false;
    float* C; int ldc; const float* bias;
    __device__ __forceinline__ void operator()(const f32x4 (&acc)[2][2][4][2], const Unit& u, int wr, int wc, int fr, int fq) const {
        const int row0 = u.pm * BM + wr * 64 + fr, col0 = u.pn * BM + wc * 32 + 4 * fq;
        f32x4 bv[2][2];
#pragma unroll
        for (int bj = 0; bj < 2; ++bj)
#pragma unroll
            for (int n = 0; n < 2; ++n) bv[bj][n] = bias ? *(const f32x4*)(bias + col0 + bj * HALF + n * 16) : (f32x4){0.f, 0.f, 0.f, 0.f};
#pragma unroll
        for (int ai = 0; ai < 2; ++ai)
#pragma unroll
            for (int m = 0; m < 4; ++m) { float* rowp = C + (size_t)(row0 + ai * HALF + m * 16) * ldc + col0;
#pragma unroll
                for (int bj = 0; bj < 2; ++bj)
#pragma unroll
                    for (int n = 0; n < 2; ++n) *(f32x4*)(rowp + bj * HALF + n * 16) = acc[ai][bj][m][n] + bv[bj][n]; }
    }
};
template <int ACT  > struct EpiBf16 {
    static constexpr bool PERM = true, AFTER_DRAIN = false;
    bf16_t* O; int ldc; const float* bias; int split_cols; size_t split_stride;
    __device__ __forceinline__ void operator()(const f32x4 (&acc)[2][2][4][2], const Unit& u, int wr, int wc, int fr, int fq) const {
        const int row0 = u.pm * BM + wr * 64 + fr; int colt = u.pn * BM; bf16_t* base = O;
        if (split_cols) { const int t = colt / split_cols; base += (size_t)t * split_stride; colt -= t * split_cols; }
        const int col0 = colt + wc * 32 + 8 * fq, bcol0 = u.pn * BM + wc * 32 + 8 * fq;
        f32x4 bv[2][2];
#pragma unroll
        for (int bj = 0; bj < 2; ++bj)
#pragma unroll
            for (int n = 0; n < 2; ++n) bv[bj][n] = bias ? *(const f32x4*)(bias + bcol0 + bj * HALF + 4 * n) : (f32x4){0.f, 0.f, 0.f, 0.f};
#pragma unroll
        for (int ai = 0; ai < 2; ++ai)
#pragma unroll
            for (int m = 0; m < 4; ++m) { bf16_t* rowp = base + (size_t)(row0 + ai * HALF + m * 16) * ldc + col0;
#pragma unroll
                for (int bj = 0; bj < 2; ++bj) { f32x4 v0 = acc[ai][bj][m][0] + bv[bj][0], v1 = acc[ai][bj][m][1] + bv[bj][1];
                    if (ACT == 1) { f32x2 a = gelu_pk((f32x2){v0[0], v0[1]}), b = gelu_pk((f32x2){v0[2], v0[3]}), c = gelu_pk((f32x2){v1[0], v1[1]}), d = gelu_pk((f32x2){v1[2], v1[3]});
                        v0 = (f32x4){a.x, a.y, b.x, b.y}; v1 = (f32x4){c.x, c.y, d.x, d.y}; }
                    if (ACT == 2) {
#pragma unroll
                        for (int j = 0; j < 4; ++j) { v0[j] = 0.5f * v0[j] * (1.0f + erff(v0[j] * 0.70710678f)); v1[j] = 0.5f * v1[j] * (1.0f + erff(v1[j] * 0.70710678f)); } }
                    u32x4 w; w.x = cvt_pk_bf16(v0[0], v0[1]); w.y = cvt_pk_bf16(v0[2], v0[3]); w.z = cvt_pk_bf16(v1[0], v1[1]); w.w = cvt_pk_bf16(v1[2], v1[3]);
                    *(u32x4*)(rowp + bj * HALF) = w; } }
    }
};

struct PanelStats {
    unsigned* xbuf;
    unsigned* cnt;
    unsigned* tmo;
    int ntn; float eps;
    unsigned code;
    __device__ __forceinline__ bool run(const f32x4 (&v)[2][2][4][2], const Unit& u, int wr, int wc, int fr, int fq, PG8_LAS unsigned char* lds, int wid, int lane) const {
        typedef float f32x2v __attribute__((ext_vector_type(2)));
        PG8_LAS f32x2v* P = (PG8_LAS f32x2v*)lds;
        PG8_LAS f32x2v* S = (PG8_LAS f32x2v*)(lds + 8192);
        PG8_LAS unsigned* flag = (PG8_LAS unsigned*)(lds + 8192 + 2048);
#pragma unroll
        for (int ai = 0; ai < 2; ++ai)
#pragma unroll
            for (int m = 0; m < 4; ++m) {
                float s = 0.f;
#pragma unroll
                for (int bj = 0; bj < 2; ++bj)
#pragma unroll
                    for (int n = 0; n < 2; ++n) { const f32x4 x = v[ai][bj][m][n]; s += (x[0] + x[1]) + (x[2] + x[3]); }
                s += __shfl_xor(s, 16); s += __shfl_xor(s, 32);
                const float mw = s * (1.0f / 64.0f); float q = 0.f;
#pragma unroll
                for (int bj = 0; bj < 2; ++bj)
#pragma unroll
                    for (int n = 0; n < 2; ++n) { const f32x4 d = v[ai][bj][m][n] - mw; q += (d[0] * d[0] + d[1] * d[1]) + (d[2] * d[2] + d[3] * d[3]); }
                q += __shfl_xor(q, 16); q += __shfl_xor(q, 32);
                if (fq == 0) P[(ai * HALF + wr * 64 + m * 16 + fr) * 4 + wc] = (f32x2v){mw, q};
            }
        asm volatile("s_waitcnt lgkmcnt(0)" ::: "memory"); __builtin_amdgcn_s_barrier(); asm volatile("" ::: "memory");
#if defined(BROKEN_NO_WAIT)
        if (blockIdx.x >= 64) { const long long t0 = clock64(); while (clock64() - t0 < 60000) __builtin_amdgcn_s_sleep(8); }
#endif
        const int row = wid * 32 + (lane & 31);
        if (lane < 32) {
            const f32x2v a = P[row * 4 + 0], b = P[row * 4 + 1], c = P[row * 4 + 2], d = P[row * 4 + 3];
            const float mt = (a.x + b.x + c.x + d.x) * 0.25f;
            const float da = a.x - mt, db = b.x - mt, dc = c.x - mt, dd = d.x - mt;
            const float m2 = (a.y + b.y) + (c.y + d.y) + 64.0f * ((da * da + db * db) + (dc * dc + dd * dd));
            unsigned long long* slot = (unsigned long long*)xbuf + ((size_t)(u.pm * BM + row) * 4 + u.pn);
            __hip_atomic_store(slot, ((unsigned long long)__float_as_uint(m2) << 32) | __float_as_uint(mt), __ATOMIC_RELAXED, __HIP_MEMORY_SCOPE_AGENT);
        }
        asm volatile("s_waitcnt vmcnt(0)" ::: "memory");
        if (lane == 0) __hip_atomic_fetch_add(cnt + 64 * u.pm, 1u, __ATOMIC_RELAXED, __HIP_MEMORY_SCOPE_AGENT);
        if (wid == 0) {
            bool dead = false; const unsigned long long t0 = __builtin_amdgcn_s_memrealtime(); const unsigned want = 8u * (unsigned)ntn;
            for (;;) {
#if defined(BROKEN_NO_WAIT)
                break;
#endif
                if ((unsigned)__builtin_amdgcn_readfirstlane(__hip_atomic_load(cnt + 64 * u.pm, __ATOMIC_RELAXED, __HIP_MEMORY_SCOPE_AGENT)) >= want) break;
                if (__builtin_amdgcn_s_memrealtime() - t0 > 2000000ull) {
                    if (lane == 0) { unsigned expect = 0u; __hip_atomic_compare_exchange_strong(tmo + 1, &expect, code | (unsigned)(u.pm & 0xff), __ATOMIC_RELAXED, __ATOMIC_RELAXED, __HIP_MEMORY_SCOPE_AGENT);
                                     __hip_atomic_store(tmo, 1u, __ATOMIC_RELAXED, __HIP_MEMORY_SCOPE_AGENT); }
                    dead = true; break; }
                __builtin_amdgcn_s_sleep(2);
            }
            __builtin_amdgcn_fence(__ATOMIC_ACQUIRE, "agent");
            if (lane == 0) flag[0] = dead ? 1u : 0u;
        }
        asm volatile("s_waitcnt vmcnt(0) lgkmcnt(0)" ::: "memory"); __builtin_amdgcn_s_barrier(); asm volatile("" ::: "memory");
        const bool bad = flag[0] != 0u;
        if (lane < 32) {
            const unsigned long long* slot = (const unsigned long long*)xbuf + (size_t)(u.pm * BM + row) * 4; float mt[4], m2[4]; float ms = 0.f;
#pragma unroll
            for (int t = 0; t < 4; ++t) { if (t < ntn) { const unsigned long long w = __hip_atomic_load(slot + t, __ATOMIC_RELAXED, __HIP_MEMORY_SCOPE_AGENT); mt[t] = __uint_as_float((unsigned)w); m2[t] = __uint_as_float((unsigned)(w >> 32)); } else { mt[t] = 0.f; m2[t] = 0.f; } ms += mt[t]; }
            const float mean = ms / (float)ntn; float q = 0.f;
#pragma unroll
            for (int t = 0; t < 4; ++t) if (t < ntn) { const float dm = mt[t] - mean; q += m2[t] + 256.0f * dm * dm; }
            S[row] = (f32x2v){mean, 1.0f / sqrtf(q / (256.0f * (float)ntn) + eps)};
        }
        asm volatile("s_waitcnt lgkmcnt(0)" ::: "memory"); __builtin_amdgcn_s_barrier(); asm volatile("" ::: "memory");
        return bad;
    }
};
struct EpiLnRes {
    static constexpr bool PERM = false, AFTER_DRAIN = true;
    const float* base; float* out; int ldc; const float* bias; PanelStats st; unsigned poison;
    __device__ __forceinline__ void refuse(size_t i0, size_t stride, int M, int N) const { const float q = __builtin_nanf(""); for (size_t i = i0; i < (size_t)M * N; i += stride) out[(i / N) * ldc + i % N] = q;
        if (i0 == 0) { unsigned expect = 0u; __hip_atomic_compare_exchange_strong(st.tmo + 1, &expect, 0x7f0u, __ATOMIC_RELAXED, __ATOMIC_RELAXED, __HIP_MEMORY_SCOPE_AGENT); __hip_atomic_store(st.tmo, 1u, __ATOMIC_RELAXED, __HIP_MEMORY_SCOPE_AGENT); } }
    __device__ __forceinline__ void fused(f32x4 (&acc)[2][2][4][2], const Unit& u, int wr, int wc, int fr, int fq, PG8_LAS unsigned char* lds, int wid, int lane) const {
        typedef float f32x2v __attribute__((ext_vector_type(2)));
        const PG8_LAS f32x2v* S = (const PG8_LAS f32x2v*)(lds + 8192);
        const int col0 = u.pn * BM + wc * 32 + 4 * fq;
#pragma unroll
        for (int bj = 0; bj < 2; ++bj)
#pragma unroll
            for (int n = 0; n < 2; ++n) { const f32x4 bv = bias ? *(const f32x4*)(bias + col0 + bj * HALF + n * 16) : (f32x4){0.f, 0.f, 0.f, 0.f};
#pragma unroll
                for (int ai = 0; ai < 2; ++ai)
#pragma unroll
                    for (int m = 0; m < 4; ++m) acc[ai][bj][m][n] += bv; }
        const bool bad = st.run(acc, u, wr, wc, fr, fq, lds, wid, lane) || poison != 0u;
        const float qnan = __builtin_nanf("");
#pragma unroll
        for (int ai = 0; ai < 2; ++ai)
#pragma unroll
            for (int m = 0; m < 4; ++m) { const int r = ai * HALF + wr * 64 + m * 16 + fr; const f32x2v sr = S[r]; const size_t off = (size_t)(u.pm * BM + r) * ldc + col0;
#pragma unroll
                for (int bj = 0; bj < 2; ++bj)
#pragma unroll
                    for (int n = 0; n < 2; ++n) { const f32x4 bs = *(const f32x4*)(base + off + bj * HALF + n * 16); f32x4 o = bs + (acc[ai][bj][m][n] - sr.x) * sr.y;
                        if (bad) o = (f32x4){qnan, qnan, qnan, qnan}; *(f32x4*)(out + off + bj * HALF + n * 16) = o; }
                asm volatile("" ::: "memory"); }
    }
};
struct EpiLnResLn {
    static constexpr bool PERM = false, AFTER_DRAIN = true;
    const float* base; float* out; bf16_t* xn; int ldc; const float* bias; PanelStats st1, st2; unsigned poison;
    __device__ __forceinline__ void refuse(size_t i0, size_t stride, int M, int N) const { const float q = __builtin_nanf(""); for (size_t i = i0; i < (size_t)M * N; i += stride) { const size_t o = (i / N) * ldc + i % N; out[o] = q; xn[o] = (bf16_t)0x7fc0u; }
        if (i0 == 0) { unsigned expect = 0u; __hip_atomic_compare_exchange_strong(st1.tmo + 1, &expect, 0x7f0u, __ATOMIC_RELAXED, __ATOMIC_RELAXED, __HIP_MEMORY_SCOPE_AGENT); __hip_atomic_store(st1.tmo, 1u, __ATOMIC_RELAXED, __HIP_MEMORY_SCOPE_AGENT); } }
    __device__ __forceinline__ void fused(f32x4 (&acc)[2][2][4][2], const Unit& u, int wr, int wc, int fr, int fq, PG8_LAS unsigned char* lds, int wid, int lane) const {
        typedef float f32x2v __attribute__((ext_vector_type(2))); typedef unsigned u32x2v __attribute__((ext_vector_type(2)));
        const PG8_LAS f32x2v* S = (const PG8_LAS f32x2v*)(lds + 8192);
        const int col0 = u.pn * BM + wc * 32 + 4 * fq;
#pragma unroll
        for (int bj = 0; bj < 2; ++bj)
#pragma unroll
            for (int n = 0; n < 2; ++n) { const f32x4 bv = bias ? *(const f32x4*)(bias + col0 + bj * HALF + n * 16) : (f32x4){0.f, 0.f, 0.f, 0.f};
#pragma unroll
                for (int ai = 0; ai < 2; ++ai)
#pragma unroll
                    for (int m = 0; m < 4; ++m) acc[ai][bj][m][n] += bv; }
        bool bad = st1.run(acc, u, wr, wc, fr, fq, lds, wid, lane) || poison != 0u;
        const float qnan = __builtin_nanf("");
#pragma unroll
        for (int ai = 0; ai < 2; ++ai)
#pragma unroll
            for (int m = 0; m < 4; ++m) { const int r = ai * HALF + wr * 64 + m * 16 + fr; const f32x2v sr = S[r]; const size_t off = (size_t)(u.pm * BM + r) * ldc + col0;
#pragma unroll
                for (int bj = 0; bj < 2; ++bj)
#pragma unroll
                    for (int n = 0; n < 2; ++n) { const f32x4 bs = *(const f32x4*)(base + off + bj * HALF + n * 16); acc[ai][bj][m][n] = bs + (acc[ai][bj][m][n] - sr.x) * sr.y; }
                asm volatile("" : "+v"(acc[ai][0][m][0]), "+v"(acc[ai][0][m][1]), "+v"(acc[ai][1][m][0]), "+v"(acc[ai][1][m][1]));
                if (m & 1) asm volatile("" ::: "memory"); }
        const bool bad1 = bad;
        bad = st2.run(acc, u, wr, wc, fr, fq, lds, wid, lane) || bad;
#pragma unroll
        for (int ai = 0; ai < 2; ++ai)
#pragma unroll
            for (int m = 0; m < 4; ++m) { const int r = ai * HALF + wr * 64 + m * 16 + fr; const f32x2v sr = S[r]; const size_t off = (size_t)(u.pm * BM + r) * ldc + col0;
#pragma unroll
                for (int bj = 0; bj < 2; ++bj)
#pragma unroll
                    for (int n = 0; n < 2; ++n) { const f32x4 x1 = acc[ai][bj][m][n]; *(f32x4*)(out + off + bj * HALF + n * 16) = bad1 ? (f32x4){qnan, qnan, qnan, qnan} : x1;
                        const f32x4 o = (x1 - sr.x) * sr.y; u32x2v w; w.x = cvt_pk_bf16(o[0], o[1]); w.y = cvt_pk_bf16(o[2], o[3]);
                        if (bad) { w.x = 0x7fc07fc0u; w.y = 0x7fc07fc0u; } *(u32x2v*)(xn + off + bj * HALF + n * 16) = w; }
                asm volatile("" ::: "memory"); }
    }
};

template <class Epi, class Sched, bool STAMP = false, bool FP8 = false, bool ALIGN_EPI = true, bool SP2 = true>
__device__ __forceinline__ void gemm_phase(PG8_LAS unsigned char* lds, const Gemm g, const Sched& S, const Epi& E, unsigned long long* stamps) {
    const int tid = fresh_tid(), wid = __builtin_amdgcn_readfirstlane(tid >> 6), lane = tid & 63, wr = wid >> 2, wc = wid & 3, fr = lane & 15, fq = lane >> 4;
    const int K = g.K, nt = K / BK, LD = g.ld ? g.ld : K;
    int ts_lo = 0, ts_hi = 0, nts = 0; const unsigned long long rt_entry = STAMP ? (unsigned long long)wall_clock64() : 0ull;
#define PG8_STAMP() do { if (STAMP && wid == 0 && nts < 64) { const unsigned long long _c = (unsigned long long)clock64(); \
        ts_lo = (lane == nts) ? (int)(unsigned)_c : ts_lo; ts_hi = (lane == nts) ? (int)(unsigned)(_c >> 32) : ts_hi; ++nts; } } while (0)
    PG8_STAMP();
    unsigned voffA[2], voffB[2];
#pragma unroll
    for (int i = 0; i < 2; ++i) { int R, C; stage_rc(tid * 16 + i * 8192, R, C); const int Rb = Epi::PERM ? ((R & ~31) + perm32(R & 31)) : R;
        voffA[i] = (unsigned)(R * LD + C) * 2u; voffB[i] = (unsigned)(Rb * LD + C) * 2u; }
    const size_t kstep = (size_t)(BK * 2);
    const size_t hstep = (size_t)HALF * LD * 2;
    const size_t tstep = 2 * hstep;
    const unsigned ldsw = (unsigned)wid * 1024u;
    const int aoff = lds_byte(wr * 64 + fr, fq * 8), boff = lds_byte(wc * 32 + fr, fq * 8);
#define PG8_SA(b, h) (((b) * 2 + (h)) * HTB)
#define PG8_SB(b, h) ((4 + (b) * 2 + (h)) * HTB)
#define PG8_STAGE(bufoff, gbase, voff) do { _Pragma("unroll") for (int _i = 0; _i < 2; ++_i) \
        __builtin_amdgcn_global_load_lds((const unsigned*)((const char*)(gbase) + (voff)[_i]), (PG8_LAS unsigned*)(lds + (bufoff) + ldsw + _i * 8192), 16, 0, 0); } while (0)
#define PG8_LDA(dst, b, h) do { if constexpr (FP8) { _Pragma("unroll") for (int m = 0; m < 4; ++m) { const i32x4v lo_ = *(const PG8_LAS i32x4v*)(lds + PG8_SA(b, h) + aoff + m * 2048), hi_ = *(const PG8_LAS i32x4v*)(lds + PG8_SA(b, h) + aoff + m * 2048 + 1024); dst##8[m] = __builtin_shufflevector(lo_, hi_, 0, 1, 2, 3, 4, 5, 6, 7); } } \
        else { _Pragma("unroll") for (int m = 0; m < 4; ++m) _Pragma("unroll") for (int k = 0; k < 2; ++k) dst[m][k] = *(const PG8_LAS bf16x8*)(lds + PG8_SA(b, h) + aoff + m * 2048 + k * 1024); } } while (0)
#define PG8_LDB(dst, b, h) do { if constexpr (FP8) { _Pragma("unroll") for (int n = 0; n < 2; ++n) { const i32x4v lo_ = *(const PG8_LAS i32x4v*)(lds + PG8_SB(b, h) + boff + n * 2048), hi_ = *(const PG8_LAS i32x4v*)(lds + PG8_SB(b, h) + boff + n * 2048 + 1024); dst##8[n] = __builtin_shufflevector(lo_, hi_, 0, 1, 2, 3, 4, 5, 6, 7); } } \
        else { _Pragma("unroll") for (int n = 0; n < 2; ++n) _Pragma("unroll") for (int k = 0; k < 2; ++k) dst[n][k] = *(const PG8_LAS bf16x8*)(lds + PG8_SB(b, h) + boff + n * 2048 + k * 1024); } } while (0)
#define PG8_MMA(ai, bj, At, Bt) do { __builtin_amdgcn_s_setprio(1); _Pragma("unroll") for (int m = 0; m < 4; ++m) _Pragma("unroll") for (int n = 0; n < 2; ++n) { \
        if constexpr (FP8) asm volatile("v_mfma_scale_f32_16x16x128_f8f6f4 %0, %1, %2, %0, %3, %3 op_sel_hi:[0,0,0]" : "+v"(acc[ai][bj][m][n]) : "v"(Bt##8[n]), "v"(At##8[m]), "v"(fp8_unit_scale)); \
        else { _Pragma("unroll") for (int k = 0; k < 2; ++k) acc[ai][bj][m][n] = __builtin_amdgcn_mfma_f32_16x16x32_bf16(Bt[n][k], At[m][k], acc[ai][bj][m][n], 0, 0, 0); } } \
        __builtin_amdgcn_s_setprio(0); } while (0)
#define PG8_WAIT_V(n) asm volatile("s_waitcnt vmcnt(" #n ")" ::: "memory")
#define PG8_WAIT_L(n) asm volatile("s_waitcnt lgkmcnt(" #n ")" ::: "memory")
#define PG8_BAR __builtin_amdgcn_s_barrier()
#define PG8_SCHED __builtin_amdgcn_sched_barrier(0)
    Unit cur, nxt; int ui = 0;
    if (!S.next(0, cur)) return;
    f32x4 acc[2][2][4][2];
#pragma unroll
    for (int a = 0; a < 2; ++a)
#pragma unroll
        for (int b = 0; b < 2; ++b)
#pragma unroll
            for (int m = 0; m < 4; ++m)
#pragma unroll
                for (int n = 0; n < 2; ++n) acc[a][b][m][n] = (f32x4){0.f, 0.f, 0.f, 0.f};
    typedef int i32x4v __attribute__((ext_vector_type(4))); typedef int i32x8v __attribute__((ext_vector_type(8)));
    int fp8_unit_scale = 0x7f7f7f7f; asm volatile("" : "+v"(fp8_unit_scale));
    bf16x8 At[4][2], B0[2][2], B1[2][2]; i32x8v At8[4], B08[2], B18[2];
    const char* cA = (const char*)g.A + (size_t)cur.pm * tstep + cur.kb; const char* cB = (const char*)g.Bt + (size_t)cur.pn * tstep + cur.kb;
    S.a_ready(cur);
    if constexpr (SP2) {
        PG8_STAGE(PG8_SB(0, 0), cB, voffB); PG8_STAGE(PG8_SB(0, 1), cB + hstep, voffB); PG8_STAGE(PG8_SA(0, 0), cA, voffA); PG8_STAGE(PG8_SA(0, 1), cA + hstep, voffA);
        if (wr == 1) PG8_BAR;
        PG8_WAIT_V(2); PG8_BAR;
        PG8_STAGE(PG8_SB(1, 0), cB + kstep, voffB); PG8_STAGE(PG8_SA(1, 0), cA + kstep, voffA); PG8_STAGE(PG8_SB(1, 1), cB + hstep + kstep, voffB);
        PG8_WAIT_V(6); PG8_BAR;
    } else {
        PG8_STAGE(PG8_SB(0, 0), cB, voffB); PG8_STAGE(PG8_SA(0, 0), cA, voffA); PG8_STAGE(PG8_SB(0, 1), cB + hstep, voffB); PG8_STAGE(PG8_SA(0, 1), cA + hstep, voffA);
        if (wr == 1) PG8_BAR;
        PG8_WAIT_V(4); PG8_BAR;
        PG8_STAGE(PG8_SB(1, 0), cB + kstep, voffB); PG8_STAGE(PG8_SA(1, 0), cA + kstep, voffA); PG8_STAGE(PG8_SB(1, 1), cB + hstep + kstep, voffB);
        PG8_WAIT_V(6); PG8_BAR;
    }
    PG8_STAMP();
    for (;;) {
        const bool has_next = S.next(ui + 1, nxt);
        const char* nA = has_next ? (const char*)g.A + (size_t)nxt.pm * tstep + nxt.kb : cA; const char* nB = has_next ? (const char*)g.Bt + (size_t)nxt.pn * tstep + nxt.kb : cB;
        for (int t = 0; t < nt; t += 2) {
            const bool last = (t == nt - 2);
            const char* a1 = cA + (size_t)(t + 1) * kstep;
            const char* a2 = last ? nA : cA + (size_t)(t + 2) * kstep; const char* b2 = last ? nB : cB + (size_t)(t + 2) * kstep;
            const char* a3 = a2 + kstep; const char* b3 = b2 + kstep;
            if (last && has_next) S.a_ready(nxt);
            if constexpr (SP2) {
            PG8_LDB(B0, 0, 0); PG8_LDB(B1, 0, 1); PG8_SCHED; PG8_LDA(At, 0, 0); PG8_STAGE(PG8_SA(1, 1), a1 + hstep, voffA);
            PG8_WAIT_V(8); PG8_WAIT_L(0); PG8_BAR; PG8_MMA(0, 0, At, B0); PG8_MMA(0, 1, At, B1); PG8_BAR; PG8_SCHED;
            PG8_LDA(At, 0, 1); PG8_STAGE(PG8_SB(0, 0), b2, voffB); PG8_STAGE(PG8_SB(0, 1), b2 + hstep, voffB); PG8_STAGE(PG8_SA(0, 0), a2, voffA);
            PG8_WAIT_V(8); PG8_WAIT_L(0); PG8_BAR; PG8_MMA(1, 0, At, B0); PG8_MMA(1, 1, At, B1); PG8_BAR; PG8_SCHED;
            PG8_LDB(B0, 1, 0); PG8_LDB(B1, 1, 1); PG8_SCHED; PG8_LDA(At, 1, 0); PG8_STAGE(PG8_SA(0, 1), a2 + hstep, voffA);
            PG8_WAIT_V(8); PG8_WAIT_L(0); PG8_BAR; PG8_MMA(0, 0, At, B0); PG8_MMA(0, 1, At, B1); PG8_BAR; PG8_SCHED;
            PG8_LDA(At, 1, 1); PG8_STAGE(PG8_SB(1, 0), b3, voffB); PG8_STAGE(PG8_SB(1, 1), b3 + hstep, voffB); PG8_STAGE(PG8_SA(1, 0), a3, voffA);
            PG8_WAIT_V(8); PG8_WAIT_L(0); PG8_BAR; PG8_MMA(1, 0, At, B0); PG8_MMA(1, 1, At, B1); PG8_BAR; PG8_SCHED;
            } else {
            PG8_LDB(B0, 0, 0); PG8_SCHED; PG8_LDA(At, 0, 0); PG8_STAGE(PG8_SA(1, 1), a1 + hstep, voffA);
            PG8_WAIT_L(8); PG8_BAR; PG8_WAIT_L(0); PG8_MMA(0, 0, At, B0); PG8_BAR; PG8_SCHED;
            PG8_LDB(B1, 0, 1); PG8_STAGE(PG8_SB(0, 0), b2, voffB);
            PG8_BAR; PG8_WAIT_L(0); PG8_MMA(0, 1, At, B1); PG8_BAR;
            PG8_LDA(At, 0, 1); PG8_STAGE(PG8_SA(0, 0), a2, voffA);
            PG8_BAR; PG8_WAIT_L(0); PG8_MMA(1, 0, At, B0); PG8_BAR; PG8_SCHED;
            PG8_STAGE(PG8_SB(0, 1), b2 + hstep, voffB);
            PG8_WAIT_V(6); PG8_BAR; PG8_MMA(1, 1, At, B1); PG8_BAR;
            PG8_LDB(B0, 1, 0); PG8_SCHED; PG8_LDA(At, 1, 0); PG8_STAGE(PG8_SA(0, 1), a2 + hstep, voffA);
            PG8_WAIT_L(8); PG8_BAR; PG8_WAIT_L(0); PG8_MMA(0, 0, At, B0); PG8_BAR; PG8_SCHED;
            PG8_LDB(B1, 1, 1); PG8_STAGE(PG8_SB(1, 0), b3, voffB);
            PG8_BAR; PG8_WAIT_L(0); PG8_MMA(0, 1, At, B1); PG8_BAR;
            PG8_LDA(At, 1, 1); PG8_STAGE(PG8_SA(1, 0), a3, voffA);
            PG8_BAR; PG8_WAIT_L(0); PG8_MMA(1, 0, At, B0); PG8_BAR; PG8_SCHED;
            PG8_STAGE(PG8_SB(1, 1), b3 + hstep, voffB);
            PG8_WAIT_V(6); PG8_BAR; PG8_MMA(1, 1, At, B1); PG8_BAR;
            }
        }
        PG8_STAMP();
        if constexpr (ALIGN_EPI) { if (wr == 0) PG8_BAR; }
        if constexpr (FP8) asm volatile("s_nop 15\n\ts_nop 15" ::: "memory");
        if constexpr (!Epi::AFTER_DRAIN) { E(acc, cur, wr, wc, fr, fq); S.done(cur); }
        PG8_STAMP();
        if (!has_next) break;
#pragma unroll
        for (int a = 0; a < 2; ++a)
#pragma unroll
            for (int b = 0; b < 2; ++b)
#pragma unroll
                for (int m = 0; m < 4; ++m)
#pragma unroll
                    for (int n = 0; n < 2; ++n) acc[a][b][m][n] = (f32x4){0.f, 0.f, 0.f, 0.f};
        cur = nxt; cA = nA; cB = nB; ++ui;
        if constexpr (ALIGN_EPI) { if (wr == 1) PG8_BAR; }
    }
    PG8_WAIT_V(0);
    if constexpr (!ALIGN_EPI) { if (wr == 0) PG8_BAR; }
    PG8_BAR;
    if constexpr (Epi::AFTER_DRAIN) { E.fused(acc, cur, wr, wc, fr, fq, lds, wid, lane); S.done(cur); }
    PG8_STAMP();
    if (STAMP && wid == 0) { stamps[lane] = lane < nts ? (((unsigned long long)(unsigned)ts_hi << 32) | (unsigned)ts_lo) : 0ull;
        if (lane == 62) stamps[62] = rt_entry; if (lane == 63) stamps[63] = (unsigned long long)wall_clock64(); }
#undef PG8_STAMP
#undef PG8_SA
#undef PG8_SB
#undef PG8_STAGE
#undef PG8_LDA
#undef PG8_LDB
#undef PG8_MMA
#undef PG8_WAIT_V
#undef PG8_WAIT_L
#undef PG8_BAR
#undef PG8_SCHED
}
}

constexpr float HY_MIN_DECAY = -3.0701134573253944f;
constexpr float HY_MAX_DECAY = -15.350567286626972f;
constexpr float RET_SCALE = 0.08838834764831845f;

__device__ __forceinline__ void p0_mod_item(ARGS_REF a, int item, LAS unsigned char* lds) {
    const int tid = fresh_tid(), lane = tid & 63, wave = tid >> 6;
    const int l = item / 192, n0 = (item % 192) * 128;
    LAS float* sc = (LAS float*)lds;
    LAS float* red = (LAS float*)(lds + 81920);
    const float* c = a.in[1]; const float* cc = a.in[3];
    for (int i = tid; i < 5 * 4096; i += NTHREADS) { const int r = i >> 12, k = i & 4095; const float x = r < 4 ? c[r * 4096 + k] : cc[k]; sc[i] = silu_f(x); }
    __syncthreads();
    float acc[5][2];
#pragma unroll
    for (int r = 0; r < 5; ++r) { acc[r][0] = 0.f; acc[r][1] = 0.f; }
    const float* W = a.in[4] + (size_t)l * 4096 * NMOD + n0 + 2 * lane;
#pragma unroll 8
    for (int k = wave; k < 4096; k += 8) {
        const v2f w = *(const v2f*)(W + (size_t)k * NMOD);
#pragma unroll
        for (int r = 0; r < 5; ++r) { const float s = sc[r * 4096 + k]; acc[r][0] += s * w.x; acc[r][1] += s * w.y; }
    }
#pragma unroll
    for (int r = 0; r < 5; ++r) { red[(wave * 5 + r) * 128 + 2 * lane] = acc[r][0]; red[(wave * 5 + r) * 128 + 2 * lane + 1] = acc[r][1]; }
    __syncthreads();
    float* MOD = (float*)(a.ws + WS_MOD);
    for (int i = tid; i < 640; i += NTHREADS) {
        const int r = i >> 7, n = i & 127; float s = 0.f;
#pragma unroll
        for (int w = 0; w < 8; ++w) s += red[(w * 5 + r) * 128 + n];
        MOD[(size_t)(l * 5 + r) * NMOD + n0 + n] = s + a.in[5][(size_t)l * NMOD + n0 + n];
    }
    __syncthreads();
}

__device__ __forceinline__ void p0_filter_item(ARGS_REF a, int item, LAS unsigned char* lds) {
    const int tid = fresh_tid(), lane = tid & 63, wave = tid >> 6;
    const bool ctx = item >= 128; const int l = ctx ? 0 : item / 64; const int L = ctx ? 256 : 4096; const int t0 = (ctx ? item - 128 : item % 64) * 64;
    LAS float* z = (LAS float*)lds;
    LAS float* h1 = z + 64 * 33;
    LAS float* h2 = h1 + 64 * 64;
    const float* w1 = a.in[10] + l * 33 * 64; const float* b1 = a.in[11] + l * 64; const float* fq = a.in[12] + l * 64;
    const float* w2 = a.in[13] + l * 4096; const float* b2 = a.in[14] + l * 64; const float* w3 = a.in[15] + l * 4096; const float* b3 = a.in[16] + l * 64;
    const float* w4 = a.in[17] + (size_t)l * 64 * 4096;
    for (int i = tid; i < 64 * 33; i += NTHREADS) {
        const int tl = i / 33, j = i - tl * 33; const int t = t0 + tl; float val;
        if (j == 0) val = (float)t / (float)(L - 1);
        else { const int bi = (j - 1) & 15; const float f = 1e-4f + (float)bi * ((15.0f - 1e-4f) / 15.0f); const float turns = f * (float)t / (float)L;
               val = (j <= 16) ? cos_turns(turns) : -sin_turns(turns); }
        z[i] = val;
    }
    __syncthreads();
    const float frq = fq[lane];
#pragma unroll 1
    for (int i = 0; i < 8; ++i) { const int tl = wave + 8 * i; float s = b1[lane]; for (int q = 0; q < 33; ++q) s += z[tl * 33 + q] * w1[q * 64 + lane]; h1[tl * 64 + lane] = sin_rad(frq * s); }
    __syncthreads();
#pragma unroll 1
    for (int i = 0; i < 8; ++i) { const int tl = wave + 8 * i; float s = b2[lane]; for (int q = 0; q < 64; ++q) s += h1[tl * 64 + q] * w2[q * 64 + lane]; h2[tl * 64 + lane] = sin_rad(frq * s); }
    __syncthreads();
#pragma unroll 1
    for (int i = 0; i < 8; ++i) { const int tl = wave + 8 * i; float s = b3[lane]; for (int q = 0; q < 64; ++q) s += h2[tl * 64 + q] * w3[q * 64 + lane]; h1[tl * 64 + lane] = sin_rad(frq * s); }
    __syncthreads();
    float* KT = ctx ? (float*)(a.ws + WS_KTC) : (float*)(a.ws + WS_KT) + (size_t)l * 4096 * 4096;
    {
        const int fr = lane & 15, fq = lane >> 4;
        LAS bf16_t* Hh = (LAS bf16_t*)(lds + 41216);
        LAS bf16_t* Hl = Hh + 64 * 72;
        {
            const int row = tid >> 3, c8 = (tid & 7) * 8; const v4f x0 = *(const LAS v4f*)(h1 + row * 64 + c8), x1 = *(const LAS v4f*)(h1 + row * 64 + c8 + 4);
            const unsigned a0 = pack2bf(x0.x, x0.y), a1 = pack2bf(x0.z, x0.w), a2 = pack2bf(x1.x, x1.y), a3 = pack2bf(x1.z, x1.w);
            *(LAS v4u*)(Hh + row * 72 + c8) = make_v4u(a0, a1, a2, a3);
            *(LAS v4u*)(Hl + row * 72 + c8) = make_v4u(pack2bf(x0.x - bflo(a0), x0.y - bfhi(a0)), pack2bf(x0.z - bflo(a1), x0.w - bfhi(a1)), pack2bf(x1.x - bflo(a2), x1.y - bfhi(a2)), pack2bf(x1.z - bflo(a3), x1.w - bfhi(a3)));
        }
        __syncthreads();
        bf16x8_t ah[4][2], al[4][2];
#pragma unroll
        for (int tm = 0; tm < 4; ++tm)
#pragma unroll
            for (int ks = 0; ks < 2; ++ks) { ah[tm][ks] = *(const LAS bf16x8_t*)(Hh + (16 * tm + fr) * 72 + 8 * fq + 32 * ks); al[tm][ks] = *(const LAS bf16x8_t*)(Hl + (16 * tm + fr) * 72 + 8 * fq + 32 * ks); }
#pragma unroll 1
        for (int i = 0; i < 32; ++i) {
            const int col = 16 * (wave + 8 * i) + fr, c = col & 1023;
            bf16x8_t bh[2], bl[2];
#pragma unroll
            for (int ks = 0; ks < 2; ++ks) {
                float w[8];
#pragma unroll
                for (int e = 0; e < 8; ++e) w[e] = w4[(size_t)(32 * ks + 8 * fq + e) * 4096 + col];
                const unsigned h0 = pack2bf(w[0], w[1]), h1_ = pack2bf(w[2], w[3]), h2_ = pack2bf(w[4], w[5]), h3 = pack2bf(w[6], w[7]);
                bh[ks] = __builtin_bit_cast(bf16x8_t, make_v4u(h0, h1_, h2_, h3));
                bl[ks] = __builtin_bit_cast(bf16x8_t, make_v4u(pack2bf(w[0] - bflo(h0), w[1] - bfhi(h0)), pack2bf(w[2] - bflo(h1_), w[3] - bfhi(h1_)), pack2bf(w[4] - bflo(h2_), w[5] - bfhi(h2_)), pack2bf(w[6] - bflo(h3), w[7] - bfhi(h3))));
            }
            const float delta = fabsf(HY_MIN_DECAY + (HY_MAX_DECAY - HY_MIN_DECAY) * ((float)c / 1023.0f));
#pragma unroll
            for (int tm = 0; tm < 4; ++tm) {
                f32x4_t acc = (f32x4_t){0.f, 0.f, 0.f, 0.f};
#pragma unroll
                for (int ks = 0; ks < 2; ++ks) {
                    acc = __builtin_amdgcn_mfma_f32_16x16x32_bf16(al[tm][ks], bh[ks], acc, 0, 0, 0);
                    acc = __builtin_amdgcn_mfma_f32_16x16x32_bf16(ah[tm][ks], bl[ks], acc, 0, 0, 0);
                    acc = __builtin_amdgcn_mfma_f32_16x16x32_bf16(ah[tm][ks], bh[ks], acc, 0, 0, 0);
                }
                const int tb = t0 + 16 * tm + 4 * fq; v4f o;
#pragma unroll
                for (int r = 0; r < 4; ++r) { const float tt = (float)(tb + r) / (float)(L - 1); o[r] = acc[r] * __expf(-tt * delta); }
                *(v4f*)(KT + (size_t)col * L + tb) = o;
            }
        }
    }
    __syncthreads();
}

__device__ __forceinline__ void p0_tr_tile(const float* src, int N, bf16_t* dst, int KD, int k0, int n0, LAS unsigned char* lds) {
    const int tid = fresh_tid();
    LAS float* T = (LAS float*)lds;
#pragma unroll
    for (int i = 0; i < 4; ++i) {
        const int idx = tid + 512 * i; const int r = idx >> 5, c4 = idx & 31;
        const v4f v = *(const v4f*)(src + (size_t)(k0 + r) * N + n0 + c4 * 4);
        LAS float* p = T + r * 129 + c4 * 4; p[0] = v.x; p[1] = v.y; p[2] = v.z; p[3] = v.w;
    }
    __syncthreads();
    {
        const int n = tid >> 2, kc = (tid & 3) * 16; unsigned w[8];
#pragma unroll
        for (int j = 0; j < 8; ++j) w[j] = pack2bf(T[(kc + 2 * j) * 129 + n], T[(kc + 2 * j + 1) * 129 + n]);
        bf16_t* d = dst + (size_t)(n0 + n) * KD + k0 + kc;
        *(v4u*)d = make_v4u(w[0], w[1], w[2], w[3]); *(v4u*)(d + 8) = make_v4u(w[4], w[5], w[6], w[7]);
    }
    __syncthreads();
}

__device__ __forceinline__ void p0_tr_tile_fp8(const float* src, int N, unsigned char* dst, int KD, int k0, int n0, LAS unsigned char* lds) {
    const int tid = fresh_tid();
    LAS float* T = (LAS float*)lds;
#pragma unroll
    for (int i = 0; i < 4; ++i) {
        const int idx = tid + 512 * i; const int r = idx >> 5, c4 = idx & 31;
        const v4f v = *(const v4f*)(src + (size_t)(k0 + r) * N + n0 + c4 * 4);
        LAS float* p = T + r * 129 + c4 * 4; p[0] = v.x; p[1] = v.y; p[2] = v.z; p[3] = v.w;
    }
    __syncthreads();
    {
        const int n = tid >> 2, kc = (tid & 3) * 16; unsigned w[4];
#pragma unroll
        for (int j = 0; j < 4; ++j) w[j] = pack4fp8(T[(kc + 4 * j) * 129 + n], T[(kc + 4 * j + 1) * 129 + n], T[(kc + 4 * j + 2) * 129 + n], T[(kc + 4 * j + 3) * 129 + n]);
        *(v4u*)(dst + (size_t)(n0 + n) * KD + k0 + kc) = make_v4u(w[0], w[1], w[2], w[3]);
    }
    __syncthreads();
}

struct TrDesc { const float* src; unsigned char* dst; int N, KD, k0, n0, fp8; };
__device__ __forceinline__ TrDesc p0_tile_desc(ARGS_REF a, int idx) {
    TrDesc d;
    if (idx < 2 * 9984) {
        const int l = idx / 9984; int j = idx - l * 9984; d.fp8 = 0; d.KD = 4096;
        if (j < 6912) { d.src = a.in[7] + (size_t)l * 4096 * INC; d.N = INC; d.dst = a.ws + WS_WIN + (size_t)l * INC * 4096 * 2; d.k0 = (j / 108) * 64; d.n0 = (j % 108) * 128; }
        else if (j < 8960) { j -= 6912; d.src = a.in[23] + (size_t)l * 4096 * 4096; d.N = 4096; d.dst = a.ws + WS_WOUT + (size_t)l * 4096 * 4096 * 2; d.k0 = (j / 32) * 64; d.n0 = (j % 32) * 128; }
        else { j -= 8960; d.src = a.in[25] + (size_t)l * 4096 * PQ; d.N = PQ; d.dst = a.ws + WS_WQ + (size_t)l * PQ * 4096 * 2; d.k0 = (j / 16) * 64; d.n0 = (j % 16) * 128; }
    } else {
        idx -= 2 * 9984; const int l = idx >> 13, j = idx & 8191; d.fp8 = 1; d.KD = PN;
        d.src = a.in[28] + (size_t)l * PN * 4096; d.N = 4096; d.dst = a.ws + WS_VT + (size_t)l * PN * 4096; d.k0 = (j >> 5) * 64; d.n0 = (j & 31) * 128;
    }
    return d;
}
__device__ __forceinline__ void p0_tile_load(const TrDesc& d, int tid, v4f (&r)[4]) {
#pragma unroll
    for (int i = 0; i < 4; ++i) { const int idx = tid + 512 * i; const int rr = idx >> 5, c4 = idx & 31; r[i] = *(const v4f*)(d.src + (size_t)(d.k0 + rr) * d.N + d.n0 + c4 * 4); }
}
__device__ __forceinline__ void p0_prologue(ARGS_REF a, LAS unsigned char* lds, int pmode = 0) {
    const int tid = fresh_tid(); const int G = gridDim.x, bx = blockIdx.x;
    if (pmode == 0 || pmode == 1) for (int it = bx; it < 384; it += G) p0_mod_item(a, it, lds);
    if (pmode == 0 || pmode == 2) for (int it = G - 1 - bx; it < 132; it += G) p0_filter_item(a, it, lds);
    if (pmode == 1 || pmode == 2) return;
    {
        constexpr int NP = (2 * 9984 + 16384) / 2;
        LAS float* T = (LAS float*)lds;
        volatile LAS int* slot = (volatile LAS int*)(lds + MISC_OFF + 64);
        unsigned* ctr = (unsigned*)(a.ws + WS_CTL) + CW_QUEUE + 64 * 40;
        v4f r[2][4], rn[2][4];
        int cur = bx, nxt = bx + G;
        TrDesc d0 = p0_tile_desc(a, cur < NP ? 2 * cur : 0), d1 = p0_tile_desc(a, cur < NP ? 2 * cur + 1 : 1);
        if (cur < NP) { p0_tile_load(d0, tid, r[0]); p0_tile_load(d1, tid, r[1]); }
#pragma unroll 1
        while (cur < NP) {
            TrDesc dn0 = d0, dn1 = d1;
            if (nxt < NP) { dn0 = p0_tile_desc(a, 2 * nxt); dn1 = p0_tile_desc(a, 2 * nxt + 1); p0_tile_load(dn0, tid, rn[0]); p0_tile_load(dn1, tid, rn[1]); }
            if (tid == 0) *slot = 2 * G + (int)atomicAdd(ctr, 1u);
#pragma unroll
            for (int h = 0; h < 2; ++h)
#pragma unroll
                for (int i = 0; i < 4; ++i) { const int idx = tid + 512 * i; const int rr = idx >> 5, c4 = idx & 31; LAS float* p = T + h * (64 * 129) + rr * 129 + c4 * 4; p[0] = r[h][i].x; p[1] = r[h][i].y; p[2] = r[h][i].z; p[3] = r[h][i].w; }
            __syncthreads();
            const int nn = __builtin_amdgcn_readfirstlane(*slot);
#pragma unroll
            for (int h = 0; h < 2; ++h) {
                const TrDesc& d = h ? d1 : d0; const LAS float* Th = T + h * (64 * 129);
                const int n = tid >> 2, kc = (tid & 3) * 16;
                if (d.fp8) {
                    unsigned w[4];
#pragma unroll
                    for (int j = 0; j < 4; ++j) w[j] = pack4fp8(Th[(kc + 4 * j) * 129 + n], Th[(kc + 4 * j + 1) * 129 + n], Th[(kc + 4 * j + 2) * 129 + n], Th[(kc + 4 * j + 3) * 129 + n]);
                    *(v4u*)(d.dst + (size_t)(d.n0 + n) * d.KD + d.k0 + kc) = make_v4u(w[0], w[1], w[2], w[3]);
                } else {
                    unsigned w[8];
#pragma unroll
                    for (int j = 0; j < 8; ++j) w[j] = pack2bf(Th[(kc + 2 * j) * 129 + n], Th[(kc + 2 * j + 1) * 129 + n]);
                    bf16_t* dd = (bf16_t*)d.dst + (size_t)(d.n0 + n) * d.KD + d.k0 + kc;
                    *(v4u*)dd = make_v4u(w[0], w[1], w[2], w[3]); *(v4u*)(dd + 8) = make_v4u(w[4], w[5], w[6], w[7]);
                }
            }
            __syncthreads();
#pragma unroll
            for (int h = 0; h < 2; ++h)
#pragma unroll
                for (int i = 0; i < 4; ++i) r[h][i] = rn[h][i];
            d0 = dn0; d1 = dn1; cur = nxt; nxt = nn;
        }
    }
    for (int it = bx; it < 32; it += G) {
        const float* kp = a.in[26] + (size_t)it * 128 * 128; bf16_t* kh = (bf16_t*)(a.ws + WS_KHL) + (size_t)it * 2 * 128 * 128; bf16_t* kl = kh + 128 * 128;
#pragma unroll
        for (int i = 0; i < 8; ++i) {
            const int idx4 = tid + 512 * i; const v4f x = *(const v4f*)(kp + idx4 * 4);
            const unsigned h01 = pack2bf(x.x, x.y), h23 = pack2bf(x.z, x.w);
            *(v2u*)(kh + idx4 * 4) = make_v2u(h01, h23);
            *(v2u*)(kl + idx4 * 4) = make_v2u(pack2bf(x.x - bflo(h01), x.y - bfhi(h01)), pack2bf(x.z - bflo(h23), x.w - bfhi(h23)));
        }
    }
    {
        const v4f* su = (const v4f*)a.in[27]; unsigned* du = (unsigned*)(a.ws + WS_UB);
        const size_t n4 = (size_t)2 * PN * 4096 / 4, stride = (size_t)G * NTHREADS;
        for (size_t i0 = (size_t)bx * NTHREADS + tid; i0 < n4; i0 += 8 * stride) {
            v4f x[8];
#pragma unroll
            for (int u = 0; u < 8; ++u) { const size_t i = i0 + u * stride; x[u] = su[i < n4 ? i : i0]; }
#pragma unroll
            for (int u = 0; u < 8; ++u) { const size_t i = i0 + u * stride; if (i < n4) du[i] = pack4fp8(x[u].x * U8_SCALE, x[u].y * U8_SCALE, x[u].z * U8_SCALE, x[u].w * U8_SCALE); }
        }
    }
}

__device__ __forceinline__ void norm_phase(ARGS_REF a, int l, int which, int nrows, int tmode = 0, const float* tgate = nullptr, float tsc = 1.0f) {
    const int tid = fresh_tid(), lane = tid & 63, wave = tid >> 6;
    const float* MOD = (const float*)(a.ws + WS_MOD);
    bf16_t* H = (bf16_t*)(a.ws + WS_H);
    const float* g = (which ? a.in[24] : a.in[6]) + l * 4096;
    const bool first = (l == 0 && which == 0);
    for (int row = blockIdx.x * 8 + wave; row < nrows; row += gridDim.x * 8) {
        const float* src; int r;
        if (row < TL) { src = (first ? a.in[0] : (const float*)a.out) + (size_t)row * 4096; r = row >> 12; }
        else { src = ((first || tmode == 1) ? a.in[2] : (const float*)(a.ws + WS_XC)) + (size_t)(row - TL) * 4096; r = 4; }
        const float* shift = MOD + (size_t)(l * 5 + r) * NMOD + (which ? 3 : 0) * 4096; const float* scale = shift + 4096;
        v4f v[16]; float ss = 0.f;
#pragma unroll
        for (int i = 0; i < 16; ++i) { v[i] = ((const v4f*)src)[i * 64 + lane]; ss += v[i].x * v[i].x + v[i].y * v[i].y + v[i].z * v[i].z + v[i].w * v[i].w; }
        if (tmode != 0 && row >= TL) {
            const float* part = (const float*)(a.ws + WS_PART) + (size_t)(row - TL) * 4096; ss = 0.f;
#pragma unroll
            for (int i = 0; i < 16; ++i) {
                const int j = (i * 64 + lane) * 4;
                v4f ps = *(const v4f*)(part + j);
#pragma unroll
                for (int s = 1; s < 4; ++s) ps += *(const v4f*)(part + (size_t)s * TC * 4096 + j);
                v[i] += *(const v4f*)(tgate + j) * tsc * ps;
                ss += v[i].x * v[i].x + v[i].y * v[i].y + v[i].z * v[i].z + v[i].w * v[i].w;
                if (tmode == 1) *(v4f*)((float*)(a.ws + WS_XC) + (size_t)(row - TL) * 4096 + j) = v[i];
            }
        }
        ss = wave_sum(ss);
        const float rs = rsqrtf(ss * (1.0f / 4096.0f) + EPS);
#pragma unroll
        for (int i = 0; i < 16; ++i) {
            const int j = (i * 64 + lane) * 4;
            const v4f gg = *(const v4f*)(g + j), sh = *(const v4f*)(shift + j), scl = *(const v4f*)(scale + j);
            const float o0 = v[i].x * rs * gg.x * (1.0f + scl.x) + sh.x, o1 = v[i].y * rs * gg.y * (1.0f + scl.y) + sh.y;
            const float o2 = v[i].z * rs * gg.z * (1.0f + scl.z) + sh.z, o3 = v[i].w * rs * gg.w * (1.0f + scl.w) + sh.w;
            *(v2u*)(H + (size_t)row * 4096 + j) = make_v2u(pack2bf(o0, o1), pack2bf(o2, o3));
            if (which) *(unsigned*)(a.ws + WS_HF8 + (size_t)row * 4096 + j) = pack4fp8(o0, o1, o2, o3);
        }
    }
}

struct EpiRes {
    static constexpr bool PERM = false, AFTER_DRAIN = false;
    const float* baseL; const float* baseC; float* outL; float* outC; const float* gate; float sc;
    __device__ __forceinline__ void operator()(const pg8::f32x4 (&acc)[2][2][4][2], const pg8::Unit& u, int wr, int wc, int fr, int fq) const {
        const int urow = u.pm * 256, row0 = urow + wr * 64 + fr, col0 = u.pn * 256 + wc * 32 + 4 * fq;
        const int r = urow < TL ? (urow >> 12) : 4;
        const float* bp0 = urow < TL ? baseL + (size_t)row0 * 4096 : baseC + (size_t)(row0 - TL) * 4096;
        float* op0 = urow < TL ? outL + (size_t)row0 * 4096 : outC + (size_t)(row0 - TL) * 4096;
        pg8::f32x4 gv[2][2];
#pragma unroll
        for (int bj = 0; bj < 2; ++bj)
#pragma unroll
            for (int n = 0; n < 2; ++n) gv[bj][n] = *(const pg8::f32x4*)(gate + (size_t)r * NMOD + col0 + bj * 128 + n * 16) * sc;
#pragma unroll
        for (int ai = 0; ai < 2; ++ai)
#pragma unroll
            for (int m2 = 0; m2 < 2; ++m2) {
                pg8::f32x4 bv[2][2][2];
#pragma unroll
                for (int mm = 0; mm < 2; ++mm)
#pragma unroll
                    for (int bj = 0; bj < 2; ++bj)
#pragma unroll
                        for (int n = 0; n < 2; ++n) bv[mm][bj][n] = *(const pg8::f32x4*)(bp0 + (size_t)(ai * 128 + (2 * m2 + mm) * 16) * 4096 + col0 + bj * 128 + n * 16);
                __builtin_amdgcn_sched_barrier(0);
#pragma unroll
                for (int mm = 0; mm < 2; ++mm)
#pragma unroll
                    for (int bj = 0; bj < 2; ++bj)
#pragma unroll
                        for (int n = 0; n < 2; ++n)
                            *(pg8::f32x4*)(op0 + (size_t)(ai * 128 + (2 * m2 + mm) * 16) * 4096 + col0 + bj * 128 + n * 16) = bv[mm][bj][n] + gv[bj][n] * acc[ai][bj][2 * m2 + mm][n];
                __builtin_amdgcn_sched_barrier(0);
            }
    }
};

struct EpiPart {
    static constexpr bool PERM = false, AFTER_DRAIN = false;
    float* P; int ldc, rows, kpb;
    __device__ __forceinline__ void operator()(const pg8::f32x4 (&acc)[2][2][4][2], const pg8::Unit& u, int wr, int wc, int fr, int fq) const {
        float* base = P + (size_t)(u.kb / kpb) * rows * ldc + (size_t)(u.pm * 256 + wr * 64 + fr) * ldc + u.pn * 256 + wc * 32 + 4 * fq;
#pragma unroll
        for (int ai = 0; ai < 2; ++ai)
#pragma unroll
            for (int m = 0; m < 4; ++m)
#pragma unroll
                for (int bj = 0; bj < 2; ++bj)
#pragma unroll
                    for (int n = 0; n < 2; ++n) *(pg8::f32x4*)(base + (size_t)(ai * 128 + m * 16) * ldc + bj * 128 + n * 16) = acc[ai][bj][m][n];
    }
};

struct EpiProj {
    static constexpr bool PERM = true, AFTER_DRAIN = false;
    bf16_t* O; bf16_t* UT;
    __device__ __forceinline__ void operator()(const pg8::f32x4 (&acc)[2][2][4][2], const pg8::Unit& u, int wr, int wc, int fr, int fq) const {
        const int row0 = u.pm * 256 + wr * 64 + fr, colt = u.pn * 256, col0 = colt + wc * 32 + 8 * fq;
        if (colt >= C_HY && colt < C_HY + 3072) {
#pragma unroll
            for (int ai = 0; ai < 2; ++ai)
#pragma unroll
                for (int m = 0; m < 4; ++m) {
                    const int row = row0 + ai * 128 + m * 16;
#pragma unroll
                    for (int bj = 0; bj < 2; ++bj) {
                        const pg8::f32x4 v0 = acc[ai][bj][m][0], v1 = acc[ai][bj][m][1];
                        const unsigned o = (unsigned)(col0 + bj * 128 - C_HY) * (unsigned)MT + (unsigned)row;
                        const unsigned w0 = pack2bf(v0[0], v0[1]), w1 = pack2bf(v0[2], v0[3]), w2 = pack2bf(v1[0], v1[1]), w3 = pack2bf(v1[2], v1[3]);
                        UT[o] = (bf16_t)(w0 & 0xffffu); UT[o + (unsigned)MT] = (bf16_t)(w0 >> 16); UT[o + 2u * (unsigned)MT] = (bf16_t)(w1 & 0xffffu); UT[o + 3u * (unsigned)MT] = (bf16_t)(w1 >> 16);
                        UT[o + 4u * (unsigned)MT] = (bf16_t)(w2 & 0xffffu); UT[o + 5u * (unsigned)MT] = (bf16_t)(w2 >> 16); UT[o + 6u * (unsigned)MT] = (bf16_t)(w3 & 0xffffu); UT[o + 7u * (unsigned)MT] = (bf16_t)(w3 >> 16);
                        __builtin_amdgcn_sched_barrier(0);
                    }
                }
        } else {
#pragma unroll
            for (int ai = 0; ai < 2; ++ai)
#pragma unroll
                for (int m = 0; m < 4; ++m) {
                    bf16_t* rowp = O + (size_t)(row0 + ai * 128 + m * 16) * INC + col0;
#pragma unroll
                    for (int bj = 0; bj < 2; ++bj) {
                        const pg8::f32x4 v0 = acc[ai][bj][m][0], v1 = acc[ai][bj][m][1];
                        *(v4u*)(rowp + bj * 128) = make_v4u(pack2bf(v0[0], v0[1]), pack2bf(v0[2], v0[3]), pack2bf(v1[0], v1[1]), pack2bf(v1[2], v1[3]));
                    }
                }
        }
    }
};

template <int NTN, int PER, int K, int LDA, int LDB, bool SWA = false, bool SWB = false>
__device__ __forceinline__ void mma_lds(const LAS bf16_t* A, const LAS bf16_t* Bt, f32x4_t (&acc)[PER], int wave, int fr, int fq) {
#pragma unroll
    for (int i = 0; i < PER; ++i) {
        const int tt = wave + 8 * i, tm = tt / NTN, tn = tt % NTN;
        const LAS bf16_t* ap = A + (tm * 16 + fr) * LDA + (SWA ? 0 : fq * 8); const LAS bf16_t* bp = Bt + (tn * 16 + fr) * LDB + (SWB ? 0 : fq * 8);
#pragma unroll
        for (int k0 = 0; k0 < K; k0 += 32) {
            const bf16x8_t av = *(const LAS bf16x8_t*)(ap + (SWA ? 8 * (fq ^ (tm & 3)) : 0) + k0);
            const bf16x8_t bv = *(const LAS bf16x8_t*)(bp + (SWB ? 8 * (fq ^ (tn & 3)) : 0) + k0);
            acc[i] = __builtin_amdgcn_mfma_f32_16x16x32_bf16(av, bv, acc[i], 0, 0, 0);
        }
        __builtin_amdgcn_sched_barrier(0);
    }
}

struct RetRaw { v2u qa[2], qb[2]; v2u ka[4], kb[4]; v2u vv[4]; };
__device__ __forceinline__ void ret_fetch(const bf16_t* P, int r0, int h, bool need_q, int tid, RetRaw& R) {
    if (need_q) {
#pragma unroll
        for (int it = 0; it < 2; ++it) {
            const int task = tid + 512 * it; const int t = task >> 4, half = (task >> 3) & 1, i0 = (task & 7) * 4;
            const bf16_t* src = P + (size_t)(r0 + t) * INC + C_RQ + h * 128 + half * 64 + i0;
            R.qa[it] = *(const v2u*)src; R.qb[it] = *(const v2u*)(src + 32);
        }
    }
    {
        const int s4 = tid >> 5, half = (tid >> 4) & 1, iq = (tid >> 1) & 7;
        const bf16_t* src = P + (size_t)(r0 + 4 * s4) * INC + C_RK + h * 128 + half * 64 + 4 * iq;
#pragma unroll
        for (int j = 0; j < 4; ++j) { R.ka[j] = *(const v2u*)(src + (size_t)j * INC); R.kb[j] = *(const v2u*)(src + (size_t)j * INC + 32); }
    }
    {
        const int s4 = tid >> 5, e4 = tid & 31;
        const bf16_t* src = P + (size_t)(r0 + 4 * s4) * INC + C_RV + h * 128 + 4 * e4;
#pragma unroll
        for (int j = 0; j < 4; ++j) R.vv[j] = *(const v2u*)(src + (size_t)j * INC);
    }
}
__device__ __forceinline__ void ret_stage(const RetRaw& R, int pos0, bool need_q, bool do_rope, int dir, float lg, int tid,
                                          LAS bf16_t* Qs, LAS bf16_t* Ks, LAS bf16_t* Ktd, LAS bf16_t* Vt, const LAS v2f* rope) {
    if (need_q) {
#pragma unroll
        for (int it = 0; it < 2; ++it) {
            const int task = tid + 512 * it; const int t = task >> 4, half = (task >> 3) & 1, i0 = (task & 7) * 4;
            const v2u wa = R.qa[it], wb = R.qb[it];
            const float av[4] = {bflo(wa.x), bfhi(wa.x), bflo(wa.y), bfhi(wa.y)}; const float bv[4] = {bflo(wb.x), bfhi(wb.x), bflo(wb.y), bfhi(wb.y)};
            float oa[4], ob[4];
            if (do_rope) {
                const int pos = half ? ((pos0 + t) & 63) : ((pos0 + t) >> 6);
#pragma unroll
                for (int q = 0; q < 4; ++q) { const v2f cs = rope[pos * 32 + i0 + q]; oa[q] = av[q] * cs.x - bv[q] * cs.y; ob[q] = av[q] * cs.y + bv[q] * cs.x; }
            } else {
#pragma unroll
                for (int q = 0; q < 4; ++q) { oa[q] = av[q]; ob[q] = bv[q]; }
            }
            *(LAS v2u*)(Qs + t * 136 + half * 64 + i0) = make_v2u(pack2bf(oa[0], oa[1]), pack2bf(oa[2], oa[3]));
            *(LAS v2u*)(Qs + t * 136 + half * 64 + 32 + i0) = make_v2u(pack2bf(ob[0], ob[1]), pack2bf(ob[2], ob[3]));
        }
    }
    {
        const int s4 = tid >> 5, half = (tid >> 4) & 1, iq = (tid >> 1) & 7, ab = tid & 1;
        float o[4][4];
#pragma unroll
        for (int j = 0; j < 4; ++j) {
            const int t = 4 * s4 + j; const v2u wa = R.ka[j], wb = R.kb[j];
            const float av[4] = {bflo(wa.x) * RET_SCALE, bfhi(wa.x) * RET_SCALE, bflo(wa.y) * RET_SCALE, bfhi(wa.y) * RET_SCALE};
            const float bv[4] = {bflo(wb.x) * RET_SCALE, bfhi(wb.x) * RET_SCALE, bflo(wb.y) * RET_SCALE, bfhi(wb.y) * RET_SCALE};
            if (do_rope) {
                const int pos = half ? ((pos0 + t) & 63) : ((pos0 + t) >> 6);
#pragma unroll
                for (int q = 0; q < 4; ++q) { const v2f cs = rope[pos * 32 + 4 * iq + q]; o[j][q] = ab ? (av[q] * cs.y + bv[q] * cs.x) : (av[q] * cs.x - bv[q] * cs.y); }
            } else {
#pragma unroll
                for (int q = 0; q < 4; ++q) o[j][q] = ab ? bv[q] : av[q];
            }
            if (need_q) *(LAS v2u*)(Ks + t * 136 + half * 64 + ab * 32 + 4 * iq) = make_v2u(pack2bf(o[j][0], o[j][1]), pack2bf(o[j][2], o[j][3]));
        }
        float kd[4];
#pragma unroll
        for (int j = 0; j < 4; ++j) { const int t = 4 * s4 + j; kd[j] = __expf(lg * (float)(dir ? t : 63 - t)); }
#pragma unroll
        for (int q = 0; q < 4; ++q)
            *(LAS v2u*)(Ktd + (half * 64 + ab * 32 + 4 * iq + q) * 72 + 4 * s4) = make_v2u(pack2bf(o[0][q] * kd[0], o[1][q] * kd[1]), pack2bf(o[2][q] * kd[2], o[3][q] * kd[3]));
    }
    {
        const int s4 = tid >> 5, e4 = tid & 31;
        const unsigned r0x = R.vv[0].x, r0y = R.vv[0].y, r1x = R.vv[1].x, r1y = R.vv[1].y, r2x = R.vv[2].x, r2y = R.vv[2].y, r3x = R.vv[3].x, r3y = R.vv[3].y;
        *(LAS v2u*)(Vt + (4 * e4 + 0) * 72 + 8 * ((s4 >> 1) ^ ((e4 >> 2) & 3)) + 4 * (s4 & 1)) = make_v2u((r0x & 0xffffu) | (r1x << 16), (r2x & 0xffffu) | (r3x << 16));
        *(LAS v2u*)(Vt + (4 * e4 + 1) * 72 + 8 * ((s4 >> 1) ^ ((e4 >> 2) & 3)) + 4 * (s4 & 1)) = make_v2u((r0x >> 16) | (r1x & 0xffff0000u), (r2x >> 16) | (r3x & 0xffff0000u));
        *(LAS v2u*)(Vt + (4 * e4 + 2) * 72 + 8 * ((s4 >> 1) ^ ((e4 >> 2) & 3)) + 4 * (s4 & 1)) = make_v2u((r0y & 0xffffu) | (r1y << 16), (r2y & 0xffffu) | (r3y << 16));
        *(LAS v2u*)(Vt + (4 * e4 + 3) * 72 + 8 * ((s4 >> 1) ^ ((e4 >> 2) & 3)) + 4 * (s4 & 1)) = make_v2u((r0y >> 16) | (r1y & 0xffff0000u), (r2y >> 16) | (r3y & 0xffff0000u));
    }
}

__device__ __forceinline__ void ret_item(ARGS_REF a, int l, int b, int h, int dir, bool cstream, LAS unsigned char* lds) {
    const int tid = fresh_tid(), lane = tid & 63, wave = tid >> 6, fr = lane & 15, fq = lane >> 4;
    LAS bf16_t* Qs  = (LAS bf16_t*)(lds);
    LAS bf16_t* Ks  = (LAS bf16_t*)(lds + 17408);
    LAS bf16_t* Ktd = (LAS bf16_t*)(lds + 34816);
    LAS bf16_t* Vt  = (LAS bf16_t*)(lds + 53248);
    LAS bf16_t* St  = (LAS bf16_t*)(lds + 71680);
    LAS float*  Af  = (LAS float*)(lds + 106496);
    LAS bf16_t* Pb  = (LAS bf16_t*)(lds + 123904);
    LAS v2f* rope = (LAS v2f*)(lds + 133120);
    volatile LAS int* slot = (volatile LAS int*)(lds + MISC_OFF + 128);
    const bf16_t* P = (const bf16_t*)(a.ws + WS_PROJ);
    float* OFd = (float*)(a.ws + WS_OF) + (size_t)dir * MT * 1536;
    const int L = cstream ? 256 : 4096, row0 = cstream ? TL + b * 256 : b * 4096, NCH = L / 64, crow0 = TL + b * 256;
    const int n_init = cstream ? 0 : 4, n_steps = n_init + NCH;
    __syncthreads();
    for (int i = tid; i < 2048; i += NTHREADS) {
        const int pos = i >> 5, fi = i & 31; const float inv = exp2f(-(float)fi * (13.287712379549449f / 32.0f));
        const float turns = ((float)pos * inv) * 0.15915494309189535f;
        rope[i] = make_v2f(cos_turns(turns), sin_turns(turns));
    }
    const float lg = -__expf(a.in[19][(l * 2 + dir) * 12 + h]);
    const float cdec = __expf(lg * 64.0f);
    f32x4_t Sacc[8];
#pragma unroll
    for (int i = 0; i < 8; ++i) Sacc[i] = (f32x4_t){0.f, 0.f, 0.f, 0.f};
#pragma unroll
    for (int i = 0; i < 8; ++i) *(LAS v2u*)(St + (wave * 16 + fr) * 136 + i * 16 + fq * 4) = make_v2u(0u, 0u);
    RetRaw R;
    {
        const bool init = 0 < n_init; const int ch = init ? (dir ? 3 : 0) : (dir ? NCH - 1 : 0);
        ret_fetch(P, init ? crow0 + ch * 64 : row0 + ch * 64, h, !init, tid, R);
    }
#pragma unroll 1
    for (int st = 0; st < n_steps; ++st) {
        const bool init = st < n_init; const int cc = init ? st : st - n_init;
        const int ch = init ? (dir ? 3 - cc : cc) : (dir ? NCH - 1 - cc : cc);
        const int r0 = init ? crow0 + ch * 64 : row0 + ch * 64, pos0 = ch * 64;
        __syncthreads();
        ret_stage(R, pos0, !init, !init && !cstream, dir, lg, tid, Qs, Ks, Ktd, Vt, rope);
        if (st + 1 < n_steps) {
            const bool ninit = st + 1 < n_init; const int ncc = ninit ? st + 1 : st + 1 - n_init;
            const int nch = ninit ? (dir ? 3 - ncc : ncc) : (dir ? NCH - 1 - ncc : ncc);
            ret_fetch(P, ninit ? crow0 + nch * 64 : row0 + nch * 64, h, !ninit, tid, R);
        }
        __syncthreads();
        if (init) {
#pragma unroll
            for (int i = 0; i < 8; ++i) Sacc[i] *= cdec;
            mma_lds<8, 8, 64, 72, 72, false, true>(Ktd, Vt, Sacc, wave, fr, fq);
            if (st + 1 == n_init) {
                __syncthreads();
#pragma unroll
                for (int i = 0; i < 8; ++i)
                    *(LAS v2u*)(St + (wave * 16 + fr) * 136 + i * 16 + fq * 4) = make_v2u(pack2bf(Sacc[i][0], Sacc[i][1]), pack2bf(Sacc[i][2], Sacc[i][3]));
            }
            continue;
        }
        {
            f32x4_t sa[2] = {(f32x4_t){0.f, 0.f, 0.f, 0.f}, (f32x4_t){0.f, 0.f, 0.f, 0.f}};
            mma_lds<4, 2, 128, 136, 136>(Qs, Ks, sa, wave, fr, fq);
#pragma unroll
            for (int i = 0; i < 2; ++i) { const int tt = wave + 8 * i, tm = tt >> 2, tn = tt & 3;
#pragma unroll
                for (int r = 0; r < 4; ++r) Af[(tm * 16 + fq * 4 + r) * 68 + tn * 16 + fr] = sa[i][r]; }
        }
        __syncthreads();
        for (int i = tid; i < 4096; i += NTHREADS) {
            const int ii = i >> 6, jj = i & 63; const int dd = dir ? jj - ii : ii - jj;
            const float val = dd >= 0 ? Af[ii * 68 + jj] * __expf(lg * (float)dd) : 0.f;
            Pb[ii * 72 + jj] = f2bf(val);
        }
        __syncthreads();
        f32x4_t o1[4];
#pragma unroll
        for (int i = 0; i < 4; ++i) o1[i] = (f32x4_t){0.f, 0.f, 0.f, 0.f};
        mma_lds<8, 4, 128, 136, 136>(Qs, St, o1, wave, fr, fq);
#pragma unroll
        for (int i = 0; i < 4; ++i) {
            const int tt = wave + 8 * i, tm = tt >> 3;
#pragma unroll
            for (int r = 0; r < 4; ++r) { const int il = tm * 16 + fq * 4 + r; o1[i][r] *= __expf(lg * (float)(dir ? 64 - il : il + 1)); }
        }
        mma_lds<8, 4, 64, 72, 72, false, true>(Pb, Vt, o1, wave, fr, fq);
#pragma unroll
        for (int i = 0; i < 8; ++i) Sacc[i] *= cdec;
        mma_lds<8, 8, 64, 72, 72, false, true>(Ktd, Vt, Sacc, wave, fr, fq);
        __syncthreads();
#pragma unroll
        for (int i = 0; i < 8; ++i)
            *(LAS v2u*)(St + (wave * 16 + fr) * 136 + i * 16 + fq * 4) = make_v2u(pack2bf(Sacc[i][0], Sacc[i][1]), pack2bf(Sacc[i][2], Sacc[i][3]));
#pragma unroll
        for (int i = 0; i < 4; ++i) {
            const int tt = wave + 8 * i, tm = tt >> 3, tn = tt & 7;
#pragma unroll
            for (int r = 0; r < 4; ++r) {
                const int il = tm * 16 + fq * 4 + r, e = tn * 16 + fr;
                __hip_atomic_store(OFd + (size_t)(r0 + il) * 1536 + h * 128 + e, o1[i][r], __ATOMIC_RELAXED, __HIP_MEMORY_SCOPE_AGENT);
            }
        }
    }
    asm volatile("s_waitcnt vmcnt(0)" ::: "memory");
    __syncthreads();
    if (tid == 0) {
        unsigned* cnt = (unsigned*)(a.ws + WS_CTL) + CW_RET + ((l * 2 + (cstream ? 1 : 0)) * 48 + b * 12 + h);
        *slot = (int)__hip_atomic_fetch_add(cnt, 1u, __ATOMIC_RELAXED, __HIP_MEMORY_SCOPE_AGENT);
    }
    __syncthreads();
    if (*slot == 1) {
        __builtin_amdgcn_fence(__ATOMIC_ACQUIRE, "agent");
        const float* OF0 = (const float*)(a.ws + WS_OF); const float* OF1 = OF0 + (size_t)MT * 1536;
        bf16_t* MIX = (bf16_t*)(a.ws + WS_MIX);
#pragma unroll 2
        for (int t = wave; t < L; t += 8) {
            const size_t row = (size_t)(row0 + t);
            const v2f x0 = *(const v2f*)(OF0 + row * 1536 + h * 128 + 2 * lane), x1 = *(const v2f*)(OF1 + row * 1536 + h * 128 + 2 * lane);
            const float y0 = x0.x + x1.x, y1 = x0.y + x1.y;
            const float ss = wave_sum(y0 * y0 + y1 * y1); const float rs = rsqrtf(ss * (1.0f / 128.0f) + EPS);
            const unsigned gw = *(const unsigned*)(P + row * INC + C_RG + h * 128 + 2 * lane);
            *(unsigned*)(MIX + row * 4096 + M_RO + h * 128 + 2 * lane) = pack2bf(y0 * rs * silu_f(bflo(gw)), y1 * rs * silu_f(bfhi(gw)));
        }
    }
    __syncthreads();
}

__device__ __forceinline__ void hy_conv8(const LAS float* U, const LAS float* G, int L, float (&y)[8]) {
    const int tb = 8 * fresh_tid();
#pragma unroll
    for (int j = 0; j < 8; ++j) y[j] = 0.f;
    if (tb < L) {
#pragma unroll 2
        for (int s0 = 0; s0 < L; s0 += 4) {
            const int base = tb - s0 + L;
            const v4f g0 = *(const LAS v4f*)(G + base - 4), g1 = *(const LAS v4f*)(G + base), g2 = *(const LAS v4f*)(G + base + 4);
            const v4f u = *(const LAS v4f*)(U + s0);
            const float g[12] = {g0.x, g0.y, g0.z, g0.w, g1.x, g1.y, g1.z, g1.w, g2.x, g2.y, g2.z, g2.w};
            const float uu[4] = {u.x, u.y, u.z, u.w};
#pragma unroll
            for (int j = 0; j < 8; ++j)
#pragma unroll
                for (int i = 0; i < 4; ++i) y[j] += g[4 + j - i] * uu[i];
        }
    }
}
__device__ __forceinline__ void hyena_item(ARGS_REF a, int l, int c, int b, bool cstream, LAS unsigned char* lds) {
    const int tid = fresh_tid();
    const int L = cstream ? 256 : 4096, row0 = cstream ? TL + b * 256 : b * 4096;
    LAS float* sv = (LAS float*)lds; LAS float* sx1 = sv + L; LAS float* sx2 = sx1 + L; LAS float* sz = sx2 + L; LAS float* G0 = sz + L; LAS float* G1 = G0 + 2 * L;
    const bf16_t* UT = (const bf16_t*)(a.ws + WS_UT);
    bf16_t* MIX = (bf16_t*)(a.ws + WS_MIX);
    const float* cw = a.in[8] + l * 3 * 3072; const float* cb = a.in[9] + l * 3072;
    const float* K = cstream ? (const float*)(a.ws + WS_KTC) : (const float*)(a.ws + WS_KT) + (size_t)l * 4096 * 4096;
    __syncthreads();
    for (int t = tid; t < L; t += NTHREADS) {
#pragma unroll
        for (int which = 0; which < 3; ++which) {
            const int chn = which * 1024 + c; float acc = cb[chn];
#pragma unroll
            for (int i = 0; i < 3; ++i) { const int tt = t + i - 1; if (tt >= 0 && tt < L) acc += cw[i * 3072 + chn] * bf2f(UT[(size_t)chn * MT + row0 + tt]); }
            (which == 0 ? sv : (which == 1 ? sx1 : sx2))[t] = acc;
        }
    }
    for (int i = tid; i < 2 * L; i += NTHREADS) {
        const int d = i - L;
        const size_t cf0 = (size_t)(0 * 1024 + c) * L, cb0 = (size_t)(1 * 1024 + c) * L, cf1 = (size_t)(2 * 1024 + c) * L, cb1 = (size_t)(3 * 1024 + c) * L;
        float v0 = 0.f, v1 = 0.f;
        if (d >= 0) { v0 = K[cf0 + d]; v1 = K[cf1 + d]; } else if (d > -L) { v0 = K[cb0 - d]; v1 = K[cb1 - d]; }
        G0[i] = v0; G1[i] = v1;
    }
    __syncthreads();
    const float skip0 = a.in[18][(l * 2 + 0) * 1024 + c], skip1 = a.in[18][(l * 2 + 1) * 1024 + c];
    float y[8];
    hy_conv8(sv, G0, L, y);
    if (8 * tid < L) {
#pragma unroll
        for (int j = 0; j < 8; ++j) { const int t = 8 * tid + j; sz[t] = sx1[t] * (y[j] + skip0 * sv[t]); }
    }
    __syncthreads();
    hy_conv8(sz, G1, L, y);
    if (8 * tid < L) {
#pragma unroll
        for (int j = 0; j < 8; ++j) { const int t = 8 * tid + j; MIX[(size_t)(row0 + t) * 4096 + M_HY + c] = f2bf(sx2[t] * (y[j] + skip1 * sz[t])); }
    }
    __syncthreads();
}


#define HY_DEV __device__ __forceinline__
#define HY_LDS LAS
__device__ __forceinline__ float hy_cos_turns(float t) { return __builtin_amdgcn_cosf(t); }
__device__ __forceinline__ float hy_sin_turns(float t) { return __builtin_amdgcn_sinf(t); }

#define HY_CPX_DEFINED
typedef float cpx __attribute__((ext_vector_type(2)));
__device__ __forceinline__ cpx cmk(float x, float y) { return (cpx){x, y}; }
#ifndef HY_CPX_DEFINED
struct __attribute__((aligned(8))) cpx { float x, y; };
HY_DEV cpx cmk(float x, float y) { cpx r; r.x = x; r.y = y; return r; }
#endif
HY_DEV cpx cadd(cpx a, cpx b) { return cmk(a.x + b.x, a.y + b.y); }
HY_DEV cpx csub(cpx a, cpx b) { return cmk(a.x - b.x, a.y - b.y); }
HY_DEV cpx cmul(cpx a, cpx b) { return cmk(a.x * b.x - a.y * b.y, a.x * b.y + a.y * b.x); }
HY_DEV cpx cmuli(cpx a, bool inv) { return inv ? cmk(-a.y, a.x) : cmk(a.y, -a.x); }
constexpr int HY_N = 8192, HY_BUFN = 8192 + 256;
HY_DEV int hy_pad(int p) { return p + (p >> 5); }
HY_DEV int hy_freq(int p) { return (p >> 9) | (((p >> 5) & 15) << 4) | (((p >> 1) & 15) << 8) | ((p & 1) << 12); }
HY_DEV int hy_pos(int w) { return ((w & 15) << 9) | (((w >> 4) & 15) << 5) | (((w >> 8) & 15) << 1) | (w >> 12); }

template <bool INV> HY_DEV void dft16(cpx (&x)[16]) {
    const float C1 = 0.92387953251128674f, S1 = 0.38268343236508977f, R2 = 0.70710678118654752f;
    cpx u[4][4];
#pragma unroll
    for (int b = 0; b < 4; ++b) {
        const cpx t0 = cadd(x[b], x[8 + b]), t1 = csub(x[b], x[8 + b]), t2 = cadd(x[4 + b], x[12 + b]), t3 = cmuli(csub(x[4 + b], x[12 + b]), INV);
        u[b][0] = cadd(t0, t2); u[b][2] = csub(t0, t2); u[b][1] = cadd(t1, t3); u[b][3] = csub(t1, t3);
    }
    const float sg = INV ? 1.0f : -1.0f;
    u[1][1] = cmul(u[1][1], cmk(C1, sg * S1));  u[1][2] = cmul(u[1][2], cmk(R2, sg * R2));  u[1][3] = cmul(u[1][3], cmk(S1, sg * C1));
    u[2][1] = cmul(u[2][1], cmk(R2, sg * R2));  u[2][2] = cmuli(u[2][2], INV);              u[2][3] = cmul(u[2][3], cmk(-R2, sg * R2));
    u[3][1] = cmul(u[3][1], cmk(S1, sg * C1));  u[3][2] = cmul(u[3][2], cmk(-R2, sg * R2)); u[3][3] = cmul(u[3][3], cmk(-C1, -sg * S1));
#pragma unroll
    for (int c = 0; c < 4; ++c) {
        const cpx t0 = cadd(u[0][c], u[2][c]), t1 = csub(u[0][c], u[2][c]), t2 = cadd(u[1][c], u[3][c]), t3 = cmuli(csub(u[1][c], u[3][c]), INV);
        x[c] = cadd(t0, t2); x[c + 8] = csub(t0, t2); x[c + 4] = cadd(t1, t3); x[c + 12] = csub(t1, t3);
    }
}
template <bool INV> HY_DEV void hy_twiddle(cpx (&x)[16], int j, int n) {
    const float turns = (float)j / (float)n;
    const cpx w1 = cmk(hy_cos_turns(turns), INV ? hy_sin_turns(turns) : -hy_sin_turns(turns));
    cpx w = w1;
#pragma unroll
    for (int q = 1; q < 16; ++q) { x[q] = cmul(x[q], w); w = cmul(w, w1); }
}
template <bool LOAD> HY_DEV void hy_fwd16(int tid, int n, HY_LDS cpx* Z, cpx (&x)[16]) {
    const int m = n >> 4, blk = tid / m, j = tid - blk * m, base = blk * n + j;
    const int bp = hy_pad(base), S = m + (m >> 5);
    if (LOAD) {
#pragma unroll
        for (int k = 0; k < 16; ++k) x[k] = Z[bp + k * S];
    }
    dft16<false>(x);
    hy_twiddle<false>(x, j, n);
#pragma unroll
    for (int q = 0; q < 16; ++q) Z[bp + q * S] = x[q];
}
template <bool STORE> HY_DEV void hy_inv16(int tid, int n, HY_LDS cpx* Z, cpx (&x)[16]) {
    const int m = n >> 4, blk = tid / m, j = tid - blk * m, base = blk * n + j;
    const int bp = hy_pad(base), S = m + (m >> 5);
#pragma unroll
    for (int q = 0; q < 16; ++q) x[q] = Z[bp + q * S];
    hy_twiddle<true>(x, j, n);
    dft16<true>(x);
    if (STORE) {
#pragma unroll
        for (int k = 0; k < 16; ++k) Z[bp + k * S] = x[k];
    }
}
HY_DEV void hy_fwd2(int tid, HY_LDS cpx* Z) {
#pragma unroll
    for (int i = 0; i < 8; ++i) { const int pp = 16 * tid + (tid >> 1) + 2 * i; const cpx a = Z[pp], b = Z[pp + 1]; Z[pp] = cadd(a, b); Z[pp + 1] = csub(a, b); }
}
HY_DEV cpx hy_kfilter(const HY_LDS cpx* F, int p, int order) {
    const int w = hy_freq(p); const cpx A = F[hy_pad(p)], B = F[hy_pad(hy_pos((HY_N - w) & (HY_N - 1)))];
    return order == 0 ? cmk(0.5f * (A.x + B.x), 0.5f * (A.y - B.y)) : cmk(0.5f * (A.y + B.y), -0.5f * (A.x - B.x));
}
HY_DEV void hy_mid(int tid, HY_LDS cpx* Z, const HY_LDS cpx* F, int order, float scale) {
#pragma unroll
    for (int i = 0; i < 8; ++i) {
        const int p0 = 16 * tid + 2 * i, pp = p0 + (tid >> 1); const cpx a = Z[pp], b = Z[pp + 1];
        cpx k0 = hy_kfilter(F, p0, order), k1 = hy_kfilter(F, p0 + 1, order);
        k0.x *= scale; k0.y *= scale; k1.x *= scale; k1.y *= scale;
        const cpx y0 = cmul(cadd(a, b), k0), y1 = cmul(csub(a, b), k1);
        Z[pp] = cadd(y0, y1); Z[pp + 1] = csub(y0, y1);
    }
}
__device__ __forceinline__ void hy_conv_fft(LAS cpx* Z, const LAS cpx* F, int order, cpx (&x)[16], int pmode = 0) {
    if (pmode == 1) return;
    hy_fwd16<false>(fresh_tid(), 8192, Z, x); __syncthreads();
    hy_fwd16<true>(fresh_tid(), 512, Z, x); __syncthreads();
    hy_fwd16<true>(fresh_tid(), 32, Z, x); __syncthreads();
    hy_mid(fresh_tid(), Z, F, order, 1.0f / 8192.0f); __syncthreads();
    hy_inv16<true>(fresh_tid(), 32, Z, x); __syncthreads();
    hy_inv16<true>(fresh_tid(), 512, Z, x); __syncthreads();
    hy_inv16<false>(fresh_tid(), 8192, Z, x);
}
__device__ __forceinline__ void hy_load_short(const bf16_t* U0, const bf16_t* U1, float w0, float w1, float w2, float bias, int tid, cpx (&o)[8]) {
    const int lane = tid & 63, tb = tid - lane;
    unsigned c0[8], c1[8], e0[8], e1[8];
#pragma unroll
    for (int k = 0; k < 8; ++k) {
        const int t = tid + 512 * k, ter = (lane < 32) ? (tb + 512 * k - 1) : (tb + 512 * k + 64), te = ter < 0 ? 0 : (ter > 4095 ? 4095 : ter);
        c0[k] = U0[t]; c1[k] = U1[t]; e0[k] = U0[te]; e1[k] = U1[te];
    }
#pragma unroll
    for (int k = 0; k < 8; ++k) {
        const int ter = (lane < 32) ? (tb + 512 * k - 1) : (tb + 512 * k + 64); const bool ev = (ter >= 0) && (ter <= 4095);
        const unsigned m0 = ev ? e0[k] : 0u, m1 = ev ? e1[k] : 0u;
        const unsigned l0 = (unsigned)__builtin_amdgcn_update_dpp((int)m0, (int)c0[k], 0x138, 0xf, 0xf, false), r0 = (unsigned)__builtin_amdgcn_update_dpp((int)m0, (int)c0[k], 0x130, 0xf, 0xf, false);
        const unsigned l1 = (unsigned)__builtin_amdgcn_update_dpp((int)m1, (int)c1[k], 0x138, 0xf, 0xf, false), r1 = (unsigned)__builtin_amdgcn_update_dpp((int)m1, (int)c1[k], 0x130, 0xf, 0xf, false);
        o[k] = cmk(bias + w0 * bf2f((bf16_t)l0) + w1 * bf2f((bf16_t)c0[k]) + w2 * bf2f((bf16_t)r0), bias + w0 * bf2f((bf16_t)l1) + w1 * bf2f((bf16_t)c1[k]) + w2 * bf2f((bf16_t)r1));
    }
}
__device__ __forceinline__ void hyena_fft_item(ARGS_REF a, int l, int c4, LAS unsigned char* lds, int pmode = 0) {
    LAS cpx* F = (LAS cpx*)lds; LAS cpx* Z = F + HY_BUFN;
    const bf16_t* UT = (const bf16_t*)(a.ws + WS_UT);
    bf16_t* MIX = (bf16_t*)(a.ws + WS_MIX);
    const float* cw = a.in[8] + l * 3 * 3072; const float* cb = a.in[9] + l * 3072;
    const float* K = (const float*)(a.ws + WS_KT) + (size_t)l * 4096 * 4096;
    unsigned olo[2][8][2], ohi[2][8][2];
#pragma unroll
    for (int i = 0; i < 2; ++i)
#pragma unroll
        for (int k = 0; k < 8; ++k) { olo[i][k][0] = 0u; olo[i][k][1] = 0u; ohi[i][k][0] = 0u; ohi[i][k][1] = 0u; }
#pragma unroll 1
    for (int ci = 0; ci < 4; ++ci) {
        const int c = 4 * c4 + ci;
        const float skip0 = a.in[18][(l * 2 + 0) * 1024 + c], skip1 = a.in[18][(l * 2 + 1) * 1024 + c];
        __syncthreads();
        cpx x[16];
        {
            const int tid = fresh_tid();
            const float* kf0 = K + (size_t)(0 * 1024 + c) * 4096; const float* kb0 = K + (size_t)(1 * 1024 + c) * 4096;
            const float* kf1 = K + (size_t)(2 * 1024 + c) * 4096; const float* kb1 = K + (size_t)(3 * 1024 + c) * 4096;
#pragma unroll
            for (int k = 0; k < 8; ++k) x[k] = cmk(kf0[tid + 512 * k], kf1[tid + 512 * k]);
#pragma unroll
            for (int k = 8; k < 16; ++k) { const int i = tid + 512 * k; const int ii = (i == 4096) ? 1 : 8192 - i; const cpx v = cmk(kb0[ii], kb1[ii]); x[k] = (i == 4096) ? cmk(0.f, 0.f) : v; }
            hy_fwd16<false>(fresh_tid(), 8192, F, x); __syncthreads();
            hy_fwd16<true>(fresh_tid(), 512, F, x); __syncthreads();
            hy_fwd16<true>(fresh_tid(), 32, F, x); __syncthreads();
            hy_fwd2(fresh_tid(), F); __syncthreads();
        }
#pragma unroll
        for (int bp = 0; bp < 2; ++bp) {
            const int rb0 = (2 * bp) * 4096, rb1 = (2 * bp + 1) * 4096;
            unsigned vvp[8], z1p[8];
            {
                cpx vv[8];
                const int chn = c; hy_load_short(UT + (size_t)chn * MT + rb0, UT + (size_t)chn * MT + rb1, cw[chn], cw[3072 + chn], cw[2 * 3072 + chn], cb[chn], fresh_tid(), vv);
#pragma unroll
                for (int k = 0; k < 8; ++k) { x[k] = vv[k]; x[k + 8] = cmk(0.f, 0.f); vvp[k] = pack2bf(vv[k].x, vv[k].y); }
            }
            hy_conv_fft(Z, F, 0, x, pmode);
            {
                cpx x1v[8];
                const int chn = 1024 + c; hy_load_short(UT + (size_t)chn * MT + rb0, UT + (size_t)chn * MT + rb1, cw[chn], cw[3072 + chn], cw[2 * 3072 + chn], cb[chn], fresh_tid(), x1v);
#pragma unroll
                for (int k = 0; k < 8; ++k) {
                    const cpx z = cmk(x1v[k].x * (x[k].x + skip0 * bflo(vvp[k])), x1v[k].y * (x[k].y + skip0 * bfhi(vvp[k])));
                    x[k] = z; x[k + 8] = cmk(0.f, 0.f); z1p[k] = pack2bf(z.x, z.y);
                }
            }
            __syncthreads();
            hy_conv_fft(Z, F, 1, x, pmode);
            {
                cpx x2v[8];
                const int chn = 2048 + c; hy_load_short(UT + (size_t)chn * MT + rb0, UT + (size_t)chn * MT + rb1, cw[chn], cw[3072 + chn], cw[2 * 3072 + chn], cb[chn], fresh_tid(), x2v);
                const unsigned sh = (ci & 1) ? 16u : 0u;
#pragma unroll
                for (int k = 0; k < 8; ++k) {
                    const unsigned w0 = (unsigned)f2bf(x2v[k].x * (x[k].x + skip1 * bflo(z1p[k]))) << sh, w1 = (unsigned)f2bf(x2v[k].y * (x[k].y + skip1 * bfhi(z1p[k]))) << sh;
                    if (ci < 2) { olo[bp][k][0] |= w0; olo[bp][k][1] |= w1; } else { ohi[bp][k][0] |= w0; ohi[bp][k][1] |= w1; }
                }
            }
            __syncthreads();
        }
    }
    if (pmode == 0 || pmode == 3) {
        const int tid = fresh_tid();
#pragma unroll
        for (int bp = 0; bp < 2; ++bp)
#pragma unroll
            for (int k = 0; k < 8; ++k) {
                const int t = tid + 512 * k;
                *(v2u*)(MIX + (size_t)((2 * bp) * 4096 + t) * 4096 + M_HY + 4 * c4) = make_v2u(olo[bp][k][0], ohi[bp][k][0]);
                *(v2u*)(MIX + (size_t)((2 * bp + 1) * 4096 + t) * 4096 + M_HY + 4 * c4) = make_v2u(olo[bp][k][1], ohi[bp][k][1]);
            }
    }
}

__device__ __forceinline__ void hy_ctx_conv2(const LAS float* U, const LAS float* G, int t2, float (&y)[2]) {
    y[0] = 0.f; y[1] = 0.f;
#pragma unroll 4
    for (int s0 = 0; s0 < 256; s0 += 4) {
        const int base = t2 - s0 + 256; const v4f u = *(const LAS v4f*)(U + s0);
        const float g0 = G[base - 3], g1 = G[base - 2], g2 = G[base - 1], g3 = G[base], g4 = G[base + 1];
        y[0] += g3 * u.x + g2 * u.y + g1 * u.z + g0 * u.w;
        y[1] += g4 * u.x + g3 * u.y + g2 * u.z + g1 * u.w;
    }
}
__device__ __forceinline__ void hyena_ctx_item(ARGS_REF a, int l, int c, LAS unsigned char* lds) {
    const int tid = fresh_tid();
    LAS float* G0 = (LAS float*)lds; LAS float* G1 = G0 + 512;
    LAS float* sv = G1 + 512; LAS float* sx1 = sv + 1024; LAS float* sx2 = sx1 + 1024; LAS float* sz = sx2 + 1024;
    const bf16_t* UT = (const bf16_t*)(a.ws + WS_UT);
    bf16_t* MIX = (bf16_t*)(a.ws + WS_MIX);
    const float* cw = a.in[8] + l * 3 * 3072; const float* cb = a.in[9] + l * 3072;
    const float* K = (const float*)(a.ws + WS_KTC);
    __syncthreads();
#pragma unroll
    for (int i = 0; i < 2; ++i) {
        const int idx = tid + 512 * i; const int b = idx >> 8, t = idx & 255, tm = t > 0 ? t - 1 : 0, tp = t < 255 ? t + 1 : 255;
        const float m0 = t > 0 ? 1.f : 0.f, m2 = t < 255 ? 1.f : 0.f;
#pragma unroll
        for (int which = 0; which < 3; ++which) {
            const int chn = which * 1024 + c; const bf16_t* U = UT + (size_t)chn * MT + TL + b * 256;
            const float val = cb[chn] + cw[chn] * m0 * bf2f(U[tm]) + cw[3072 + chn] * bf2f(U[t]) + cw[2 * 3072 + chn] * m2 * bf2f(U[tp]);
            (which == 0 ? sv : (which == 1 ? sx1 : sx2))[idx] = val;
        }
    }
    {
        const int d = tid - 256, dd = d >= 0 ? d : -d, ok = (d > -256) ? 1 : 0;
        const float f0 = K[(size_t)(0 * 1024 + c) * 256 + dd], b0 = K[(size_t)(1 * 1024 + c) * 256 + dd], f1 = K[(size_t)(2 * 1024 + c) * 256 + dd], b1 = K[(size_t)(3 * 1024 + c) * 256 + dd];
        G0[tid] = ok ? (d >= 0 ? f0 : b0) : 0.f; G1[tid] = ok ? (d >= 0 ? f1 : b1) : 0.f;
    }
    __syncthreads();
    const float skip0 = a.in[18][(l * 2 + 0) * 1024 + c], skip1 = a.in[18][(l * 2 + 1) * 1024 + c];
    const int b = tid >> 7, t2 = (tid & 127) * 2;
    float y[2];
    hy_ctx_conv2(sv + b * 256, G0, t2, y);
    sz[b * 256 + t2] = sx1[b * 256 + t2] * (y[0] + skip0 * sv[b * 256 + t2]); sz[b * 256 + t2 + 1] = sx1[b * 256 + t2 + 1] * (y[1] + skip0 * sv[b * 256 + t2 + 1]);
    __syncthreads();
    hy_ctx_conv2(sz + b * 256, G1, t2, y);
    MIX[(size_t)(TL + b * 256 + t2) * 4096 + M_HY + c] = f2bf(sx2[b * 256 + t2] * (y[0] + skip1 * sz[b * 256 + t2]));
    MIX[(size_t)(TL + b * 256 + t2 + 1) * 4096 + M_HY + c] = f2bf(sx2[b * 256 + t2 + 1] * (y[1] + skip1 * sz[b * 256 + t2 + 1]));
    __syncthreads();
}

struct NaRaw { v4u k[4]; v2u v[2][4]; };
__device__ __forceinline__ void na_fetch(const bf16_t* P, int krow0, int h, int tid, NaRaw& R) {
#pragma unroll
    for (int i = 0; i < 4; ++i) { const int idx = tid + 512 * i; const int kr = idx >> 4, c8 = idx & 15; R.k[i] = *(const v4u*)(P + (size_t)(krow0 + kr) * INC + C_NK + h * 128 + c8 * 8); }
#pragma unroll
    for (int it = 0; it < 2; ++it) {
        const int task = tid + 512 * it; const int s4 = task >> 5, e4 = task & 31;
        const bf16_t* src = P + (size_t)(krow0 + 4 * s4) * INC + C_NV + h * 128 + 4 * e4;
#pragma unroll
        for (int j = 0; j < 4; ++j) R.v[it][j] = *(const v2u*)(src + (size_t)j * INC);
    }
}
__device__ __forceinline__ void na_stage(const NaRaw& R, int tid, LAS bf16_t* Kb, LAS bf16_t* Vt) {
#pragma unroll
    for (int i = 0; i < 4; ++i) { const int idx = tid + 512 * i; const int kr = idx >> 4, c8 = idx & 15; *(LAS v4u*)(Kb + kr * 136 + c8 * 8) = R.k[i]; }
#pragma unroll
    for (int it = 0; it < 2; ++it) {
        const int task = tid + 512 * it; const int s4 = task >> 5, e4 = task & 31, sw = s4 ^ (e4 >> 2);
        const unsigned r0x = R.v[it][0].x, r0y = R.v[it][0].y, r1x = R.v[it][1].x, r1y = R.v[it][1].y, r2x = R.v[it][2].x, r2y = R.v[it][2].y, r3x = R.v[it][3].x, r3y = R.v[it][3].y;
        *(LAS v2u*)(Vt + (4 * e4 + 0) * 136 + 4 * sw) = make_v2u((r0x & 0xffffu) | (r1x << 16), (r2x & 0xffffu) | (r3x << 16));
        *(LAS v2u*)(Vt + (4 * e4 + 1) * 136 + 4 * sw) = make_v2u((r0x >> 16) | (r1x & 0xffff0000u), (r2x >> 16) | (r3x & 0xffff0000u));
        *(LAS v2u*)(Vt + (4 * e4 + 2) * 136 + 4 * sw) = make_v2u((r0y & 0xffffu) | (r1y << 16), (r2y & 0xffffu) | (r3y << 16));
        *(LAS v2u*)(Vt + (4 * e4 + 3) * 136 + 4 * sw) = make_v2u((r0y >> 16) | (r1y & 0xffff0000u), (r2y >> 16) | (r3y & 0xffff0000u));
    }
}
__device__ __forceinline__ void na_item(ARGS_REF a, int l, int b, int h, int r, bool cstream, LAS unsigned char* lds, int pmode = 0) {
    const int tid = fresh_tid(), lane = tid & 63, wave = tid >> 6, fr = lane & 15, fq = lane >> 4;
    LAS bf16_t* Qs = (LAS bf16_t*)lds;
    LAS bf16_t* Kb = (LAS bf16_t*)(lds + 17408);
    LAS bf16_t* Vt = (LAS bf16_t*)(lds + 52224);
    LAS float*  Sf = (LAS float*)(lds + 87040);
    LAS bf16_t* Pb = (LAS bf16_t*)(lds + 120832);
    LAS float*  rk = (LAS float*)(lds + 138240);
    LAS float*  st_m = rk + 128;
    LAS float*  st_l = st_m + 64;
    LAS float*  st_a = st_l + 64;
    LAS float*  rpbs = st_a + 64;
    const bf16_t* P = (const bf16_t*)(a.ws + WS_PROJ);
    bf16_t* MIX = (bf16_t*)(a.ws + WS_MIX);
    const int qrow0 = cstream ? TL + b * 256 + r * 64 : b * 4096 + r * 64;
    const float* gq = a.in[21] + l * 128; const float* gk = a.in[22] + l * 128;
    const float* rpb = a.in[20] + (size_t)(l * 12 + h) * 15 * 31;
    const int nloc = cstream ? 0 : 4, start = clampi(r - 4, 0, 56), nsteps = nloc + 2;
    NaRaw R;
    na_fetch(P, cstream ? TL + b * 256 : b * 4096 + start * 64, h, tid, R);
    __syncthreads();
#pragma unroll 1
    for (int qq = 0; qq < 8; ++qq) {
        const int q = wave * 8 + qq; const bf16_t* p = P + (size_t)(qrow0 + q) * INC + C_NQ + h * 128;
        const unsigned w = *(const unsigned*)(p + 2 * lane); const float x0 = bflo(w), x1 = bfhi(w);
        const float ss = wave_sum(x0 * x0 + x1 * x1); const float rs = rsqrtf(ss * (1.0f / 128.0f) + EPS) * RET_SCALE;
        *(LAS unsigned*)(Qs + q * 136 + 2 * lane) = pack2bf(x0 * rs * gq[2 * lane] * gk[2 * lane], x1 * rs * gq[2 * lane + 1] * gk[2 * lane + 1]);
    }
    if (tid < 64) { st_m[tid] = -1.0e30f; st_l[tid] = 0.f; }
    if (tid < 465) rpbs[tid] = rpb[tid];
    f32x4_t O[4];
#pragma unroll
    for (int i = 0; i < 4; ++i) O[i] = (f32x4_t){0.f, 0.f, 0.f, 0.f};
#pragma unroll 1
    for (int st = 0; st < nsteps; ++st) {
        const bool local = st < nloc;
        __syncthreads();
        na_stage(R, tid, Kb, Vt);
        if (st + 1 < nsteps) { const bool nl = st + 1 < nloc; na_fetch(P, nl ? b * 4096 + (start + 2 * (st + 1)) * 64 : TL + b * 256 + (st + 1 - nloc) * 128, h, tid, R); }
        __syncthreads();
        if (pmode == 4) continue;
        {
            const int key = tid >> 2, part = tid & 3; float ss = 0.f;
#pragma unroll
            for (int i = 0; i < 4; ++i) { const v4u w = *(const LAS v4u*)(Kb + key * 136 + part * 32 + i * 8);
                ss += bflo(w.x) * bflo(w.x) + bfhi(w.x) * bfhi(w.x) + bflo(w.y) * bflo(w.y) + bfhi(w.y) * bfhi(w.y) + bflo(w.z) * bflo(w.z) + bfhi(w.z) * bfhi(w.z) + bflo(w.w) * bflo(w.w) + bfhi(w.w) * bfhi(w.w); }
            ss += WAVE_DPP(ss, 0xB1); ss += WAVE_DPP(ss, 0x4E);
            if (part == 0) rk[key] = rsqrtf(ss * (1.0f / 128.0f) + EPS);
            f32x4_t sa[4];
#pragma unroll
            for (int i = 0; i < 4; ++i) sa[i] = (f32x4_t){0.f, 0.f, 0.f, 0.f};
            mma_lds<8, 4, 128, 136, 136>(Qs, Kb, sa, wave, fr, fq);
#pragma unroll
            for (int i = 0; i < 4; ++i)
#pragma unroll
                for (int rr = 0; rr < 4; ++rr) Sf[(i * 16 + fq * 4 + rr) * 132 + wave * 16 + fr] = sa[i][rr];
        }
        __syncthreads();
        if (pmode == 5) continue;
        {
            const int q = tid >> 3, part = tid & 7, col0 = part * 16;
            float s[16]; float mx = -1.0e30f;
            if (local) {
                const int cs = clampi(q - 8, 0, 48), kc0 = (part & 3) * 16, ridx = start + 2 * st + (part >> 2) - r + 7;
#pragma unroll
                for (int j4 = 0; j4 < 4; ++j4) {
                    const v4f sv = *(const LAS v4f*)(Sf + q * 132 + col0 + 4 * j4), kv = *(const LAS v4f*)(rk + col0 + 4 * j4);
#pragma unroll
                    for (int jj = 0; jj < 4; ++jj) {
                        const int kc = kc0 + 4 * j4 + jj; const bool ok = (kc >= cs) && (kc < cs + 16);
                        const float v = sv[jj] * kv[jj] + rpbs[ridx * 31 + clampi(kc - q + 15, 0, 30)];
                        s[4 * j4 + jj] = ok ? v : -1.0e30f; mx = fmaxf(mx, s[4 * j4 + jj]);
                    }
                }
            } else {
#pragma unroll
                for (int j4 = 0; j4 < 4; ++j4) {
                    const v4f sv = *(const LAS v4f*)(Sf + q * 132 + col0 + 4 * j4), kv = *(const LAS v4f*)(rk + col0 + 4 * j4);
#pragma unroll
                    for (int jj = 0; jj < 4; ++jj) { s[4 * j4 + jj] = sv[jj] * kv[jj]; mx = fmaxf(mx, s[4 * j4 + jj]); }
                }
            }
            mx = fmaxf(mx, WAVE_DPP(mx, 0xB1)); mx = fmaxf(mx, WAVE_DPP(mx, 0x4E)); mx = fmaxf(mx, WAVE_DPP(mx, 0x141));
            const float mo = st_m[q], mn = fmaxf(mo, mx);
            float sum = 0.f; unsigned pw[8];
#pragma unroll
            for (int j2 = 0; j2 < 8; ++j2) { const float p0 = __expf(s[2 * j2] - mn), p1 = __expf(s[2 * j2 + 1] - mn); sum += p0 + p1; pw[j2] = pack2bf(p0, p1); }
            *(LAS v4u*)(Pb + q * 136 + col0) = make_v4u(pw[0], pw[1], pw[2], pw[3]); *(LAS v4u*)(Pb + q * 136 + col0 + 8) = make_v4u(pw[4], pw[5], pw[6], pw[7]);
            sum += WAVE_DPP(sum, 0xB1); sum += WAVE_DPP(sum, 0x4E); sum += WAVE_DPP(sum, 0x141);
            const float al = __expf(mo - mn);
            if (part == 0) { st_m[q] = mn; st_l[q] = st_l[q] * al + sum; st_a[q] = al; }
        }
        __syncthreads();
        if (pmode == 6) continue;
#pragma unroll
        for (int i = 0; i < 4; ++i)
#pragma unroll
            for (int rr = 0; rr < 4; ++rr) O[i][rr] *= st_a[i * 16 + fq * 4 + rr];
        mma_lds<8, 4, 128, 136, 136>(Pb, Vt, O, wave, fr, fq);
    }
    __syncthreads();
    if (pmode >= 4) return;
#pragma unroll
    for (int i = 0; i < 4; ++i)
#pragma unroll
        for (int rr = 0; rr < 4; ++rr) { const int q = i * 16 + fq * 4 + rr; MIX[(size_t)(qrow0 + q) * 4096 + M_NO + h * 128 + wave * 16 + fr] = f2bf(O[i][rr] / st_l[q]); }
    __syncthreads();
}

__device__ __forceinline__ void na2_fetch(const bf16_t* P, int rowA, int rowB, int h, int tid, NaRaw& R) {
#pragma unroll
    for (int i = 0; i < 4; ++i) { const int idx = tid + 512 * i; const int kr = idx >> 4, c8 = idx & 15; const int row = kr < 64 ? rowA + kr : rowB + kr - 64;
        R.k[i] = *(const v4u*)(P + (size_t)row * INC + C_NK + h * 128 + c8 * 8); }
#pragma unroll
    for (int it = 0; it < 2; ++it) {
        const int task = tid + 512 * it; const int s4 = task >> 5, e4 = task & 31; const int r0 = 4 * s4, row = r0 < 64 ? rowA + r0 : rowB + r0 - 64;
        const bf16_t* src = P + (size_t)row * INC + C_NV + h * 128 + 4 * e4;
#pragma unroll
        for (int j = 0; j < 4; ++j) R.v[it][j] = *(const v2u*)(src + (size_t)j * INC);
    }
}
__device__ __forceinline__ void na2_item(ARGS_REF a, int l, int b, int h, int rp, bool cstream, LAS unsigned char* lds, int namode = 0) {
    const int tid = fresh_tid(), lane = tid & 63, wave = tid >> 6, fr = lane & 15, fq = lane >> 4;
    LAS bf16_t* Qs = (LAS bf16_t*)lds;
    LAS bf16_t* Kb = (LAS bf16_t*)(lds + 34816);
    LAS bf16_t* Vt = (LAS bf16_t*)(lds + 69632);
    LAS float*  rk = (LAS float*)(lds + 104448);
    LAS float*  rpbs = rk + 128;
    LAS float*  alx = rpbs + 480;
    const bf16_t* P = (const bf16_t*)(a.ws + WS_PROJ);
    bf16_t* MIX = (bf16_t*)(a.ws + WS_MIX);
    const float* gqp = a.in[21] + l * 128; const float* gkp = a.in[22] + l * 128;
    const float* rpb = a.in[20] + (size_t)(l * 12 + h) * 15 * 31;
    const int r0 = 2 * rp, start0 = clampi(r0 - 4, 0, 56), start1 = clampi(r0 - 3, 0, 56);
    const int nloc = cstream ? 0 : ((start1 + 9 - start0) >> 1), nsteps = nloc + 2;
    const int qb0 = cstream ? TL + b * 256 + rp * 128 + 16 * wave : b * 4096 + r0 * 64 + 8 * wave;
#define NA2_QTOK(j) (cstream ? qb0 + (j) : qb0 + ((j) >> 3) * 64 + ((j) & 7))
    const int rq = r0 + (fr >> 3), startq = (fr < 8) ? start0 : start1, qcol = 8 * wave + (fr & 7), cs = clampi(qcol - 8, 0, 48);
    const int wu = __builtin_amdgcn_readfirstlane(wave), tlo = wu <= 2 ? 0 : (wu <= 4 ? 1 : 2);
#define NA2_ROWA(s) ((s) < nloc ? b * 4096 + (start0 + 2 * (s) < 63 ? start0 + 2 * (s) : 63) * 64 : TL + b * 256 + ((s) - nloc) * 128)
#define NA2_ROWB(s) ((s) < nloc ? b * 4096 + (start0 + 2 * (s) + 1 < 63 ? start0 + 2 * (s) + 1 : 63) * 64 : TL + b * 256 + ((s) - nloc) * 128 + 64)
    NaRaw R;
    na2_fetch(P, NA2_ROWA(0), NA2_ROWB(0), h, tid, R);
    __syncthreads();
    if (tid < 465) rpbs[tid] = rpb[tid];
    {
        const v4f g0 = *(const v4f*)(gqp + 8 * fr), g1 = *(const v4f*)(gqp + 8 * fr + 4), k0 = *(const v4f*)(gkp + 8 * fr), k1 = *(const v4f*)(gkp + 8 * fr + 4);
#pragma unroll
        for (int it = 0; it < 4; ++it) {
            const int j = it * 4 + fq; const v4u w = *(const v4u*)(P + (size_t)NA2_QTOK(j) * INC + C_NQ + h * 128 + 8 * fr);
            const float x0 = bflo(w.x), x1 = bfhi(w.x), x2 = bflo(w.y), x3 = bfhi(w.y), x4 = bflo(w.z), x5 = bfhi(w.z), x6 = bflo(w.w), x7 = bfhi(w.w);
            float ss = (x0 * x0 + x1 * x1) + (x2 * x2 + x3 * x3) + (x4 * x4 + x5 * x5) + (x6 * x6 + x7 * x7);
            ss += WAVE_DPP(ss, 0xB1); ss += WAVE_DPP(ss, 0x4E); ss += WAVE_DPP(ss, 0x141); ss += WAVE_DPP(ss, 0x140);
            const float rs = rsqrtf(ss * (1.0f / 128.0f) + EPS) * RET_SCALE;
            *(LAS v4u*)(Qs + (16 * wave + j) * 136 + 8 * fr) = make_v4u(pack2bf(x0 * rs * g0.x * k0.x, x1 * rs * g0.y * k0.y), pack2bf(x2 * rs * g0.z * k0.z, x3 * rs * g0.w * k0.w),
                                                                          pack2bf(x4 * rs * g1.x * k1.x, x5 * rs * g1.y * k1.y), pack2bf(x6 * rs * g1.z * k1.z, x7 * rs * g1.w * k1.w));
        }
    }
    bf16x8_t qf[4];
#pragma unroll
    for (int ks = 0; ks < 4; ++ks) qf[ks] = *(const LAS bf16x8_t*)(Qs + (16 * wave + fr) * 136 + 8 * fq + 32 * ks);
    float m_run = -1.0e30f, l_run = 0.f;
    f32x4_t O[8];
#pragma unroll
    for (int i = 0; i < 8; ++i) O[i] = (f32x4_t){0.f, 0.f, 0.f, 0.f};
#pragma unroll 1
    for (int st = 0; st < nsteps; ++st) {
        const bool local = st < nloc; const int kra = start0 + 2 * st;
        __syncthreads();
        na_stage(R, tid, Kb, Vt);
#pragma unroll
        for (int i = 0; i < 4; ++i) {
            const v4u w = R.k[i];
            float ss = (bflo(w.x) * bflo(w.x) + bfhi(w.x) * bfhi(w.x)) + (bflo(w.y) * bflo(w.y) + bfhi(w.y) * bfhi(w.y)) + (bflo(w.z) * bflo(w.z) + bfhi(w.z) * bfhi(w.z)) + (bflo(w.w) * bflo(w.w) + bfhi(w.w) * bfhi(w.w));
            ss += WAVE_DPP(ss, 0xB1); ss += WAVE_DPP(ss, 0x4E); ss += WAVE_DPP(ss, 0x141); ss += WAVE_DPP(ss, 0x140);
            if (fr == 0) rk[(tid + 512 * i) >> 4] = rsqrtf(ss * (1.0f / 128.0f) + EPS);
        }
        if (st + 1 < nsteps && namode != 1) na2_fetch(P, NA2_ROWA(st + 1), NA2_ROWB(st + 1), h, tid, R);
        __syncthreads();
        if (namode == 3) continue;
        if (local) {
        f32x4_t sa[4];
#pragma unroll
        for (int u = 0; u < 4; ++u) {
            const int t = 4 * (u >> 1) + tlo + (u & 1);
            sa[u] = (f32x4_t){0.f, 0.f, 0.f, 0.f};
#pragma unroll
            for (int ks = 0; ks < 4; ++ks) sa[u] = __builtin_amdgcn_mfma_f32_16x16x32_bf16(*(const LAS bf16x8_t*)(Kb + (16 * t + fr) * 136 + 8 * fq + 32 * ks), qf[ks], sa[u], 0, 0, 0);
        }
        float mx = -1.0e30f;
#pragma unroll
        for (int u = 0; u < 4; ++u) {
            const int t = 4 * (u >> 1) + tlo + (u & 1);
            const v4f kv = *(const LAS v4f*)(rk + 16 * t + 4 * fq);
#pragma unroll
            for (int rr = 0; rr < 4; ++rr) {
                float v = sa[u][rr] * kv[rr];
                const int kr = kra + (u >> 1), kc = 16 * (tlo + (u & 1)) + 4 * fq + rr;
                const bool ok = (kr >= startq) && (kr <= startq + 7) && (kc >= cs) && (kc < cs + 16);
                v += rpbs[clampi(kr - rq + 7, 0, 14) * 31 + clampi(kc - qcol + 15, 0, 30)];
                v = ok ? v : -1.0e30f; sa[u][rr] = v; mx = fmaxf(mx, v);
            }
        }
        mx = fmaxf(mx, __shfl_xor(mx, 16)); mx = fmaxf(mx, __shfl_xor(mx, 32));
        const float mn = fmaxf(m_run, mx), al = __expf(m_run - mn); m_run = mn;
        float sum = 0.f; bf16x8_t pf[2];
#pragma unroll
        for (int s2 = 0; s2 < 2; ++s2) {
            const float p0 = __expf(sa[2 * s2][0] - mn), p1 = __expf(sa[2 * s2][1] - mn), p2 = __expf(sa[2 * s2][2] - mn), p3 = __expf(sa[2 * s2][3] - mn);
            const float p4 = __expf(sa[2 * s2 + 1][0] - mn), p5 = __expf(sa[2 * s2 + 1][1] - mn), p6 = __expf(sa[2 * s2 + 1][2] - mn), p7 = __expf(sa[2 * s2 + 1][3] - mn);
            sum += ((p0 + p1) + (p2 + p3)) + ((p4 + p5) + (p6 + p7));
            pf[s2] = __builtin_bit_cast(bf16x8_t, make_v4u(pack2bf(p0, p1), pack2bf(p2, p3), pack2bf(p4, p5), pack2bf(p6, p7)));
        }
        sum += __shfl_xor(sum, 16); sum += __shfl_xor(sum, 32);
        l_run = l_run * al + sum;
        if (fq == 0) alx[wave * 16 + fr] = al;
        const v4f a4 = *(const LAS v4f*)(alx + wave * 16 + 4 * fq);
#pragma unroll
        for (int te = 0; te < 8; ++te) {
#pragma unroll
            for (int rr = 0; rr < 4; ++rr) O[te][rr] *= a4[rr];
#pragma unroll
            for (int s2 = 0; s2 < 2; ++s2) {
                const v2u lo = *(const LAS v2u*)(Vt + (16 * te + fr) * 136 + 64 * s2 + 4 * ((4 * tlo + fq) ^ te)), hi = *(const LAS v2u*)(Vt + (16 * te + fr) * 136 + 64 * s2 + 4 * ((4 * tlo + 4 + fq) ^ te));
                O[te] = __builtin_amdgcn_mfma_f32_16x16x32_bf16(pf[s2], __builtin_bit_cast(bf16x8_t, make_v4u(lo.x, lo.y, hi.x, hi.y)), O[te], 0, 0, 0);
            }
        }
        } else {
        f32x4_t sa[8];
#pragma unroll
        for (int t = 0; t < 8; ++t) {
            sa[t] = (f32x4_t){0.f, 0.f, 0.f, 0.f};
#pragma unroll
            for (int ks = 0; ks < 4; ++ks) sa[t] = __builtin_amdgcn_mfma_f32_16x16x32_bf16(*(const LAS bf16x8_t*)(Kb + (16 * t + fr) * 136 + 8 * fq + 32 * ks), qf[ks], sa[t], 0, 0, 0);
        }
        float mx = -1.0e30f;
#pragma unroll
        for (int t = 0; t < 8; ++t) {
            const v4f kv = *(const LAS v4f*)(rk + 16 * t + 4 * fq);
#pragma unroll
            for (int rr = 0; rr < 4; ++rr) {
                const float v = sa[t][rr] * kv[rr];
                sa[t][rr] = v; mx = fmaxf(mx, v);
            }
        }
        mx = fmaxf(mx, __shfl_xor(mx, 16)); mx = fmaxf(mx, __shfl_xor(mx, 32));
        const float mn = fmaxf(m_run, mx), al = __expf(m_run - mn); m_run = mn;
        float sum = 0.f; bf16x8_t pf[4];
#pragma unroll
        for (int s4 = 0; s4 < 4; ++s4) {
            const float p0 = __expf(sa[2 * s4][0] - mn), p1 = __expf(sa[2 * s4][1] - mn), p2 = __expf(sa[2 * s4][2] - mn), p3 = __expf(sa[2 * s4][3] - mn);
            const float p4 = __expf(sa[2 * s4 + 1][0] - mn), p5 = __expf(sa[2 * s4 + 1][1] - mn), p6 = __expf(sa[2 * s4 + 1][2] - mn), p7 = __expf(sa[2 * s4 + 1][3] - mn);
            sum += ((p0 + p1) + (p2 + p3)) + ((p4 + p5) + (p6 + p7));
            pf[s4] = __builtin_bit_cast(bf16x8_t, make_v4u(pack2bf(p0, p1), pack2bf(p2, p3), pack2bf(p4, p5), pack2bf(p6, p7)));
        }
        sum += __shfl_xor(sum, 16); sum += __shfl_xor(sum, 32);
        l_run = l_run * al + sum;
        if (fq == 0) alx[wave * 16 + fr] = al;
        const v4f a4 = *(const LAS v4f*)(alx + wave * 16 + 4 * fq);
#pragma unroll
        for (int te = 0; te < 8; ++te) {
#pragma unroll
            for (int rr = 0; rr < 4; ++rr) O[te][rr] *= a4[rr];
#pragma unroll
            for (int s4 = 0; s4 < 4; ++s4) {
                const v2u lo = *(const LAS v2u*)(Vt + (16 * te + fr) * 136 + 32 * s4 + 4 * (fq ^ te)), hi = *(const LAS v2u*)(Vt + (16 * te + fr) * 136 + 32 * s4 + 4 * ((4 + fq) ^ te));
                O[te] = __builtin_amdgcn_mfma_f32_16x16x32_bf16(pf[s4], __builtin_bit_cast(bf16x8_t, make_v4u(lo.x, lo.y, hi.x, hi.y)), O[te], 0, 0, 0);
            }
        }

        }
    }
    if (fq == 0) alx[wave * 16 + fr] = l_run;
    {
        const v4f l4 = *(const LAS v4f*)(alx + wave * 16 + 4 * fq);
#pragma unroll
        for (int te = 0; te < 8; ++te)
#pragma unroll
            for (int rr = 0; rr < 4; ++rr) MIX[(size_t)NA2_QTOK(4 * fq + rr) * 4096 + M_NO + h * 128 + 16 * te + fr] = f2bf(O[te][rr] / l4[rr]);
    }
#undef NA2_ROWA
#undef NA2_ROWB
#undef NA2_QTOK
}

__device__ __forceinline__ void mixer_phase(ARGS_REF a, int l, LAS unsigned char* lds, unsigned* qctr, unsigned* nactr, int cls_mask = 7, int pmode = 0, int namode = 0) {
    volatile LAS int* slot = (volatile LAS int*)(lds + MISC_OFF + 64);
    const int n_ret = (l == 0) ? 192 : 96, n_hy = (l == 0) ? 256 + 1024 : 256;
    const int n_zero = (l == 0) ? MT / 32 : 0;
    const int total = n_ret + n_hy + n_zero;
    for (;;) {
        __syncthreads();
        if (fresh_tid() == 0) *slot = (int)atomicAdd(qctr, 1u);
        __syncthreads();
        int it = *slot;
        if (it >= total) break;
#ifndef NO_RET
        if (it < n_ret) { if (!(cls_mask & 1)) continue; const bool cs = it >= 96; const int j = cs ? it - 96 : it; ret_item(a, l, (j >> 1) / 12, (j >> 1) % 12, j & 1, cs, lds); continue; }
#endif
        it -= n_ret;
#ifndef NO_HY
        if (it < n_hy) { if (!(cls_mask & 2)) continue; if (it < 256) hyena_fft_item(a, l, it, lds, pmode); else { if (pmode) continue; hyena_ctx_item(a, l, it - 256, lds); } continue; }
#endif
        it -= n_hy;
        if (!(cls_mask & 4) || pmode) continue;
        {
            v4u* zp = (v4u*)(a.ws + WS_GA + (size_t)it * 32 * PN * 2); const v4u z = make_v4u(0u, 0u, 0u, 0u); const int t_ = fresh_tid();
#pragma unroll 8
            for (int i = 0; i < 128; ++i) zp[i * NTHREADS + t_] = z;
        }
    }
#ifndef NO_NA
    if (!(cls_mask & 4) || pmode) return;
    const int x0 = (int)(xb_xcc_id() & 7u), len = 192 + ((l == 0) ? 12 : 0);
#pragma unroll 1
    for (int k = 0; k < 8; ++k) {
        const int x = (x0 + k) & 7;
        for (;;) {
            __syncthreads();
            if (fresh_tid() == 0) *slot = (int)atomicAdd(nactr + 64 * x, 1u);
            __syncthreads();
            const int idx = *slot;
            if (idx >= len) break;
            const bool cs = idx >= 192; const int j = cs ? idx - 192 : idx;
            const int g = x + 8 * (cs ? (j >> 1) : (j >> 5)), rp = cs ? (j & 1) : (j & 31);
            na2_item(a, l, g / 12, g % 12, rp, cs, lds, namode);
        }
    }
#endif
}

__device__ __forceinline__ unsigned mono_key(float x) { const unsigned u = __float_as_uint(x); return (u & 0x80000000u) ? ~u : (u | 0x80000000u); }
__device__ __forceinline__ int lanes_below(unsigned long long m) { return (int)__builtin_amdgcn_mbcnt_hi((unsigned)(m >> 32), __builtin_amdgcn_mbcnt_lo((unsigned)m, 0u)); }
struct SelRaw { v4u kh[4], kl[4]; v4f q[2]; };
__device__ __forceinline__ void sel_fetch(ARGS_REF a, int l, int tile, int h, int p, int tid, SelRaw& R) {
    const bf16_t* kh = (const bf16_t*)(a.ws + WS_KHL) + (size_t)((l * 8 + h) * 2 + p) * 2 * 128 * 128; const bf16_t* kl = kh + 128 * 128;
    const float* Qb = (const float*)(a.ws + WS_Q);
    const int row0 = tile * 32;
#pragma unroll
    for (int i = 0; i < 4; ++i) { const int idx8 = tid + 512 * i; R.kh[i] = *(const v4u*)(kh + idx8 * 8); R.kl[i] = *(const v4u*)(kl + idx8 * 8); }
#pragma unroll
    for (int i = 0; i < 2; ++i) {
        const int idx4 = tid + 512 * i; const int t = idx4 >> 5, k4 = (idx4 & 31) * 4;
        v4f x;
        if (row0 < TL || l != 0) x = *(const v4f*)(Qb + (size_t)(row0 + t) * PQ + h * 256 + p * 128 + k4);
        else {
            const float* pp = (const float*)(a.ws + WS_PART) + (size_t)(row0 - TL + t) * PQ + h * 256 + p * 128 + k4;
            x = *(const v4f*)pp;
#pragma unroll
            for (int s = 1; s < 8; ++s) x += *(const v4f*)(pp + (size_t)s * TC * PQ);
        }
        R.q[i] = x;
    }
}
__device__ __forceinline__ void sel_stage(const SelRaw& R, int tid, LAS bf16_t* Qh, LAS bf16_t* Ql, LAS bf16_t* Kh, LAS bf16_t* Kl) {
#pragma unroll
    for (int i = 0; i < 4; ++i) { const int idx8 = tid + 512 * i; const int n = idx8 >> 4, k8 = (idx8 & 15) * 8; *(LAS v4u*)(Kh + n * 136 + k8) = R.kh[i]; *(LAS v4u*)(Kl + n * 136 + k8) = R.kl[i]; }
#pragma unroll
    for (int i = 0; i < 2; ++i) {
        const int idx4 = tid + 512 * i; const int t = idx4 >> 5, k4 = (idx4 & 31) * 4; const v4f x = R.q[i];
        const unsigned h01 = pack2bf(x.x, x.y), h23 = pack2bf(x.z, x.w);
        *(LAS v2u*)(Qh + t * 136 + k4) = make_v2u(h01, h23);
        *(LAS v2u*)(Ql + t * 136 + k4) = make_v2u(pack2bf(x.x - bflo(h01), x.y - bfhi(h01)), pack2bf(x.z - bflo(h23), x.w - bfhi(h23)));
    }
}
__device__ __forceinline__ void peer_select_phase(ARGS_REF a, int l, int nrows, LAS unsigned char* lds) {
    const int nit = (nrows / 32) * 8, G = gridDim.x;
    if ((int)blockIdx.x >= nit) return;
    SelRaw R;
    sel_fetch(a, l, (int)blockIdx.x >> 3, (int)blockIdx.x & 7, 0, fresh_tid(), R);
#pragma unroll 1
    for (int it = blockIdx.x; it < nit; it += G) {
    const int tile = it >> 3, h = it & 7;
    const int tid = fresh_tid(), lane = tid & 63, wave = tid >> 6, fr = lane & 15, fq = lane >> 4;
    LAS bf16_t* Qh = (LAS bf16_t*)lds;
    LAS bf16_t* Ql = Qh + 32 * 136;
    LAS bf16_t* Kh = Ql + 32 * 136;
    LAS bf16_t* Kl = Kh + 128 * 136;
    LAS float* Ss = (LAS float*)(Kl + 128 * 136);
    LAS float* tops = Ss + 64 * 129;
    LAS int* topi = (LAS int*)(tops + 64 * 16);
    LAS float* GL = (LAS float*)(topi + 64 * 16);
    LAS int* EL = (LAS int*)(GL + 32 * 16);
    const float* Qb = (const float*)(a.ws + WS_Q);
    unsigned* GA32 = (unsigned*)(a.ws + WS_GA);
    const int row0 = tile * 32;
#pragma unroll 1
    for (int p = 0; p < 2; ++p) {
        __syncthreads();
        sel_stage(R, tid, Qh, Ql, Kh, Kl);
        if (p == 0) sel_fetch(a, l, tile, h, 1, tid, R);
        else if (it + G < nit) sel_fetch(a, l, (it + G) >> 3, (it + G) & 7, 0, tid, R);
        __syncthreads();
        f32x4_t sa[2] = {(f32x4_t){0.f, 0.f, 0.f, 0.f}, (f32x4_t){0.f, 0.f, 0.f, 0.f}};
        mma_lds<8, 2, 128, 136, 136>(Ql, Kh, sa, wave, fr, fq);
        mma_lds<8, 2, 128, 136, 136>(Qh, Kl, sa, wave, fr, fq);
        mma_lds<8, 2, 128, 136, 136>(Qh, Kh, sa, wave, fr, fq);
#pragma unroll
        for (int i = 0; i < 2; ++i)
#pragma unroll
            for (int r = 0; r < 4; ++r) Ss[((i * 16 + fq * 4 + r) * 2 + p) * 129 + wave * 16 + fr] = sa[i][r];
    }
    __syncthreads();
    {
        float v0[8], v1[8]; unsigned k0[8], k1[8], T[8]; int ex[8];
#pragma unroll
        for (int rr = 0; rr < 8; ++rr) {
            const int row = wave * 8 + rr; v0[rr] = Ss[row * 129 + lane]; v1[rr] = Ss[row * 129 + lane + 64];
            k0[rr] = (mono_key(v0[rr]) & ~127u) | (unsigned)(127 - lane); k1[rr] = (mono_key(v1[rr]) & ~127u) | (unsigned)(63 - lane); T[rr] = 0u; ex[rr] = 0;
        }
#pragma unroll 1
        for (int bit = 31; bit >= 0; --bit) {
            int fin = 1;
#pragma unroll
            for (int g = 0; g < 2; ++g) {
                unsigned c[4]; unsigned long long ma[4], mb[4]; int cnt[4];
#pragma unroll
                for (int rr = 0; rr < 4; ++rr) c[rr] = T[4 * g + rr] | (1u << bit);
#pragma unroll
                for (int rr = 0; rr < 4; ++rr) { ma[rr] = __ballot(k0[4 * g + rr] >= c[rr]); mb[rr] = __ballot(k1[4 * g + rr] >= c[rr]); }
                __builtin_amdgcn_sched_barrier(0);
#pragma unroll
                for (int rr = 0; rr < 4; ++rr) cnt[rr] = __popcll(ma[rr]) + __popcll(mb[rr]);
                __builtin_amdgcn_sched_barrier(0);
#pragma unroll
                for (int rr = 0; rr < 4; ++rr) { T[4 * g + rr] = cnt[rr] >= 16 ? c[rr] : T[4 * g + rr]; ex[4 * g + rr] |= (cnt[rr] == 16) ? 1 : 0; fin &= ex[4 * g + rr]; }
                __builtin_amdgcn_sched_barrier(0);
            }
            if (fin) break;
        }
#pragma unroll
        for (int rr = 0; rr < 8; ++rr) {
            const int row = wave * 8 + rr; const bool s0 = k0[rr] >= T[rr], s1 = k1[rr] >= T[rr];
            const unsigned long long m0 = __ballot(s0), m1 = __ballot(s1);
            const int p0 = lanes_below(m0), p1 = __popcll(m0) + lanes_below(m1);
            if (s0 && p0 < 16) { tops[row * 16 + p0] = v0[rr]; topi[row * 16 + p0] = lane; }
            if (s1 && p1 < 16) { tops[row * 16 + p1] = v1[rr]; topi[row * 16 + p1] = lane + 64; }
        }
    }
    __syncthreads();
    {
        float cv[4][4]; unsigned ck[4][4], T[4]; int exb[4];
#pragma unroll
        for (int tt = 0; tt < 4; ++tt) {
            const int t = wave * 4 + tt; const int r0 = (t * 2) * 16, r1 = (t * 2 + 1) * 16;
#pragma unroll
            for (int j = 0; j < 4; ++j) { const int ci = lane * 4 + j; cv[tt][j] = tops[r0 + (ci >> 4)] + tops[r1 + (ci & 15)]; ck[tt][j] = (mono_key(cv[tt][j]) & ~255u) | (unsigned)(255 - ci); }
            T[tt] = 0u; exb[tt] = 0;
        }
#pragma unroll 1
        for (int bit = 31; bit >= 0; --bit) {
            int fin = 1;
#pragma unroll
            for (int g = 0; g < 2; ++g) {
                unsigned c[2]; unsigned long long mm[2][4]; int cnt[2];
#pragma unroll
                for (int tt = 0; tt < 2; ++tt) c[tt] = T[2 * g + tt] | (1u << bit);
#pragma unroll
                for (int tt = 0; tt < 2; ++tt)
#pragma unroll
                    for (int j = 0; j < 4; ++j) mm[tt][j] = __ballot(ck[2 * g + tt][j] >= c[tt]);
                __builtin_amdgcn_sched_barrier(0);
#pragma unroll
                for (int tt = 0; tt < 2; ++tt) cnt[tt] = (__popcll(mm[tt][0]) + __popcll(mm[tt][1])) + (__popcll(mm[tt][2]) + __popcll(mm[tt][3]));
                __builtin_amdgcn_sched_barrier(0);
#pragma unroll
                for (int tt = 0; tt < 2; ++tt) { T[2 * g + tt] = cnt[tt] >= 16 ? c[tt] : T[2 * g + tt]; exb[2 * g + tt] |= (cnt[tt] == 16) ? 1 : 0; fin &= exb[2 * g + tt]; }
                __builtin_amdgcn_sched_barrier(0);
            }
            if (fin) break;
        }
#pragma unroll
        for (int tt = 0; tt < 4; ++tt) {
            const int t = wave * 4 + tt; const int r0 = (t * 2) * 16, r1 = (t * 2 + 1) * 16; int base = 0;
#pragma unroll
            for (int j = 0; j < 4; ++j) {
                const bool sel = ck[tt][j] >= T[tt]; const unsigned long long m = __ballot(sel); const int pos = base + lanes_below(m); base += __popcll(m);
                if (sel && pos < 16) { const int ci = lane * 4 + j; EL[t * 16 + pos] = topi[r0 + (ci >> 4)] * 128 + topi[r1 + (ci & 15)]; GL[t * 16 + pos] = cv[tt][j]; }
            }
        }
        {
            const int t = wave * 4 + fq; const float sv = GL[t * 16 + fr]; const int eid = EL[t * 16 + fr];
            float m = sv;
#pragma unroll
            for (int o = 8; o >= 1; o >>= 1) m = fmaxf(m, __shfl_xor(m, o));
            const float e = __expf(sv - m); float s = e;
#pragma unroll
            for (int o = 8; o >= 1; o >>= 1) s += __shfl_xor(s, o);
            const unsigned gb = (unsigned)f2bf(e / s);
            typedef short s2v __attribute__((ext_vector_type(2)));
            const s2v val = __builtin_bit_cast(s2v, (eid & 1) ? (gb << 16) : gb);
            __builtin_amdgcn_global_atomic_fadd_v2bf16((__attribute__((address_space(1))) s2v*)(GA32 + (((size_t)(row0 + t) * PN + eid) >> 1)), val);
        }
    }
    }
}

struct EpiGate {
    static constexpr bool PERM = true, AFTER_DRAIN = false;
    bf16_t* GM; unsigned char* GA8; int ldc; float sc;
    __device__ __forceinline__ void operator()(const pg8::f32x4 (&acc)[2][2][4][2], const pg8::Unit& u, int wr, int wc, int fr, int fq) const {
        const int row0 = u.pm * 256 + wr * 64 + fr, col0 = u.pn * 256 + wc * 32 + 8 * fq;
#pragma unroll
        for (int ai = 0; ai < 2; ++ai) {
            v4u gm[4][2];
#pragma unroll
            for (int m = 0; m < 4; ++m)
#pragma unroll
                for (int bj = 0; bj < 2; ++bj) gm[m][bj] = *(const v4u*)(GM + (size_t)(row0 + ai * 128 + m * 16) * ldc + col0 + bj * 128);
            __builtin_amdgcn_sched_barrier(0);
#pragma unroll
            for (int m = 0; m < 4; ++m) {
                const size_t ro = (size_t)(row0 + ai * 128 + m * 16) * ldc + col0;
#pragma unroll
                for (int bj = 0; bj < 2; ++bj) {
                    const v4u g = gm[m][bj];
                    v2u w = make_v2u(0u, 0u);
                    if ((g.x | g.y | g.z | g.w) != 0u) {
                        const pg8::f32x4 v0 = acc[ai][bj][m][0] * sc, v1 = acc[ai][bj][m][1] * sc;
                        w.x = pack4fp8(A8_SCALE * bflo(g.x) * gelu_tanh_f(v0[0]), A8_SCALE * bfhi(g.x) * gelu_tanh_f(v0[1]), A8_SCALE * bflo(g.y) * gelu_tanh_f(v0[2]), A8_SCALE * bfhi(g.y) * gelu_tanh_f(v0[3]));
                        w.y = pack4fp8(A8_SCALE * bflo(g.z) * gelu_tanh_f(v1[0]), A8_SCALE * bfhi(g.z) * gelu_tanh_f(v1[1]), A8_SCALE * bflo(g.w) * gelu_tanh_f(v1[2]), A8_SCALE * bfhi(g.w) * gelu_tanh_f(v1[3]));
                        *(v4u*)(GM + ro + bj * 128) = make_v4u(0u, 0u, 0u, 0u);
                    }
                    *(v2u*)(GA8 + ro + bj * 128) = w;
                }
            }
        }
    }
};

constexpr int N_PHASES = 19;
__global__ void __launch_bounds__(NTHREADS, 2) fwd_kernel(Args a) {
    extern __shared__ __attribute__((aligned(16))) unsigned char lds_raw[];
    LAS unsigned char* lds = (LAS unsigned char*)lds_raw;
    const int tid = threadIdx.x;
    const KARG Args* ap0 = (const KARG Args*)__builtin_amdgcn_kernarg_segment_ptr();
#define FRESH(name) const KARG Args* name = ap0; asm volatile("" : "+s"(name))
    const int lo = ap0->ph_lo, hi = ap0->ph_hi;
    unsigned* ctl = (unsigned*)(ap0->ws + WS_CTL);
    const bool fused = (hi - lo) > 1;
    if (tid < 64) ((LAS unsigned*)(lds + MISC_OFF))[tid] = 0u;
    __syncthreads();
    XcdBarrier bar; bar.bar = ctl + CW_BAR; bar.x = 0; bar.st = (volatile LAS unsigned*)(lds + MISC_OFF);
    if (fused) bar = xcd_barrier_post(ctl + CW_BAR, (volatile LAS unsigned*)(lds + MISC_OFF));
#define IN(k) (lo <= (k) && (k) < hi)
#if defined(ONLY)
#define EN(x) ((ONLY) == (x))
#elif defined(DISABLE)
#define EN(x) (!(((DISABLE) >> (x)) & 1))
#else
#define EN(x) 1
#endif
#ifndef DUP
#define DUP 0
#endif
#ifndef DUPMIX
#define DUPMIX 7
#endif
#ifndef SELMODE
#define SELMODE 0
#endif
#ifndef NAMODE
#define NAMODE 0
#endif
#ifndef HYMODE
#define HYMODE 0
#endif
#ifndef P0MODE
#define P0MODE 0
#endif
#ifndef WGM_IN
#define WGM_IN 8
#endif
#ifndef WGM_OUT
#define WGM_OUT 4
#endif
#ifndef WGM_Q
#define WGM_Q 4
#endif
#ifndef WGM_P1
#define WGM_P1 4
#endif
#ifndef WGM_P2
#define WGM_P2 4
#endif
#define NREP(x) ((((DUP) >> (x)) & 1) ? 2 : 1)
#define REPBAR(x) do { if (rep + 1 < NREP(x)) xcd_barrier(bar); } while (0)
#define SEAM(k) do { if (IN(k) && IN((k) + 1)) xcd_barrier(bar); } while (0)

    if (EN(0) && IN(0)) for (int rep = 0; rep < NREP(0); ++rep) { FRESH(ap); p0_prologue(*ap, lds, rep ? P0MODE : 0); REPBAR(0); }
    SEAM(0);
#pragma unroll 1
    for (int l = 0; l < 2; ++l) {
        const int pb = 1 + 9 * l;
        const int nrows = (l == 0) ? MT : TL;
        if (EN(1) && IN(pb + 0)) for (int rep = 0; rep < NREP(1); ++rep) { FRESH(ap); if (l == 1) norm_phase(*ap, l, 0, MT, 2, (const float*)(ap->ws + WS_MOD) + (size_t)4 * NMOD + 5 * 4096, 1.0f / A8_SCALE); else norm_phase(*ap, l, 0, MT); REPBAR(1); }
        SEAM(pb + 0);
        if (EN(2) && IN(pb + 1)) for (int rep = 0; rep < NREP(2); ++rep) {
            FRESH(ap); ARGS_REF a = *ap;
            pg8::Gemm g{(const bf16_t*)(a.ws + WS_H), (const bf16_t*)(a.ws + WS_WIN) + (size_t)l * INC * 4096, MT, INC, D};
            pg8::TwoPartOrder S; S.init(TL, TC, INC, l == 0 ? INC / 256 : 6144 / 256, (int)gridDim.x, (int)blockIdx.x, WGM_IN);
            EpiProj E{(bf16_t*)(a.ws + WS_PROJ), (bf16_t*)(a.ws + WS_UT)};
            pg8::gemm_phase<EpiProj, pg8::TwoPartOrder, false>(lds, g, S, E, nullptr);
            REPBAR(2);
        }
        SEAM(pb + 1);
        if (EN(3) && IN(pb + 2)) for (int rep = 0; rep < NREP(3); ++rep) { FRESH(ap); mixer_phase(*ap, l, lds, (unsigned*)(ap->ws + WS_CTL) + CW_QUEUE + 64 * (l + 2 * rep), (unsigned*)(ap->ws + WS_CTL) + CW_QUEUE + 64 * (8 + 8 * (l + 2 * rep)), (NREP(3) == 2 && rep == 0) ? DUPMIX : 7, (NREP(3) == 2 && rep == 0) ? HYMODE : 0, (NREP(3) == 2 && rep == 0) ? NAMODE : 0); REPBAR(3); }
        SEAM(pb + 2);
        if (EN(4) && IN(pb + 3)) {
            FRESH(ap); ARGS_REF a = *ap;
            {
                pg8::Gemm g{(const bf16_t*)(a.ws + WS_MIX), (const bf16_t*)(a.ws + WS_WOUT) + (size_t)l * D * D, TL, D, D};
                pg8::StaticOrder S; S.init(TL, D, (int)gridDim.x, (int)blockIdx.x, WGM_OUT);
                EpiRes E{l == 0 ? a.in[0] : (const float*)a.out, (const float*)(a.ws + WS_XC), a.out, (float*)(a.ws + WS_XC), (const float*)(a.ws + WS_MOD) + (size_t)l * 5 * NMOD + 2 * 4096, 1.0f};
                pg8::gemm_phase<EpiRes, pg8::StaticOrder, false>(lds, g, S, E, nullptr);
            }
            if (l == 0) {
                pg8::Gemm g{(const bf16_t*)(a.ws + WS_MIX) + (size_t)TL * D, (const bf16_t*)(a.ws + WS_WOUT), TC, D, D / 4, D};
                pg8::SplitKOrder S; S.init(TC, D, 4, (D / 4) * 2, (int)gridDim.x, (int)blockIdx.x);
                EpiPart E{(float*)(a.ws + WS_PART), D, TC, (D / 4) * 2};
                pg8::gemm_phase<EpiPart, pg8::SplitKOrder, false>(lds, g, S, E, nullptr);
            }
        }
        SEAM(pb + 3);
        if (EN(1) && IN(pb + 4)) for (int rep = 0; rep < NREP(1); ++rep) { FRESH(ap); if (l == 0) norm_phase(*ap, l, 1, nrows, 1, (const float*)(ap->ws + WS_MOD) + (size_t)4 * NMOD + 2 * 4096, 1.0f); else norm_phase(*ap, l, 1, nrows); REPBAR(1); }
        SEAM(pb + 4);
        if (EN(5) && IN(pb + 5)) {
            FRESH(ap); ARGS_REF a = *ap;
            {
                pg8::Gemm g{(const bf16_t*)(a.ws + WS_H), (const bf16_t*)(a.ws + WS_WQ) + (size_t)l * PQ * D, TL, PQ, D};
                pg8::StaticOrder S; S.init(TL, PQ, (int)gridDim.x, (int)blockIdx.x, WGM_Q);
                pg8::EpiF32 E{(float*)(a.ws + WS_Q), PQ, nullptr};
                pg8::gemm_phase<pg8::EpiF32, pg8::StaticOrder, false>(lds, g, S, E, nullptr);
            }
            if (l == 0) {
                pg8::Gemm g{(const bf16_t*)(a.ws + WS_H) + (size_t)TL * D, (const bf16_t*)(a.ws + WS_WQ), TC, PQ, D / 8, D};
                pg8::SplitKOrder S; S.init(TC, PQ, 8, (D / 8) * 2, (int)gridDim.x, (int)blockIdx.x);
                EpiPart E{(float*)(a.ws + WS_PART), PQ, TC, (D / 8) * 2};
                pg8::gemm_phase<EpiPart, pg8::SplitKOrder, false>(lds, g, S, E, nullptr);
            }
        }
        SEAM(pb + 5);
        if (EN(6) && IN(pb + 6)) for (int rep = 0; rep < NREP(6); ++rep) { FRESH(ap); peer_select_phase(*ap, l, nrows, lds); REPBAR(6); }
        SEAM(pb + 6);
        if (EN(7) && IN(pb + 7)) for (int rep = 0; rep < NREP(7); ++rep) {
            FRESH(ap); ARGS_REF a = *ap;
            pg8::Gemm g{(const bf16_t*)(a.ws + WS_HF8), (const bf16_t*)(a.ws + WS_UB + (size_t)l * PN * D), nrows, PN, D / 2};
            pg8::StaticOrder S; S.init(nrows, PN, (int)gridDim.x, (int)blockIdx.x, WGM_P1);
            EpiGate E{(bf16_t*)(a.ws + WS_GA), a.ws + WS_GA8, PN, 1.0f / U8_SCALE};
            pg8::gemm_phase<EpiGate, pg8::StaticOrder, false, true>(lds, g, S, E, nullptr);
            REPBAR(7);
        }
        SEAM(pb + 7);
        if (EN(8) && IN(pb + 8)) {
            FRESH(ap); ARGS_REF a = *ap;
            {
                pg8::Gemm g{(const bf16_t*)(a.ws + WS_GA8), (const bf16_t*)(a.ws + WS_VT + (size_t)l * PN * D), TL, D, PN / 2};
                pg8::StaticOrder S; S.init(TL, D, (int)gridDim.x, (int)blockIdx.x, WGM_P2);
                EpiRes E{(const float*)a.out, (const float*)(a.ws + WS_XC), a.out, (float*)(a.ws + WS_XC), (const float*)(a.ws + WS_MOD) + (size_t)l * 5 * NMOD + 5 * 4096, 1.0f / A8_SCALE};
                pg8::gemm_phase<EpiRes, pg8::StaticOrder, false, true>(lds, g, S, E, nullptr);
            }
            if (l == 0) {
                pg8::Gemm g{(const bf16_t*)(a.ws + WS_GA8 + (size_t)TL * PN), (const bf16_t*)(a.ws + WS_VT), TC, D, PN / 8, PN / 2};
                pg8::SplitKOrder S; S.init(TC, D, 4, PN / 4, (int)gridDim.x, (int)blockIdx.x);
                EpiPart E{(float*)(a.ws + WS_PART), D, TC, PN / 4};
                pg8::gemm_phase<EpiPart, pg8::SplitKOrder, false, true>(lds, g, S, E, nullptr);
            }
        }
        SEAM(pb + 8);
    }
#undef IN
#undef SEAM
}

extern "C" void kernel_launch(void* const* d_in, const int* in_sizes, int n_in, void* d_out, int out_size, void* d_ws, size_t ws_size, hipStream_t stream) {
    static int grid = 0;
    if (grid == 0) {
        if (n_in != 29 || out_size != TL * D || ws_size < WS_END) {
            fprintf(stderr, "kernel_launch: expected 29 inputs, out %d floats, ws >= %zu bytes; got n_in %d out %d ws %zu; nothing launched\n", TL * D, (size_t)WS_END, n_in, out_size, ws_size);
            grid = -1; return;
        }
        int dev = 0, cus = 0, per_cu = 0;
        if (hipGetDevice(&dev) != hipSuccess || hipDeviceGetAttribute(&cus, hipDeviceAttributeMultiprocessorCount, dev) != hipSuccess) { fprintf(stderr, "kernel_launch: device query failed\n"); grid = -1; return; }
        if (hipFuncSetAttribute((const void*)fwd_kernel, hipFuncAttributeMaxDynamicSharedMemorySize, LDS_BYTES) != hipSuccess) { fprintf(stderr, "kernel_launch: hipFuncSetAttribute failed\n"); grid = -1; return; }
        if (hipOccupancyMaxActiveBlocksPerMultiprocessor(&per_cu, (const void*)fwd_kernel, NTHREADS, LDS_BYTES) != hipSuccess || per_cu < 1)
            fprintf(stderr, "kernel_launch: note: occupancy query reports %d workgroups per CU\n", per_cu);
        (void)hipGetLastError();
        grid = cus;
    }
    if (grid < 0) return;
    if (hipMemsetAsync((char*)d_ws + WS_CTL, 0, CTL_BYTES, stream) != hipSuccess) { fprintf(stderr, "kernel_launch: memset failed\n"); return; }
    Args a{};
    for (int i = 0; i < 29; ++i) a.in[i] = (const float*)d_in[i];
    a.out = (float*)d_out; a.ws = (unsigned char*)d_ws;
#if MK_ONE_LAUNCH
    a.ph_lo = 0; a.ph_hi = N_PHASES;
    hipLaunchKernelGGL(fwd_kernel, dim3(grid), dim3(NTHREADS), LDS_BYTES, stream, a);
#else
    for (int p = 0; p < N_PHASES; ++p) { a.ph_lo = p; a.ph_hi = p + 1; hipLaunchKernelGGL(fwd_kernel, dim3(grid), dim3(NTHREADS), LDS_BYTES, stream, a); }
#endif
    const hipError_t le = hipPeekAtLastError();
    if (le != hipSuccess) fprintf(stderr, "kernel_launch: launch failed: %s\n", hipGetErrorName(le));
}
```

```cpp
#include <hip/hip_runtime.h>
#include <cstdio>
#include <cstdint>

#ifndef MK_ONE_LAUNCH
#define MK_ONE_LAUNCH 1
#endif

typedef unsigned short bf16_t;
typedef short bf16x8_t __attribute__((ext_vector_type(8)));
typedef float f32x4_t __attribute__((ext_vector_type(4)));
typedef float v4f __attribute__((ext_vector_type(4)));
typedef float v2f __attribute__((ext_vector_type(2)));
typedef unsigned v4u __attribute__((ext_vector_type(4)));
typedef unsigned v2u __attribute__((ext_vector_type(2)));
__device__ __forceinline__ v4f make_v4f(float a, float b, float c, float d) { return (v4f){a, b, c, d}; }
__device__ __forceinline__ v2f make_v2f(float a, float b) { return (v2f){a, b}; }
__device__ __forceinline__ v4u make_v4u(unsigned a, unsigned b, unsigned c, unsigned d) { return (v4u){a, b, c, d}; }
__device__ __forceinline__ v2u make_v2u(unsigned a, unsigned b) { return (v2u){a, b}; }

constexpr int D = 4096, NB = 4, SEQ = 4096, TL = NB * SEQ, CTXL = 256, TC = NB * CTXL, MT = TL + TC;
constexpr int INC = 13824;
constexpr int C_RK = 0, C_RV = 1536, C_NK = 3072, C_NV = 4608, C_HY = 6144, C_RQ = 9216, C_RG = 10752, C_NQ = 12288;
constexpr int M_HY = 0, M_RO = 1024, M_NO = 2560;
constexpr int NMOD = 6 * D;
constexpr int PQ = 2048;
constexpr int PN = 16384;
constexpr float EPS = 1e-6f;
constexpr float A8_SCALE = 16.0f;
constexpr float W8_SCALE = 64.0f;
constexpr float U8_SCALE = 64.0f;

constexpr size_t al256(size_t x) { return (x + 255) & ~(size_t)255; }
constexpr size_t WS_CTL  = 0;
constexpr size_t CTL_BYTES = 65536;
constexpr size_t WS_MOD  = WS_CTL + CTL_BYTES;
constexpr size_t WS_KT   = al256(WS_MOD + (size_t)2 * 5 * NMOD * 4);
constexpr size_t WS_KTC  = al256(WS_KT + (size_t)2 * 4096 * 4096 * 4);
constexpr size_t WS_WIN  = al256(WS_KTC + (size_t)4096 * 256 * 4);
constexpr size_t WS_WOUT = al256(WS_WIN + (size_t)2 * INC * D * 2);
constexpr size_t WS_WQ   = al256(WS_WOUT + (size_t)2 * D * D * 2);
constexpr size_t WS_H    = al256(WS_WQ + (size_t)2 * PQ * D * 2);
constexpr size_t WS_PROJ = al256(WS_H + (size_t)MT * D * 2);
constexpr size_t WS_MIX  = al256(WS_PROJ + (size_t)MT * INC * 2);
constexpr size_t WS_XC   = al256(WS_MIX + (size_t)MT * D * 2);
constexpr size_t WS_Q    = al256(WS_XC + (size_t)TC * D * 4);
constexpr size_t WS_OF   = al256(WS_Q + (size_t)MT * PQ * 4);
constexpr size_t WS_UB   = al256(WS_OF + (size_t)2 * MT * 1536 * 4);
constexpr size_t WS_VT   = al256(WS_UB + (size_t)2 * 16384 * D);
constexpr size_t WS_GA   = al256(WS_VT + (size_t)2 * 16384 * D);
constexpr size_t WS_UT   = al256(WS_GA + (size_t)MT * 16384 * 2);
constexpr size_t WS_HF8  = al256(WS_UT + (size_t)3072 * MT * 2);
constexpr size_t WS_GA8  = al256(WS_HF8 + (size_t)MT * D);
constexpr size_t WS_KHL  = al256(WS_GA8 + (size_t)MT * 16384);
constexpr size_t WS_PART = al256(WS_KHL + (size_t)2 * 8 * 2 * 2 * 128 * 128 * 2);
constexpr size_t WS_END  = al256(WS_PART + (size_t)4 * TC * D * 4);

constexpr int CW_BAR = 0;
constexpr int CW_QUEUE = 4096;
constexpr int CW_RET = 8192;

constexpr int LDS_BYTES = 156 * 1024;
constexpr int MISC_OFF = LDS_BYTES - 1024;
constexpr int NTHREADS = 512;

struct Args { const float* in[29]; float* out; unsigned char* ws; int ph_lo, ph_hi; };
#define KARG __attribute__((address_space(4)))
#define ARGS_REF const KARG Args&

__device__ __forceinline__ int fresh_tid() { int t = (int)threadIdx.x; asm volatile("" : "+v"(t)); return t; }
__device__ __forceinline__ float bf2f(bf16_t b) { return __uint_as_float(((unsigned)b) << 16); }
__device__ __forceinline__ unsigned pack2bf(float lo, float hi) { unsigned r; asm volatile("v_cvt_pk_bf16_f32 %0, %1, %2" : "=v"(r) : "v"(lo), "v"(hi)); return r; }
__device__ __forceinline__ unsigned pack4fp8(float a, float b, float c, float d) { int w = 0; w = __builtin_amdgcn_cvt_pk_fp8_f32(a, b, w, false); w = __builtin_amdgcn_cvt_pk_fp8_f32(c, d, w, true); return (unsigned)w; }
__device__ __forceinline__ unsigned char f2fp8(float f) { return (unsigned char)(__builtin_amdgcn_cvt_pk_fp8_f32(f, 0.0f, 0, false) & 0xff); }
__device__ __forceinline__ bf16_t f2bf(float f) { return (bf16_t)(pack2bf(f, 0.0f) & 0xffffu); }
__device__ __forceinline__ float bflo(unsigned w) { return __uint_as_float(w << 16); }
__device__ __forceinline__ float bfhi(unsigned w) { return __uint_as_float(w & 0xffff0000u); }
#define WAVE_DPP(v, ctrl) __int_as_float(__builtin_amdgcn_update_dpp(0, __float_as_int(v), (ctrl), 0xf, 0xf, true))
__device__ __forceinline__ float wave_sum(float v) {
    v += WAVE_DPP(v, 0xB1); v += WAVE_DPP(v, 0x4E); v += WAVE_DPP(v, 0x141); v += WAVE_DPP(v, 0x140);
    const float r0 = __int_as_float(__builtin_amdgcn_readlane(__float_as_int(v), 0)), r1 = __int_as_float(__builtin_amdgcn_readlane(__float_as_int(v), 16));
    const float r2 = __int_as_float(__builtin_amdgcn_readlane(__float_as_int(v), 32)), r3 = __int_as_float(__builtin_amdgcn_readlane(__float_as_int(v), 48));
    return (r0 + r1) + (r2 + r3);
}
__device__ __forceinline__ float wave_max(float v) {
    v = fmaxf(v, WAVE_DPP(v, 0xB1)); v = fmaxf(v, WAVE_DPP(v, 0x4E)); v = fmaxf(v, WAVE_DPP(v, 0x141)); v = fmaxf(v, WAVE_DPP(v, 0x140));
    const float r0 = __int_as_float(__builtin_amdgcn_readlane(__float_as_int(v), 0)), r1 = __int_as_float(__builtin_amdgcn_readlane(__float_as_int(v), 16));
    const float r2 = __int_as_float(__builtin_amdgcn_readlane(__float_as_int(v), 32)), r3 = __int_as_float(__builtin_amdgcn_readlane(__float_as_int(v), 48));
    return fmaxf(fmaxf(r0, r1), fmaxf(r2, r3));
}
__device__ __forceinline__ float sin_turns(float t) { return __builtin_amdgcn_sinf(t - floorf(t)); }
__device__ __forceinline__ float cos_turns(float t) { return __builtin_amdgcn_cosf(t - floorf(t)); }
__device__ __forceinline__ float sin_rad(float x) { return sin_turns(x * 0.15915494309189535f); }
__device__ __forceinline__ float silu_f(float x) { return x / (1.0f + __expf(-x)); }
__device__ __forceinline__ float gelu_tanh_f(float x) {
    const float u = 0.7978845608028654f * (x + 0.044715f * x * x * x);
    const float th = 1.0f - 2.0f / (__expf(2.0f * u) + 1.0f);
    return 0.5f * x * (1.0f + th);
}
__device__ __forceinline__ int clampi(int x, int lo, int hi) { return x < lo ? lo : (x > hi ? hi : x); }

#define XB_TMO      128
#define XB_XCNT(j)  (256  + 64 * (j))
#define XB_XSUB(j)  (1280 + 64 * (j))
#define XB_XGEN(j)  (2304 + 64 * (j))
#define XB_TOP      3328
#define XB_TOPGEN   3392
#define XCD_BAR_WORDS 3456
#define XB_SPIN_CAP (1u << 21)
#define LAS __attribute__((address_space(3)))

__device__ __forceinline__ unsigned xb_ld(unsigned* p)              { return __hip_atomic_load(p, __ATOMIC_RELAXED, __HIP_MEMORY_SCOPE_AGENT); }
__device__ __forceinline__ unsigned xb_add(unsigned* p, unsigned v) { return __hip_atomic_fetch_add(p, v, __ATOMIC_RELAXED, __HIP_MEMORY_SCOPE_AGENT); }
__device__ __forceinline__ unsigned xb_xcc_id() { return (unsigned)__builtin_amdgcn_s_getreg((3 << 11) | 20) & 0xFu; }
#define XB_SPIN(cond, bar) do { unsigned _sp = 0; while (cond) { __builtin_amdgcn_s_sleep(1); \
    if ((++_sp & 255u) == 0u) { if (xb_ld(&(bar)[XB_TMO])) break; if (_sp > XB_SPIN_CAP) { atomicAdd(&(bar)[XB_TMO], 1u); break; } } } } while (0)

struct XcdBarrier {
    unsigned* bar; unsigned x;
    volatile LAS unsigned* st;
};

__device__ __forceinline__ XcdBarrier xcd_barrier_post(unsigned* bar, volatile LAS unsigned* st) {
    XcdBarrier b; b.bar = bar; b.x = xb_xcc_id(); b.st = st;
    if (threadIdx.x == 0) (void)xb_add(&bar[XB_XCNT(b.x)], 1u);
    return b;
}
__device__ __forceinline__ void xcd_barrier_complete(unsigned* bar, unsigned x, unsigned& nloc, unsigned& nx) {
    const unsigned G = gridDim.x * gridDim.y * gridDim.z;
    unsigned sum, cnt, mine, sp = 0u;
    for (;;) {
        sum = 0u; cnt = 0u; mine = 0u;
#pragma unroll
        for (unsigned j = 0; j < 16; ++j) { const unsigned c = xb_ld(&bar[XB_XCNT(j)]); sum += c; cnt += (c > 0u) ? 1u : 0u; mine = (j == x) ? c : mine; }
        if (sum == G) break;
        __builtin_amdgcn_s_sleep(1);
        if ((++sp & 255u) == 0u) { if (xb_ld(&bar[XB_TMO])) break; if (sp > XB_SPIN_CAP) { atomicAdd(&bar[XB_TMO], 1u); break; } }
    }
    nloc = mine > 0u ? mine : 1u; nx = cnt > 0u ? cnt : 1u;
}

__device__ __forceinline__ void xcd_barrier(const XcdBarrier& b) {
    asm volatile("s_waitcnt vmcnt(0)" ::: "memory");
    __syncthreads();
    if (threadIdx.x == 0) {
        unsigned* bar = b.bar;
        __builtin_amdgcn_s_waitcnt(0);
        unsigned nloc = b.st[0], nx = b.st[1];
        if (nloc == 0u) { xcd_barrier_complete(bar, b.x, nloc, nx); b.st[0] = nloc; b.st[1] = nx; }
        const unsigned old = xb_add(&bar[XB_XSUB(b.x)], 1u);
        const unsigned gen = old / nloc;
        if (old + 1u == (gen + 1u) * nloc) {
            __builtin_amdgcn_fence(__ATOMIC_RELEASE, "agent");
            asm volatile("s_waitcnt vmcnt(0)" ::: "memory");
            const unsigned og = xb_add(&bar[XB_TOP], 1u);
            const unsigned tg = og / nx;
            if (og + 1u == (tg + 1u) * nx) xb_add(&bar[XB_TOPGEN], 1u);
            else XB_SPIN(xb_ld(&bar[XB_TOPGEN]) == tg, bar);
            __builtin_amdgcn_fence(__ATOMIC_ACQUIRE, "agent");
            xb_add(&bar[XB_XGEN(b.x)], 1u);
            asm volatile("s_waitcnt vmcnt(0)" ::: "memory");
        } else {
            XB_SPIN(xb_ld(&bar[XB_XGEN(b.x)]) == gen, bar);
            __builtin_amdgcn_fence(__ATOMIC_ACQUIRE, "agent");
            asm volatile("s_waitcnt vmcnt(0)" ::: "memory");
        }
    }
    __syncthreads();
}
namespace pg8 {
#define PG8_LAS __attribute__((address_space(3)))
typedef unsigned short bf16_t;
typedef short bf16x8 __attribute__((ext_vector_type(8)));
typedef float f32x4 __attribute__((ext_vector_type(4)));
typedef unsigned u32x4 __attribute__((ext_vector_type(4)));
constexpr int BM = 256, BK = 64, HALF = 128, HTB = HALF * BK * 2  , STAGE_BYTES = 8 * HTB, NXCD = 8, WGM = 8;

__host__ __device__ __forceinline__ int lds_byte(int r, int c) { const int st = (r >> 4) * 2 + (c >> 5), rr = r & 15, cc = c & 31, ob = rr * 64 + cc * 2; return st * 1024 + (ob ^ (((ob >> 9) & 1) << 5)); }
__host__ __device__ __forceinline__ void stage_rc(int b, int& R, int& C) { const int st = b / 1024, sb = b % 1024, swz = sb ^ (((sb >> 9) & 1) << 5); R = (st >> 1) * 16 + swz / 64; C = (st & 1) * 32 + (swz % 64) / 2; }
__host__ __device__ __forceinline__ int perm32(int rho) { const int n = rho >> 4, i = rho & 15; return 8 * (i >> 2) + 4 * n + (i & 3); }

struct Unit { int pm, pn, kb; };
struct Gemm { const bf16_t* A; const bf16_t* Bt; int M, N, K, ld; };

struct StaticOrder {
    int nM, nN, nwg, G, c, W;
    __host__ __device__ void init(int M, int N, int G_, int c_, int W_ = 4) { nM = M / BM; nN = N / BM; nwg = nM * nN; G = G_; c = c_; W = W_; }
    __host__ __device__ bool next(int i, Unit& u) const {
        const long L = (long)i * G + c; if (L >= nwg) return false;
        int wgid = (int)L; { const int q = nwg / NXCD, r = nwg % NXCD, xcd = wgid % NXCD, off = wgid / NXCD; wgid = (xcd < r ? xcd * (q + 1) : r * (q + 1) + (xcd - r) * q) + off; }
        const int nig = W * nN, gid = wgid / nig, fm = gid * W, gsz = (nM - fm) < W ? (nM - fm) : W;
        u.pm = fm + ((wgid % nig) % gsz); u.pn = (wgid % nig) / gsz; u.kb = 0; return true;
    }
    __device__ __forceinline__ void a_ready(const Unit&) const {}
    __device__ __forceinline__ void done(const Unit&) const {}
};
struct CountedOrder : StaticOrder {
    const unsigned* ready; unsigned need; unsigned* tmo;
    __device__ __forceinline__ void a_ready(const Unit& u) const {
        if (threadIdx.x < 64) {
            const unsigned long long t0 = __builtin_amdgcn_s_memrealtime(); unsigned polls = 0;
            while ((unsigned)__builtin_amdgcn_readfirstlane(__hip_atomic_load(ready + 64 * u.pm, __ATOMIC_RELAXED, __HIP_MEMORY_SCOPE_AGENT)) < need) {
                if ((++polls & 255u) == 0u && __builtin_amdgcn_readfirstlane(__hip_atomic_load(tmo, __ATOMIC_RELAXED, __HIP_MEMORY_SCOPE_AGENT)) != 0u) break;
                if (__builtin_amdgcn_s_memrealtime() - t0 > 2000000ull) {
                    if (threadIdx.x == 0) { unsigned expect = 0u; __hip_atomic_compare_exchange_strong(tmo + 1, &expect, 0x600u | (unsigned)(u.pm & 0xff), __ATOMIC_RELAXED, __ATOMIC_RELAXED, __HIP_MEMORY_SCOPE_AGENT); __hip_atomic_store(tmo, 1u, __ATOMIC_RELAXED, __HIP_MEMORY_SCOPE_AGENT); }
                    break; }
                __builtin_amdgcn_s_sleep(2); }
            __builtin_amdgcn_fence(__ATOMIC_ACQUIRE, "agent");
            asm volatile("s_waitcnt vmcnt(0)" ::: "memory");
        }
#if !defined(BROKEN_HOOK_NO_BARRIER)
        asm volatile("" ::: "memory"); __builtin_amdgcn_s_barrier(); asm volatile("" ::: "memory");
#endif
    }
};

struct TwoPartOrder {
    StaticOrder base; int ncol2, n2;
    __host__ __device__ void init(int M1, int M2, int N, int ncol2_, int G_, int c_, int W_ = 4) { base.init(M1, N, G_, c_, W_); ncol2 = ncol2_; n2 = (M2 / BM) * ncol2_; }
    __host__ __device__ bool next(int i, Unit& u) const {
        if (base.next(i, u)) return true;
        const long L = (long)i * base.G + base.c - base.nwg; if (L >= n2) return false;
        const int li = (int)L; u.pm = base.nM + (li & 3); u.pn = li >> 2;
        u.kb = 0; return true;
    }
    __device__ __forceinline__ void a_ready(const Unit&) const {}
    __device__ __forceinline__ void done(const Unit&) const {}
};
struct SplitKOrder {
    int nN, S, kpb, tot, G, c;
    __host__ __device__ void init(int M, int N, int S_, int kpb_, int G_, int c_) { nN = N / BM; S = S_; kpb = kpb_; tot = (M / BM) * nN * S_; G = G_; c = c_; }
    __host__ __device__ bool next(int i, Unit& u) const { const long L = (long)i * G + c; if (L >= tot) return false; const int l = (int)L, s = l % S, t = l / S; u.pn = t % nN; u.pm = t / nN; u.kb = s * kpb; return true; }
    __device__ __forceinline__ void a_ready(const Unit&) const {}
    __device__ __forceinline__ void done(const Unit&) const {}
};

__device__ __forceinline__ unsigned cvt_pk_bf16(float lo, float hi) { unsigned r; asm volatile("v_cvt_pk_bf16_f32 %0, %1, %2" : "=v"(r) : "v"(lo), "v"(hi)); return r; }
typedef float f32x2 __attribute__((ext_vector_type(2)));
__device__ __forceinline__ f32x2 gelu_pk(f32x2 v) {
    const f32x2 av = __builtin_elementwise_abs(v), d = av * 0.2316418882f + 1.0f;
    f32x2 t; t.x = __builtin_amdgcn_rcpf(d.x); t.y = __builtin_amdgcn_rcpf(d.y);
    f32x2 q = t * 0.5307027145f + (-0.7265760135f); q = q * t + 0.7107068705f; q = q * t + (-0.142248368f); q = q * t + 0.127414796f; q = q * t;
    const f32x2 s = (v * v) * (-0.72134752044f);
    f32x2 e; e.x = __builtin_amdgcn_exp2f(s.x); e.y = __builtin_amdgcn_exp2f(s.y);
    const f32x2 m = v * (q * e), r = v - m;
    f32x2 o; o.x = v.x < 0.f ? m.x : r.x; o.y = v.y < 0.f ? m.y : r.y; return o;
}

struct EpiF32 {
    static constexpr bool PERM = false, AFTER_DRAIN = false;
    float* C; int ldc; const float* bias;
    __device__ __forceinline__ void operator()(const f32x4 (&acc)[2][2][4][2], const Unit& u, int wr, int wc, int fr, int fq) const {
        const int row0 = u.pm * BM + wr * 64 + fr, col0 = u.pn * BM + wc * 32 + 4 * fq;
        f32x4 bv[2][2];
#pragma unroll
        for (int bj = 0; bj < 2; ++bj)
#pragma unroll
            for (int n = 0; n < 2; ++n) bv[bj][n] = bias ? *(const f32x4*)(bias + col0 + bj * HALF + n * 16) : (f32x4){0.f, 0.f, 0.f, 0.f};
#pragma unroll
        for (int ai = 0; ai < 2; ++ai)
#pragma unroll
            for (int m = 0; m < 4; ++m) { float* rowp = C + (size_t)(row0 + ai * HALF + m * 16) * ldc + col0;
#pragma unroll
                for (int bj = 0; bj < 2; ++bj)
#pragma unroll
                    for (int n = 0; n < 2; ++n) *(f32x4*)(rowp + bj * HALF + n * 16) = acc[ai][bj][m][n] + bv[bj][n]; }
    }
};
template <int ACT  > struct EpiBf16 {
    static constexpr bool PERM = true, AFTER_DRAIN = false;
    bf16_t* O; int ldc; const float* bias; int split_cols; size_t split_stride;
    __device__ __forceinline__ void operator()(const f32x4 (&acc)[2][2][4][2], const Unit& u, int wr, int wc, int fr, int fq) const {
        const int row0 = u.pm * BM + wr * 64 + fr; int colt = u.pn * BM; bf16_t* base = O;
        if (split_cols) { const int t = colt / split_cols; base += (size_t)t * split_stride; colt -= t * split_cols; }
        const int col0 = colt + wc * 32 + 8 * fq, bcol0 = u.pn * BM + wc * 32 + 8 * fq;
        f32x4 bv[2][2];
#pragma unroll
        for (int bj = 0; bj < 2; ++bj)
#pragma unroll
            for (int n = 0; n < 2; ++n) bv[bj][n] = bias ? *(const f32x4*)(bias + bcol0 + bj * HALF + 4 * n) : (f32x4){0.f, 0.f, 0.f, 0.f};
#pragma unroll
        for (int ai = 0; ai < 2; ++ai)
#pragma unroll
            for (int m = 0; m < 4; ++m) { bf16_t* rowp = base + (size_t)(row0 + ai * HALF + m * 16) * ldc + col0;
#pragma unroll
                for (int bj = 0; bj < 2; ++bj) { f32x4 v0 = acc[ai][bj][m][0] + bv[bj][0], v1 = acc[ai][bj][m][1] + bv[bj][1];
                    if (ACT == 1) { f32x2 a = gelu_pk((f32x2){v0[0], v0[1]}), b = gelu_pk((f32x2){v0[2], v0[3]}), c = gelu_pk((f32x2){v1[0], v1[1]}), d = gelu_pk((f32x2){v1[2], v1[3]});
                        v0 = (f32x4){a.x, a.y, b.x, b.y}; v1 = (f32x4){c.x, c.y, d.x, d.y}; }
                    if (ACT == 2) {
#pragma unroll
                        for (int j = 0; j < 4; ++j) { v0[j] = 0.5f * v0[j] * (1.0f + erff(v0[j] * 0.70710678f)); v1[j] = 0.5f * v1[j] * (1.0f + erff(v1[j] * 0.70710678f)); } }
                    u32x4 w; w.x = cvt_pk_bf16(v0[0], v0[1]); w.y = cvt_pk_bf16(v0[2], v0[3]); w.z = cvt_pk_bf16(v1[0], v1[1]); w.w = cvt_pk_bf16(v1[2], v1[3]);
                    *(u32x4*)(rowp + bj * HALF) = w; } }
    }
};

struct PanelStats {
    unsigned* xbuf;
    unsigned* cnt;
    unsigned* tmo;
    int ntn; float eps;
    unsigned code;
    __device__ __forceinline__ bool run(const f32x4 (&v)[2][2][4][2], const Unit& u, int wr, int wc, int fr, int fq, PG8_LAS unsigned char* lds, int wid, int lane) const {
        typedef float f32x2v __attribute__((ext_vector_type(2)));
        PG8_LAS f32x2v* P = (PG8_LAS f32x2v*)lds;
        PG8_LAS f32x2v* S = (PG8_LAS f32x2v*)(lds + 8192);
        PG8_LAS unsigned* flag = (PG8_LAS unsigned*)(lds + 8192 + 2048);
#pragma unroll
        for (int ai = 0; ai < 2; ++ai)
#pragma unroll
            for (int m = 0; m < 4; ++m) {
                float s = 0.f;
#pragma unroll
                for (int bj = 0; bj < 2; ++bj)
#pragma unroll
                    for (int n = 0; n < 2; ++n) { const f32x4 x = v[ai][bj][m][n]; s += (x[0] + x[1]) + (x[2] + x[3]); }
                s += __shfl_xor(s, 16); s += __shfl_xor(s, 32);
                const float mw = s * (1.0f / 64.0f); float q = 0.f;
#pragma unroll
                for (int bj = 0; bj < 2; ++bj)
#pragma unroll
                    for (int n = 0; n < 2; ++n) { const f32x4 d = v[ai][bj][m][n] - mw; q += (d[0] * d[0] + d[1] * d[1]) + (d[2] * d[2] + d[3] * d[3]); }
                q += __shfl_xor(q, 16); q += __shfl_xor(q, 32);
                if (fq == 0) P[(ai * HALF + wr * 64 + m * 16 + fr) * 4 + wc] = (f32x2v){mw, q};
            }
        asm volatile("s_waitcnt lgkmcnt(0)" ::: "memory"); __builtin_amdgcn_s_barrier(); asm volatile("" ::: "memory");
#if defined(BROKEN_NO_WAIT)
        if (blockIdx.x >= 64) { const long long t0 = clock64(); while (clock64() - t0 < 60000) __builtin_amdgcn_s_sleep(8); }
#endif
        const int row = wid * 32 + (lane & 31);
        if (lane < 32) {
            const f32x2v a = P[row * 4 + 0], b = P[row * 4 + 1], c = P[row * 4 + 2], d = P[row * 4 + 3];
            const float mt = (a.x + b.x + c.x + d.x) * 0.25f;
            const float da = a.x - mt, db = b.x - mt, dc = c.x - mt, dd = d.x - mt;
            const float m2 = (a.y + b.y) + (c.y + d.y) + 64.0f * ((da * da + db * db) + (dc * dc + dd * dd));
            unsigned long long* slot = (unsigned long long*)xbuf + ((size_t)(u.pm * BM + row) * 4 + u.pn);
            __hip_atomic_store(slot, ((unsigned long long)__float_as_uint(m2) << 32) | __float_as_uint(mt), __ATOMIC_RELAXED, __HIP_MEMORY_SCOPE_AGENT);
        }
        asm volatile("s_waitcnt vmcnt(0)" ::: "memory");
        if (lane == 0) __hip_atomic_fetch_add(cnt + 64 * u.pm, 1u, __ATOMIC_RELAXED, __HIP_MEMORY_SCOPE_AGENT);
        if (wid == 0) {
            bool dead = false; const unsigned long long t0 = __builtin_amdgcn_s_memrealtime(); const unsigned want = 8u * (unsigned)ntn;
            for (;;) {
#if defined(BROKEN_NO_WAIT)
                break;
#endif
                if ((unsigned)__builtin_amdgcn_readfirstlane(__hip_atomic_load(cnt + 64 * u.pm, __ATOMIC_RELAXED, __HIP_MEMORY_SCOPE_AGENT)) >= want) break;
                if (__builtin_amdgcn_s_memrealtime() - t0 > 2000000ull) {
                    if (lane == 0) { unsigned expect = 0u; __hip_atomic_compare_exchange_strong(tmo + 1, &expect, code | (unsigned)(u.pm & 0xff), __ATOMIC_RELAXED, __ATOMIC_RELAXED, __HIP_MEMORY_SCOPE_AGENT);
                                     __hip_atomic_store(tmo, 1u, __ATOMIC_RELAXED, __HIP_MEMORY_SCOPE_AGENT); }
                    dead = true; break; }
                __builtin_amdgcn_s_sleep(2);
            }
            __builtin_amdgcn_fence(__ATOMIC_ACQUIRE, "agent");
            if (lane == 0) flag[0] = dead ? 1u : 0u;
        }
        asm volatile("s_waitcnt vmcnt(0) lgkmcnt(0)" ::: "memory"); __builtin_amdgcn_s_barrier(); asm volatile("" ::: "memory");
        const bool bad = flag[0] != 0u;
        if (lane < 32) {
            const unsigned long long* slot = (const unsigned long long*)xbuf + (size_t)(u.pm * BM + row) * 4; float mt[4], m2[4]; float ms = 0.f;
#pragma unroll
            for (int t = 0; t < 4; ++t) { if (t < ntn) { const unsigned long long w = __hip_atomic_load(slot + t, __ATOMIC_RELAXED, __HIP_MEMORY_SCOPE_AGENT); mt[t] = __uint_as_float((unsigned)w); m2[t] = __uint_as_float((unsigned)(w >> 32)); } else { mt[t] = 0.f; m2[t] = 0.f; } ms += mt[t]; }
            const float mean = ms / (float)ntn; float q = 0.f;
#pragma unroll
            for (int t = 0; t < 4; ++t) if (t < ntn) { const float dm = mt[t] - mean; q += m2[t] + 256.0f * dm * dm; }
            S[row] = (f32x2v){mean, 1.0f / sqrtf(q / (256.0f * (float)ntn) + eps)};
        }
        asm volatile("s_waitcnt lgkmcnt(0)" ::: "memory"); __builtin_amdgcn_s_barrier(); asm volatile("" ::: "memory");
        return bad;
    }
};
struct EpiLnRes {
    static constexpr bool PERM = false, AFTER_DRAIN = true;
    const float* base; float* out; int ldc; const float* bias; PanelStats st; unsigned poison;
    __device__ __forceinline__ void refuse(size_t i0, size_t stride, int M, int N) const { const float q = __builtin_nanf(""); for (size_t i = i0; i < (size_t)M * N; i += stride) out[(i / N) * ldc + i % N] = q;
        if (i0 == 0) { unsigned expect = 0u; __hip_atomic_compare_exchange_strong(st.tmo + 1, &expect, 0x7f0u, __ATOMIC_RELAXED, __ATOMIC_RELAXED, __HIP_MEMORY_SCOPE_AGENT); __hip_atomic_store(st.tmo, 1u, __ATOMIC_RELAXED, __HIP_MEMORY_SCOPE_AGENT); } }
    __device__ __forceinline__ void fused(f32x4 (&acc)[2][2][4][2], const Unit& u, int wr, int wc, int fr, int fq, PG8_LAS unsigned char* lds, int wid, int lane) const {
        typedef float f32x2v __attribute__((ext_vector_type(2)));
        const PG8_LAS f32x2v* S = (const PG8_LAS f32x2v*)(lds + 8192);
        const int col0 = u.pn * BM + wc * 32 + 4 * fq;
#pragma unroll
        for (int bj = 0; bj < 2; ++bj)
#pragma unroll
            for (int n = 0; n < 2; ++n) { const f32x4 bv = bias ? *(const f32x4*)(bias + col0 + bj * HALF + n * 16) : (f32x4){0.f, 0.f, 0.f, 0.f};
#pragma unroll
                for (int ai = 0; ai < 2; ++ai)
#pragma unroll
                    for (int m = 0; m < 4; ++m) acc[ai][bj][m][n] += bv; }
        const bool bad = st.run(acc, u, wr, wc, fr, fq, lds, wid, lane) || poison != 0u;
        const float qnan = __builtin_nanf("");
#pragma unroll
        for (int ai = 0; ai < 2; ++ai)
#pragma unroll
            for (int m = 0; m < 4; ++m) { const int r = ai * HALF + wr * 64 + m * 16 + fr; const f32x2v sr = S[r]; const size_t off = (size_t)(u.pm * BM + r) * ldc + col0;
#pragma unroll
                for (int bj = 0; bj < 2; ++bj)
#pragma unroll
                    for (int n = 0; n < 2; ++n) { const f32x4 bs = *(const f32x4*)(base + off + bj * HALF + n * 16); f32x4 o = bs + (acc[ai][bj][m][n] - sr.x) * sr.y;
                        if (bad) o = (f32x4){qnan, qnan, qnan, qnan}; *(f32x4*)(out + off + bj * HALF + n * 16) = o; }
                asm volatile("" ::: "memory"); }
    }
};
struct EpiLnResLn {
    static constexpr bool PERM = false, AFTER_DRAIN = true;
    const float* base; float* out; bf16_t* xn; int ldc; const float* bias; PanelStats st1, st2; unsigned poison;
    __device__ __forceinline__ void refuse(size_t i0, size_t stride, int M, int N) const { const float q = __builtin_nanf(""); for (size_t i = i0; i < (size_t)M * N; i += stride) { const size_t o = (i / N) * ldc + i % N; out[o] = q; xn[o] = (bf16_t)0x7fc0u; }
        if (i0 == 0) { unsigned expect = 0u; __hip_atomic_compare_exchange_strong(st1.tmo + 1, &expect, 0x7f0u, __ATOMIC_RELAXED, __ATOMIC_RELAXED, __HIP_MEMORY_SCOPE_AGENT); __hip_atomic_store(st1.tmo, 1u, __ATOMIC_RELAXED, __HIP_MEMORY_SCOPE_AGENT); } }
    __device__ __forceinline__ void fused(f32x4 (&acc)[2][2][4][2], const Unit& u, int wr, int wc, int fr, int fq, PG8_LAS unsigned char* lds, int wid, int lane) const {
        typedef float f32x2v __attribute__((ext_vector_type(2))); typedef unsigned u32x2v __attribute__((ext_vector_type(2)));
        const PG8_LAS f32x2v* S = (const PG8_LAS f32x2v*)(lds + 8192);
        const int col0 = u.pn * BM + wc * 32 + 4 * fq;
#pragma unroll
        for (int bj = 0; bj < 2; ++bj)
#pragma unroll
            for (int n = 0; n < 2; ++n) { const f32x4 bv = bias ? *(const f32x4*)(bias + col0 + bj * HALF + n * 16) : (f32x4){0.f, 0.f, 0.f, 0.f};
#pragma unroll
                for (int ai = 0; ai < 2; ++ai)
#pragma unroll
                    for (int m = 0; m < 4; ++m) acc[ai][bj][m][n] += bv; }
        bool bad = st1.run(acc, u, wr, wc, fr, fq, lds, wid, lane) || poison != 0u;
        const float qnan = __builtin_nanf("");
#pragma unroll
        for (int ai = 0; ai < 2; ++ai)
#pragma unroll
            for (int m = 0; m < 4; ++m) { const int r = ai * HALF + wr * 64 + m * 16 + fr; const f32x2v sr = S[r]; const size_t off = (size_t)(u.pm * BM + r) * ldc + col0;
#pragma unroll
                for (int bj = 0; bj < 2; ++bj)
#pragma unroll
                    for (int n = 0; n < 2; ++n) { const f32x4 bs = *(const f32x4*)(base + off + bj * HALF + n * 16); acc[ai][bj][m][n] = bs + (acc[ai][bj][m][n] - sr.x) * sr.y; }
                asm volatile("" : "+v"(acc[ai][0][m][0]), "+v"(acc[ai][0][m][1]), "+v"(acc[ai][1][m][0]), "+v"(acc[ai][1][m][1]));
                if (m & 1) asm volatile("" ::: "memory"); }
        const bool bad1 = bad;
        bad = st2.run(acc, u, wr, wc, fr, fq, lds, wid, lane) || bad;
#pragma unroll
        for (int ai = 0; ai < 2; ++ai)
#pragma unroll
            for (int m = 0; m < 4; ++m) { const int r = ai * HALF + wr * 64 + m * 16 + fr; const f32x2v sr = S[r]; const size_t off = (size_t)(u.pm * BM + r) * ldc + col0;
#pragma unroll
                for (int bj = 0; bj < 2; ++bj)
#pragma unroll
                    for (int n = 0; n < 2; ++n) { const f32x4 x1 = acc[ai][bj][m][n]; *(f32x4*)(out + off + bj * HALF + n * 16) = bad1 ? (f32x4){qnan, qnan, qnan, qnan} : x1;
                        const f32x4 o = (x1 - sr.x) * sr.y; u32x2v w; w.x = cvt_pk_bf16(o[0], o[1]); w.y = cvt_pk_bf16(o[2], o[3]);
                        if (bad) { w.x = 0x7fc07fc0u; w.y = 0x7fc07fc0u; } *(u32x2v*)(xn + off + bj * HALF + n * 16) = w; }
                asm volatile("" ::: "memory"); }
    }
};

template <class Epi, class Sched, bool STAMP = false, bool FP8 = false, bool ALIGN_EPI = true, bool SP2 = true>
__device__ __forceinline__ void gemm_phase(PG8_LAS unsigned char* lds, const Gemm g, const Sched& S, const Epi& E, unsigned long long* stamps) {
    const int tid = fresh_tid(), wid = __builtin_amdgcn_readfirstlane(tid >> 6), lane = tid & 63, wr = wid >> 2, wc = wid & 3, fr = lane & 15, fq = lane >> 4;
    const int K = g.K, nt = K / BK, LD = g.ld ? g.ld : K;
    int ts_lo = 0, ts_hi = 0, nts = 0; const unsigned long long rt_entry = STAMP ? (unsigned long long)wall_clock64() : 0ull;
#define PG8_STAMP() do { if (STAMP && wid == 0 && nts < 64) { const unsigned long long _c = (unsigned long long)clock64(); \
        ts_lo = (lane == nts) ? (int)(unsigned)_c : ts_lo; ts_hi = (lane == nts) ? (int)(unsigned)(_c >> 32) : ts_hi; ++nts; } } while (0)
    PG8_STAMP();
    unsigned voffA[2], voffB[2];
#pragma unroll
    for (int i = 0; i < 2; ++i) { int R, C; stage_rc(tid * 16 + i * 8192, R, C); const int Rb = Epi::PERM ? ((R & ~31) + perm32(R & 31)) : R;
        voffA[i] = (unsigned)(R * LD + C) * 2u; voffB[i] = (unsigned)(Rb * LD + C) * 2u; }
    const size_t kstep = (size_t)(BK * 2);
    const size_t hstep = (size_t)HALF * LD * 2;
    const size_t tstep = 2 * hstep;
    const unsigned ldsw = (unsigned)wid * 1024u;
    const int aoff = lds_byte(wr * 64 + fr, fq * 8), boff = lds_byte(wc * 32 + fr, fq * 8);
#define PG8_SA(b, h) (((b) * 2 + (h)) * HTB)
#define PG8_SB(b, h) ((4 + (b) * 2 + (h)) * HTB)
#define PG8_STAGE(bufoff, gbase, voff) do { _Pragma("unroll") for (int _i = 0; _i < 2; ++_i) \
        __builtin_amdgcn_global_load_lds((const unsigned*)((const char*)(gbase) + (voff)[_i]), (PG8_LAS unsigned*)(lds + (bufoff) + ldsw + _i * 8192), 16, 0, 0); } while (0)
#define PG8_LDA(dst, b, h) do { if constexpr (FP8) { _Pragma("unroll") for (int m = 0; m < 4; ++m) { const i32x4v lo_ = *(const PG8_LAS i32x4v*)(lds + PG8_SA(b, h) + aoff + m * 2048), hi_ = *(const PG8_LAS i32x4v*)(lds + PG8_SA(b, h) + aoff + m * 2048 + 1024); dst##8[m] = __builtin_shufflevector(lo_, hi_, 0, 1, 2, 3, 4, 5, 6, 7); } } \
        else { _Pragma("unroll") for (int m = 0; m < 4; ++m) _Pragma("unroll") for (int k = 0; k < 2; ++k) dst[m][k] = *(const PG8_LAS bf16x8*)(lds + PG8_SA(b, h) + aoff + m * 2048 + k * 1024); } } while (0)
#define PG8_LDB(dst, b, h) do { if constexpr (FP8) { _Pragma("unroll") for (int n = 0; n < 2; ++n) { const i32x4v lo_ = *(const PG8_LAS i32x4v*)(lds + PG8_SB(b, h) + boff + n * 2048), hi_ = *(const PG8_LAS i32x4v*)(lds + PG8_SB(b, h) + boff + n * 2048 + 1024); dst##8[n] = __builtin_shufflevector(lo_, hi_, 0, 1, 2, 3, 4, 5, 6, 7); } } \
        else { _Pragma("unroll") for (int n = 0; n < 2; ++n) _Pragma("unroll") for (int k = 0; k < 2; ++k) dst[n][k] = *(const PG8_LAS bf16x8*)(lds + PG8_SB(b, h) + boff + n * 2048 + k * 1024); } } while (0)
#define PG8_MMA(ai, bj, At, Bt) do { __builtin_amdgcn_s_setprio(1); _Pragma("unroll") for (int m = 0; m < 4; ++m) _Pragma("unroll") for (int n = 0; n < 2; ++n) { \
        if constexpr (FP8) asm volatile("v_mfma_scale_f32_16x16x128_f8f6f4 %0, %1, %2, %0, %3, %3 op_sel_hi:[0,0,0]" : "+v"(acc[ai][bj][m][n]) : "v"(Bt##8[n]), "v"(At##8[m]), "v"(fp8_unit_scale)); \
        else { _Pragma("unroll") for (int k = 0; k < 2; ++k) acc[ai][bj][m][n] = __builtin_amdgcn_mfma_f32_16x16x32_bf16(Bt[n][k], At[m][k], acc[ai][bj][m][n], 0, 0, 0); } } \
        __builtin_amdgcn_s_setprio(0); } while (0)
#define PG8_WAIT_V(n) asm volatile("s_waitcnt vmcnt(" #n ")" ::: "memory")
#define PG8_WAIT_L(n) asm volatile("s_waitcnt lgkmcnt(" #n ")" ::: "memory")
#define PG8_BAR __builtin_amdgcn_s_barrier()
#define PG8_SCHED __builtin_amdgcn_sched_barrier(0)
    Unit cur, nxt; int ui = 0;
    if (!S.next(0, cur)) return;
    f32x4 acc[2][2][4][2];
#pragma unroll
    for (int a = 0; a < 2; ++a)
#pragma unroll
        for (int b = 0; b < 2; ++b)
#pragma unroll
            for (int m = 0; m < 4; ++m)
#pragma unroll
                for (int n = 0; n < 2; ++n) acc[a][b][m][n] = (f32x4){0.f, 0.f, 0.f, 0.f};
    typedef int i32x4v __attribute__((ext_vector_type(4))); typedef int i32x8v __attribute__((ext_vector_type(8)));
    int fp8_unit_scale = 0x7f7f7f7f; asm volatile("" : "+v"(fp8_unit_scale));
    bf16x8 At[4][2], B0[2][2], B1[2][2]; i32x8v At8[4], B08[2], B18[2];
    const char* cA = (const char*)g.A + (size_t)cur.pm * tstep + cur.kb; const char* cB = (const char*)g.Bt + (size_t)cur.pn * tstep + cur.kb;
    S.a_ready(cur);
    if constexpr (SP2) {
        PG8_STAGE(PG8_SB(0, 0), cB, voffB); PG8_STAGE(PG8_SB(0, 1), cB + hstep, voffB); PG8_STAGE(PG8_SA(0, 0), cA, voffA); PG8_STAGE(PG8_SA(0, 1), cA + hstep, voffA);
        if (wr == 1) PG8_BAR;
        PG8_WAIT_V(2); PG8_BAR;
        PG8_STAGE(PG8_SB(1, 0), cB + kstep, voffB); PG8_STAGE(PG8_SA(1, 0), cA + kstep, voffA); PG8_STAGE(PG8_SB(1, 1), cB + hstep + kstep, voffB);
        PG8_WAIT_V(6); PG8_BAR;
    } else {
        PG8_STAGE(PG8_SB(0, 0), cB, voffB); PG8_STAGE(PG8_SA(0, 0), cA, voffA); PG8_STAGE(PG8_SB(0, 1), cB + hstep, voffB); PG8_STAGE(PG8_SA(0, 1), cA + hstep, voffA);
        if (wr == 1) PG8_BAR;
        PG8_WAIT_V(4); PG8_BAR;
        PG8_STAGE(PG8_SB(1, 0), cB + kstep, voffB); PG8_STAGE(PG8_SA(1, 0), cA + kstep, voffA); PG8_STAGE(PG8_SB(1, 1), cB + hstep + kstep, voffB);
        PG8_WAIT_V(6); PG8_BAR;
    }
    PG8_STAMP();
    for (;;) {
        const bool has_next = S.next(ui + 1, nxt);
        const char* nA = has_next ? (const char*)g.A + (size_t)nxt.pm * tstep + nxt.kb : cA; const char* nB = has_next ? (const char*)g.Bt + (size_t)nxt.pn * tstep + nxt.kb : cB;
        for (int t = 0; t < nt; t += 2) {
            const bool last = (t == nt - 2);
            const char* a1 = cA + (size_t)(t + 1) * kstep;
            const char* a2 = last ? nA : cA + (size_t)(t + 2) * kstep; const char* b2 = last ? nB : cB + (size_t)(t + 2) * kstep;
            const char* a3 = a2 + kstep; const char* b3 = b2 + kstep;
            if (last && has_next) S.a_ready(nxt);
            if constexpr (SP2) {
            PG8_LDB(B0, 0, 0); PG8_LDB(B1, 0, 1); PG8_SCHED; PG8_LDA(At, 0, 0); PG8_STAGE(PG8_SA(1, 1), a1 + hstep, voffA);
            PG8_WAIT_V(8); PG8_WAIT_L(0); PG8_BAR; PG8_MMA(0, 0, At, B0); PG8_MMA(0, 1, At, B1); PG8_BAR; PG8_SCHED;
            PG8_LDA(At, 0, 1); PG8_STAGE(PG8_SB(0, 0), b2, voffB); PG8_STAGE(PG8_SB(0, 1), b2 + hstep, voffB); PG8_STAGE(PG8_SA(0, 0), a2, voffA);
            PG8_WAIT_V(8); PG8_WAIT_L(0); PG8_BAR; PG8_MMA(1, 0, At, B0); PG8_MMA(1, 1, At, B1); PG8_BAR; PG8_SCHED;
            PG8_LDB(B0, 1, 0); PG8_LDB(B1, 1, 1); PG8_SCHED; PG8_LDA(At, 1, 0); PG8_STAGE(PG8_SA(0, 1), a2 + hstep, voffA);
            PG8_WAIT_V(8); PG8_WAIT_L(0); PG8_BAR; PG8_MMA(0, 0, At, B0); PG8_MMA(0, 1, At, B1); PG8_BAR; PG8_SCHED;
            PG8_LDA(At, 1, 1); PG8_STAGE(PG8_SB(1, 0), b3, voffB); PG8_STAGE(PG8_SB(1, 1), b3 + hstep, voffB); PG8_STAGE(PG8_SA(1, 0), a3, voffA);
            PG8_WAIT_V(8); PG8_WAIT_L(0); PG8_BAR; PG8_MMA(1, 0, At, B0); PG8_MMA(1, 1, At, B1); PG8_BAR; PG8_SCHED;
            } else {
            PG8_LDB(B0, 0, 0); PG8_SCHED; PG8_LDA(At, 0, 0); PG8_STAGE(PG8_SA(1, 1), a1 + hstep, voffA);
            PG8_WAIT_L(8); PG8_BAR; PG8_WAIT_L(0); PG8_MMA(0, 0, At, B0); PG8_BAR; PG8_SCHED;
            PG8_LDB(B1, 0, 1); PG8_STAGE(PG8_SB(0, 0), b2, voffB);
            PG8_BAR; PG8_WAIT_L(0); PG8_MMA(0, 1, At, B1); PG8_BAR;
            PG8_LDA(At, 0, 1); PG8_STAGE(PG8_SA(0, 0), a2, voffA);
            PG8_BAR; PG8_WAIT_L(0); PG8_MMA(1, 0, At, B0); PG8_BAR; PG8_SCHED;
            PG8_STAGE(PG8_SB(0, 1), b2 + hstep, voffB);
            PG8_WAIT_V(6); PG8_BAR; PG8_MMA(1, 1, At, B1); PG8_BAR;
            PG8_LDB(B0, 1, 0); PG8_SCHED; PG8_LDA(At, 1, 0); PG8_STAGE(PG8_SA(0, 1), a2 + hstep, voffA);
            PG8_WAIT_L(8); PG8_BAR; PG8_WAIT_L(0); PG8_MMA(0, 0, At, B0); PG8_BAR; PG8_SCHED;
            PG8_LDB(B1, 1, 1); PG8_STAGE(PG8_SB(1, 0), b3, voffB);
            PG8_BAR; PG8_WAIT_L(0); PG8_MMA(0, 1, At, B1); PG8_BAR;
            PG8_LDA(At, 1, 1); PG8_STAGE(PG8_SA(1, 0), a3, voffA);
            PG8_BAR; PG8_WAIT_L(0); PG8_MMA(1, 0, At, B0); PG8_BAR; PG8_SCHED;
            PG8_STAGE(PG8_SB(1, 1), b3 + hstep, voffB);
            PG8_WAIT_V(6); PG8_BAR; PG8_MMA(1, 1, At, B1); PG8_BAR;
            }
        }
        PG8_STAMP();
        if constexpr (ALIGN_EPI) { if (wr == 0) PG8_BAR; }
        if constexpr (FP8) asm volatile("s_nop 15\n\ts_nop 15" ::: "memory");
        if constexpr (!Epi::AFTER_DRAIN) { E(acc, cur, wr, wc, fr, fq); S.done(cur); }
        PG8_STAMP();
        if (!has_next) break;
#pragma unroll
        for (int a = 0; a < 2; ++a)
#pragma unroll
            for (int b = 0; b < 2; ++b)
#pragma unroll
                for (int m = 0; m < 4; ++m)
#pragma unroll
                    for (int n = 0; n < 2; ++n) acc[a][b][m][n] = (f32x4){0.f, 0.f, 0.f, 0.f};
        cur = nxt; cA = nA; cB = nB; ++ui;
        if constexpr (ALIGN_EPI) { if (wr == 1) PG8_BAR; }
    }
    PG8_WAIT_V(0);
    if constexpr (!ALIGN_EPI) { if (wr == 0) PG8_BAR; }
    PG8_BAR;
    if constexpr (Epi::AFTER_DRAIN) { E.fused(acc, cur, wr, wc, fr, fq, lds, wid, lane); S.done(cur); }
    PG8_STAMP();
    if (STAMP && wid == 0) { stamps[lane] = lane < nts ? (((unsigned long long)(unsigned)ts_hi << 32) | (unsigned)ts_lo) : 0ull;
        if (lane == 62) stamps[62] = rt_entry; if (lane == 63) stamps[63] = (unsigned long long)wall_clock64(); }
#undef PG8_STAMP
#undef PG8_SA
#undef PG8_SB
#undef PG8_STAGE
#undef PG8_LDA
#undef PG8_LDB
#undef PG8_MMA
#undef PG8_WAIT_V
#undef PG8_WAIT_L
#undef PG8_BAR
#undef PG8_SCHED
}
}

constexpr float HY_MIN_DECAY = -3.0701134573253944f;
constexpr float HY_MAX_DECAY = -15.350567286626972f;
constexpr float RET_SCALE = 0.08838834764831845f;

__device__ __forceinline__ void p0_mod_item(ARGS_REF a, int item, LAS unsigned char* lds) {
    const int tid = fresh_tid(), lane = tid & 63, wave = tid >> 6;
    const int l = item / 192, n0 = (item % 192) * 128;
    LAS float* sc = (LAS float*)lds;
    LAS float* red = (LAS float*)(lds + 81920);
    const float* c = a.in[1]; const float* cc = a.in[3];
    for (int i = tid; i < 5 * 4096; i += NTHREADS) { const int r = i >> 12, k = i & 4095; const float x = r < 4 ? c[r * 4096 + k] : cc[k]; sc[i] = silu_f(x); }
    __syncthreads();
    float acc[5][2];
#pragma unroll
    for (int r = 0; r < 5; ++r) { acc[r][0] = 0.f; acc[r][1] = 0.f; }
    const float* W = a.in[4] + (size_t)l * 4096 * NMOD + n0 + 2 * lane;
#pragma unroll 8
    for (int k = wave; k < 4096; k += 8) {
        const v2f w = *(const v2f*)(W + (size_t)k * NMOD);
#pragma unroll
        for (int r = 0; r < 5; ++r) { const float s = sc[r * 4096 + k]; acc[r][0] += s * w.x; acc[r][1] += s * w.y; }
    }
#pragma unroll
    for (int r = 0; r < 5; ++r) { red[(wave * 5 + r) * 128 + 2 * lane] = acc[r][0]; red[(wave * 5 + r) * 128 + 2 * lane + 1] = acc[r][1]; }
    __syncthreads();
    float* MOD = (float*)(a.ws + WS_MOD);
    for (int i = tid; i < 640; i += NTHREADS) {
        const int r = i >> 7, n = i & 127; float s = 0.f;
#pragma unroll
        for (int w = 0; w < 8; ++w) s += red[(w * 5 + r) * 128 + n];
        MOD[(size_t)(l * 5 + r) * NMOD + n0 + n] = s + a.in[5][(size_t)l * NMOD + n0 + n];
    }
    __syncthreads();
}

__device__ __forceinline__ void p0_filter_item(ARGS_REF a, int item, LAS unsigned char* lds) {
    const int tid = fresh_tid(), lane = tid & 63, wave = tid >> 6;
    const bool ctx = item >= 128; const int l = ctx ? 0 : item / 64; const int L = ctx ? 256 : 4096; const int t0 = (ctx ? item - 128 : item % 64) * 64;
    LAS float* z = (LAS float*)lds;
    LAS float* h1 = z + 64 * 33;
    LAS float* h2 = h1 + 64 * 64;
    const float* w1 = a.in[10] + l * 33 * 64; const float* b1 = a.in[11] + l * 64; const float* fq = a.in[12] + l * 64;
    const float* w2 = a.in[13] + l * 4096; const float* b2 = a.in[14] + l * 64; const float* w3 = a.in[15] + l * 4096; const float* b3 = a.in[16] + l * 64;
    const float* w4 = a.in[17] + (size_t)l * 64 * 4096;
    for (int i = tid; i < 64 * 33; i += NTHREADS) {
        const int tl = i / 33, j = i - tl * 33; const int t = t0 + tl; float val;
        if (j == 0) val = (float)t / (float)(L - 1);
        else { const int bi = (j - 1) & 15; const float f = 1e-4f + (float)bi * ((15.0f - 1e-4f) / 15.0f); const float turns = f * (float)t / (float)L;
               val = (j <= 16) ? cos_turns(turns) : -sin_turns(turns); }
        z[i] = val;
    }
    __syncthreads();
    const float frq = fq[lane];
#pragma unroll 1
    for (int i = 0; i < 8; ++i) { const int tl = wave + 8 * i; float s = b1[lane]; for (int q = 0; q < 33; ++q) s += z[tl * 33 + q] * w1[q * 64 + lane]; h1[tl * 64 + lane] = sin_rad(frq * s); }
    __syncthreads();
#pragma unroll 1
    for (int i = 0; i < 8; ++i) { const int tl = wave + 8 * i; float s = b2[lane]; for (int q = 0; q < 64; ++q) s += h1[tl * 64 + q] * w2[q * 64 + lane]; h2[tl * 64 + lane] = sin_rad(frq * s); }
    __syncthreads();
#pragma unroll 1
    for (int i = 0; i < 8; ++i) { const int tl = wave + 8 * i; float s = b3[lane]; for (int q = 0; q < 64; ++q) s += h2[tl * 64 + q] * w3[q * 64 + lane]; h1[tl * 64 + lane] = sin_rad(frq * s); }
    __syncthreads();
    float* KT = ctx ? (float*)(a.ws + WS_KTC) : (float*)(a.ws + WS_KT) + (size_t)l * 4096 * 4096;
    {
        const int fr = lane & 15, fq = lane >> 4;
        LAS bf16_t* Hh = (LAS bf16_t*)(lds + 41216);
        LAS bf16_t* Hl = Hh + 64 * 72;
        {
            const int row = tid >> 3, c8 = (tid & 7) * 8; const v4f x0 = *(const LAS v4f*)(h1 + row * 64 + c8), x1 = *(const LAS v4f*)(h1 + row * 64 + c8 + 4);
            const unsigned a0 = pack2bf(x0.x, x0.y), a1 = pack2bf(x0.z, x0.w), a2 = pack2bf(x1.x, x1.y), a3 = pack2bf(x1.z, x1.w);
            *(LAS v4u*)(Hh + row * 72 + c8) = make_v4u(a0, a1, a2, a3);
            *(LAS v4u*)(Hl + row * 72 + c8) = make_v4u(pack2bf(x0.x - bflo(a0), x0.y - bfhi(a0)), pack2bf(x0.z - bflo(a1), x0.w - bfhi(a1)), pack2bf(x1.x - bflo(a2), x1.y - bfhi(a2)), pack2bf(x1.z - bflo(a3), x1.w - bfhi(a3)));
        }
        __syncthreads();
        bf16x8_t ah[4][2], al[4][2];
#pragma unroll
        for (int tm = 0; tm < 4; ++tm)
#pragma unroll
            for (int ks = 0; ks < 2; ++ks) { ah[tm][ks] = *(const LAS bf16x8_t*)(Hh + (16 * tm + fr) * 72 + 8 * fq + 32 * ks); al[tm][ks] = *(const LAS bf16x8_t*)(Hl + (16 * tm + fr) * 72 + 8 * fq + 32 * ks); }
#pragma unroll 1
        for (int i = 0; i < 32; ++i) {
            const int col = 16 * (wave + 8 * i) + fr, c = col & 1023;
            bf16x8_t bh[2], bl[2];
#pragma unroll
            for (int ks = 0; ks < 2; ++ks) {
                float w[8];
#pragma unroll
                for (int e = 0; e < 8; ++e) w[e] = w4[(size_t)(32 * ks + 8 * fq + e) * 4096 + col];
                const unsigned h0 = pack2bf(w[0], w[1]), h1_ = pack2bf(w[2], w[3]), h2_ = pack2bf(w[4], w[5]), h3 = pack2bf(w[6], w[7]);
                bh[ks] = __builtin_bit_cast(bf16x8_t, make_v4u(h0, h1_, h2_, h3));
                bl[ks] = __builtin_bit_cast(bf16x8_t, make_v4u(pack2bf(w[0] - bflo(h0), w[1] - bfhi(h0)), pack2bf(w[2] - bflo(h1_), w[3] - bfhi(h1_)), pack2bf(w[4] - bflo(h2_), w[5] - bfhi(h2_)), pack2bf(w[6] - bflo(h3), w[7] - bfhi(h3))));
            }
            const float delta = fabsf(HY_MIN_DECAY + (HY_MAX_DECAY - HY_MIN_DECAY) * ((float)c / 1023.0f));
#pragma unroll
            for (int tm = 0; tm < 4; ++tm) {
                f32x4_t acc = (f32x4_t){0.f, 0.f, 0.f, 0.f};
#pragma unroll
                for (int ks = 0; ks < 2; ++ks) {
                    acc = __builtin_amdgcn_mfma_f32_16x16x32_bf16(al[tm][ks], bh[ks], acc, 0, 0, 0);
                    acc = __builtin_amdgcn_mfma_f32_16x16x32_bf16(ah[tm][ks], bl[ks], acc, 0, 0, 0);
                    acc = __builtin_amdgcn_mfma_f32_16x16x32_bf16(ah[tm][ks], bh[ks], acc, 0, 0, 0);
                }
                const int tb = t0 + 16 * tm + 4 * fq; v4f o;
#pragma unroll
                for (int r = 0; r < 4; ++r) { const float tt = (float)(tb + r) / (float)(L - 1); o[r] = acc[r] * __expf(-tt * delta); }
                *(v4f*)(KT + (size_t)col * L + tb) = o;
            }
        }
    }
    __syncthreads();
}

__device__ __forceinline__ void p0_tr_tile(const float* src, int N, bf16_t* dst, int KD, int k0, int n0, LAS unsigned char* lds) {
    const int tid = fresh_tid();
    LAS float* T = (LAS float*)lds;
#pragma unroll
    for (int i = 0; i < 4; ++i) {
        const int idx = tid + 512 * i; const int r = idx >> 5, c4 = idx & 31;
        const v4f v = *(const v4f*)(src + (size_t)(k0 + r) * N + n0 + c4 * 4);
        LAS float* p = T + r * 129 + c4 * 4; p[0] = v.x; p[1] = v.y; p[2] = v.z; p[3] = v.w;
    }
    __syncthreads();
    {
        const int n = tid >> 2, kc = (tid & 3) * 16; unsigned w[8];
#pragma unroll
        for (int j = 0; j < 8; ++j) w[j] = pack2bf(T[(kc + 2 * j) * 129 + n], T[(kc + 2 * j + 1) * 129 + n]);
        bf16_t* d = dst + (size_t)(n0 + n) * KD + k0 + kc;
        *(v4u*)d = make_v4u(w[0], w[1], w[2], w[3]); *(v4u*)(d + 8) = make_v4u(w[4], w[5], w[6], w[7]);
    }
    __syncthreads();
}

__device__ __forceinline__ void p0_tr_tile_fp8(const float* src, int N, unsigned char* dst, int KD, int k0, int n0, LAS unsigned char* lds) {
    const int tid = fresh_tid();
    LAS float* T = (LAS float*)lds;
#pragma unroll
    for (int i = 0; i < 4; ++i) {
        const int idx = tid + 512 * i; const int r = idx >> 5, c4 = idx & 31;
        const v4f v = *(const v4f*)(src + (size_t)(k0 + r) * N + n0 + c4 * 4);
        LAS float* p = T + r * 129 + c4 * 4; p[0] = v.x; p[1] = v.y; p[2] = v.z; p[3] = v.w;
    }
    __syncthreads();
    {
        const int n = tid >> 2, kc = (tid & 3) * 16; unsigned w[4];
#pragma unroll
        for (int j = 0; j < 4; ++j) w[j] = pack4fp8(T[(kc + 4 * j) * 129 + n], T[(kc + 4 * j + 1) * 129 + n], T[(kc + 4 * j + 2) * 129 + n], T[(kc + 4 * j + 3) * 129 + n]);
        *(v4u*)(dst + (size_t)(n0 + n) * KD + k0 + kc) = make_v4u(w[0], w[1], w[2], w[3]);
    }
    __syncthreads();
}

struct TrDesc { const float* src; unsigned char* dst; int N, KD, k0, n0, fp8; };
__device__ __forceinline__ TrDesc p0_tile_desc(ARGS_REF a, int idx) {
    TrDesc d;
    if (idx < 2 * 9984) {
        const int l = idx / 9984; int j = idx - l * 9984; d.fp8 = 0; d.KD = 4096;
        if (j < 6912) { d.src = a.in[7] + (size_t)l * 4096 * INC; d.N = INC; d.dst = a.ws + WS_WIN + (size_t)l * INC * 4096 * 2; d.k0 = (j / 108) * 64; d.n0 = (j % 108) * 128; }
        else if (j < 8960) { j -= 6912; d.src = a.in[23] + (size_t)l * 4096 * 4096; d.N = 4096; d.dst = a.ws + WS_WOUT + (size_t)l * 4096 * 4096 * 2; d.k0 = (j / 32) * 64; d.n0 = (j % 32) * 128; }
        else { j -= 8960; d.src = a.in[25] + (size_t)l * 4096 * PQ; d.N = PQ; d.dst = a.ws + WS_WQ + (size_t)l * PQ * 4096 * 2; d.k0 = (j / 16) * 64; d.n0 = (j % 16) * 128; }
    } else {
        idx -= 2 * 9984; const int l = idx >> 13, j = idx & 8191; d.fp8 = 1; d.KD = PN;
        d.src = a.in[28] + (size_t)l * PN * 4096; d.N = 4096; d.dst = a.ws + WS_VT + (size_t)l * PN * 4096; d.k0 = (j >> 5) * 64; d.n0 = (j & 31) * 128;
    }
    return d;
}
__device__ __forceinline__ void p0_tile_load(const TrDesc& d, int tid, v4f (&r)[4]) {
#pragma unroll
    for (int i = 0; i < 4; ++i) { const int idx = tid + 512 * i; const int rr = idx >> 5, c4 = idx & 31; r[i] = *(const v4f*)(d.src + (size_t)(d.k0 + rr) * d.N + d.n0 + c4 * 4); }
}
__device__ __forceinline__ void p0_prologue(ARGS_REF a, LAS unsigned char* lds, int pmode = 0) {
    const int tid = fresh_tid(); const int G = gridDim.x, bx = blockIdx.x;
    if (pmode == 0 || pmode == 1) for (int it = bx; it < 384; it += G) p0_mod_item(a, it, lds);
    if (pmode == 0 || pmode == 2) for (int it = G - 1 - bx; it < 132; it += G) p0_filter_item(a, it, lds);
    if (pmode == 1 || pmode == 2) return;
    {
        constexpr int NP = (2 * 9984 + 16384) / 2;
        LAS float* T = (LAS float*)lds;
        volatile LAS int* slot = (volatile LAS int*)(lds + MISC_OFF + 64);
        unsigned* ctr = (unsigned*)(a.ws + WS_CTL) + CW_QUEUE + 64 * 40;
        v4f r[2][4], rn[2][4];
        int cur = bx, nxt = bx + G;
        TrDesc d0 = p0_tile_desc(a, cur < NP ? 2 * cur : 0), d1 = p0_tile_desc(a, cur < NP ? 2 * cur + 1 : 1);
        if (cur < NP) { p0_tile_load(d0, tid, r[0]); p0_tile_load(d1, tid, r[1]); }
#pragma unroll 1
        while (cur < NP) {
            TrDesc dn0 = d0, dn1 = d1;
            if (nxt < NP) { dn0 = p0_tile_desc(a, 2 * nxt); dn1 = p0_tile_desc(a, 2 * nxt + 1); p0_tile_load(dn0, tid, rn[0]); p0_tile_load(dn1, tid, rn[1]); }
            if (tid == 0) *slot = 2 * G + (int)atomicAdd(ctr, 1u);
#pragma unroll
            for (int h = 0; h < 2; ++h)
#pragma unroll
                for (int i = 0; i < 4; ++i) { const int idx = tid + 512 * i; const int rr = idx >> 5, c4 = idx & 31; LAS float* p = T + h * (64 * 129) + rr * 129 + c4 * 4; p[0] = r[h][i].x; p[1] = r[h][i].y; p[2] = r[h][i].z; p[3] = r[h][i].w; }
            __syncthreads();
            const int nn = __builtin_amdgcn_readfirstlane(*slot);
#pragma unroll
            for (int h = 0; h < 2; ++h) {
                const TrDesc& d = h ? d1 : d0; const LAS float* Th = T + h * (64 * 129);
                const int n = tid >> 2, kc = (tid & 3) * 16;
                if (d.fp8) {
                    unsigned w[4];
#pragma unroll
                    for (int j = 0; j < 4; ++j) w[j] = pack4fp8(Th[(kc + 4 * j) * 129 + n], Th[(kc + 4 * j + 1) * 129 + n], Th[(kc + 4 * j + 2) * 129 + n], Th[(kc + 4 * j + 3) * 129 + n]);
                    *(v4u*)(d.dst + (size_t)(d.n0 + n) * d.KD + d.k0 + kc) = make_v4u(w[0], w[1], w[2], w[3]);
                } else {
                    unsigned w[8];
#pragma unroll
                    for (int j = 0; j < 8; ++j) w[j] = pack2bf(Th[(kc + 2 * j) * 129 + n], Th[(kc + 2 * j + 1) * 129 + n]);
                    bf16_t* dd = (bf16_t*)d.dst + (size_t)(d.n0 + n) * d.KD + d.k0 + kc;
                    *(v4u*)dd = make_v4u(w[0], w[1], w[2], w[3]); *(v4u*)(dd + 8) = make_v4u(w[4], w[5], w[6], w[7]);
                }
            }
            __syncthreads();
#pragma unroll
            for (int h = 0; h < 2; ++h)
#pragma unroll
                for (int i = 0; i < 4; ++i) r[h][i] = rn[h][i];
            d0 = dn0; d1 = dn1; cur = nxt; nxt = nn;
        }
    }
    for (int it = bx; it < 32; it += G) {
        const float* kp = a.in[26] + (size_t)it * 128 * 128; bf16_t* kh = (bf16_t*)(a.ws + WS_KHL) + (size_t)it * 2 * 128 * 128; bf16_t* kl = kh + 128 * 128;
#pragma unroll
        for (int i = 0; i < 8; ++i) {
            const int idx4 = tid + 512 * i; const v4f x = *(const v4f*)(kp + idx4 * 4);
            const unsigned h01 = pack2bf(x.x, x.y), h23 = pack2bf(x.z, x.w);
            *(v2u*)(kh + idx4 * 4) = make_v2u(h01, h23);
            *(v2u*)(kl + idx4 * 4) = make_v2u(pack2bf(x.x - bflo(h01), x.y - bfhi(h01)), pack2bf(x.z - bflo(h23), x.w - bfhi(h23)));
        }
    }
    {
        const v4f* su = (const v4f*)a.in[27]; unsigned* du = (unsigned*)(a.ws + WS_UB);
        const size_t n4 = (size_t)2 * PN * 4096 / 4, stride = (size_t)G * NTHREADS;
        for (size_t i0 = (size_t)bx * NTHREADS + tid; i0 < n4; i0 += 8 * stride) {
            v4f x[8];
#pragma unroll
            for (int u = 0; u < 8; ++u) { const size_t i = i0 + u * stride; x[u] = su[i < n4 ? i : i0]; }
#pragma unroll
            for (int u = 0; u < 8; ++u) { const size_t i = i0 + u * stride; if (i < n4) du[i] = pack4fp8(x[u].x * U8_SCALE, x[u].y * U8_SCALE, x[u].z * U8_SCALE, x[u].w * U8_SCALE); }
        }
    }
}

__device__ __forceinline__ void norm_phase(ARGS_REF a, int l, int which, int nrows, int tmode = 0, const float* tgate = nullptr, float tsc = 1.0f) {
    const int tid = fresh_tid(), lane = tid & 63, wave = tid >> 6;
    const float* MOD = (const float*)(a.ws + WS_MOD);
    bf16_t* H = (bf16_t*)(a.ws + WS_H);
    const float* g = (which ? a.in[24] : a.in[6]) + l * 4096;
    const bool first = (l == 0 && which == 0);
    for (int row = blockIdx.x * 8 + wave; row < nrows; row += gridDim.x * 8) {
        const float* src; int r;
        if (row < TL) { src = (first ? a.in[0] : (const float*)a.out) + (size_t)row * 4096; r = row >> 12; }
        else { src = ((first || tmode == 1) ? a.in[2] : (const float*)(a.ws + WS_XC)) + (size_t)(row - TL) * 4096; r = 4; }
        const float* shift = MOD + (size_t)(l * 5 + r) * NMOD + (which ? 3 : 0) * 4096; const float* scale = shift + 4096;
        v4f v[16]; float ss = 0.f;
#pragma unroll
        for (int i = 0; i < 16; ++i) { v[i] = ((const v4f*)src)[i * 64 + lane]; ss += v[i].x * v[i].x + v[i].y * v[i].y + v[i].z * v[i].z + v[i].w * v[i].w; }
        if (tmode != 0 && row >= TL) {
            const float* part = (const float*)(a.ws + WS_PART) + (size_t)(row - TL) * 4096; ss = 0.f;
#pragma unroll
            for (int i = 0; i < 16; ++i) {
                const int j = (i * 64 + lane) * 4;
                v4f ps = *(const v4f*)(part + j);
#pragma unroll
                for (int s = 1; s < 4; ++s) ps += *(const v4f*)(part + (size_t)s * TC * 4096 + j);
                v[i] += *(const v4f*)(tgate + j) * tsc * ps;
                ss += v[i].x * v[i].x + v[i].y * v[i].y + v[i].z * v[i].z + v[i].w * v[i].w;
                if (tmode == 1) *(v4f*)((float*)(a.ws + WS_XC) + (size_t)(row - TL) * 4096 + j) = v[i];
            }
        }
        ss = wave_sum(ss);
        const float rs = rsqrtf(ss * (1.0f / 4096.0f) + EPS);
#pragma unroll
        for (int i = 0; i < 16; ++i) {
            const int j = (i * 64 + lane) * 4;
            const v4f gg = *(const v4f*)(g + j), sh = *(const v4f*)(shift + j), scl = *(const v4f*)(scale + j);
            const float o0 = v[i].x * rs * gg.x * (1.0f + scl.x) + sh.x, o1 = v[i].y * rs * gg.y * (1.0f + scl.y) + sh.y;
            const float o2 = v[i].z * rs * gg.z * (1.0f + scl.z) + sh.z, o3 = v[i].w * rs * gg.w * (1.0f + scl.w) + sh.w;
            *(v2u*)(H + (size_t)row * 4096 + j) = make_v2u(pack2bf(o0, o1), pack2bf(o2, o3));
            if (which) *(unsigned*)(a.ws + WS_HF8 + (size_t)row * 4096 + j) = pack4fp8(o0, o1, o2, o3);
        }
    }
}

struct EpiRes {
    static constexpr bool PERM = false, AFTER_DRAIN = false;
    const float* baseL; const float* baseC; float* outL; float* outC; const float* gate; float sc;
    __device__ __forceinline__ void operator()(const pg8::f32x4 (&acc)[2][2][4][2], const pg8::Unit& u, int wr, int wc, int fr, int fq) const {
        const int urow = u.pm * 256, row0 = urow + wr * 64 + fr, col0 = u.pn * 256 + wc * 32 + 4 * fq;
        const int r = urow < TL ? (urow >> 12) : 4;
        const float* bp0 = urow < TL ? baseL + (size_t)row0 * 4096 : baseC + (size_t)(row0 - TL) * 4096;
        float* op0 = urow < TL ? outL + (size_t)row0 * 4096 : outC + (size_t)(row0 - TL) * 4096;
        pg8::f32x4 gv[2][2];
#pragma unroll
        for (int bj = 0; bj < 2; ++bj)
#pragma unroll
            for (int n = 0; n < 2; ++n) gv[bj][n] = *(const pg8::f32x4*)(gate + (size_t)r * NMOD + col0 + bj * 128 + n * 16) * sc;
#pragma unroll
        for (int ai = 0; ai < 2; ++ai)
#pragma unroll
            for (int m2 = 0; m2 < 2; ++m2) {
                pg8::f32x4 bv[2][2][2];
#pragma unroll
                for (int mm = 0; mm < 2; ++mm)
#pragma unroll
                    for (int bj = 0; bj < 2; ++bj)
#pragma unroll
                        for (int n = 0; n < 2; ++n) bv[mm][bj][n] = *(const pg8::f32x4*)(bp0 + (size_t)(ai * 128 + (2 * m2 + mm) * 16) * 4096 + col0 + bj * 128 + n * 16);
                __builtin_amdgcn_sched_barrier(0);
#pragma unroll
                for (int mm = 0; mm < 2; ++mm)
#pragma unroll
                    for (int bj = 0; bj < 2; ++bj)
#pragma unroll
                        for (int n = 0; n < 2; ++n)
                            *(pg8::f32x4*)(op0 + (size_t)(ai * 128 + (2 * m2 + mm) * 16) * 4096 + col0 + bj * 128 + n * 16) = bv[mm][bj][n] + gv[bj][n] * acc[ai][bj][2 * m2 + mm][n];
                __builtin_amdgcn_sched_barrier(0);
            }
    }
};

struct EpiPart {
    static constexpr bool PERM = false, AFTER_DRAIN = false;
    float* P; int ldc, rows, kpb;
    __device__ __forceinline__ void operator()(const pg8::f32x4 (&acc)[2][2][4][2], const pg8::Unit& u, int wr, int wc, int fr, int fq) const {
        float* base = P + (size_t)(u.kb / kpb) * rows * ldc + (size_t)(u.pm * 256 + wr * 64 + fr) * ldc + u.pn * 256 + wc * 32 + 4 * fq;
#pragma unroll
        for (int ai = 0; ai < 2; ++ai)
#pragma unroll
            for (int m = 0; m < 4; ++m)
#pragma unroll
                for (int bj = 0; bj < 2; ++bj)
#pragma unroll
                    for (int n = 0; n < 2; ++n) *(pg8::f32x4*)(base + (size_t)(ai * 128 + m * 16) * ldc + bj * 128 + n * 16) = acc[ai][bj][m][n];
    }
};

struct EpiProj {
    static constexpr bool PERM = true, AFTER_DRAIN = false;
    bf16_t* O; bf16_t* UT;
    __device__ __forceinline__ void operator()(const pg8::f32x4 (&acc)[2][2][4][2], const pg8::Unit& u, int wr, int wc, int fr, int fq) const {
        const int row0 = u.pm * 256 + wr * 64 + fr, colt = u.pn * 256, col0 = colt + wc * 32 + 8 * fq;
        if (colt >= C_HY && colt < C_HY + 3072) {
#pragma unroll
            for (int ai = 0; ai < 2; ++ai)
#pragma unroll
                for (int m = 0; m < 4; ++m) {
                    const int row = row0 + ai * 128 + m * 16;
#pragma unroll
                    for (int bj = 0; bj < 2; ++bj) {
                        const pg8::f32x4 v0 = acc[ai][bj][m][0], v1 = acc[ai][bj][m][1];
                        const unsigned o = (unsigned)(col0 + bj * 128 - C_HY) * (unsigned)MT + (unsigned)row;
                        const unsigned w0 = pack2bf(v0[0], v0[1]), w1 = pack2bf(v0[2], v0[3]), w2 = pack2bf(v1[0], v1[1]), w3 = pack2bf(v1[2], v1[3]);
                        UT[o] = (bf16_t)(w0 & 0xffffu); UT[o + (unsigned)MT] = (bf16_t)(w0 >> 16); UT[o + 2u * (unsigned)MT] = (bf16_t)(w1 & 0xffffu); UT[o + 3u * (unsigned)MT] = (bf16_t)(w1 >> 16);
                        UT[o + 4u * (unsigned)MT] = (bf16_t)(w2 & 0xffffu); UT[o + 5u * (unsigned)MT] = (bf16_t)(w2 >> 16); UT[o + 6u * (unsigned)MT] = (bf16_t)(w3 & 0xffffu); UT[o + 7u * (unsigned)MT] = (bf16_t)(w3 >> 16);
                        __builtin_amdgcn_sched_barrier(0);
                    }
                }
        } else {
#pragma unroll
            for (int ai = 0; ai < 2; ++ai)
#pragma unroll
                for (int m = 0; m < 4; ++m) {
                    bf16_t* rowp = O + (size_t)(row0 + ai * 128 + m * 16) * INC + col0;
#pragma unroll
                    for (int bj = 0; bj < 2; ++bj) {
                        const pg8::f32x4 v0 = acc[ai][bj][m][0], v1 = acc[ai][bj][m][1];
                        *(v4u*)(rowp + bj * 128) = make_v4u(pack2bf(v0[0], v0[1]), pack2bf(v0[2], v0[3]), pack2bf(v1[0], v1[1]), pack2bf(v1[2], v1[3]));
                    }
                }
        }
    }
};

template <int NTN, int PER, int K, int LDA, int LDB, bool SWA = false, bool SWB = false>
__device__ __forceinline__ void mma_lds(const LAS bf16_t* A, const LAS bf16_t* Bt, f32x4_t (&acc)[PER], int wave, int fr, int fq) {
#pragma unroll
    for (int i = 0; i < PER; ++i) {
        const int tt = wave + 8 * i, tm = tt / NTN, tn = tt % NTN;
        const LAS bf16_t* ap = A + (tm * 16 + fr) * LDA + (SWA ? 0 : fq * 8); const LAS bf16_t* bp = Bt + (tn * 16 + fr) * LDB + (SWB ? 0 : fq * 8);
#pragma unroll
        for (int k0 = 0; k0 < K; k0 += 32) {
            const bf16x8_t av = *(const LAS bf16x8_t*)(ap + (SWA ? 8 * (fq ^ (tm & 3)) : 0) + k0);
            const bf16x8_t bv = *(const LAS bf16x8_t*)(bp + (SWB ? 8 * (fq ^ (tn & 3)) : 0) + k0);
            acc[i] = __builtin_amdgcn_mfma_f32_16x16x32_bf16(av, bv, acc[i], 0, 0, 0);
        }
        __builtin_amdgcn_sched_barrier(0);
    }
}

struct RetRaw { v2u qa[2], qb[2]; v2u ka[4], kb[4]; v2u vv[4]; };
__device__ __forceinline__ void ret_fetch(const bf16_t* P, int r0, int h, bool need_q, int tid, RetRaw& R) {
    if (need_q) {
#pragma unroll
        for (int it = 0; it < 2; ++it) {
            const int task = tid + 512 * it; const int t = task >> 4, half = (task >> 3) & 1, i0 = (task & 7) * 4;
            const bf16_t* src = P + (size_t)(r0 + t) * INC + C_RQ + h * 128 + half * 64 + i0;
            R.qa[it] = *(const v2u*)src; R.qb[it] = *(const v2u*)(src + 32);
        }
    }
    {
        const int s4 = tid >> 5, half = (tid >> 4) & 1, iq = (tid >> 1) & 7;
        const bf16_t* src = P + (size_t)(r0 + 4 * s4) * INC + C_RK + h * 128 + half * 64 + 4 * iq;
#pragma unroll
        for (int j = 0; j < 4; ++j) { R.ka[j] = *(const v2u*)(src + (size_t)j * INC); R.kb[j] = *(const v2u*)(src + (size_t)j * INC + 32); }
    }
    {
        const int s4 = tid >> 5, e4 = tid & 31;
        const bf16_t* src = P + (size_t)(r0 + 4 * s4) * INC + C_RV + h * 128 + 4 * e4;
#pragma unroll
        for (int j = 0; j < 4; ++j) R.vv[j] = *(const v2u*)(src + (size_t)j * INC);
    }
}
__device__ __forceinline__ void ret_stage(const RetRaw& R, int pos0, bool need_q, bool do_rope, int dir, float lg, int tid,
                                          LAS bf16_t* Qs, LAS bf16_t* Ks, LAS bf16_t* Ktd, LAS bf16_t* Vt, const LAS v2f* rope) {
    if (need_q) {
#pragma unroll
        for (int it = 0; it < 2; ++it) {
            const int task = tid + 512 * it; const int t = task >> 4, half = (task >> 3) & 1, i0 = (task & 7) * 4;
            const v2u wa = R.qa[it], wb = R.qb[it];
            const float av[4] = {bflo(wa.x), bfhi(wa.x), bflo(wa.y), bfhi(wa.y)}; const float bv[4] = {bflo(wb.x), bfhi(wb.x), bflo(wb.y), bfhi(wb.y)};
            float oa[4], ob[4];
            if (do_rope) {
                const int pos = half ? ((pos0 + t) & 63) : ((pos0 + t) >> 6);
#pragma unroll
                for (int q = 0; q < 4; ++q) { const v2f cs = rope[pos * 32 + i0 + q]; oa[q] = av[q] * cs.x - bv[q] * cs.y; ob[q] = av[q] * cs.y + bv[q] * cs.x; }
            } else {
#pragma unroll
                for (int q = 0; q < 4; ++q) { oa[q] = av[q]; ob[q] = bv[q]; }
            }
            *(LAS v2u*)(Qs + t * 136 + half * 64 + i0) = make_v2u(pack2bf(oa[0], oa[1]), pack2bf(oa[2], oa[3]));
            *(LAS v2u*)(Qs + t * 136 + half * 64 + 32 + i0) = make_v2u(pack2bf(ob[0], ob[1]), pack2bf(ob[2], ob[3]));
        }
    }
    {
        const int s4 = tid >> 5, half = (tid >> 4) & 1, iq = (tid >> 1) & 7, ab = tid & 1;
        float o[4][4];
#pragma unroll
        for (int j = 0; j < 4; ++j) {
            const int t = 4 * s4 + j; const v2u wa = R.ka[j], wb = R.kb[j];
            const float av[4] = {bflo(wa.x) * RET_SCALE, bfhi(wa.x) * RET_SCALE, bflo(wa.y) * RET_SCALE, bfhi(wa.y) * RET_SCALE};
            const float bv[4] = {bflo(wb.x) * RET_SCALE, bfhi(wb.x) * RET_SCALE, bflo(wb.y) * RET_SCALE, bfhi(wb.y) * RET_SCALE};
            if (do_rope) {
                const int pos = half ? ((pos0 + t) & 63) : ((pos0 + t) >> 6);
#pragma unroll
                for (int q = 0; q < 4; ++q) { const v2f cs = rope[pos * 32 + 4 * iq + q]; o[j][q] = ab ? (av[q] * cs.y + bv[q] * cs.x) : (av[q] * cs.x - bv[q] * cs.y); }
            } else {
#pragma unroll
                for (int q = 0; q < 4; ++q) o[j][q] = ab ? bv[q] : av[q];
            }
            if (need_q) *(LAS v2u*)(Ks + t * 136 + half * 64 + ab * 32 + 4 * iq) = make_v2u(pack2bf(o[j][0], o[j][1]), pack2bf(o[j][2], o[j][3]));
        }
        float kd[4];
#pragma unroll
        for (int j = 0; j < 4; ++j) { const int t = 4 * s4 + j; kd[j] = __expf(lg * (float)(dir ? t : 63 - t)); }
#pragma unroll
        for (int q = 0; q < 4; ++q)
            *(LAS v2u*)(Ktd + (half * 64 + ab * 32 + 4 * iq + q) * 72 + 4 * s4) = make_v2u(pack2bf(o[0][q] * kd[0], o[1][q] * kd[1]), pack2bf(o[2][q] * kd[2], o[3][q] * kd[3]));
    }
    {
        const int s4 = tid >> 5, e4 = tid & 31;
        const unsigned r0x = R.vv[0].x, r0y = R.vv[0].y, r1x = R.vv[1].x, r1y = R.vv[1].y, r2x = R.vv[2].x, r2y = R.vv[2].y, r3x = R.vv[3].x, r3y = R.vv[3].y;
        *(LAS v2u*)(Vt + (4 * e4 + 0) * 72 + 8 * ((s4 >> 1) ^ ((e4 >> 2) & 3)) + 4 * (s4 & 1)) = make_v2u((r0x & 0xffffu) | (r1x << 16), (r2x & 0xffffu) | (r3x << 16));
        *(LAS v2u*)(Vt + (4 * e4 + 1) * 72 + 8 * ((s4 >> 1) ^ ((e4 >> 2) & 3)) + 4 * (s4 & 1)) = make_v2u((r0x >> 16) | (r1x & 0xffff0000u), (r2x >> 16) | (r3x & 0xffff0000u));
        *(LAS v2u*)(Vt + (4 * e4 + 2) * 72 + 8 * ((s4 >> 1) ^ ((e4 >> 2) & 3)) + 4 * (s4 & 1)) = make_v2u((r0y & 0xffffu) | (r1y << 16), (r2y & 0xffffu) | (r3y << 16));
        *(LAS v2u*)(Vt + (4 * e4 + 3) * 72 + 8 * ((s4 >> 1) ^ ((e4 >> 2) & 3)) + 4 * (s4 & 1)) = make_v2u((r0y >> 16) | (r1y & 0xffff0000u), (r2y >> 16) | (r3y & 0xffff0000u));
    }
}

__device__ __forceinline__ void ret_item(ARGS_REF a, int l, int b, int h, int dir, bool cstream, LAS unsigned char* lds) {
    const int tid = fresh_tid(), lane = tid & 63, wave = tid >> 6, fr = lane & 15, fq = lane >> 4;
    LAS bf16_t* Qs  = (LAS bf16_t*)(lds);
    LAS bf16_t* Ks  = (LAS bf16_t*)(lds + 17408);
    LAS bf16_t* Ktd = (LAS bf16_t*)(lds + 34816);
    LAS bf16_t* Vt  = (LAS bf16_t*)(lds + 53248);
    LAS bf16_t* St  = (LAS bf16_t*)(lds + 71680);
    LAS float*  Af  = (LAS float*)(lds + 106496);
    LAS bf16_t* Pb  = (LAS bf16_t*)(lds + 123904);
    LAS v2f* rope = (LAS v2f*)(lds + 133120);
    volatile LAS int* slot = (volatile LAS int*)(lds + MISC_OFF + 128);
    const bf16_t* P = (const bf16_t*)(a.ws + WS_PROJ);
    float* OFd = (float*)(a.ws + WS_OF) + (size_t)dir * MT * 1536;
    const int L = cstream ? 256 : 4096, row0 = cstream ? TL + b * 256 : b * 4096, NCH = L / 64, crow0 = TL + b * 256;
    const int n_init = cstream ? 0 : 4, n_steps = n_init + NCH;
    __syncthreads();
    for (int i = tid; i < 2048; i += NTHREADS) {
        const int pos = i >> 5, fi = i & 31; const float inv = exp2f(-(float)fi * (13.287712379549449f / 32.0f));
        const float turns = ((float)pos * inv) * 0.15915494309189535f;
        rope[i] = make_v2f(cos_turns(turns), sin_turns(turns));
    }
    const float lg = -__expf(a.in[19][(l * 2 + dir) * 12 + h]);
    const float cdec = __expf(lg * 64.0f);
    f32x4_t Sacc[8];
#pragma unroll
    for (int i = 0; i < 8; ++i) Sacc[i] = (f32x4_t){0.f, 0.f, 0.f, 0.f};
#pragma unroll
    for (int i = 0; i < 8; ++i) *(LAS v2u*)(St + (wave * 16 + fr) * 136 + i * 16 + fq * 4) = make_v2u(0u, 0u);
    RetRaw R;
    {
        const bool init = 0 < n_init; const int ch = init ? (dir ? 3 : 0) : (dir ? NCH - 1 : 0);
        ret_fetch(P, init ? crow0 + ch * 64 : row0 + ch * 64, h, !init, tid, R);
    }
#pragma unroll 1
    for (int st = 0; st < n_steps; ++st) {
        const bool init = st < n_init; const int cc = init ? st : st - n_init;
        const int ch = init ? (dir ? 3 - cc : cc) : (dir ? NCH - 1 - cc : cc);
        const int r0 = init ? crow0 + ch * 64 : row0 + ch * 64, pos0 = ch * 64;
        __syncthreads();
        ret_stage(R, pos0, !init, !init && !cstream, dir, lg, tid, Qs, Ks, Ktd, Vt, rope);
        if (st + 1 < n_steps) {
            const bool ninit = st + 1 < n_init; const int ncc = ninit ? st + 1 : st + 1 - n_init;
            const int nch = ninit ? (dir ? 3 - ncc : ncc) : (dir ? NCH - 1 - ncc : ncc);
            ret_fetch(P, ninit ? crow0 + nch * 64 : row0 + nch * 64, h, !ninit, tid, R);
        }
        __syncthreads();
        if (init) {
#pragma unroll
            for (int i = 0; i < 8; ++i) Sacc[i] *= cdec;
            mma_lds<8, 8, 64, 72, 72, false, true>(Ktd, Vt, Sacc, wave, fr, fq);
            if (st + 1 == n_init) {
                __syncthreads();
#pragma unroll
                for (int i = 0; i < 8; ++i)
                    *(LAS v2u*)(St + (wave * 16 + fr) * 136 + i * 16 + fq * 4) = make_v2u(pack2bf(Sacc[i][0], Sacc[i][1]), pack2bf(Sacc[i][2], Sacc[i][3]));
            }
            continue;
        }
        {
            f32x4_t sa[2] = {(f32x4_t){0.f, 0.f, 0.f, 0.f}, (f32x4_t){0.f, 0.f, 0.f, 0.f}};
            mma_lds<4, 2, 128, 136, 136>(Qs, Ks, sa, wave, fr, fq);
#pragma unroll
            for (int i = 0; i < 2; ++i) { const int tt = wave + 8 * i, tm = tt >> 2, tn = tt & 3;
#pragma unroll
                for (int r = 0; r < 4; ++r) Af[(tm * 16 + fq * 4 + r) * 68 + tn * 16 + fr] = sa[i][r]; }
        }
        __syncthreads();
        for (int i = tid; i < 4096; i += NTHREADS) {
            const int ii = i >> 6, jj = i & 63; const int dd = dir ? jj - ii : ii - jj;
            const float val = dd >= 0 ? Af[ii * 68 + jj] * __expf(lg * (float)dd) : 0.f;
            Pb[ii * 72 + jj] = f2bf(val);
        }
        __syncthreads();
        f32x4_t o1[4];
#pragma unroll
        for (int i = 0; i < 4; ++i) o1[i] = (f32x4_t){0.f, 0.f, 0.f, 0.f};
        mma_lds<8, 4, 128, 136, 136>(Qs, St, o1, wave, fr, fq);
#pragma unroll
        for (int i = 0; i < 4; ++i) {
            const int tt = wave + 8 * i, tm = tt >> 3;
#pragma unroll
            for (int r = 0; r < 4; ++r) { const int il = tm * 16 + fq * 4 + r; o1[i][r] *= __expf(lg * (float)(dir ? 64 - il : il + 1)); }
        }
        mma_lds<8, 4, 64, 72, 72, false, true>(Pb, Vt, o1, wave, fr, fq);
#pragma unroll
        for (int i = 0; i < 8; ++i) Sacc[i] *= cdec;
        mma_lds<8, 8, 64, 72, 72, false, true>(Ktd, Vt, Sacc, wave, fr, fq);
        __syncthreads();
#pragma unroll
        for (int i = 0; i < 8; ++i)
            *(LAS v2u*)(St + (wave * 16 + fr) * 136 + i * 16 + fq * 4) = make_v2u(pack2bf(Sacc[i][0], Sacc[i][1]), pack2bf(Sacc[i][2], Sacc[i][3]));
#pragma unroll
        for (int i = 0; i < 4; ++i) {
            const int tt = wave + 8 * i, tm = tt >> 3, tn = tt & 7;
#pragma unroll
            for (int r = 0; r < 4; ++r) {
                const int il = tm * 16 + fq * 4 + r, e = tn * 16 + fr;
                __hip_atomic_store(OFd + (size_t)(r0 + il) * 1536 + h * 128 + e, o1[i][r], __ATOMIC_RELAXED, __HIP_MEMORY_SCOPE_AGENT);
            }
        }
    }
    asm volatile("s_waitcnt vmcnt(0)" ::: "memory");
    __syncthreads();
    if (tid == 0) {
        unsigned* cnt = (unsigned*)(a.ws + WS_CTL) + CW_RET + ((l * 2 + (cstream ? 1 : 0)) * 48 + b * 12 + h);
        *slot = (int)__hip_atomic_fetch_add(cnt, 1u, __ATOMIC_RELAXED, __HIP_MEMORY_SCOPE_AGENT);
    }
    __syncthreads();
    if (*slot == 1) {
        __builtin_amdgcn_fence(__ATOMIC_ACQUIRE, "agent");
        const float* OF0 = (const float*)(a.ws + WS_OF); const float* OF1 = OF0 + (size_t)MT * 1536;
        bf16_t* MIX = (bf16_t*)(a.ws + WS_MIX);
#pragma unroll 2
        for (int t = wave; t < L; t += 8) {
            const size_t row = (size_t)(row0 + t);
            const v2f x0 = *(const v2f*)(OF0 + row * 1536 + h * 128 + 2 * lane), x1 = *(const v2f*)(OF1 + row * 1536 + h * 128 + 2 * lane);
            const float y0 = x0.x + x1.x, y1 = x0.y + x1.y;
            const float ss = wave_sum(y0 * y0 + y1 * y1); const float rs = rsqrtf(ss * (1.0f / 128.0f) + EPS);
            const unsigned gw = *(const unsigned*)(P + row * INC + C_RG + h * 128 + 2 * lane);
            *(unsigned*)(MIX + row * 4096 + M_RO + h * 128 + 2 * lane) = pack2bf(y0 * rs * silu_f(bflo(gw)), y1 * rs * silu_f(bfhi(gw)));
        }
    }
    __syncthreads();
}

__device__ __forceinline__ void hy_conv8(const LAS float* U, const LAS float* G, int L, float (&y)[8]) {
    const int tb = 8 * fresh_tid();
#pragma unroll
    for (int j = 0; j < 8; ++j) y[j] = 0.f;
    if (tb < L) {
#pragma unroll 2
        for (int s0 = 0; s0 < L; s0 += 4) {
            const int base = tb - s0 + L;
            const v4f g0 = *(const LAS v4f*)(G + base - 4), g1 = *(const LAS v4f*)(G + base), g2 = *(const LAS v4f*)(G + base + 4);
            const v4f u = *(const LAS v4f*)(U + s0);
            const float g[12] = {g0.x, g0.y, g0.z, g0.w, g1.x, g1.y, g1.z, g1.w, g2.x, g2.y, g2.z, g2.w};
            const float uu[4] = {u.x, u.y, u.z, u.w};
#pragma unroll
            for (int j = 0; j < 8; ++j)
#pragma unroll
                for (int i = 0; i < 4; ++i) y[j] += g[4 + j - i] * uu[i];
        }
    }
}
__device__ __forceinline__ void hyena_item(ARGS_REF a, int l, int c, int b, bool cstream, LAS unsigned char* lds) {
    const int tid = fresh_tid();
    const int L = cstream ? 256 : 4096, row0 = cstream ? TL + b * 256 : b * 4096;
    LAS float* sv = (LAS float*)lds; LAS float* sx1 = sv + L; LAS float* sx2 = sx1 + L; LAS float* sz = sx2 + L; LAS float* G0 = sz + L; LAS float* G1 = G0 + 2 * L;
    const bf16_t* UT = (const bf16_t*)(a.ws + WS_UT);
    bf16_t* MIX = (bf16_t*)(a.ws + WS_MIX);
    const float* cw = a.in[8] + l * 3 * 3072; const float* cb = a.in[9] + l * 3072;
    const float* K = cstream ? (const float*)(a.ws + WS_KTC) : (const float*)(a.ws + WS_KT) + (size_t)l * 4096 * 4096;
    __syncthreads();
    for (int t = tid; t < L; t += NTHREADS) {
#pragma unroll
        for (int which = 0; which < 3; ++which) {
            const int chn = which * 1024 + c; float acc = cb[chn];
#pragma unroll
            for (int i = 0; i < 3; ++i) { const int tt = t + i - 1; if (tt >= 0 && tt < L) acc += cw[i * 3072 + chn] * bf2f(UT[(size_t)chn * MT + row0 + tt]); }
            (which == 0 ? sv : (which == 1 ? sx1 : sx2))[t] = acc;
        }
    }
    for (int i = tid; i < 2 * L; i += NTHREADS) {
        const int d = i - L;
        const size_t cf0 = (size_t)(0 * 1024 + c) * L, cb0 = (size_t)(1 * 1024 + c) * L, cf1 = (size_t)(2 * 1024 + c) * L, cb1 = (size_t)(3 * 1024 + c) * L;
        float v0 = 0.f, v1 = 0.f;
        if (d >= 0) { v0 = K[cf0 + d]; v1 = K[cf1 + d]; } else if (d > -L) { v0 = K[cb0 - d]; v1 = K[cb1 - d]; }
        G0[i] = v0; G1[i] = v1;
    }
    __syncthreads();
    const float skip0 = a.in[18][(l * 2 + 0) * 1024 + c], skip1 = a.in[18][(l * 2 + 1) * 1024 + c];
    float y[8];
    hy_conv8(sv, G0, L, y);
    if (8 * tid < L) {
#pragma unroll
        for (int j = 0; j < 8; ++j) { const int t = 8 * tid + j; sz[t] = sx1[t] * (y[j] + skip0 * sv[t]); }
    }
    __syncthreads();
    hy_conv8(sz, G1, L, y);
    if (8 * tid < L) {
#pragma unroll
        for (int j = 0; j < 8; ++j) { const int t = 8 * tid + j; MIX[(size_t)(row0 + t) * 4096 + M_HY + c] = f2bf(sx2[t] * (y[j] + skip1 * sz[t])); }
    }
    __syncthreads();
}


#define HY_DEV __device__ __forceinline__
#define HY_LDS LAS
__device__ __forceinline__ float hy_cos_turns(float t) { return __builtin_amdgcn_cosf(t); }
__device__ __forceinline__ float hy_sin_turns(float t) { return __builtin_amdgcn_sinf(t); }

#define HY_CPX_DEFINED
typedef float cpx __attribute__((ext_vector_type(2)));
__device__ __forceinline__ cpx cmk(float x, float y) { return (cpx){x, y}; }
#ifndef HY_CPX_DEFINED
struct __attribute__((aligned(8))) cpx { float x, y; };
HY_DEV cpx cmk(float x, float y) { cpx r; r.x = x; r.y = y; return r; }
#endif
HY_DEV cpx cadd(cpx a, cpx b) { return cmk(a.x + b.x, a.y + b.y); }
HY_DEV cpx csub(cpx a, cpx b) { return cmk(a.x - b.x, a.y - b.y); }
HY_DEV cpx cmul(cpx a, cpx b) { return cmk(a.x * b.x - a.y * b.y, a.x * b.y + a.y * b.x); }
HY_DEV cpx cmuli(cpx a, bool inv) { return inv ? cmk(-a.y, a.x) : cmk(a.y, -a.x); }
constexpr int HY_N = 8192, HY_BUFN = 8192 + 256;
HY_DEV int hy_pad(int p) { return p + (p >> 5); }
HY_DEV int hy_freq(int p) { return (p >> 9) | (((p >> 5) & 15) << 4) | (((p >> 1) & 15) << 8) | ((p & 1) << 12); }
HY_DEV int hy_pos(int w) { return ((w & 15) << 9) | (((w >> 4) & 15) << 5) | (((w >> 8) & 15) << 1) | (w >> 12); }

template <bool INV> HY_DEV void dft16(cpx (&x)[16]) {
    const float C1 = 0.92387953251128674f, S1 = 0.38268343236508977f, R2 = 0.70710678118654752f;
    cpx u[4][4];
#pragma unroll
    for (int b = 0; b < 4; ++b) {
        const cpx t0 = cadd(x[b], x[8 + b]), t1 = csub(x[b], x[8 + b]), t2 = cadd(x[4 + b], x[12 + b]), t3 = cmuli(csub(x[4 + b], x[12 + b]), INV);
        u[b][0] = cadd(t0, t2); u[b][2] = csub(t0, t2); u[b][1] = cadd(t1, t3); u[b][3] = csub(t1, t3);
    }
    const float sg = INV ? 1.0f : -1.0f;
    u[1][1] = cmul(u[1][1], cmk(C1, sg * S1));  u[1][2] = cmul(u[1][2], cmk(R2, sg * R2));  u[1][3] = cmul(u[1][3], cmk(S1, sg * C1));
    u[2][1] = cmul(u[2][1], cmk(R2, sg * R2));  u[2][2] = cmuli(u[2][2], INV);              u[2][3] = cmul(u[2][3], cmk(-R2, sg * R2));
    u[3][1] = cmul(u[3][1], cmk(S1, sg * C1));  u[3][2] = cmul(u[3][2], cmk(-R2, sg * R2)); u[3][3] = cmul(u[3][3], cmk(-C1, -sg * S1));
#pragma unroll
    for (int c = 0; c < 4; ++c) {
        const cpx t0 = cadd(u[0][c], u[2][c]), t1 = csub(u[0][c], u[2][c]), t2 = cadd(u[1][c], u[3][c]), t3 = cmuli(csub(u[1][c], u[3][c]), INV);
        x[c] = cadd(t0, t2); x[c + 8] = csub(t0, t2); x[c + 4] = cadd(t1, t3); x[c + 12] = csub(t1, t3);
    }
}
template <bool INV> HY_DEV void hy_twiddle(cpx (&x)[16], int j, int n) {
    const float turns = (float)j / (float)n;
    const cpx w1 = cmk(hy_cos_turns(turns), INV ? hy_sin_turns(turns) : -hy_sin_turns(turns));
    cpx w = w1;
#pragma unroll
    for (int q = 1; q < 16; ++q) { x[q] = cmul(x[q], w); w = cmul(w, w1); }
}
template <bool LOAD> HY_DEV void hy_fwd16(int tid, int n, HY_LDS cpx* Z, cpx (&x)[16]) {
    const int m = n >> 4, blk = tid / m, j = tid - blk * m, base = blk * n + j;
    const int bp = hy_pad(base), S = m + (m >> 5);
    if (LOAD) {
#pragma unroll
        for (int k = 0; k < 16; ++k) x[k] = Z[bp + k * S];
    }
    dft16<false>(x);
    hy_twiddle<false>(x, j, n);
#pragma unroll
    for (int q = 0; q < 16; ++q) Z[bp + q * S] = x[q];
}
template <bool STORE> HY_DEV void hy_inv16(int tid, int n, HY_LDS cpx* Z, cpx (&x)[16]) {
    const int m = n >> 4, blk = tid / m, j = tid - blk * m, base = blk * n + j;
    const int bp = hy_pad(base), S = m + (m >> 5);
#pragma unroll
    for (int q = 0; q < 16; ++q) x[q] = Z[bp + q * S];
    hy_twiddle<true>(x, j, n);
    dft16<true>(x);
    if (STORE) {
#pragma unroll
        for (int k = 0; k < 16; ++k) Z[bp + k * S] = x[k];
    }
}
HY_DEV void hy_fwd2(int tid, HY_LDS cpx* Z) {
#pragma unroll
    for (int i = 0; i < 8; ++i) { const int pp = 16 * tid + (tid >> 1) + 2 * i; const cpx a = Z[pp], b = Z[pp + 1]; Z[pp] = cadd(a, b); Z[pp + 1] = csub(a, b); }
}
HY_DEV cpx hy_kfilter(const HY_LDS cpx* F, int p, int order) {
    const int w = hy_freq(p); const cpx A = F[hy_pad(p)], B = F[hy_pad(hy_pos((HY_N - w) & (HY_N - 1)))];
    return order == 0 ? cmk(0.5f * (A.x + B.x), 0.5f * (A.y - B.y)) : cmk(0.5f * (A.y + B.y), -0.5f * (A.x - B.x));
}
HY_DEV void hy_mid(int tid, HY_LDS cpx* Z, const HY_LDS cpx* F, int order, float scale) {
#pragma unroll
    for (int i = 0; i < 8; ++i) {
        const int p0 = 16 * tid + 2 * i, pp = p0 + (tid >> 1); const cpx a = Z[pp], b = Z[pp + 1];
        cpx k0 = hy_kfilter(F, p0, order), k1 = hy_kfilter(F, p0 + 1, order);
        k0.x *= scale; k0.y *= scale; k1.x *= scale; k1.y *= scale;
        const cpx y0 = cmul(cadd(a, b), k0), y1 = cmul(csub(a, b), k1);
        Z[pp] = cadd(y0, y1); Z[pp + 1] = csub(y0, y1);
    }
}
__device__ __forceinline__ void hy_conv_fft(LAS cpx* Z, const LAS cpx* F, int order, cpx (&x)[16], int pmode = 0) {
    if (pmode == 1) return;
    hy_fwd16<false>(fresh_tid(), 8192, Z, x); __syncthreads();
    hy_fwd16<true>(fresh_tid(), 512, Z, x); __syncthreads();
    hy_fwd16<true>(fresh_tid(), 32, Z, x); __syncthreads();
    hy_mid(fresh_tid(), Z, F, order, 1.0f / 8192.0f); __syncthreads();
    hy_inv16<true>(fresh_tid(), 32, Z, x); __syncthreads();
    hy_inv16<true>(fresh_tid(), 512, Z, x); __syncthreads();
    hy_inv16<false>(fresh_tid(), 8192, Z, x);
}
__device__ __forceinline__ void hy_load_short(const bf16_t* U0, const bf16_t* U1, float w0, float w1, float w2, float bias, int tid, cpx (&o)[8]) {
    const int lane = tid & 63, tb = tid - lane;
    unsigned c0[8], c1[8], e0[8], e1[8];
#pragma unroll
    for (int k = 0; k < 8; ++k) {
        const int t = tid + 512 * k, ter = (lane < 32) ? (tb + 512 * k - 1) : (tb + 512 * k + 64), te = ter < 0 ? 0 : (ter > 4095 ? 4095 : ter);
        c0[k] = U0[t]; c1[k] = U1[t]; e0[k] = U0[te]; e1[k] = U1[te];
    }
#pragma unroll
    for (int k = 0; k < 8; ++k) {
        const int ter = (lane < 32) ? (tb + 512 * k - 1) : (tb + 512 * k + 64); const bool ev = (ter >= 0) && (ter <= 4095);
        const unsigned m0 = ev ? e0[k] : 0u, m1 = ev ? e1[k] : 0u;
        const unsigned l0 = (unsigned)__builtin_amdgcn_update_dpp((int)m0, (int)c0[k], 0x138, 0xf, 0xf, false), r0 = (unsigned)__builtin_amdgcn_update_dpp((int)m0, (int)c0[k], 0x130, 0xf, 0xf, false);
        const unsigned l1 = (unsigned)__builtin_amdgcn_update_dpp((int)m1, (int)c1[k], 0x138, 0xf, 0xf, false), r1 = (unsigned)__builtin_amdgcn_update_dpp((int)m1, (int)c1[k], 0x130, 0xf, 0xf, false);
        o[k] = cmk(bias + w0 * bf2f((bf16_t)l0) + w1 * bf2f((bf16_t)c0[k]) + w2 * bf2f((bf16_t)r0), bias + w0 * bf2f((bf16_t)l1) + w1 * bf2f((bf16_t)c1[k]) + w2 * bf2f((bf16_t)r1));
    }
}
__device__ __forceinline__ void hyena_fft_item(ARGS_REF a, int l, int c4, LAS unsigned char* lds, int pmode = 0) {
    LAS cpx* F = (LAS cpx*)lds; LAS cpx* Z = F + HY_BUFN;
    const bf16_t* UT = (const bf16_t*)(a.ws + WS_UT);
    bf16_t* MIX = (bf16_t*)(a.ws + WS_MIX);
    const float* cw = a.in[8] + l * 3 * 3072; const float* cb = a.in[9] + l * 3072;
    const float* K = (const float*)(a.ws + WS_KT) + (size_t)l * 4096 * 4096;
    unsigned olo[2][8][2], ohi[2][8][2];
#pragma unroll
    for (int i = 0; i < 2; ++i)
#pragma unroll
        for (int k = 0; k < 8; ++k) { olo[i][k][0] = 0u; olo[i][k][1] = 0u; ohi[i][k][0] = 0u; ohi[i][k][1] = 0u; }
#pragma unroll 1
    for (int ci = 0; ci < 4; ++ci) {
        const int c = 4 * c4 + ci;
        const float skip0 = a.in[18][(l * 2 + 0) * 1024 + c], skip1 = a.in[18][(l * 2 + 1) * 1024 + c];
        __syncthreads();
        cpx x[16];
        {
            const int tid = fresh_tid();
            const float* kf0 = K + (size_t)(0 * 1024 + c) * 4096; const float* kb0 = K + (size_t)(1 * 1024 + c) * 4096;
            const float* kf1 = K + (size_t)(2 * 1024 + c) * 4096; const float* kb1 = K + (size_t)(3 * 1024 + c) * 4096;
#pragma unroll
            for (int k = 0; k < 8; ++k) x[k] = cmk(kf0[tid + 512 * k], kf1[tid + 512 * k]);
#pragma unroll
            for (int k = 8; k < 16; ++k) { const int i = tid + 512 * k; const int ii = (i == 4096) ? 1 : 8192 - i; const cpx v = cmk(kb0[ii], kb1[ii]); x[k] = (i == 4096) ? cmk(0.f, 0.f) : v; }
            hy_fwd16<false>(fresh_tid(), 8192, F, x); __syncthreads();
            hy_fwd16<true>(fresh_tid(), 512, F, x); __syncthreads();
            hy_fwd16<true>(fresh_tid(), 32, F, x); __syncthreads();
            hy_fwd2(fresh_tid(), F); __syncthreads();
        }
#pragma unroll
        for (int bp = 0; bp < 2; ++bp) {
            const int rb0 = (2 * bp) * 4096, rb1 = (2 * bp + 1) * 4096;
            unsigned vvp[8], z1p[8];
            {
                cpx vv[8];
                const int chn = c; hy_load_short(UT + (size_t)chn * MT + rb0, UT + (size_t)chn * MT + rb1, cw[chn], cw[3072 + chn], cw[2 * 3072 + chn], cb[chn], fresh_tid(), vv);
#pragma unroll
                for (int k = 0; k < 8; ++k) { x[k] = vv[k]; x[k + 8] = cmk(0.f, 0.f); vvp[k] = pack2bf(vv[k].x, vv[k].y); }
            }
            hy_conv_fft(Z, F, 0, x, pmode);
            {
                cpx x1v[8];
                const int chn = 1024 + c; hy_load_short(UT + (size_t)chn * MT + rb0, UT + (size_t)chn * MT + rb1, cw[chn], cw[3072 + chn], cw[2 * 3072 + chn], cb[chn], fresh_tid(), x1v);
#pragma unroll
                for (int k = 0; k < 8; ++k) {
                    const cpx z = cmk(x1v[k].x * (x[k].x + skip0 * bflo(vvp[k])), x1v[k].y * (x[k].y + skip0 * bfhi(vvp[k])));
                    x[k] = z; x[k + 8] = cmk(0.f, 0.f); z1p[k] = pack2bf(z.x, z.y);
                }
            }
            __syncthreads();
            hy_conv_fft(Z, F, 1, x, pmode);
            {
                cpx x2v[8];
                const int chn = 2048 + c; hy_load_short(UT + (size_t)chn * MT + rb0, UT + (size_t)chn * MT + rb1, cw[chn], cw[3072 + chn], cw[2 * 3072 + chn], cb[chn], fresh_tid(), x2v);
                const unsigned sh = (ci & 1) ? 16u : 0u;
#pragma unroll
                for (int k = 0; k < 8; ++k) {
                    const unsigned w0 = (unsigned)f2bf(x2v[k].x * (x[k].x + skip1 * bflo(z1p[k]))) << sh, w1 = (unsigned)f2bf(x2v[k].y * (x[k].y + skip1 * bfhi(z1p[k]))) << sh;
                    if (ci < 2) { olo[bp][k][0] |= w0; olo[bp][k][1] |= w1; } else { ohi[bp][k][0] |= w0; ohi[bp][k][1] |= w1; }
                }
            }
            __syncthreads();
        }
    }
    if (pmode == 0 || pmode == 3) {
        const int tid = fresh_tid();
#pragma unroll
        for (int bp = 0; bp < 2; ++bp)
#pragma unroll
            for (int k = 0; k < 8; ++k) {
                const int t = tid + 512 * k;
                *(v2u*)(MIX + (size_t)((2 * bp) * 4096 + t) * 4096 + M_HY + 4 * c4) = make_v2u(olo[bp][k][0], ohi[bp][k][0]);
                *(v2u*)(MIX + (size_t)((2 * bp + 1) * 4096 + t) * 4096 + M_HY + 4 * c4) = make_v2u(olo[bp][k][1], ohi[bp][k][1]);
            }
    }
}

__device__ __forceinline__ void hy_ctx_conv2(const LAS float* U, const LAS float* G, int t2, float (&y)[2]) {
    y[0] = 0.f; y[1] = 0.f;
#pragma unroll 4
    for (int s0 = 0; s0 < 256; s0 += 4) {
        const int base = t2 - s0 + 256; const v4f u = *(const LAS v4f*)(U + s0);
        const float g0 = G[base - 3], g1 = G[base - 2], g2 = G[base - 1], g3 = G[base], g4 = G[base + 1];
        y[0] += g3 * u.x + g2 * u.y + g1 * u.z + g0 * u.w;
        y[1] += g4 * u.x + g3 * u.y + g2 * u.z + g1 * u.w;
    }
}
__device__ __forceinline__ void hyena_ctx_item(ARGS_REF a, int l, int c, LAS unsigned char* lds) {
    const int tid = fresh_tid();
    LAS float* G0 = (LAS float*)lds; LAS float* G1 = G0 + 512;
    LAS float* sv = G1 + 512; LAS float* sx1 = sv + 1024; LAS float* sx2 = sx1 + 1024; LAS float* sz = sx2 + 1024;
    const bf16_t* UT = (const bf16_t*)(a.ws + WS_UT);
    bf16_t* MIX = (bf16_t*)(a.ws + WS_MIX);
    const float* cw = a.in[8] + l * 3 * 3072; const float* cb = a.in[9] + l * 3072;
    const float* K = (const float*)(a.ws + WS_KTC);
    __syncthreads();
#pragma unroll
    for (int i = 0; i < 2; ++i) {
        const int idx = tid + 512 * i; const int b = idx >> 8, t = idx & 255, tm = t > 0 ? t - 1 : 0, tp = t < 255 ? t + 1 : 255;
        const float m0 = t > 0 ? 1.f : 0.f, m2 = t < 255 ? 1.f : 0.f;
#pragma unroll
        for (int which = 0; which < 3; ++which) {
            const int chn = which * 1024 + c; const bf16_t* U = UT + (size_t)chn * MT + TL + b * 256;
            const float val = cb[chn] + cw[chn] * m0 * bf2f(U[tm]) + cw[3072 + chn] * bf2f(U[t]) + cw[2 * 3072 + chn] * m2 * bf2f(U[tp]);
            (which == 0 ? sv : (which == 1 ? sx1 : sx2))[idx] = val;
        }
    }
    {
        const int d = tid - 256, dd = d >= 0 ? d : -d, ok = (d > -256) ? 1 : 0;
        const float f0 = K[(size_t)(0 * 1024 + c) * 256 + dd], b0 = K[(size_t)(1 * 1024 + c) * 256 + dd], f1 = K[(size_t)(2 * 1024 + c) * 256 + dd], b1 = K[(size_t)(3 * 1024 + c) * 256 + dd];
        G0[tid] = ok ? (d >= 0 ? f0 : b0) : 0.f; G1[tid] = ok ? (d >= 0 ? f1 : b1) : 0.f;
    }
    __syncthreads();
    const float skip0 = a.in[18][(l * 2 + 0) * 1024 + c], skip1 = a.in[18][(l * 2 + 1) * 1024 + c];
    const int b = tid >> 7, t2 = (tid & 127) * 2;
    float y[2];
    hy_ctx_conv2(sv + b * 256, G0, t2, y);
    sz[b * 256 + t2] = sx1[b * 256 + t2] * (y[0] + skip0 * sv[b * 256 + t2]); sz[b * 256 + t2 + 1] = sx1[b * 256 + t2 + 1] * (y[1] + skip0 * sv[b * 256 + t2 + 1]);
    __syncthreads();
    hy_ctx_conv2(sz + b * 256, G1, t2, y);
    MIX[(size_t)(TL + b * 256 + t2) * 4096 + M_HY + c] = f2bf(sx2[b * 256 + t2] * (y[0] + skip1 * sz[b * 256 + t2]));
    MIX[(size_t)(TL + b * 256 + t2 + 1) * 4096 + M_HY + c] = f2bf(sx2[b * 256 + t2 + 1] * (y[1] + skip1 * sz[b * 256 + t2 + 1]));
    __syncthreads();
}

struct NaRaw { v4u k[4]; v2u v[2][4]; };
__device__ __forceinline__ void na_fetch(const bf16_t* P, int krow0, int h, int tid, NaRaw& R) {
#pragma unroll
    for (int i = 0; i < 4; ++i) { const int idx = tid + 512 * i; const int kr = idx >> 4, c8 = idx & 15; R.k[i] = *(const v4u*)(P + (size_t)(krow0 + kr) * INC + C_NK + h * 128 + c8 * 8); }
#pragma unroll
    for (int it = 0; it < 2; ++it) {
        const int task = tid + 512 * it; const int s4 = task >> 5, e4 = task & 31;
        const bf16_t* src = P + (size_t)(krow0 + 4 * s4) * INC + C_NV + h * 128 + 4 * e4;
#pragma unroll
        for (int j = 0; j < 4; ++j) R.v[it][j] = *(const v2u*)(src + (size_t)j * INC);
    }
}
__device__ __forceinline__ void na_stage(const NaRaw& R, int tid, LAS bf16_t* Kb, LAS bf16_t* Vt) {
#pragma unroll
    for (int i = 0; i < 4; ++i) { const int idx = tid + 512 * i; const int kr = idx >> 4, c8 = idx & 15; *(LAS v4u*)(Kb + kr * 136 + c8 * 8) = R.k[i]; }
#pragma unroll
    for (int it = 0; it < 2; ++it) {
        const int task = tid + 512 * it; const int s4 = task >> 5, e4 = task & 31, sw = s4 ^ (e4 >> 2);
        const unsigned r0x = R.v[it][0].x, r0y = R.v[it][0].y, r1x = R.v[it][1].x, r1y = R.v[it][1].y, r2x = R.v[it][2].x, r2y = R.v[it][2].y, r3x = R.v[it][3].x, r3y = R.v[it][3].y;
        *(LAS v2u*)(Vt + (4 * e4 + 0) * 136 + 4 * sw) = make_v2u((r0x & 0xffffu) | (r1x << 16), (r2x & 0xffffu) | (r3x << 16));
        *(LAS v2u*)(Vt + (4 * e4 + 1) * 136 + 4 * sw) = make_v2u((r0x >> 16) | (r1x & 0xffff0000u), (r2x >> 16) | (r3x & 0xffff0000u));
        *(LAS v2u*)(Vt + (4 * e4 + 2) * 136 + 4 * sw) = make_v2u((r0y & 0xffffu) | (r1y << 16), (r2y & 0xffffu) | (r3y << 16));
        *(LAS v2u*)(Vt + (4 * e4 + 3) * 136 + 4 * sw) = make_v2u((r0y >> 16) | (r1y & 0xffff0000u), (r2y >> 16) | (r3y & 0xffff0000u));
    }
}
__device__ __forceinline__ void na_item(ARGS_REF a, int l, int b, int h, int r, bool cstream, LAS unsigned char* lds, int pmode = 0) {
    const int tid = fresh_tid(), lane = tid & 63, wave = tid >> 6, fr = lane & 15, fq = lane >> 4;
    LAS bf16_t* Qs = (LAS bf16_t*)lds;
    LAS bf16_t* Kb = (LAS bf16_t*)(lds + 17408);
    LAS bf16_t* Vt = (LAS bf16_t*)(lds + 52224);
    LAS float*  Sf = (LAS float*)(lds + 87040);
    LAS bf16_t* Pb = (LAS bf16_t*)(lds + 120832);
    LAS float*  rk = (LAS float*)(lds + 138240);
    LAS float*  st_m = rk + 128;
    LAS float*  st_l = st_m + 64;
    LAS float*  st_a = st_l + 64;
    LAS float*  rpbs = st_a + 64;
    const bf16_t* P = (const bf16_t*)(a.ws + WS_PROJ);
    bf16_t* MIX = (bf16_t*)(a.ws + WS_MIX);
    const int qrow0 = cstream ? TL + b * 256 + r * 64 : b * 4096 + r * 64;
    const float* gq = a.in[21] + l * 128; const float* gk = a.in[22] + l * 128;
    const float* rpb = a.in[20] + (size_t)(l * 12 + h) * 15 * 31;
    const int nloc = cstream ? 0 : 4, start = clampi(r - 4, 0, 56), nsteps = nloc + 2;
    NaRaw R;
    na_fetch(P, cstream ? TL + b * 256 : b * 4096 + start * 64, h, tid, R);
    __syncthreads();
#pragma unroll 1
    for (int qq = 0; qq < 8; ++qq) {
        const int q = wave * 8 + qq; const bf16_t* p = P + (size_t)(qrow0 + q) * INC + C_NQ + h * 128;
        const unsigned w = *(const unsigned*)(p + 2 * lane); const float x0 = bflo(w), x1 = bfhi(w);
        const float ss = wave_sum(x0 * x0 + x1 * x1); const float rs = rsqrtf(ss * (1.0f / 128.0f) + EPS) * RET_SCALE;
        *(LAS unsigned*)(Qs + q * 136 + 2 * lane) = pack2bf(x0 * rs * gq[2 * lane] * gk[2 * lane], x1 * rs * gq[2 * lane + 1] * gk[2 * lane + 1]);
    }
    if (tid < 64) { st_m[tid] = -1.0e30f; st_l[tid] = 0.f; }
    if (tid < 465) rpbs[tid] = rpb[tid];
    f32x4_t O[4];
#pragma unroll
    for (int i = 0; i < 4; ++i) O[i] = (f32x4_t){0.f, 0.f, 0.f, 0.f};
#pragma unroll 1
    for (int st = 0; st < nsteps; ++st) {
        const bool local = st < nloc;
        __syncthreads();
        na_stage(R, tid, Kb, Vt);
        if (st + 1 < nsteps) { const bool nl = st + 1 < nloc; na_fetch(P, nl ? b * 4096 + (start + 2 * (st + 1)) * 64 : TL + b * 256 + (st + 1 - nloc) * 128, h, tid, R); }
        __syncthreads();
        if (pmode == 4) continue;
        {
            const int key = tid >> 2, part = tid & 3; float ss = 0.f;
#pragma unroll
            for (int i = 0; i < 4; ++i) { const v4u w = *(const LAS v4u*)(Kb + key * 136 + part * 32 + i * 8);
                ss += bflo(w.x) * bflo(w.x) + bfhi(w.x) * bfhi(w.x) + bflo(w.y) * bflo(w.y) + bfhi(w.y) * bfhi(w.y) + bflo(w.z) * bflo(w.z) + bfhi(w.z) * bfhi(w.z) + bflo(w.w) * bflo(w.w) + bfhi(w.w) * bfhi(w.w); }
            ss += WAVE_DPP(ss, 0xB1); ss += WAVE_DPP(ss, 0x4E);
            if (part == 0) rk[key] = rsqrtf(ss * (1.0f / 128.0f) + EPS);
            f32x4_t sa[4];
#pragma unroll
            for (int i = 0; i < 4; ++i) sa[i] = (f32x4_t){0.f, 0.f, 0.f, 0.f};
            mma_lds<8, 4, 128, 136, 136>(Qs, Kb, sa, wave, fr, fq);
#pragma unroll
            for (int i = 0; i < 4; ++i)
#pragma unroll
                for (int rr = 0; rr < 4; ++rr) Sf[(i * 16 + fq * 4 + rr) * 132 + wave * 16 + fr] = sa[i][rr];
        }
        __syncthreads();
        if (pmode == 5) continue;
        {
            const int q = tid >> 3, part = tid & 7, col0 = part * 16;
            float s[16]; float mx = -1.0e30f;
            if (local) {
                const int cs = clampi(q - 8, 0, 48), kc0 = (part & 3) * 16, ridx = start + 2 * st + (part >> 2) - r + 7;
#pragma unroll
                for (int j4 = 0; j4 < 4; ++j4) {
                    const v4f sv = *(const LAS v4f*)(Sf + q * 132 + col0 + 4 * j4), kv = *(const LAS v4f*)(rk + col0 + 4 * j4);
#pragma unroll
                    for (int jj = 0; jj < 4; ++jj) {
                        const int kc = kc0 + 4 * j4 + jj; const bool ok = (kc >= cs) && (kc < cs + 16);
                        const float v = sv[jj] * kv[jj] + rpbs[ridx * 31 + clampi(kc - q + 15, 0, 30)];
                        s[4 * j4 + jj] = ok ? v : -1.0e30f; mx = fmaxf(mx, s[4 * j4 + jj]);
                    }
                }
            } else {
#pragma unroll
                for (int j4 = 0; j4 < 4; ++j4) {
                    const v4f sv = *(const LAS v4f*)(Sf + q * 132 + col0 + 4 * j4), kv = *(const LAS v4f*)(rk + col0 + 4 * j4);
#pragma unroll
                    for (int jj = 0; jj < 4; ++jj) { s[4 * j4 + jj] = sv[jj] * kv[jj]; mx = fmaxf(mx, s[4 * j4 + jj]); }
                }
            }
            mx = fmaxf(mx, WAVE_DPP(mx, 0xB1)); mx = fmaxf(mx, WAVE_DPP(mx, 0x4E)); mx = fmaxf(mx, WAVE_DPP(mx, 0x141));
            const float mo = st_m[q], mn = fmaxf(mo, mx);
            float sum = 0.f; unsigned pw[8];
#pragma unroll
            for (int j2 = 0; j2 < 8; ++j2) { const float p0 = __expf(s[2 * j2] - mn), p1 = __expf(s[2 * j2 + 1] - mn); sum += p0 + p1; pw[j2] = pack2bf(p0, p1); }
            *(LAS v4u*)(Pb + q * 136 + col0) = make_v4u(pw[0], pw[1], pw[2], pw[3]); *(LAS v4u*)(Pb + q * 136 + col0 + 8) = make_v4u(pw[4], pw[5], pw[6], pw[7]);
            sum += WAVE_DPP(sum, 0xB1); sum += WAVE_DPP(sum, 0x4E); sum += WAVE_DPP(sum, 0x141);
            const float al = __expf(mo - mn);
            if (part == 0) { st_m[q] = mn; st_l[q] = st_l[q] * al + sum; st_a[q] = al; }
        }
        __syncthreads();
        if (pmode == 6) continue;
#pragma unroll
        for (int i = 0; i < 4; ++i)
#pragma unroll
            for (int rr = 0; rr < 4; ++rr) O[i][rr] *= st_a[i * 16 + fq * 4 + rr];
        mma_lds<8, 4, 128, 136, 136>(Pb, Vt, O, wave, fr, fq);
    }
    __syncthreads();
    if (pmode >= 4) return;
#pragma unroll
    for (int i = 0; i < 4; ++i)
#pragma unroll
        for (int rr = 0; rr < 4; ++rr) { const int q = i * 16 + fq * 4 + rr; MIX[(size_t)(qrow0 + q) * 4096 + M_NO + h * 128 + wave * 16 + fr] = f2bf(O[i][rr] / st_l[q]); }
    __syncthreads();
}

__device__ __forceinline__ void na2_fetch(const bf16_t* P, int rowA, int rowB, int h, int tid, NaRaw& R) {
#pragma unroll
    for (int i = 0; i < 4; ++i) { const int idx = tid + 512 * i; const int kr = idx >> 4, c8 = idx & 15; const int row = kr < 64 ? rowA + kr : rowB + kr - 64;
        R.k[i] = *(const v4u*)(P + (size_t)row * INC + C_NK + h * 128 + c8 * 8); }
#pragma unroll
    for (int it = 0; it < 2; ++it) {
        const int task = tid + 512 * it; const int s4 = task >> 5, e4 = task & 31; const int r0 = 4 * s4, row = r0 < 64 ? rowA + r0 : rowB + r0 - 64;
        const bf16_t* src = P + (size_t)row * INC + C_NV + h * 128 + 4 * e4;
#pragma unroll
        for (int j = 0; j < 4; ++j) R.v[it][j] = *(const v2u*)(src + (size_t)j * INC);
    }
}
__device__ __forceinline__ void na2_item(ARGS_REF a, int l, int b, int h, int rp, bool cstream, LAS unsigned char* lds, int namode = 0) {
    const int tid = fresh_tid(), lane = tid & 63, wave = tid >> 6, fr = lane & 15, fq = lane >> 4;
    LAS bf16_t* Qs = (LAS bf16_t*)lds;
    LAS bf16_t* Kb = (LAS bf16_t*)(lds + 34816);
    LAS bf16_t* Vt = (LAS bf16_t*)(lds + 69632);
    LAS float*  rk = (LAS float*)(lds + 104448);
    LAS float*  rpbs = rk + 128;
    LAS float*  alx = rpbs + 480;
    const bf16_t* P = (const bf16_t*)(a.ws + WS_PROJ);
    bf16_t* MIX = (bf16_t*)(a.ws + WS_MIX);
    const float* gqp = a.in[21] + l * 128; const float* gkp = a.in[22] + l * 128;
    const float* rpb = a.in[20] + (size_t)(l * 12 + h) * 15 * 31;
    const int r0 = 2 * rp, start0 = clampi(r0 - 4, 0, 56), start1 = clampi(r0 - 3, 0, 56);
    const int nloc = cstream ? 0 : ((start1 + 9 - start0) >> 1), nsteps = nloc + 2;
    const int qb0 = cstream ? TL + b * 256 + rp * 128 + 16 * wave : b * 4096 + r0 * 64 + 8 * wave;
#define NA2_QTOK(j) (cstream ? qb0 + (j) : qb0 + ((j) >> 3) * 64 + ((j) & 7))
    const int rq = r0 + (fr >> 3), startq = (fr < 8) ? start0 : start1, qcol = 8 * wave + (fr & 7), cs = clampi(qcol - 8, 0, 48);
    const int wu = __builtin_amdgcn_readfirstlane(wave), tlo = wu <= 2 ? 0 : (wu <= 4 ? 1 : 2);
#define NA2_ROWA(s) ((s) < nloc ? b * 4096 + (start0 + 2 * (s) < 63 ? start0 + 2 * (s) : 63) * 64 : TL + b * 256 + ((s) - nloc) * 128)
#define NA2_ROWB(s) ((s) < nloc ? b * 4096 + (start0 + 2 * (s) + 1 < 63 ? start0 + 2 * (s) + 1 : 63) * 64 : TL + b * 256 + ((s) - nloc) * 128 + 64)
    NaRaw R;
    na2_fetch(P, NA2_ROWA(0), NA2_ROWB(0), h, tid, R);
    __syncthreads();
    if (tid < 465) rpbs[tid] = rpb[tid];
    {
        const v4f g0 = *(const v4f*)(gqp + 8 * fr), g1 = *(const v4f*)(gqp + 8 * fr + 4), k0 = *(const v4f*)(gkp + 8 * fr), k1 = *(const v4f*)(gkp + 8 * fr + 4);
#pragma unroll
        for (int it = 0; it < 4; ++it) {
            const int j = it * 4 + fq; const v4u w = *(const v4u*)(P + (size_t)NA2_QTOK(j) * INC + C_NQ + h * 128 + 8 * fr);
            const float x0 = bflo(w.x), x1 = bfhi(w.x), x2 = bflo(w.y), x3 = bfhi(w.y), x4 = bflo(w.z), x5 = bfhi(w.z), x6 = bflo(w.w), x7 = bfhi(w.w);
            float ss = (x0 * x0 + x1 * x1) + (x2 * x2 + x3 * x3) + (x4 * x4 + x5 * x5) + (x6 * x6 + x7 * x7);
            ss += WAVE_DPP(ss, 0xB1); ss += WAVE_DPP(ss, 0x4E); ss += WAVE_DPP(ss, 0x141); ss += WAVE_DPP(ss, 0x140);
            const float rs = rsqrtf(ss * (1.0f / 128.0f) + EPS) * RET_SCALE;
            *(LAS v4u*)(Qs + (16 * wave + j) * 136 + 8 * fr) = make_v4u(pack2bf(x0 * rs * g0.x * k0.x, x1 * rs * g0.y * k0.y), pack2bf(x2 * rs * g0.z * k0.z, x3 * rs * g0.w * k0.w),
                                                                          pack2bf(x4 * rs * g1.x * k1.x, x5 * rs * g1.y * k1.y), pack2bf(x6 * rs * g1.z * k1.z, x7 * rs * g1.w * k1.w));
        }
    }
    bf16x8_t qf[4];
#pragma unroll
    for (int ks = 0; ks < 4; ++ks) qf[ks] = *(const LAS bf16x8_t*)(Qs + (16 * wave + fr) * 136 + 8 * fq + 32 * ks);
    float m_run = -1.0e30f, l_run = 0.f;
    f32x4_t O[8];
#pragma unroll
    for (int i = 0; i < 8; ++i) O[i] = (f32x4_t){0.f, 0.f, 0.f, 0.f};
#pragma unroll 1
    for (int st = 0; st < nsteps; ++st) {
        const bool local = st < nloc; const int kra = start0 + 2 * st;
        __syncthreads();
        na_stage(R, tid, Kb, Vt);
#pragma unroll
        for (int i = 0; i < 4; ++i) {
            const v4u w = R.k[i];
            float ss = (bflo(w.x) * bflo(w.x) + bfhi(w.x) * bfhi(w.x)) + (bflo(w.y) * bflo(w.y) + bfhi(w.y) * bfhi(w.y)) + (bflo(w.z) * bflo(w.z) + bfhi(w.z) * bfhi(w.z)) + (bflo(w.w) * bflo(w.w) + bfhi(w.w) * bfhi(w.w));
            ss += WAVE_DPP(ss, 0xB1); ss += WAVE_DPP(ss, 0x4E); ss += WAVE_DPP(ss, 0x141); ss += WAVE_DPP(ss, 0x140);
            if (fr == 0) rk[(tid + 512 * i) >> 4] = rsqrtf(ss * (1.0f / 128.0f) + EPS);
        }
        if (st + 1 < nsteps && namode != 1) na2_fetch(P, NA2_ROWA(st + 1), NA2_ROWB(st + 1), h, tid, R);
        __syncthreads();
        if (namode == 3) continue;
        if (local) {
        f32x4_t sa[4];
#pragma unroll
        for (int u = 0; u < 4; ++u) {
            const int t = 4 * (u >> 1) + tlo + (u & 1);
            sa[u] = (f32x4_t){0.f, 0.f, 0.f, 0.f};
#pragma unroll
            for (int ks = 0; ks < 4; ++ks) sa[u] = __builtin_amdgcn_mfma_f32_16x16x32_bf16(*(const LAS bf16x8_t*)(Kb + (16 * t + fr) * 136 + 8 * fq + 32 * ks), qf[ks], sa[u], 0, 0, 0);
        }
        float mx = -1.0e30f;
#pragma unroll
        for (int u = 0; u < 4; ++u) {
            const int t = 4 * (u >> 1) + tlo + (u & 1);
            const v4f kv = *(const LAS v4f*)(rk + 16 * t + 4 * fq);
#pragma unroll
            for (int rr = 0; rr < 4; ++rr) {
                float v = sa[u][rr] * kv[rr];
                const int kr = kra + (u >> 1), kc = 16 * (tlo + (u & 1)) + 4 * fq + rr;
                const bool ok = (kr >= startq) && (kr <= startq + 7) && (kc >= cs) && (kc < cs + 16);
                v += rpbs[clampi(kr - rq + 7, 0, 14) * 31 + clampi(kc - qcol + 15, 0, 30)];
                v = ok ? v : -1.0e30f; sa[u][rr] = v; mx = fmaxf(mx, v);
            }
        }
        mx = fmaxf(mx, __shfl_xor(mx, 16)); mx = fmaxf(mx, __shfl_xor(mx, 32));
        const float mn = fmaxf(m_run, mx), al = __expf(m_run - mn); m_run = mn;
        float sum = 0.f; bf16x8_t pf[2];
#pragma unroll
        for (int s2 = 0; s2 < 2; ++s2) {
            const float p0 = __expf(sa[2 * s2][0] - mn), p1 = __expf(sa[2 * s2][1] - mn), p2 = __expf(sa[2 * s2][2] - mn), p3 = __expf(sa[2 * s2][3] - mn);
            const float p4 = __expf(sa[2 * s2 + 1][0] - mn), p5 = __expf(sa[2 * s2 + 1][1] - mn), p6 = __expf(sa[2 * s2 + 1][2] - mn), p7 = __expf(sa[2 * s2 + 1][3] - mn);
            sum += ((p0 + p1) + (p2 + p3)) + ((p4 + p5) + (p6 + p7));
            pf[s2] = __builtin_bit_cast(bf16x8_t, make_v4u(pack2bf(p0, p1), pack2bf(p2, p3), pack2bf(p4, p5), pack2bf(p6, p7)));
        }
        sum += __shfl_xor(sum, 16); sum += __shfl_xor(sum, 32);
        l_run = l_run * al + sum;
        if (fq == 0) alx[wave * 16 + fr] = al;
        const v4f a4 = *(const LAS v4f*)(alx + wave * 16 + 4 * fq);
#pragma unroll
        for (int te = 0; te < 8; ++te) {
#pragma unroll
            for (int rr = 0; rr < 4; ++rr) O[te][rr] *= a4[rr];
#pragma unroll
            for (int s2 = 0; s2 < 2; ++s2) {
                const v2u lo = *(const LAS v2u*)(Vt + (16 * te + fr) * 136 + 64 * s2 + 4 * ((4 * tlo + fq) ^ te)), hi = *(const LAS v2u*)(Vt + (16 * te + fr) * 136 + 64 * s2 + 4 * ((4 * tlo + 4 + fq) ^ te));
                O[te] = __builtin_amdgcn_mfma_f32_16x16x32_bf16(pf[s2], __builtin_bit_cast(bf16x8_t, make_v4u(lo.x, lo.y, hi.x, hi.y)), O[te], 0, 0, 0);
            }
        }
        } else {
        f32x4_t sa[8];
#pragma unroll
        for (int t = 0; t < 8; ++t) {
            sa[t] = (f32x4_t){0.f, 0.f, 0.f, 0.f};
#pragma unroll
            for (int ks = 0; ks < 4; ++ks) sa[t] = __builtin_amdgcn_mfma_f32_16x16x32_bf16(*(const LAS bf16x8_t*)(Kb + (16 * t + fr) * 136 + 8 * fq + 32 * ks), qf[ks], sa[t], 0, 0, 0);
        }
        float mx = -1.0e30f;
#pragma unroll
        for (int t = 0; t < 8; ++t) {
            const v4f kv = *(const LAS v4f*)(rk + 16 * t + 4 * fq);
#pragma unroll
            for (int rr = 0; rr < 4; ++rr) {
                const float v = sa[t][rr] * kv[rr];
                sa[t][rr] = v; mx = fmaxf(mx, v);
            }
        }
        mx = fmaxf(mx, __shfl_xor(mx, 16)); mx = fmaxf(mx, __shfl_xor(mx, 32));
        const float mn = fmaxf(m_run, mx), al = __expf(m_run - mn); m_run = mn;
        float sum = 0.f; bf16x8_t pf[4];
#pragma unroll
        for (int s4 = 0; s4 < 4; ++s4) {
            const float p0 = __expf(sa[2 * s4][0] - mn), p1 = __expf(sa[2 * s4][1] - mn), p2 = __expf(sa[2 * s4][2] - mn), p3 = __expf(sa[2 * s4][3] - mn);
            const float p4 = __expf(sa[2 * s4 + 1][0] - mn), p5 = __expf(sa[2 * s4 + 1][1] - mn), p6 = __expf(sa[2 * s4 + 1][2] - mn), p7 = __expf(sa[2 * s4 + 1][3] - mn);
            sum += ((p0 + p1) + (p2 + p3)) + ((p4 + p5) + (p6 + p7));
            pf[s4] = __builtin_bit_cast(bf16x8_t, make_v4u(pack2bf(p0, p1), pack2bf(p2, p3), pack2bf(p4, p5), pack2bf(p6, p7)));
        }
        sum += __shfl_xor(sum, 16); sum += __shfl_xor(sum, 32);
        l_run = l_run * al + sum;
        if (fq == 0) alx[wave * 16 + fr] = al;
        const v4f a4 = *(const LAS v4f*)(alx + wave * 16 + 4 * fq);
#pragma unroll
        for (int te = 0; te < 8; ++te) {
#pragma unroll
            for (int rr = 0; rr < 4; ++rr) O[te][rr] *= a4[rr];
#pragma unroll
            for (int s4 = 0; s4 < 4; ++s4) {
                const v2u lo = *(const LAS v2u*)(Vt + (16 * te + fr) * 136 + 32 * s4 + 4 * (fq ^ te)), hi = *(const LAS v2u*)(Vt + (16 * te + fr) * 136 + 32 * s4 + 4 * ((4 + fq) ^ te));
                O[te] = __builtin_amdgcn_mfma_f32_16x16x32_bf16(pf[s4], __builtin_bit_cast(bf16x8_t, make_v4u(lo.x, lo.y, hi.x, hi.y)), O[te], 0, 0, 0);
            }
        }

        }
    }
    if (fq == 0) alx[wave * 16 + fr] = l_run;
    {
        const v4f l4 = *(const LAS v4f*)(alx + wave * 16 + 4 * fq);
#pragma unroll
        for (int te = 0; te < 8; ++te)
#pragma unroll
            for (int rr = 0; rr < 4; ++rr) MIX[(size_t)NA2_QTOK(4 * fq + rr) * 4096 + M_NO + h * 128 + 16 * te + fr] = f2bf(O[te][rr] / l4[rr]);
    }
#undef NA2_ROWA
#undef NA2_ROWB
#undef NA2_QTOK
}

__device__ __forceinline__ void mixer_phase(ARGS_REF a, int l, LAS unsigned char* lds, unsigned* qctr, unsigned* nactr, int cls_mask = 7, int pmode = 0, int namode = 0) {
    volatile LAS int* slot = (volatile LAS int*)(lds + MISC_OFF + 64);
    const int n_ret = (l == 0) ? 192 : 96, n_hy = (l == 0) ? 256 + 1024 : 256;
    const int n_zero = (l == 0) ? MT / 32 : 0;
    const int total = n_ret + n_hy + n_zero;
    for (;;) {
        __syncthreads();
        if (fresh_tid() == 0) *slot = (int)atomicAdd(qctr, 1u);
        __syncthreads();
        int it = *slot;
        if (it >= total) break;
#ifndef NO_RET
        if (it < n_ret) { if (!(cls_mask & 1)) continue; const bool cs = it >= 96; const int j = cs ? it - 96 : it; ret_item(a, l, (j >> 1) / 12, (j >> 1) % 12, j & 1, cs, lds); continue; }
#endif
        it -= n_ret;
#ifndef NO_HY
        if (it < n_hy) { if (!(cls_mask & 2)) continue; if (it < 256) hyena_fft_item(a, l, it, lds, pmode); else { if (pmode) continue; hyena_ctx_item(a, l, it - 256, lds); } continue; }
#endif
        it -= n_hy;
        if (!(cls_mask & 4) || pmode) continue;
        {
            v4u* zp = (v4u*)(a.ws + WS_GA + (size_t)it * 32 * PN * 2); const v4u z = make_v4u(0u, 0u, 0u, 0u); const int t_ = fresh_tid();
#pragma unroll 8
            for (int i = 0; i < 128; ++i) zp[i * NTHREADS + t_] = z;
        }
    }
#ifndef NO_NA
    if (!(cls_mask & 4) || pmode) return;
    const int x0 = (int)(xb_xcc_id() & 7u), len = 192 + ((l == 0) ? 12 : 0);
#pragma unroll 1
    for (int k = 0; k < 8; ++k) {
        const int x = (x0 + k) & 7;
        for (;;) {
            __syncthreads();
            if (fresh_tid() == 0) *slot = (int)atomicAdd(nactr + 64 * x, 1u);
            __syncthreads();
            const int idx = *slot;
            if (idx >= len) break;
            const bool cs = idx >= 192; const int j = cs ? idx - 192 : idx;
            const int g = x + 8 * (cs ? (j >> 1) : (j >> 5)), rp = cs ? (j & 1) : (j & 31);
            na2_item(a, l, g / 12, g % 12, rp, cs, lds, namode);
        }
    }
#endif
}

__device__ __forceinline__ unsigned mono_key(float x) { const unsigned u = __float_as_uint(x); return (u & 0x80000000u) ? ~u : (u | 0x80000000u); }
__device__ __forceinline__ int lanes_below(unsigned long long m) { return (int)__builtin_amdgcn_mbcnt_hi((unsigned)(m >> 32), __builtin_amdgcn_mbcnt_lo((unsigned)m, 0u)); }
struct SelRaw { v4u kh[4], kl[4]; v4f q[2]; };
__device__ __forceinline__ void sel_fetch(ARGS_REF a, int l, int tile, int h, int p, int tid, SelRaw& R) {
    const bf16_t* kh = (const bf16_t*)(a.ws + WS_KHL) + (size_t)((l * 8 + h) * 2 + p) * 2 * 128 * 128; const bf16_t* kl = kh + 128 * 128;
    const float* Qb = (const float*)(a.ws + WS_Q);
    const int row0 = tile * 32;
#pragma unroll
    for (int i = 0; i < 4; ++i) { const int idx8 = tid + 512 * i; R.kh[i] = *(const v4u*)(kh + idx8 * 8); R.kl[i] = *(const v4u*)(kl + idx8 * 8); }
#pragma unroll
    for (int i = 0; i < 2; ++i) {
        const int idx4 = tid + 512 * i; const int t = idx4 >> 5, k4 = (idx4 & 31) * 4;
        v4f x;
        if (row0 < TL || l != 0) x = *(const v4f*)(Qb + (size_t)(row0 + t) * PQ + h * 256 + p * 128 + k4);
        else {
            const float* pp = (const float*)(a.ws + WS_PART) + (size_t)(row0 - TL + t) * PQ + h * 256 + p * 128 + k4;
            x = *(const v4f*)pp;
#pragma unroll
            for (int s = 1; s < 8; ++s) x += *(const v4f*)(pp + (size_t)s * TC * PQ);
        }
        R.q[i] = x;
    }
}
__device__ __forceinline__ void sel_stage(const SelRaw& R, int tid, LAS bf16_t* Qh, LAS bf16_t* Ql, LAS bf16_t* Kh, LAS bf16_t* Kl) {
#pragma unroll
    for (int i = 0; i < 4; ++i) { const int idx8 = tid + 512 * i; const int n = idx8 >> 4, k8 = (idx8 & 15) * 8; *(LAS v4u*)(Kh + n * 136 + k8) = R.kh[i]; *(LAS v4u*)(Kl + n * 136 + k8) = R.kl[i]; }
#pragma unroll
    for (int i = 0; i < 2; ++i) {
        const int idx4 = tid + 512 * i; const int t = idx4 >> 5, k4 = (idx4 & 31) * 4; const v4f x = R.q[i];
        const unsigned h01 = pack2bf(x.x, x.y), h23 = pack2bf(x.z, x.w);
        *(LAS v2u*)(Qh + t * 136 + k4) = make_v2u(h01, h23);
        *(LAS v2u*)(Ql + t * 136 + k4) = make_v2u(pack2bf(x.x - bflo(h01), x.y - bfhi(h01)), pack2bf(x.z - bflo(h23), x.w - bfhi(h23)));
    }
}
__device__ __forceinline__ void peer_select_phase(ARGS_REF a, int l, int nrows, LAS unsigned char* lds) {
    const int nit = (nrows / 32) * 8, G = gridDim.x;
    if ((int)blockIdx.x >= nit) return;
    SelRaw R;
    sel_fetch(a, l, (int)blockIdx.x >> 3, (int)blockIdx.x & 7, 0, fresh_tid(), R);
#pragma unroll 1
    for (int it = blockIdx.x; it < nit; it += G) {
    const int tile = it >> 3, h = it & 7;
    const int tid = fresh_tid(), lane = tid & 63, wave = tid >> 6, fr = lane & 15, fq = lane >> 4;
    LAS bf16_t* Qh = (LAS bf16_t*)lds;
    LAS bf16_t* Ql = Qh + 32 * 136;
    LAS bf16_t* Kh = Ql + 32 * 136;
    LAS bf16_t* Kl = Kh + 128 * 136;
    LAS float* Ss = (LAS float*)(Kl + 128 * 136);
    LAS float* tops = Ss + 64 * 129;
    LAS int* topi = (LAS int*)(tops + 64 * 16);
    LAS float* GL = (LAS float*)(topi + 64 * 16);
    LAS int* EL = (LAS int*)(GL + 32 * 16);
    const float* Qb = (const float*)(a.ws + WS_Q);
    unsigned* GA32 = (unsigned*)(a.ws + WS_GA);
    const int row0 = tile * 32;
#pragma unroll 1
    for (int p = 0; p < 2; ++p) {
        __syncthreads();
        sel_stage(R, tid, Qh, Ql, Kh, Kl);
        if (p == 0) sel_fetch(a, l, tile, h, 1, tid, R);
        else if (it + G < nit) sel_fetch(a, l, (it + G) >> 3, (it + G) & 7, 0, tid, R);
        __syncthreads();
        f32x4_t sa[2] = {(f32x4_t){0.f, 0.f, 0.f, 0.f}, (f32x4_t){0.f, 0.f, 0.f, 0.f}};
        mma_lds<8, 2, 128, 136, 136>(Ql, Kh, sa, wave, fr, fq);
        mma_lds<8, 2, 128, 136, 136>(Qh, Kl, sa, wave, fr, fq);
        mma_lds<8, 2, 128, 136, 136>(Qh, Kh, sa, wave, fr, fq);
#pragma unroll
        for (int i = 0; i < 2; ++i)
#pragma unroll
            for (int r = 0; r < 4; ++r) Ss[((i * 16 + fq * 4 + r) * 2 + p) * 129 + wave * 16 + fr] = sa[i][r];
    }
    __syncthreads();
    {
        float v0[8], v1[8]; unsigned k0[8], k1[8], T[8]; int ex[8];
#pragma unroll
        for (int rr = 0; rr < 8; ++rr) {
            const int row = wave * 8 + rr; v0[rr] = Ss[row * 129 + lane]; v1[rr] = Ss[row * 129 + lane + 64];
            k0[rr] = (mono_key(v0[rr]) & ~127u) | (unsigned)(127 - lane); k1[rr] = (mono_key(v1[rr]) & ~127u) | (unsigned)(63 - lane); T[rr] = 0u; ex[rr] = 0;
        }
#pragma unroll 1
        for (int bit = 31; bit >= 0; --bit) {
            int fin = 1;
#pragma unroll
            for (int g = 0; g < 2; ++g) {
                unsigned c[4]; unsigned long long ma[4], mb[4]; int cnt[4];
#pragma unroll
                for (int rr = 0; rr < 4; ++rr) c[rr] = T[4 * g + rr] | (1u << bit);
#pragma unroll
                for (int rr = 0; rr < 4; ++rr) { ma[rr] = __ballot(k0[4 * g + rr] >= c[rr]); mb[rr] = __ballot(k1[4 * g + rr] >= c[rr]); }
                __builtin_amdgcn_sched_barrier(0);
#pragma unroll
                for (int rr = 0; rr < 4; ++rr) cnt[rr] = __popcll(ma[rr]) + __popcll(mb[rr]);
                __builtin_amdgcn_sched_barrier(0);
#pragma unroll
                for (int rr = 0; rr < 4; ++rr) { T[4 * g + rr] = cnt[rr] >= 16 ? c[rr] : T[4 * g + rr]; ex[4 * g + rr] |= (cnt[rr] == 16) ? 1 : 0; fin &= ex[4 * g + rr]; }
                __builtin_amdgcn_sched_barrier(0);
            }
            if (fin) break;
        }
#pragma unroll
        for (int rr = 0; rr < 8; ++rr) {
            const int row = wave * 8 + rr; const bool s0 = k0[rr] >= T[rr], s1 = k1[rr] >= T[rr];
            const unsigned long long m0 = __ballot(s0), m1 = __ballot(s1);
            const int p0 = lanes_below(m0), p1 = __popcll(m0) + lanes_below(m1);
            if (s0 && p0 < 16) { tops[row * 16 + p0] = v0[rr]; topi[row * 16 + p0] = lane; }
            if (s1 && p1 < 16) { tops[row * 16 + p1] = v1[rr]; topi[row * 16 + p1] = lane + 64; }
        }
    }
    __syncthreads();
    {
        float cv[4][4]; unsigned ck[4][4], T[4]; int exb[4];
#pragma unroll
        for (int tt = 0; tt < 4; ++tt) {
            const int t = wave * 4 + tt; const int r0 = (t * 2) * 16, r1 = (t * 2 + 1) * 16;
#pragma unroll
            for (int j = 0; j < 4; ++j) { const int ci = lane * 4 + j; cv[tt][j] = tops[r0 + (ci >> 4)] + tops[r1 + (ci & 15)]; ck[tt][j] = (mono_key(cv[tt][j]) & ~255u) | (unsigned)(255 - ci); }
            T[tt] = 0u; exb[tt] = 0;
        }
#pragma unroll 1
        for (int bit = 31; bit >= 0; --bit) {
            int fin = 1;
#pragma unroll
            for (int g = 0; g < 2; ++g) {
                unsigned c[2]; unsigned long long mm[2][4]; int cnt[2];
#pragma unroll
                for (int tt = 0; tt < 2; ++tt) c[tt] = T[2 * g + tt] | (1u << bit);
#pragma unroll
                for (int tt = 0; tt < 2; ++tt)
#pragma unroll
                    for (int j = 0; j < 4; ++j) mm[tt][j] = __ballot(ck[2 * g + tt][j] >= c[tt]);
                __builtin_amdgcn_sched_barrier(0);
#pragma unroll
                for (int tt = 0; tt < 2; ++tt) cnt[tt] = (__popcll(mm[tt][0]) + __popcll(mm[tt][1])) + (__popcll(mm[tt][2]) + __popcll(mm[tt][3]));
                __builtin_amdgcn_sched_barrier(0);
#pragma unroll
                for (int tt = 0; tt < 2; ++tt) { T[2 * g + tt] = cnt[tt] >= 16 ? c[tt] : T[2 * g + tt]; exb[2 * g + tt] |= (cnt[tt] == 16) ? 1 : 0; fin &= exb[2 * g + tt]; }
                __builtin_amdgcn_sched_barrier(0);
            }
            if (fin) break;
        }
#pragma unroll
        for (int tt = 0; tt < 4; ++tt) {
            const int t = wave * 4 + tt; const int r0 = (t * 2) * 16, r1 = (t * 2 + 1) * 16; int base = 0;
#pragma unroll
            for (int j = 0; j < 4; ++j) {
                const bool sel = ck[tt][j] >= T[tt]; const unsigned long long m = __ballot(sel); const int pos = base + lanes_below(m); base += __popcll(m);
                if (sel && pos < 16) { const int ci = lane * 4 + j; EL[t * 16 + pos] = topi[r0 + (ci >> 4)] * 128 + topi[r1 + (ci & 15)]; GL[t * 16 + pos] = cv[tt][j]; }
            }
        }
        {
            const int t = wave * 4 + fq; const float sv = GL[t * 16 + fr]; const int eid = EL[t * 16 + fr];
            float m = sv;
#pragma unroll
            for (int o = 8; o >= 1; o >>= 1) m = fmaxf(m, __shfl_xor(m, o));
            const float e = __expf(sv - m); float s = e;
#pragma unroll
            for (int o = 8; o >= 1; o >>= 1) s += __shfl_xor(s, o);
            const unsigned gb = (unsigned)f2bf(e / s);
            typedef short s2v __attribute__((ext_vector_type(2)));
            const s2v val = __builtin_bit_cast(s2v, (eid & 1) ? (gb << 16) : gb);
            __builtin_amdgcn_global_atomic_fadd_v2bf16((__attribute__((address_space(1))) s2v*)(GA32 + (((size_t)(row0 + t) * PN + eid) >> 1)), val);
        }
    }
    }
}

struct EpiGate {
    static constexpr bool PERM = true, AFTER_DRAIN = false;
    bf16_t* GM; unsigned char* GA8; int ldc; float sc;
    __device__ __forceinline__ void operator()(const pg8::f32x4 (&acc)[2][2][4][2], const pg8::Unit& u, int wr, int wc, int fr, int fq) const {
        const int row0 = u.pm * 256 + wr * 64 + fr, col0 = u.pn * 256 + wc * 32 + 8 * fq;
#pragma unroll
        for (int ai = 0; ai < 2; ++ai) {
            v4u gm[4][2];
#pragma unroll
            for (int m = 0; m < 4; ++m)
#pragma unroll
                for (int bj = 0; bj < 2; ++bj) gm[m][bj] = *(const v4u*)(GM + (size_t)(row0 + ai * 128 + m * 16) * ldc + col0 + bj * 128);
            __builtin_amdgcn_sched_barrier(0);
#pragma unroll
            for (int m = 0; m < 4; ++m) {
                const size_t ro = (size_t)(row0 + ai * 128 + m * 16) * ldc + col0;
#pragma unroll
                for (int bj = 0; bj < 2; ++bj) {
                    const v4u g = gm[m][bj];
                    float o[8];
#pragma unroll
                    for (int e = 0; e < 8; ++e) {
                        const unsigned gw = (e >> 1) == 0 ? g.x : ((e >> 1) == 1 ? g.y : ((e >> 1) == 2 ? g.z : g.w));
                        const unsigned gb = (e & 1) ? (gw & 0xffff0000u) : (gw << 16);
                        o[e] = 0.f;
                        if (__ballot(gb != 0u) != 0ull) o[e] = A8_SCALE * __uint_as_float(gb) * gelu_tanh_f(acc[ai][bj][m][e >> 2][e & 3] * sc);
                    }
                    if ((g.x | g.y | g.z | g.w) != 0u) *(v4u*)(GM + ro + bj * 128) = make_v4u(0u, 0u, 0u, 0u);
                    *(v2u*)(GA8 + ro + bj * 128) = make_v2u(pack4fp8(o[0], o[1], o[2], o[3]), pack4fp8(o[4], o[5], o[6], o[7]));
                }
            }
        }
    }
};

constexpr int N_PHASES = 19;
__global__ void __launch_bounds__(NTHREADS, 2) fwd_kernel(Args a) {
    extern __shared__ __attribute__((aligned(16))) unsigned char lds_raw[];
    LAS unsigned char* lds = (LAS unsigned char*)lds_raw;
    const int tid = threadIdx.x;
    const KARG Args* ap0 = (const KARG Args*)__builtin_amdgcn_kernarg_segment_ptr();
#define FRESH(name) const KARG Args* name = ap0; asm volatile("" : "+s"(name))
    const int lo = ap0->ph_lo, hi = ap0->ph_hi;
    unsigned* ctl = (unsigned*)(ap0->ws + WS_CTL);
    const bool fused = (hi - lo) > 1;
    if (tid < 64) ((LAS unsigned*)(lds + MISC_OFF))[tid] = 0u;
    __syncthreads();
    XcdBarrier bar; bar.bar = ctl + CW_BAR; bar.x = 0; bar.st = (volatile LAS unsigned*)(lds + MISC_OFF);
    if (fused) bar = xcd_barrier_post(ctl + CW_BAR, (volatile LAS unsigned*)(lds + MISC_OFF));
#define IN(k) (lo <= (k) && (k) < hi)
#if defined(ONLY)
#define EN(x) ((ONLY) == (x))
#elif defined(DISABLE)
#define EN(x) (!(((DISABLE) >> (x)) & 1))
#else
#define EN(x) 1
#endif
#ifndef DUP
#define DUP 0
#endif
#ifndef DUPMIX
#define DUPMIX 7
#endif
#ifndef SELMODE
#define SELMODE 0
#endif
#ifndef NAMODE
#define NAMODE 0
#endif
#ifndef HYMODE
#define HYMODE 0
#endif
#ifndef P0MODE
#define P0MODE 0
#endif
#ifndef WGM_IN
#define WGM_IN 8
#endif
#ifndef WGM_OUT
#define WGM_OUT 4
#endif
#ifndef WGM_Q
#define WGM_Q 4
#endif
#ifndef WGM_P1
#define WGM_P1 4
#endif
#ifndef WGM_P2
#define WGM_P2 4
#endif
#define NREP(x) ((((DUP) >> (x)) & 1) ? 2 : 1)
#define REPBAR(x) do { if (rep + 1 < NREP(x)) xcd_barrier(bar); } while (0)
#define SEAM(k) do { if (IN(k) && IN((k) + 1)) xcd_barrier(bar); } while (0)

    if (EN(0) && IN(0)) for (int rep = 0; rep < NREP(0); ++rep) { FRESH(ap); p0_prologue(*ap, lds, rep ? P0MODE : 0); REPBAR(0); }
    SEAM(0);
#pragma unroll 1
    for (int l = 0; l < 2; ++l) {
        const int pb = 1 + 9 * l;
        const int nrows = (l == 0) ? MT : TL;
        if (EN(1) && IN(pb + 0)) for (int rep = 0; rep < NREP(1); ++rep) { FRESH(ap); if (l == 1) norm_phase(*ap, l, 0, MT, 2, (const float*)(ap->ws + WS_MOD) + (size_t)4 * NMOD + 5 * 4096, 1.0f / A8_SCALE); else norm_phase(*ap, l, 0, MT); REPBAR(1); }
        SEAM(pb + 0);
        if (EN(2) && IN(pb + 1)) for (int rep = 0; rep < NREP(2); ++rep) {
            FRESH(ap); ARGS_REF a = *ap;
            pg8::Gemm g{(const bf16_t*)(a.ws + WS_H), (const bf16_t*)(a.ws + WS_WIN) + (size_t)l * INC * 4096, MT, INC, D};
            pg8::TwoPartOrder S; S.init(TL, TC, INC, l == 0 ? INC / 256 : 6144 / 256, (int)gridDim.x, (int)blockIdx.x, WGM_IN);
            EpiProj E{(bf16_t*)(a.ws + WS_PROJ), (bf16_t*)(a.ws + WS_UT)};
            pg8::gemm_phase<EpiProj, pg8::TwoPartOrder, false>(lds, g, S, E, nullptr);
            REPBAR(2);
        }
        SEAM(pb + 1);
        if (EN(3) && IN(pb + 2)) for (int rep = 0; rep < NREP(3); ++rep) { FRESH(ap); mixer_phase(*ap, l, lds, (unsigned*)(ap->ws + WS_CTL) + CW_QUEUE + 64 * (l + 2 * rep), (unsigned*)(ap->ws + WS_CTL) + CW_QUEUE + 64 * (8 + 8 * (l + 2 * rep)), (NREP(3) == 2 && rep == 0) ? DUPMIX : 7, (NREP(3) == 2 && rep == 0) ? HYMODE : 0, (NREP(3) == 2 && rep == 0) ? NAMODE : 0); REPBAR(3); }
        SEAM(pb + 2);
        if (EN(4) && IN(pb + 3)) {
            FRESH(ap); ARGS_REF a = *ap;
            {
                pg8::Gemm g{(const bf16_t*)(a.ws + WS_MIX), (const bf16_t*)(a.ws + WS_WOUT) + (size_t)l * D * D, TL, D, D};
                pg8::StaticOrder S; S.init(TL, D, (int)gridDim.x, (int)blockIdx.x, WGM_OUT);
                EpiRes E{l == 0 ? a.in[0] : (const float*)a.out, (const float*)(a.ws + WS_XC), a.out, (float*)(a.ws + WS_XC), (const float*)(a.ws + WS_MOD) + (size_t)l * 5 * NMOD + 2 * 4096, 1.0f};
                pg8::gemm_phase<EpiRes, pg8::StaticOrder, false>(lds, g, S, E, nullptr);
            }
            if (l == 0) {
                pg8::Gemm g{(const bf16_t*)(a.ws + WS_MIX) + (size_t)TL * D, (const bf16_t*)(a.ws + WS_WOUT), TC, D, D / 4, D};
                pg8::SplitKOrder S; S.init(TC, D, 4, (D / 4) * 2, (int)gridDim.x, (int)blockIdx.x);
                EpiPart E{(float*)(a.ws + WS_PART), D, TC, (D / 4) * 2};
                pg8::gemm_phase<EpiPart, pg8::SplitKOrder, false>(lds, g, S, E, nullptr);
            }
        }
        SEAM(pb + 3);
        if (EN(1) && IN(pb + 4)) for (int rep = 0; rep < NREP(1); ++rep) { FRESH(ap); if (l == 0) norm_phase(*ap, l, 1, nrows, 1, (const float*)(ap->ws + WS_MOD) + (size_t)4 * NMOD + 2 * 4096, 1.0f); else norm_phase(*ap, l, 1, nrows); REPBAR(1); }
        SEAM(pb + 4);
        if (EN(5) && IN(pb + 5)) {
            FRESH(ap); ARGS_REF a = *ap;
            {
                pg8::Gemm g{(const bf16_t*)(a.ws + WS_H), (const bf16_t*)(a.ws + WS_WQ) + (size_t)l * PQ * D, TL, PQ, D};
                pg8::StaticOrder S; S.init(TL, PQ, (int)gridDim.x, (int)blockIdx.x, WGM_Q);
                pg8::EpiF32 E{(float*)(a.ws + WS_Q), PQ, nullptr};
                pg8::gemm_phase<pg8::EpiF32, pg8::StaticOrder, false>(lds, g, S, E, nullptr);
            }
            if (l == 0) {
                pg8::Gemm g{(const bf16_t*)(a.ws + WS_H) + (size_t)TL * D, (const bf16_t*)(a.ws + WS_WQ), TC, PQ, D / 8, D};
                pg8::SplitKOrder S; S.init(TC, PQ, 8, (D / 8) * 2, (int)gridDim.x, (int)blockIdx.x);
                EpiPart E{(float*)(a.ws + WS_PART), PQ, TC, (D / 8) * 2};
                pg8::gemm_phase<EpiPart, pg8::SplitKOrder, false>(lds, g, S, E, nullptr);
            }
        }
        SEAM(pb + 5);
        if (EN(6) && IN(pb + 6)) for (int rep = 0; rep < NREP(6); ++rep) { FRESH(ap); peer_select_phase(*ap, l, nrows, lds); REPBAR(6); }
        SEAM(pb + 6);
        if (EN(7) && IN(pb + 7)) for (int rep = 0; rep < NREP(7); ++rep) {
            FRESH(ap); ARGS_REF a = *ap;
            pg8::Gemm g{(const bf16_t*)(a.ws + WS_HF8), (const bf16_t*)(a.ws + WS_UB + (size_t)l * PN * D), nrows, PN, D / 2};
            pg8::StaticOrder S; S.init(nrows, PN, (int)gridDim.x, (int)blockIdx.x, WGM_P1);
            EpiGate E{(bf16_t*)(a.ws + WS_GA), a.ws + WS_GA8, PN, 1.0f / U8_SCALE};
            pg8::gemm_phase<EpiGate, pg8::StaticOrder, false, true>(lds, g, S, E, nullptr);
            REPBAR(7);
        }
        SEAM(pb + 7);
        if (EN(8) && IN(pb + 8)) {
            FRESH(ap); ARGS_REF a = *ap;
            {
                pg8::Gemm g{(const bf16_t*)(a.ws + WS_GA8), (const bf16_t*)(a.ws + WS_VT + (size_t)l * PN * D), TL, D, PN / 2};
                pg8::StaticOrder S; S.init(TL, D, (int)gridDim.x, (int)blockIdx.x, WGM_P2);
                EpiRes E{(const float*)a.out, (const float*)(a.ws + WS_XC), a.out, (float*)(a.ws + WS_XC), (const float*)(a.ws + WS_MOD) + (size_t)l * 5 * NMOD + 5 * 4096, 1.0f / A8_SCALE};
                pg8::gemm_phase<EpiRes, pg8::StaticOrder, false, true>(lds, g, S, E, nullptr);
            }
            if (l == 0) {
                pg8::Gemm g{(const bf16_t*)(a.ws + WS_GA8 + (size_t)TL * PN), (const bf16_t*)(a.ws + WS_VT), TC, D, PN / 8, PN / 2};
                pg8::SplitKOrder S; S.init(TC, D, 4, PN / 4, (int)gridDim.x, (int)blockIdx.x);
                EpiPart E{(float*)(a.ws + WS_PART), D, TC, PN / 4};
                pg8::gemm_phase<EpiPart, pg8::SplitKOrder, false, true>(lds, g, S, E, nullptr);
            }
        }
        SEAM(pb + 8);
    }
#undef IN
#undef SEAM
}

extern "C" void kernel_launch(void* const* d_in, const int* in_sizes, int n_in, void* d_out, int out_size, void* d_ws, size_t ws_size, hipStream_t stream) {
    static int grid = 0;
    if (grid == 0) {
        if (n_in != 29 || out_size != TL * D || ws_size < WS_END) {
            fprintf(stderr, "kernel_launch: expected 29 inputs, out %d floats, ws >= %zu bytes; got n_in %d out %d ws %zu; nothing launched\n", TL * D, (size_t)WS_END, n_in, out_size, ws_size);
            grid = -1; return;
        }
        int dev = 0, cus = 0, per_cu = 0;
        if (hipGetDevice(&dev) != hipSuccess || hipDeviceGetAttribute(&cus, hipDeviceAttributeMultiprocessorCount, dev) != hipSuccess) { fprintf(stderr, "kernel_launch: device query failed\n"); grid = -1; return; }
        if (hipFuncSetAttribute((const void*)fwd_kernel, hipFuncAttributeMaxDynamicSharedMemorySize, LDS_BYTES) != hipSuccess) { fprintf(stderr, "kernel_launch: hipFuncSetAttribute failed\n"); grid = -1; return; }
        if (hipOccupancyMaxActiveBlocksPerMultiprocessor(&per_cu, (const void*)fwd_kernel, NTHREADS, LDS_BYTES) != hipSuccess || per_cu < 1)
            fprintf(stderr, "kernel_launch: note: occupancy query reports %d workgroups per CU\n", per_cu);
        (void)hipGetLastError();
        grid = cus;
    }
    if (grid < 0) return;
    if (hipMemsetAsync((char*)d_ws + WS_CTL, 0, CTL_BYTES, stream) != hipSuccess) { fprintf(stderr, "kernel_launch: memset failed\n"); return; }
    Args a{};
    for (int i = 0; i < 29; ++i) a.in[i] = (const float*)d_in[i];
    a.out = (float*)d_out; a.ws = (unsigned char*)d_ws;
#if MK_ONE_LAUNCH
    a.ph_lo = 0; a.ph_hi = N_PHASES;
    hipLaunchKernelGGL(fwd_kernel, dim3(grid), dim3(NTHREADS), LDS_BYTES, stream, a);
#else
    for (int p = 0; p < N_PHASES; ++p) { a.ph_lo = p; a.ph_hi = p + 1; hipLaunchKernelGGL(fwd_kernel, dim3(grid), dim3(NTHREADS), LDS_BYTES, stream, a); }
#endif
    const hipError_t le = hipPeekAtLastError();
    if (le != hipSuccess) fprintf(stderr, "kernel_launch: launch failed: %s\n", hipGetErrorName(le));
}
```

```cpp
#include <hip/hip_runtime.h>
#include <cstdio>
#include <cstdint>

#ifndef MK_ONE_LAUNCH
#define MK_ONE_LAUNCH 1
#endif

typedef unsigned short bf16_t;
typedef short bf16x8_t __attribute__((ext_vector_type(8)));
typedef float f32x4_t __attribute__((ext_vector_type(4)));
typedef float v4f __attribute__((ext_vector_type(4)));
typedef float v2f __attribute__((ext_vector_type(2)));
typedef unsigned v4u __attribute__((ext_vector_type(4)));
typedef unsigned v2u __attribute__((ext_vector_type(2)));
__device__ __forceinline__ v4f make_v4f(float a, float b, float c, float d) { return (v4f){a, b, c, d}; }
__device__ __forceinline__ v2f make_v2f(float a, float b) { return (v2f){a, b}; }
__device__ __forceinline__ v4u make_v4u(unsigned a, unsigned b, unsigned c, unsigned d) { return (v4u){a, b, c, d}; }
__device__ __forceinline__ v2u make_v2u(unsigned a, unsigned b) { return (v2u){a, b}; }

constexpr int D = 4096, NB = 4, SEQ = 4096, TL = NB * SEQ, CTXL = 256, TC = NB * CTXL, MT = TL + TC;
constexpr int INC = 13824;
constexpr int C_RK = 0, C_RV = 1536, C_NK = 3072, C_NV = 4608, C_HY = 6144, C_RQ = 9216, C_RG = 10752, C_NQ = 12288;
constexpr int M_HY = 0, M_RO = 1024, M_NO = 2560;
constexpr int NMOD = 6 * D;
constexpr int PQ = 2048;
constexpr int PN = 16384;
constexpr float EPS = 1e-6f;
constexpr float A8_SCALE = 16.0f;
constexpr float W8_SCALE = 64.0f;
constexpr float U8_SCALE = 64.0f;

constexpr size_t al256(size_t x) { return (x + 255) & ~(size_t)255; }
constexpr size_t WS_CTL  = 0;
constexpr size_t CTL_BYTES = 65536;
constexpr size_t WS_MOD  = WS_CTL + CTL_BYTES;
constexpr size_t WS_KT   = al256(WS_MOD + (size_t)2 * 5 * NMOD * 4);
constexpr size_t WS_KTC  = al256(WS_KT + (size_t)2 * 4096 * 4096 * 4);
constexpr size_t WS_WIN  = al256(WS_KTC + (size_t)4096 * 256 * 4);
constexpr size_t WS_WOUT = al256(WS_WIN + (size_t)2 * INC * D * 2);
constexpr size_t WS_WQ   = al256(WS_WOUT + (size_t)2 * D * D * 2);
constexpr size_t WS_H    = al256(WS_WQ + (size_t)2 * PQ * D * 2);
constexpr size_t WS_PROJ = al256(WS_H + (size_t)MT * D * 2);
constexpr size_t WS_MIX  = al256(WS_PROJ + (size_t)MT * INC * 2);
constexpr size_t WS_XC   = al256(WS_MIX + (size_t)MT * D * 2);
constexpr size_t WS_Q    = al256(WS_XC + (size_t)TC * D * 4);
constexpr size_t WS_OF   = al256(WS_Q + (size_t)MT * PQ * 4);
constexpr size_t WS_UB   = al256(WS_OF + (size_t)2 * MT * 1536 * 4);
constexpr size_t WS_VT   = al256(WS_UB + (size_t)2 * 16384 * D);
constexpr size_t WS_GA   = al256(WS_VT + (size_t)2 * 16384 * D);
constexpr size_t WS_UT   = al256(WS_GA + (size_t)MT * 16384 * 2);
constexpr size_t WS_HF8  = al256(WS_UT + (size_t)3072 * MT * 2);
constexpr size_t WS_GA8  = al256(WS_HF8 + (size_t)MT * D);
constexpr size_t WS_KHL  = al256(WS_GA8 + (size_t)MT * 16384);
constexpr size_t WS_PART = al256(WS_KHL + (size_t)2 * 8 * 2 * 2 * 128 * 128 * 2);
constexpr size_t WS_END  = al256(WS_PART + (size_t)4 * TC * D * 4);

constexpr int CW_BAR = 0;
constexpr int CW_QUEUE = 4096;
constexpr int CW_RET = 8192;

constexpr int LDS_BYTES = 156 * 1024;
constexpr int MISC_OFF = LDS_BYTES - 1024;
constexpr int NTHREADS = 512;

struct Args { const float* in[29]; float* out; unsigned char* ws; int ph_lo, ph_hi; };
#define KARG __attribute__((address_space(4)))
#define ARGS_REF const KARG Args&

__device__ __forceinline__ int fresh_tid() { int t = (int)threadIdx.x; asm volatile("" : "+v"(t)); return t; }
__device__ __forceinline__ float bf2f(bf16_t b) { return __uint_as_float(((unsigned)b) << 16); }
__device__ __forceinline__ unsigned pack2bf(float lo, float hi) { unsigned r; asm volatile("v_cvt_pk_bf16_f32 %0, %1, %2" : "=v"(r) : "v"(lo), "v"(hi)); return r; }
__device__ __forceinline__ unsigned pack4fp8(float a, float b, float c, float d) { int w = 0; w = __builtin_amdgcn_cvt_pk_fp8_f32(a, b, w, false); w = __builtin_amdgcn_cvt_pk_fp8_f32(c, d, w, true); return (unsigned)w; }
__device__ __forceinline__ unsigned char f2fp8(float f) { return (unsigned char)(__builtin_amdgcn_cvt_pk_fp8_f32(f, 0.0f, 0, false) & 0xff); }
__device__ __forceinline__ bf16_t f2bf(float f) { return (bf16_t)(pack2bf(f, 0.0f) & 0xffffu); }
__device__ __forceinline__ float bflo(unsigned w) { return __uint_as_float(w << 16); }
__device__ __forceinline__ float bfhi(unsigned w) { return __uint_as_float(w & 0xffff0000u); }
#define WAVE_DPP(v, ctrl) __int_as_float(__builtin_amdgcn_update_dpp(0, __float_as_int(v), (ctrl), 0xf, 0xf, true))
__device__ __forceinline__ float wave_sum(float v) {
    v += WAVE_DPP(v, 0xB1); v += WAVE_DPP(v, 0x4E); v += WAVE_DPP(v, 0x141); v += WAVE_DPP(v, 0x140);
    const float r0 = __int_as_float(__builtin_amdgcn_readlane(__float_as_int(v), 0)), r1 = __int_as_float(__builtin_amdgcn_readlane(__float_as_int(v), 16));
    const float r2 = __int_as_float(__builtin_amdgcn_readlane(__float_as_int(v), 32)), r3 = __int_as_float(__builtin_amdgcn_readlane(__float_as_int(v), 48));
    return (r0 + r1) + (r2 + r3);
}
__device__ __forceinline__ float wave_max(float v) {
    v = fmaxf(v, WAVE_DPP(v, 0xB1)); v = fmaxf(v, WAVE_DPP(v, 0x4E)); v = fmaxf(v, WAVE_DPP(v, 0x141)); v = fmaxf(v, WAVE_DPP(v, 0x140));
    const float r0 = __int_as_float(__builtin_amdgcn_readlane(__float_as_int(v), 0)), r1 = __int_as_float(__builtin_amdgcn_readlane(__float_as_int(v), 16));
    const float r2 = __int_as_float(__builtin_amdgcn_readlane(__float_as_int(v), 32)), r3 = __int_as_float(__builtin_amdgcn_readlane(__float_as_int(v), 48));
    return fmaxf(fmaxf(r0, r1), fmaxf(r2, r3));
}
__device__ __forceinline__ float sin_turns(float t) { return __builtin_amdgcn_sinf(t - floorf(t)); }
__device__ __forceinline__ float cos_turns(float t) { return __builtin_amdgcn_cosf(t - floorf(t)); }
__device__ __forceinline__ float sin_rad(float x) { return sin_turns(x * 0.15915494309189535f); }
__device__ __forceinline__ float silu_f(float x) { return x / (1.0f + __expf(-x)); }
__device__ __forceinline__ float gelu_tanh_f(float x) {
    const float t = x * (-2.3022082f - 0.10294324f * (x * x));
    return x * __builtin_amdgcn_rcpf(1.0f + __builtin_amdgcn_exp2f(t));
}
__device__ __forceinline__ int clampi(int x, int lo, int hi) { return x < lo ? lo : (x > hi ? hi : x); }

#define XB_TMO      128
#define XB_XCNT(j)  (256  + 64 * (j))
#define XB_XSUB(j)  (1280 + 64 * (j))
#define XB_XGEN(j)  (2304 + 64 * (j))
#define XB_TOP      3328
#define XB_TOPGEN   3392
#define XCD_BAR_WORDS 3456
#define XB_SPIN_CAP (1u << 21)
#define LAS __attribute__((address_space(3)))

__device__ __forceinline__ unsigned xb_ld(unsigned* p)              { return __hip_atomic_load(p, __ATOMIC_RELAXED, __HIP_MEMORY_SCOPE_AGENT); }
__device__ __forceinline__ unsigned xb_add(unsigned* p, unsigned v) { return __hip_atomic_fetch_add(p, v, __ATOMIC_RELAXED, __HIP_MEMORY_SCOPE_AGENT); }
__device__ __forceinline__ unsigned xb_xcc_id() { return (unsigned)__builtin_amdgcn_s_getreg((3 << 11) | 20) & 0xFu; }
#define XB_SPIN(cond, bar) do { unsigned _sp = 0; while (cond) { __builtin_amdgcn_s_sleep(1); \
    if ((++_sp & 255u) == 0u) { if (xb_ld(&(bar)[XB_TMO])) break; if (_sp > XB_SPIN_CAP) { atomicAdd(&(bar)[XB_TMO], 1u); break; } } } } while (0)

struct XcdBarrier {
    unsigned* bar; unsigned x;
    volatile LAS unsigned* st;
};

__device__ __forceinline__ XcdBarrier xcd_barrier_post(unsigned* bar, volatile LAS unsigned* st) {
    XcdBarrier b; b.bar = bar; b.x = xb_xcc_id(); b.st = st;
    if (threadIdx.x == 0) (void)xb_add(&bar[XB_XCNT(b.x)], 1u);
    return b;
}
__device__ __forceinline__ void xcd_barrier_complete(unsigned* bar, unsigned x, unsigned& nloc, unsigned& nx) {
    const unsigned G = gridDim.x * gridDim.y * gridDim.z;
    unsigned sum, cnt, mine, sp = 0u;
    for (;;) {
        sum = 0u; cnt = 0u; mine = 0u;
#pragma unroll
        for (unsigned j = 0; j < 16; ++j) { const unsigned c = xb_ld(&bar[XB_XCNT(j)]); sum += c; cnt += (c > 0u) ? 1u : 0u; mine = (j == x) ? c : mine; }
        if (sum == G) break;
        __builtin_amdgcn_s_sleep(1);
        if ((++sp & 255u) == 0u) { if (xb_ld(&bar[XB_TMO])) break; if (sp > XB_SPIN_CAP) { atomicAdd(&bar[XB_TMO], 1u); break; } }
    }
    nloc = mine > 0u ? mine : 1u; nx = cnt > 0u ? cnt : 1u;
}

__device__ __forceinline__ void xcd_barrier(const XcdBarrier& b) {
    asm volatile("s_waitcnt vmcnt(0)" ::: "memory");
    __syncthreads();
    if (threadIdx.x == 0) {
        unsigned* bar = b.bar;
        __builtin_amdgcn_s_waitcnt(0);
        unsigned nloc = b.st[0], nx = b.st[1];
        if (nloc == 0u) { xcd_barrier_complete(bar, b.x, nloc, nx); b.st[0] = nloc; b.st[1] = nx; }
        const unsigned old = xb_add(&bar[XB_XSUB(b.x)], 1u);
        const unsigned gen = old / nloc;
        if (old + 1u == (gen + 1u) * nloc) {
            __builtin_amdgcn_fence(__ATOMIC_RELEASE, "agent");
            asm volatile("s_waitcnt vmcnt(0)" ::: "memory");
            const unsigned og = xb_add(&bar[XB_TOP], 1u);
            const unsigned tg = og / nx;
            if (og + 1u == (tg + 1u) * nx) xb_add(&bar[XB_TOPGEN], 1u);
            else XB_SPIN(xb_ld(&bar[XB_TOPGEN]) == tg, bar);
            __builtin_amdgcn_fence(__ATOMIC_ACQUIRE, "agent");
            xb_add(&bar[XB_XGEN(b.x)], 1u);
            asm volatile("s_waitcnt vmcnt(0)" ::: "memory");
        } else {
            XB_SPIN(xb_ld(&bar[XB_XGEN(b.x)]) == gen, bar);
            __builtin_amdgcn_fence(__ATOMIC_ACQUIRE, "agent");
            asm volatile("s_waitcnt vmcnt(0)" ::: "memory");
        }
    }
    __syncthreads();
}
namespace pg8 {
#define PG8_LAS __attribute__((address_space(3)))
typedef unsigned short bf16_t;
typedef short bf16x8 __attribute__((ext_vector_type(8)));
typedef float f32x4 __attribute__((ext_vector_type(4)));
typedef unsigned u32x4 __attribute__((ext_vector_type(4)));
constexpr int BM = 256, BK = 64, HALF = 128, HTB = HALF * BK * 2  , STAGE_BYTES = 8 * HTB, NXCD = 8, WGM = 8;

__host__ __device__ __forceinline__ int lds_byte(int r, int c) { const int st = (r >> 4) * 2 + (c >> 5), rr = r & 15, cc = c & 31, ob = rr * 64 + cc * 2; return st * 1024 + (ob ^ (((ob >> 9) & 1) << 5)); }
__host__ __device__ __forceinline__ void stage_rc(int b, int& R, int& C) { const int st = b / 1024, sb = b % 1024, swz = sb ^ (((sb >> 9) & 1) << 5); R = (st >> 1) * 16 + swz / 64; C = (st & 1) * 32 + (swz % 64) / 2; }
__host__ __device__ __forceinline__ int perm32(int rho) { const int n = rho >> 4, i = rho & 15; return 8 * (i >> 2) + 4 * n + (i & 3); }

struct Unit { int pm, pn, kb; };
struct Gemm { const bf16_t* A; const bf16_t* Bt; int M, N, K, ld; };

struct StaticOrder {
    int nM, nN, nwg, G, c, W;
    __host__ __device__ void init(int M, int N, int G_, int c_, int W_ = 4) { nM = M / BM; nN = N / BM; nwg = nM * nN; G = G_; c = c_; W = W_; }
    __host__ __device__ bool next(int i, Unit& u) const {
        const long L = (long)i * G + c; if (L >= nwg) return false;
        int wgid = (int)L; { const int q = nwg / NXCD, r = nwg % NXCD, xcd = wgid % NXCD, off = wgid / NXCD; wgid = (xcd < r ? xcd * (q + 1) : r * (q + 1) + (xcd - r) * q) + off; }
        const int nig = W * nN, gid = wgid / nig, fm = gid * W, gsz = (nM - fm) < W ? (nM - fm) : W;
        u.pm = fm + ((wgid % nig) % gsz); u.pn = (wgid % nig) / gsz; u.kb = 0; return true;
    }
    __device__ __forceinline__ void a_ready(const Unit&) const {}
    __device__ __forceinline__ void done(const Unit&) const {}
};
struct CountedOrder : StaticOrder {
    const unsigned* ready; unsigned need; unsigned* tmo;
    __device__ __forceinline__ void a_ready(const Unit& u) const {
        if (threadIdx.x < 64) {
            const unsigned long long t0 = __builtin_amdgcn_s_memrealtime(); unsigned polls = 0;
            while ((unsigned)__builtin_amdgcn_readfirstlane(__hip_atomic_load(ready + 64 * u.pm, __ATOMIC_RELAXED, __HIP_MEMORY_SCOPE_AGENT)) < need) {
                if ((++polls & 255u) == 0u && __builtin_amdgcn_readfirstlane(__hip_atomic_load(tmo, __ATOMIC_RELAXED, __HIP_MEMORY_SCOPE_AGENT)) != 0u) break;
                if (__builtin_amdgcn_s_memrealtime() - t0 > 2000000ull) {
                    if (threadIdx.x == 0) { unsigned expect = 0u; __hip_atomic_compare_exchange_strong(tmo + 1, &expect, 0x600u | (unsigned)(u.pm & 0xff), __ATOMIC_RELAXED, __ATOMIC_RELAXED, __HIP_MEMORY_SCOPE_AGENT); __hip_atomic_store(tmo, 1u, __ATOMIC_RELAXED, __HIP_MEMORY_SCOPE_AGENT); }
                    break; }
                __builtin_amdgcn_s_sleep(2); }
            __builtin_amdgcn_fence(__ATOMIC_ACQUIRE, "agent");
            asm volatile("s_waitcnt vmcnt(0)" ::: "memory");
        }
#if !defined(BROKEN_HOOK_NO_BARRIER)
        asm volatile("" ::: "memory"); __builtin_amdgcn_s_barrier(); asm volatile("" ::: "memory");
#endif
    }
};

struct TwoPartOrder {
    StaticOrder base; int ncol2, n2;
    __host__ __device__ void init(int M1, int M2, int N, int ncol2_, int G_, int c_, int W_ = 4) { base.init(M1, N, G_, c_, W_); ncol2 = ncol2_; n2 = (M2 / BM) * ncol2_; }
    __host__ __device__ bool next(int i, Unit& u) const {
        if (base.next(i, u)) return true;
        const long L = (long)i * base.G + base.c - base.nwg; if (L >= n2) return false;
        const int li = (int)L; u.pm = base.nM + (li & 3); u.pn = li >> 2;
        u.kb = 0; return true;
    }
    __device__ __forceinline__ void a_ready(const Unit&) const {}
    __device__ __forceinline__ void done(const Unit&) const {}
};
struct SplitKOrder {
    int nN, S, kpb, tot, G, c;
    __host__ __device__ void init(int M, int N, int S_, int kpb_, int G_, int c_) { nN = N / BM; S = S_; kpb = kpb_; tot = (M / BM) * nN * S_; G = G_; c = c_; }
    __host__ __device__ bool next(int i, Unit& u) const { const long L = (long)i * G + c; if (L >= tot) return false; const int l = (int)L, s = l % S, t = l / S; u.pn = t % nN; u.pm = t / nN; u.kb = s * kpb; return true; }
    __device__ __forceinline__ void a_ready(const Unit&) const {}
    __device__ __forceinline__ void done(const Unit&) const {}
};

__device__ __forceinline__ unsigned cvt_pk_bf16(float lo, float hi) { unsigned r; asm volatile("v_cvt_pk_bf16_f32 %0, %1, %2" : "=v"(r) : "v"(lo), "v"(hi)); return r; }
typedef float f32x2 __attribute__((ext_vector_type(2)));
__device__ __forceinline__ f32x2 gelu_pk(f32x2 v) {
    const f32x2 av = __builtin_elementwise_abs(v), d = av * 0.2316418882f + 1.0f;
    f32x2 t; t.x = __builtin_amdgcn_rcpf(d.x); t.y = __builtin_amdgcn_rcpf(d.y);
    f32x2 q = t * 0.5307027145f + (-0.7265760135f); q = q * t + 0.7107068705f; q = q * t + (-0.142248368f); q = q * t + 0.127414796f; q = q * t;
    const f32x2 s = (v * v) * (-0.72134752044f);
    f32x2 e; e.x = __builtin_amdgcn_exp2f(s.x); e.y = __builtin_amdgcn_exp2f(s.y);
    const f32x2 m = v * (q * e), r = v - m;
    f32x2 o; o.x = v.x < 0.f ? m.x : r.x; o.y = v.y < 0.f ? m.y : r.y; return o;
}

struct EpiF32 {
    static constexpr bool PERM = false, AFTER_DRAIN = false;
    float* C; int ldc; const float* bias;
    __device__ __forceinline__ void operator()(const f32x4 (&acc)[2][2][4][2], const Unit& u, int wr, int wc, int fr, int fq) const {
        const int row0 = u.pm * BM + wr * 64 + fr, col0 = u.pn * BM + wc * 32 + 4 * fq;
        f32x4 bv[2][2];
#pragma unroll
        for (int bj = 0; bj < 2; ++bj)
#pragma unroll
            for (int n = 0; n < 2; ++n) bv[bj][n] = bias ? *(const f32x4*)(bias + col0 + bj * HALF + n * 16) : (f32x4){0.f, 0.f, 0.f, 0.f};
#pragma unroll
        for (int ai = 0; ai < 2; ++ai)
#pragma unroll
            for (int m = 0; m < 4; ++m) { float* rowp = C + (size_t)(row0 + ai * HALF + m * 16) * ldc + col0;
#pragma unroll
                for (int bj = 0; bj < 2; ++bj)
#pragma unroll
                    for (int n = 0; n < 2; ++n) *(f32x4*)(rowp + bj * HALF + n * 16) = acc[ai][bj][m][n] + bv[bj][n]; }
    }
};
template <int ACT  > struct EpiBf16 {
    static constexpr bool PERM = true, AFTER_DRAIN = false;
    bf16_t* O; int ldc; const float* bias; int split_cols; size_t split_stride;
    __device__ __forceinline__ void operator()(const f32x4 (&acc)[2][2][4][2], const Unit& u, int wr, int wc, int fr, int fq) const {
        const int row0 = u.pm * BM + wr * 64 + fr; int colt = u.pn * BM; bf16_t* base = O;
        if (split_cols) { const int t = colt / split_cols; base += (size_t)t * split_stride; colt -= t * split_cols; }
        const int col0 = colt + wc * 32 + 8 * fq, bcol0 = u.pn * BM + wc * 32 + 8 * fq;
        f32x4 bv[2][2];
#pragma unroll
        for (int bj = 0; bj < 2; ++bj)
#pragma unroll
            for (int n = 0; n < 2; ++n) bv[bj][n] = bias ? *(const f32x4*)(bias + bcol0 + bj * HALF + 4 * n) : (f32x4){0.f, 0.f, 0.f, 0.f};
#pragma unroll
        for (int ai = 0; ai < 2; ++ai)
#pragma unroll
            for (int m = 0; m < 4; ++m) { bf16_t* rowp = base + (size_t)(row0 + ai * HALF + m * 16) * ldc + col0;
#pragma unroll
                for (int bj = 0; bj < 2; ++bj) { f32x4 v0 = acc[ai][bj][m][0] + bv[bj][0], v1 = acc[ai][bj][m][1] + bv[bj][1];
                    if (ACT == 1) { f32x2 a = gelu_pk((f32x2){v0[0], v0[1]}), b = gelu_pk((f32x2){v0[2], v0[3]}), c = gelu_pk((f32x2){v1[0], v1[1]}), d = gelu_pk((f32x2){v1[2], v1[3]});
                        v0 = (f32x4){a.x, a.y, b.x, b.y}; v1 = (f32x4){c.x, c.y, d.x, d.y}; }
                    if (ACT == 2) {
#pragma unroll
                        for (int j = 0; j < 4; ++j) { v0[j] = 0.5f * v0[j] * (1.0f + erff(v0[j] * 0.70710678f)); v1[j] = 0.5f * v1[j] * (1.0f + erff(v1[j] * 0.70710678f)); } }
                    u32x4 w; w.x = cvt_pk_bf16(v0[0], v0[1]); w.y = cvt_pk_bf16(v0[2], v0[3]); w.z = cvt_pk_bf16(v1[0], v1[1]); w.w = cvt_pk_bf16(v1[2], v1[3]);
                    *(u32x4*)(rowp + bj * HALF) = w; } }
    }
};

struct PanelStats {
    unsigned* xbuf;
    unsigned* cnt;
    unsigned* tmo;
    int ntn; float eps;
    unsigned code;
    __device__ __forceinline__ bool run(const f32x4 (&v)[2][2][4][2], const Unit& u, int wr, int wc, int fr, int fq, PG8_LAS unsigned char* lds, int wid, int lane) const {
        typedef float f32x2v __attribute__((ext_vector_type(2)));
        PG8_LAS f32x2v* P = (PG8_LAS f32x2v*)lds;
        PG8_LAS f32x2v* S = (PG8_LAS f32x2v*)(lds + 8192);
        PG8_LAS unsigned* flag = (PG8_LAS unsigned*)(lds + 8192 + 2048);
#pragma unroll
        for (int ai = 0; ai < 2; ++ai)
#pragma unroll
            for (int m = 0; m < 4; ++m) {
                float s = 0.f;
#pragma unroll
                for (int bj = 0; bj < 2; ++bj)
#pragma unroll
                    for (int n = 0; n < 2; ++n) { const f32x4 x = v[ai][bj][m][n]; s += (x[0] + x[1]) + (x[2] + x[3]); }
                s += __shfl_xor(s, 16); s += __shfl_xor(s, 32);
                const float mw = s * (1.0f / 64.0f); float q = 0.f;
#pragma unroll
                for (int bj = 0; bj < 2; ++bj)
#pragma unroll
                    for (int n = 0; n < 2; ++n) { const f32x4 d = v[ai][bj][m][n] - mw; q += (d[0] * d[0] + d[1] * d[1]) + (d[2] * d[2] + d[3] * d[3]); }
                q += __shfl_xor(q, 16); q += __shfl_xor(q, 32);
                if (fq == 0) P[(ai * HALF + wr * 64 + m * 16 + fr) * 4 + wc] = (f32x2v){mw, q};
            }
        asm volatile("s_waitcnt lgkmcnt(0)" ::: "memory"); __builtin_amdgcn_s_barrier(); asm volatile("" ::: "memory");
#if defined(BROKEN_NO_WAIT)
        if (blockIdx.x >= 64) { const long long t0 = clock64(); while (clock64() - t0 < 60000) __builtin_amdgcn_s_sleep(8); }
#endif
        const int row = wid * 32 + (lane & 31);
        if (lane < 32) {
            const f32x2v a = P[row * 4 + 0], b = P[row * 4 + 1], c = P[row * 4 + 2], d = P[row * 4 + 3];
            const float mt = (a.x + b.x + c.x + d.x) * 0.25f;
            const float da = a.x - mt, db = b.x - mt, dc = c.x - mt, dd = d.x - mt;
            const float m2 = (a.y + b.y) + (c.y + d.y) + 64.0f * ((da * da + db * db) + (dc * dc + dd * dd));
            unsigned long long* slot = (unsigned long long*)xbuf + ((size_t)(u.pm * BM + row) * 4 + u.pn);
            __hip_atomic_store(slot, ((unsigned long long)__float_as_uint(m2) << 32) | __float_as_uint(mt), __ATOMIC_RELAXED, __HIP_MEMORY_SCOPE_AGENT);
        }
        asm volatile("s_waitcnt vmcnt(0)" ::: "memory");
        if (lane == 0) __hip_atomic_fetch_add(cnt + 64 * u.pm, 1u, __ATOMIC_RELAXED, __HIP_MEMORY_SCOPE_AGENT);
        if (wid == 0) {
            bool dead = false; const unsigned long long t0 = __builtin_amdgcn_s_memrealtime(); const unsigned want = 8u * (unsigned)ntn;
            for (;;) {
#if defined(BROKEN_NO_WAIT)
                break;
#endif
                if ((unsigned)__builtin_amdgcn_readfirstlane(__hip_atomic_load(cnt + 64 * u.pm, __ATOMIC_RELAXED, __HIP_MEMORY_SCOPE_AGENT)) >= want) break;
                if (__builtin_amdgcn_s_memrealtime() - t0 > 2000000ull) {
                    if (lane == 0) { unsigned expect = 0u; __hip_atomic_compare_exchange_strong(tmo + 1, &expect, code | (unsigned)(u.pm & 0xff), __ATOMIC_RELAXED, __ATOMIC_RELAXED, __HIP_MEMORY_SCOPE_AGENT);
                                     __hip_atomic_store(tmo, 1u, __ATOMIC_RELAXED, __HIP_MEMORY_SCOPE_AGENT); }
                    dead = true; break; }
                __builtin_amdgcn_s_sleep(2);
            }
            __builtin_amdgcn_fence(__ATOMIC_ACQUIRE, "agent");
            if (lane == 0) flag[0] = dead ? 1u : 0u;
        }
        asm volatile("s_waitcnt vmcnt(0) lgkmcnt(0)" ::: "memory"); __builtin_amdgcn_s_barrier(); asm volatile("" ::: "memory");
        const bool bad = flag[0] != 0u;
        if (lane < 32) {
            const unsigned long long* slot = (const unsigned long long*)xbuf + (size_t)(u.pm * BM + row) * 4; float mt[4], m2[4]; float ms = 0.f;
#pragma unroll
            for (int t = 0; t < 4; ++t) { if (t < ntn) { const unsigned long long w = __hip_atomic_load(slot + t, __ATOMIC_RELAXED, __HIP_MEMORY_SCOPE_AGENT); mt[t] = __uint_as_float((unsigned)w); m2[t] = __uint_as_float((unsigned)(w >> 32)); } else { mt[t] = 0.f; m2[t] = 0.f; } ms += mt[t]; }
            const float mean = ms / (float)ntn; float q = 0.f;
#pragma unroll
            for (int t = 0; t < 4; ++t) if (t < ntn) { const float dm = mt[t] - mean; q += m2[t] + 256.0f * dm * dm; }
            S[row] = (f32x2v){mean, 1.0f / sqrtf(q / (256.0f * (float)ntn) + eps)};
        }
        asm volatile("s_waitcnt lgkmcnt(0)" ::: "memory"); __builtin_amdgcn_s_barrier(); asm volatile("" ::: "memory");
        return bad;
    }
};
struct EpiLnRes {
    static constexpr bool PERM = false, AFTER_DRAIN = true;
    const float* base; float* out; int ldc; const float* bias; PanelStats st; unsigned poison;
    __device__ __forceinline__ void refuse(size_t i0, size_t stride, int M, int N) const { const float q = __builtin_nanf(""); for (size_t i = i0; i < (size_t)M * N; i += stride) out[(i / N) * ldc + i % N] = q;
        if (i0 == 0) { unsigned expect = 0u; __hip_atomic_compare_exchange_strong(st.tmo + 1, &expect, 0x7f0u, __ATOMIC_RELAXED, __ATOMIC_RELAXED, __HIP_MEMORY_SCOPE_AGENT); __hip_atomic_store(st.tmo, 1u, __ATOMIC_RELAXED, __HIP_MEMORY_SCOPE_AGENT); } }
    __device__ __forceinline__ void fused(f32x4 (&acc)[2][2][4][2], const Unit& u, int wr, int wc, int fr, int fq, PG8_LAS unsigned char* lds, int wid, int lane) const {
        typedef float f32x2v __attribute__((ext_vector_type(2)));
        const PG8_LAS f32x2v* S = (const PG8_LAS f32x2v*)(lds + 8192);
        const int col0 = u.pn * BM + wc * 32 + 4 * fq;
#pragma unroll
        for (int bj = 0; bj < 2; ++bj)
#pragma unroll
            for (int n = 0; n < 2; ++n) { const f32x4 bv = bias ? *(const f32x4*)(bias + col0 + bj * HALF + n * 16) : (f32x4){0.f, 0.f, 0.f, 0.f};
#pragma unroll
                for (int ai = 0; ai < 2; ++ai)
#pragma unroll
                    for (int m = 0; m < 4; ++m) acc[ai][bj][m][n] += bv; }
        const bool bad = st.run(acc, u, wr, wc, fr, fq, lds, wid, lane) || poison != 0u;
        const float qnan = __builtin_nanf("");
#pragma unroll
        for (int ai = 0; ai < 2; ++ai)
#pragma unroll
            for (int m = 0; m < 4; ++m) { const int r = ai * HALF + wr * 64 + m * 16 + fr; const f32x2v sr = S[r]; const size_t off = (size_t)(u.pm * BM + r) * ldc + col0;
#pragma unroll
                for (int bj = 0; bj < 2; ++bj)
#pragma unroll
                    for (int n = 0; n < 2; ++n) { const f32x4 bs = *(const f32x4*)(base + off + bj * HALF + n * 16); f32x4 o = bs + (acc[ai][bj][m][n] - sr.x) * sr.y;
                        if (bad) o = (f32x4){qnan, qnan, qnan, qnan}; *(f32x4*)(out + off + bj * HALF + n * 16) = o; }
                asm volatile("" ::: "memory"); }
    }
};
struct EpiLnResLn {
    static constexpr bool PERM = false, AFTER_DRAIN = true;
    const float* base; float* out; bf16_t* xn; int ldc; const float* bias; PanelStats st1, st2; unsigned poison;
    __device__ __forceinline__ void refuse(size_t i0, size_t stride, int M, int N) const { const float q = __builtin_nanf(""); for (size_t i = i0; i < (size_t)M * N; i += stride) { const size_t o = (i / N) * ldc + i % N; out[o] = q; xn[o] = (bf16_t)0x7fc0u; }
        if (i0 == 0) { unsigned expect = 0u; __hip_atomic_compare_exchange_strong(st1.tmo + 1, &expect, 0x7f0u, __ATOMIC_RELAXED, __ATOMIC_RELAXED, __HIP_MEMORY_SCOPE_AGENT); __hip_atomic_store(st1.tmo, 1u, __ATOMIC_RELAXED, __HIP_MEMORY_SCOPE_AGENT); } }
    __device__ __forceinline__ void fused(f32x4 (&acc)[2][2][4][2], const Unit& u, int wr, int wc, int fr, int fq, PG8_LAS unsigned char* lds, int wid, int lane) const {
        typedef float f32x2v __attribute__((ext_vector_type(2))); typedef unsigned u32x2v __attribute__((ext_vector_type(2)));
        const PG8_LAS f32x2v* S = (const PG8_LAS f32x2v*)(lds + 8192);
        const int col0 = u.pn * BM + wc * 32 + 4 * fq;
#pragma unroll
        for (int bj = 0; bj < 2; ++bj)
#pragma unroll
            for (int n = 0; n < 2; ++n) { const f32x4 bv = bias ? *(const f32x4*)(bias + col0 + bj * HALF + n * 16) : (f32x4){0.f, 0.f, 0.f, 0.f};
#pragma unroll
                for (int ai = 0; ai < 2; ++ai)
#pragma unroll
                    for (int m = 0; m < 4; ++m) acc[ai][bj][m][n] += bv; }
        bool bad = st1.run(acc, u, wr, wc, fr, fq, lds, wid, lane) || poison != 0u;
        const float qnan = __builtin_nanf("");
#pragma unroll
        for (int ai = 0; ai < 2; ++ai)
#pragma unroll
            for (int m = 0; m < 4; ++m) { const int r = ai * HALF + wr * 64 + m * 16 + fr; const f32x2v sr = S[r]; const size_t off = (size_t)(u.pm * BM + r) * ldc + col0;
#pragma unroll
                for (int bj = 0; bj < 2; ++bj)
#pragma unroll
                    for (int n = 0; n < 2; ++n) { const f32x4 bs = *(const f32x4*)(base + off + bj * HALF + n * 16); acc[ai][bj][m][n] = bs + (acc[ai][bj][m][n] - sr.x) * sr.y; }
                asm volatile("" : "+v"(acc[ai][0][m][0]), "+v"(acc[ai][0][m][1]), "+v"(acc[ai][1][m][0]), "+v"(acc[ai][1][m][1]));
                if (m & 1) asm volatile("" ::: "memory"); }
        const bool bad1 = bad;
        bad = st2.run(acc, u, wr, wc, fr, fq, lds, wid, lane) || bad;
#pragma unroll
        for (int ai = 0; ai < 2; ++ai)
#pragma unroll
            for (int m = 0; m < 4; ++m) { const int r = ai * HALF + wr * 64 + m * 16 + fr; const f32x2v sr = S[r]; const size_t off = (size_t)(u.pm * BM + r) * ldc + col0;
#pragma unroll
                for (int bj = 0; bj < 2; ++bj)
#pragma unroll
                    for (int n = 0; n < 2; ++n) { const f32x4 x1 = acc[ai][bj][m][n]; *(f32x4*)(out + off + bj * HALF + n * 16) = bad1 ? (f32x4){qnan, qnan, qnan, qnan} : x1;
                        const f32x4 o = (x1 - sr.x) * sr.y; u32x2v w; w.x = cvt_pk_bf16(o[0], o[1]); w.y = cvt_pk_bf16(o[2], o[3]);
                        if (bad) { w.x = 0x7fc07fc0u; w.y = 0x7fc07fc0u; } *(u32x2v*)(xn + off + bj * HALF + n * 16) = w; }
                asm volatile("" ::: "memory"); }
    }
};

template <class Epi, class Sched, bool STAMP = false, bool FP8 = false, bool ALIGN_EPI = true, bool SP2 = true>
__device__ __forceinline__ void gemm_phase(PG8_LAS unsigned char* lds, const Gemm g, const Sched& S, const Epi& E, unsigned long long* stamps) {
    const int tid = fresh_tid(), wid = __builtin_amdgcn_readfirstlane(tid >> 6), lane = tid & 63, wr = wid >> 2, wc = wid & 3, fr = lane & 15, fq = lane >> 4;
    const int K = g.K, nt = K / BK, LD = g.ld ? g.ld : K;
    int ts_lo = 0, ts_hi = 0, nts = 0; const unsigned long long rt_entry = STAMP ? (unsigned long long)wall_clock64() : 0ull;
#define PG8_STAMP() do { if (STAMP && wid == 0 && nts < 64) { const unsigned long long _c = (unsigned long long)clock64(); \
        ts_lo = (lane == nts) ? (int)(unsigned)_c : ts_lo; ts_hi = (lane == nts) ? (int)(unsigned)(_c >> 32) : ts_hi; ++nts; } } while (0)
    PG8_STAMP();
    unsigned voffA[2], voffB[2];
#pragma unroll
    for (int i = 0; i < 2; ++i) { int R, C; stage_rc(tid * 16 + i * 8192, R, C); const int Rb = Epi::PERM ? ((R & ~31) + perm32(R & 31)) : R;
        voffA[i] = (unsigned)(R * LD + C) * 2u; voffB[i] = (unsigned)(Rb * LD + C) * 2u; }
    const size_t kstep = (size_t)(BK * 2);
    const size_t hstep = (size_t)HALF * LD * 2;
    const size_t tstep = 2 * hstep;
    const unsigned ldsw = (unsigned)wid * 1024u;
    const int aoff = lds_byte(wr * 64 + fr, fq * 8), boff = lds_byte(wc * 32 + fr, fq * 8);
#define PG8_SA(b, h) (((b) * 2 + (h)) * HTB)
#define PG8_SB(b, h) ((4 + (b) * 2 + (h)) * HTB)
#define PG8_STAGE(bufoff, gbase, voff) do { _Pragma("unroll") for (int _i = 0; _i < 2; ++_i) \
        __builtin_amdgcn_global_load_lds((const unsigned*)((const char*)(gbase) + (voff)[_i]), (PG8_LAS unsigned*)(lds + (bufoff) + ldsw + _i * 8192), 16, 0, 0); } while (0)
#define PG8_LDA(dst, b, h) do { if constexpr (FP8) { _Pragma("unroll") for (int m = 0; m < 4; ++m) { const i32x4v lo_ = *(const PG8_LAS i32x4v*)(lds + PG8_SA(b, h) + aoff + m * 2048), hi_ = *(const PG8_LAS i32x4v*)(lds + PG8_SA(b, h) + aoff + m * 2048 + 1024); dst##8[m] = __builtin_shufflevector(lo_, hi_, 0, 1, 2, 3, 4, 5, 6, 7); } } \
        else { _Pragma("unroll") for (int m = 0; m < 4; ++m) _Pragma("unroll") for (int k = 0; k < 2; ++k) dst[m][k] = *(const PG8_LAS bf16x8*)(lds + PG8_SA(b, h) + aoff + m * 2048 + k * 1024); } } while (0)
#define PG8_LDB(dst, b, h) do { if constexpr (FP8) { _Pragma("unroll") for (int n = 0; n < 2; ++n) { const i32x4v lo_ = *(const PG8_LAS i32x4v*)(lds + PG8_SB(b, h) + boff + n * 2048), hi_ = *(const PG8_LAS i32x4v*)(lds + PG8_SB(b, h) + boff + n * 2048 + 1024); dst##8[n] = __builtin_shufflevector(lo_, hi_, 0, 1, 2, 3, 4, 5, 6, 7); } } \
        else { _Pragma("unroll") for (int n = 0; n < 2; ++n) _Pragma("unroll") for (int k = 0; k < 2; ++k) dst[n][k] = *(const PG8_LAS bf16x8*)(lds + PG8_SB(b, h) + boff + n * 2048 + k * 1024); } } while (0)
#define PG8_MMA(ai, bj, At, Bt) do { __builtin_amdgcn_s_setprio(1); _Pragma("unroll") for (int m = 0; m < 4; ++m) _Pragma("unroll") for (int n = 0; n < 2; ++n) { \
        if constexpr (FP8) asm volatile("v_mfma_scale_f32_16x16x128_f8f6f4 %0, %1, %2, %0, %3, %3 op_sel_hi:[0,0,0]" : "+v"(acc[ai][bj][m][n]) : "v"(Bt##8[n]), "v"(At##8[m]), "v"(fp8_unit_scale)); \
        else { _Pragma("unroll") for (int k = 0; k < 2; ++k) acc[ai][bj][m][n] = __builtin_amdgcn_mfma_f32_16x16x32_bf16(Bt[n][k], At[m][k], acc[ai][bj][m][n], 0, 0, 0); } } \
        __builtin_amdgcn_s_setprio(0); } while (0)
#define PG8_WAIT_V(n) asm volatile("s_waitcnt vmcnt(" #n ")" ::: "memory")
#define PG8_WAIT_L(n) asm volatile("s_waitcnt lgkmcnt(" #n ")" ::: "memory")
#define PG8_BAR __builtin_amdgcn_s_barrier()
#define PG8_SCHED __builtin_amdgcn_sched_barrier(0)
    Unit cur, nxt; int ui = 0;
    if (!S.next(0, cur)) return;
    f32x4 acc[2][2][4][2];
#pragma unroll
    for (int a = 0; a < 2; ++a)
#pragma unroll
        for (int b = 0; b < 2; ++b)
#pragma unroll
            for (int m = 0; m < 4; ++m)
#pragma unroll
                for (int n = 0; n < 2; ++n) acc[a][b][m][n] = (f32x4){0.f, 0.f, 0.f, 0.f};
    typedef int i32x4v __attribute__((ext_vector_type(4))); typedef int i32x8v __attribute__((ext_vector_type(8)));
    int fp8_unit_scale = 0x7f7f7f7f; asm volatile("" : "+v"(fp8_unit_scale));
    bf16x8 At[4][2], B0[2][2], B1[2][2]; i32x8v At8[4], B08[2], B18[2];
    const char* cA = (const char*)g.A + (size_t)cur.pm * tstep + cur.kb; const char* cB = (const char*)g.Bt + (size_t)cur.pn * tstep + cur.kb;
    S.a_ready(cur);
    if constexpr (SP2) {
        PG8_STAGE(PG8_SB(0, 0), cB, voffB); PG8_STAGE(PG8_SB(0, 1), cB + hstep, voffB); PG8_STAGE(PG8_SA(0, 0), cA, voffA); PG8_STAGE(PG8_SA(0, 1), cA + hstep, voffA);
        if (wr == 1) PG8_BAR;
        PG8_WAIT_V(2); PG8_BAR;
        PG8_STAGE(PG8_SB(1, 0), cB + kstep, voffB); PG8_STAGE(PG8_SA(1, 0), cA + kstep, voffA); PG8_STAGE(PG8_SB(1, 1), cB + hstep + kstep, voffB);
        PG8_WAIT_V(6); PG8_BAR;
    } else {
        PG8_STAGE(PG8_SB(0, 0), cB, voffB); PG8_STAGE(PG8_SA(0, 0), cA, voffA); PG8_STAGE(PG8_SB(0, 1), cB + hstep, voffB); PG8_STAGE(PG8_SA(0, 1), cA + hstep, voffA);
        if (wr == 1) PG8_BAR;
        PG8_WAIT_V(4); PG8_BAR;
        PG8_STAGE(PG8_SB(1, 0), cB + kstep, voffB); PG8_STAGE(PG8_SA(1, 0), cA + kstep, voffA); PG8_STAGE(PG8_SB(1, 1), cB + hstep + kstep, voffB);
        PG8_WAIT_V(6); PG8_BAR;
    }
    PG8_STAMP();
    for (;;) {
        const bool has_next = S.next(ui + 1, nxt);
        const char* nA = has_next ? (const char*)g.A + (size_t)nxt.pm * tstep + nxt.kb : cA; const char* nB = has_next ? (const char*)g.Bt + (size_t)nxt.pn * tstep + nxt.kb : cB;
        for (int t = 0; t < nt; t += 2) {
            const bool last = (t == nt - 2);
            const char* a1 = cA + (size_t)(t + 1) * kstep;
            const char* a2 = last ? nA : cA + (size_t)(t + 2) * kstep; const char* b2 = last ? nB : cB + (size_t)(t + 2) * kstep;
            const char* a3 = a2 + kstep; const char* b3 = b2 + kstep;
            if (last && has_next) S.a_ready(nxt);
            if constexpr (SP2) {
            PG8_LDB(B0, 0, 0); PG8_LDB(B1, 0, 1); PG8_SCHED; PG8_LDA(At, 0, 0); PG8_STAGE(PG8_SA(1, 1), a1 + hstep, voffA);
            PG8_WAIT_V(8); PG8_WAIT_L(0); PG8_BAR; PG8_MMA(0, 0, At, B0); PG8_MMA(0, 1, At, B1); PG8_BAR; PG8_SCHED;
            PG8_LDA(At, 0, 1); PG8_STAGE(PG8_SB(0, 0), b2, voffB); PG8_STAGE(PG8_SB(0, 1), b2 + hstep, voffB); PG8_STAGE(PG8_SA(0, 0), a2, voffA);
            PG8_WAIT_V(8); PG8_WAIT_L(0); PG8_BAR; PG8_MMA(1, 0, At, B0); PG8_MMA(1, 1, At, B1); PG8_BAR; PG8_SCHED;
            PG8_LDB(B0, 1, 0); PG8_LDB(B1, 1, 1); PG8_SCHED; PG8_LDA(At, 1, 0); PG8_STAGE(PG8_SA(0, 1), a2 + hstep, voffA);
            PG8_WAIT_V(8); PG8_WAIT_L(0); PG8_BAR; PG8_MMA(0, 0, At, B0); PG8_MMA(0, 1, At, B1); PG8_BAR; PG8_SCHED;
            PG8_LDA(At, 1, 1); PG8_STAGE(PG8_SB(1, 0), b3, voffB); PG8_STAGE(PG8_SB(1, 1), b3 + hstep, voffB); PG8_STAGE(PG8_SA(1, 0), a3, voffA);
            PG8_WAIT_V(8); PG8_WAIT_L(0); PG8_BAR; PG8_MMA(1, 0, At, B0); PG8_MMA(1, 1, At, B1); PG8_BAR; PG8_SCHED;
            } else {
            PG8_LDB(B0, 0, 0); PG8_SCHED; PG8_LDA(At, 0, 0); PG8_STAGE(PG8_SA(1, 1), a1 + hstep, voffA);
            PG8_WAIT_L(8); PG8_BAR; PG8_WAIT_L(0); PG8_MMA(0, 0, At, B0); PG8_BAR; PG8_SCHED;
            PG8_LDB(B1, 0, 1); PG8_STAGE(PG8_SB(0, 0), b2, voffB);
            PG8_BAR; PG8_WAIT_L(0); PG8_MMA(0, 1, At, B1); PG8_BAR;
            PG8_LDA(At, 0, 1); PG8_STAGE(PG8_SA(0, 0), a2, voffA);
            PG8_BAR; PG8_WAIT_L(0); PG8_MMA(1, 0, At, B0); PG8_BAR; PG8_SCHED;
            PG8_STAGE(PG8_SB(0, 1), b2 + hstep, voffB);
            PG8_WAIT_V(6); PG8_BAR; PG8_MMA(1, 1, At, B1); PG8_BAR;
            PG8_LDB(B0, 1, 0); PG8_SCHED; PG8_LDA(At, 1, 0); PG8_STAGE(PG8_SA(0, 1), a2 + hstep, voffA);
            PG8_WAIT_L(8); PG8_BAR; PG8_WAIT_L(0); PG8_MMA(0, 0, At, B0); PG8_BAR; PG8_SCHED;
            PG8_LDB(B1, 1, 1); PG8_STAGE(PG8_SB(1, 0), b3, voffB);
            PG8_BAR; PG8_WAIT_L(0); PG8_MMA(0, 1, At, B1); PG8_BAR;
            PG8_LDA(At, 1, 1); PG8_STAGE(PG8_SA(1, 0), a3, voffA);
            PG8_BAR; PG8_WAIT_L(0); PG8_MMA(1, 0, At, B0); PG8_BAR; PG8_SCHED;
            PG8_STAGE(PG8_SB(1, 1), b3 + hstep, voffB);
            PG8_WAIT_V(6); PG8_BAR; PG8_MMA(1, 1, At, B1); PG8_BAR;
            }
        }
        PG8_STAMP();
        if constexpr (ALIGN_EPI) { if (wr == 0) PG8_BAR; }
        if constexpr (FP8) asm volatile("s_nop 15\n\ts_nop 15" ::: "memory");
        if constexpr (!Epi::AFTER_DRAIN) { E(acc, cur, wr, wc, fr, fq); S.done(cur); }
        PG8_STAMP();
        if (!has_next) break;
#pragma unroll
        for (int a = 0; a < 2; ++a)
#pragma unroll
            for (int b = 0; b < 2; ++b)
#pragma unroll
                for (int m = 0; m < 4; ++m)
#pragma unroll
                    for (int n = 0; n < 2; ++n) acc[a][b][m][n] = (f32x4){0.f, 0.f, 0.f, 0.f};
        cur = nxt; cA = nA; cB = nB; ++ui;
        if constexpr (ALIGN_EPI) { if (wr == 1) PG8_BAR; }
    }
    PG8_WAIT_V(0);
    if constexpr (!ALIGN_EPI) { if (wr == 0) PG8_BAR; }
    PG8_BAR;
    if constexpr (Epi::AFTER_DRAIN) { E.fused(acc, cur, wr, wc, fr, fq, lds, wid, lane); S.done(cur); }
    PG8_STAMP();
    if (STAMP && wid == 0) { stamps[lane] = lane < nts ? (((unsigned long long)(unsigned)ts_hi << 32) | (unsigned)ts_lo) : 0ull;
        if (lane == 62) stamps[62] = rt_entry; if (lane == 63) stamps[63] = (unsigned long long)wall_clock64(); }
#undef PG8_STAMP
#undef PG8_SA
#undef PG8_SB
#undef PG8_STAGE
#undef PG8_LDA
#undef PG8_LDB
#undef PG8_MMA
#undef PG8_WAIT_V
#undef PG8_WAIT_L
#undef PG8_BAR
#undef PG8_SCHED
}
}

constexpr float HY_MIN_DECAY = -3.0701134573253944f;
constexpr float HY_MAX_DECAY = -15.350567286626972f;
constexpr float RET_SCALE = 0.08838834764831845f;

__device__ __forceinline__ void p0_mod_item(ARGS_REF a, int item, LAS unsigned char* lds) {
    const int tid = fresh_tid(), lane = tid & 63, wave = tid >> 6;
    const int l = item / 192, n0 = (item % 192) * 128;
    LAS float* sc = (LAS float*)lds;
    LAS float* red = (LAS float*)(lds + 81920);
    const float* c = a.in[1]; const float* cc = a.in[3];
    for (int i = tid; i < 5 * 4096; i += NTHREADS) { const int r = i >> 12, k = i & 4095; const float x = r < 4 ? c[r * 4096 + k] : cc[k]; sc[i] = silu_f(x); }
    __syncthreads();
    float acc[5][2];
#pragma unroll
    for (int r = 0; r < 5; ++r) { acc[r][0] = 0.f; acc[r][1] = 0.f; }
    const float* W = a.in[4] + (size_t)l * 4096 * NMOD + n0 + 2 * lane;
#pragma unroll 8
    for (int k = wave; k < 4096; k += 8) {
        const v2f w = *(const v2f*)(W + (size_t)k * NMOD);
#pragma unroll
        for (int r = 0; r < 5; ++r) { const float s = sc[r * 4096 + k]; acc[r][0] += s * w.x; acc[r][1] += s * w.y; }
    }
#pragma unroll
    for (int r = 0; r < 5; ++r) { red[(wave * 5 + r) * 128 + 2 * lane] = acc[r][0]; red[(wave * 5 + r) * 128 + 2 * lane + 1] = acc[r][1]; }
    __syncthreads();
    float* MOD = (float*)(a.ws + WS_MOD);
    for (int i = tid; i < 640; i += NTHREADS) {
        const int r = i >> 7, n = i & 127; float s = 0.f;
#pragma unroll
        for (int w = 0; w < 8; ++w) s += red[(w * 5 + r) * 128 + n];
        MOD[(size_t)(l * 5 + r) * NMOD + n0 + n] = s + a.in[5][(size_t)l * NMOD + n0 + n];
    }
    __syncthreads();
}

__device__ __forceinline__ void p0_filter_item(ARGS_REF a, int item, LAS unsigned char* lds) {
    const int tid = fresh_tid(), lane = tid & 63, wave = tid >> 6;
    const bool ctx = item >= 128; const int l = ctx ? 0 : item / 64; const int L = ctx ? 256 : 4096; const int t0 = (ctx ? item - 128 : item % 64) * 64;
    LAS float* z = (LAS float*)lds;
    LAS float* h1 = z + 64 * 33;
    LAS float* h2 = h1 + 64 * 64;
    const float* w1 = a.in[10] + l * 33 * 64; const float* b1 = a.in[11] + l * 64; const float* fq = a.in[12] + l * 64;
    const float* w2 = a.in[13] + l * 4096; const float* b2 = a.in[14] + l * 64; const float* w3 = a.in[15] + l * 4096; const float* b3 = a.in[16] + l * 64;
    const float* w4 = a.in[17] + (size_t)l * 64 * 4096;
    for (int i = tid; i < 64 * 33; i += NTHREADS) {
        const int tl = i / 33, j = i - tl * 33; const int t = t0 + tl; float val;
        if (j == 0) val = (float)t / (float)(L - 1);
        else { const int bi = (j - 1) & 15; const float f = 1e-4f + (float)bi * ((15.0f - 1e-4f) / 15.0f); const float turns = f * (float)t / (float)L;
               val = (j <= 16) ? cos_turns(turns) : -sin_turns(turns); }
        z[i] = val;
    }
    __syncthreads();
    const float frq = fq[lane];
#pragma unroll 1
    for (int i = 0; i < 8; ++i) { const int tl = wave + 8 * i; float s = b1[lane]; for (int q = 0; q < 33; ++q) s += z[tl * 33 + q] * w1[q * 64 + lane]; h1[tl * 64 + lane] = sin_rad(frq * s); }
    __syncthreads();
#pragma unroll 1
    for (int i = 0; i < 8; ++i) { const int tl = wave + 8 * i; float s = b2[lane]; for (int q = 0; q < 64; ++q) s += h1[tl * 64 + q] * w2[q * 64 + lane]; h2[tl * 64 + lane] = sin_rad(frq * s); }
    __syncthreads();
#pragma unroll 1
    for (int i = 0; i < 8; ++i) { const int tl = wave + 8 * i; float s = b3[lane]; for (int q = 0; q < 64; ++q) s += h2[tl * 64 + q] * w3[q * 64 + lane]; h1[tl * 64 + lane] = sin_rad(frq * s); }
    __syncthreads();
    float* KT = ctx ? (float*)(a.ws + WS_KTC) : (float*)(a.ws + WS_KT) + (size_t)l * 4096 * 4096;
    {
        const int fr = lane & 15, fq = lane >> 4;
        LAS bf16_t* Hh = (LAS bf16_t*)(lds + 41216);
        LAS bf16_t* Hl = Hh + 64 * 72;
        {
            const int row = tid >> 3, c8 = (tid & 7) * 8; const v4f x0 = *(const LAS v4f*)(h1 + row * 64 + c8), x1 = *(const LAS v4f*)(h1 + row * 64 + c8 + 4);
            const unsigned a0 = pack2bf(x0.x, x0.y), a1 = pack2bf(x0.z, x0.w), a2 = pack2bf(x1.x, x1.y), a3 = pack2bf(x1.z, x1.w);
            *(LAS v4u*)(Hh + row * 72 + c8) = make_v4u(a0, a1, a2, a3);
            *(LAS v4u*)(Hl + row * 72 + c8) = make_v4u(pack2bf(x0.x - bflo(a0), x0.y - bfhi(a0)), pack2bf(x0.z - bflo(a1), x0.w - bfhi(a1)), pack2bf(x1.x - bflo(a2), x1.y - bfhi(a2)), pack2bf(x1.z - bflo(a3), x1.w - bfhi(a3)));
        }
        __syncthreads();
        bf16x8_t ah[4][2], al[4][2];
#pragma unroll
        for (int tm = 0; tm < 4; ++tm)
#pragma unroll
            for (int ks = 0; ks < 2; ++ks) { ah[tm][ks] = *(const LAS bf16x8_t*)(Hh + (16 * tm + fr) * 72 + 8 * fq + 32 * ks); al[tm][ks] = *(const LAS bf16x8_t*)(Hl + (16 * tm + fr) * 72 + 8 * fq + 32 * ks); }
#pragma unroll 1
        for (int i = 0; i < 32; ++i) {
            const int col = 16 * (wave + 8 * i) + fr, c = col & 1023;
            bf16x8_t bh[2], bl[2];
#pragma unroll
            for (int ks = 0; ks < 2; ++ks) {
                float w[8];
#pragma unroll
                for (int e = 0; e < 8; ++e) w[e] = w4[(size_t)(32 * ks + 8 * fq + e) * 4096 + col];
                const unsigned h0 = pack2bf(w[0], w[1]), h1_ = pack2bf(w[2], w[3]), h2_ = pack2bf(w[4], w[5]), h3 = pack2bf(w[6], w[7]);
                bh[ks] = __builtin_bit_cast(bf16x8_t, make_v4u(h0, h1_, h2_, h3));
                bl[ks] = __builtin_bit_cast(bf16x8_t, make_v4u(pack2bf(w[0] - bflo(h0), w[1] - bfhi(h0)), pack2bf(w[2] - bflo(h1_), w[3] - bfhi(h1_)), pack2bf(w[4] - bflo(h2_), w[5] - bfhi(h2_)), pack2bf(w[6] - bflo(h3), w[7] - bfhi(h3))));
            }
            const float delta = fabsf(HY_MIN_DECAY + (HY_MAX_DECAY - HY_MIN_DECAY) * ((float)c / 1023.0f));
#pragma unroll
            for (int tm = 0; tm < 4; ++tm) {
                f32x4_t acc = (f32x4_t){0.f, 0.f, 0.f, 0.f};
#pragma unroll
                for (int ks = 0; ks < 2; ++ks) {
                    acc = __builtin_amdgcn_mfma_f32_16x16x32_bf16(al[tm][ks], bh[ks], acc, 0, 0, 0);
                    acc = __builtin_amdgcn_mfma_f32_16x16x32_bf16(ah[tm][ks], bl[ks], acc, 0, 0, 0);
                    acc = __builtin_amdgcn_mfma_f32_16x16x32_bf16(ah[tm][ks], bh[ks], acc, 0, 0, 0);
                }
                const int tb = t0 + 16 * tm + 4 * fq; v4f o;
#pragma unroll
                for (int r = 0; r < 4; ++r) { const float tt = (float)(tb + r) / (float)(L - 1); o[r] = acc[r] * __expf(-tt * delta); }
                *(v4f*)(KT + (size_t)col * L + tb) = o;
            }
        }
    }
    __syncthreads();
}

__device__ __forceinline__ void p0_tr_tile(const float* src, int N, bf16_t* dst, int KD, int k0, int n0, LAS unsigned char* lds) {
    const int tid = fresh_tid();
    LAS float* T = (LAS float*)lds;
#pragma unroll
    for (int i = 0; i < 4; ++i) {
        const int idx = tid + 512 * i; const int r = idx >> 5, c4 = idx & 31;
        const v4f v = *(const v4f*)(src + (size_t)(k0 + r) * N + n0 + c4 * 4);
        LAS float* p = T + r * 129 + c4 * 4; p[0] = v.x; p[1] = v.y; p[2] = v.z; p[3] = v.w;
    }
    __syncthreads();
    {
        const int n = tid >> 2, kc = (tid & 3) * 16; unsigned w[8];
#pragma unroll
        for (int j = 0; j < 8; ++j) w[j] = pack2bf(T[(kc + 2 * j) * 129 + n], T[(kc + 2 * j + 1) * 129 + n]);
        bf16_t* d = dst + (size_t)(n0 + n) * KD + k0 + kc;
        *(v4u*)d = make_v4u(w[0], w[1], w[2], w[3]); *(v4u*)(d + 8) = make_v4u(w[4], w[5], w[6], w[7]);
    }
    __syncthreads();
}

__device__ __forceinline__ void p0_tr_tile_fp8(const float* src, int N, unsigned char* dst, int KD, int k0, int n0, LAS unsigned char* lds) {
    const int tid = fresh_tid();
    LAS float* T = (LAS float*)lds;
#pragma unroll
    for (int i = 0; i < 4; ++i) {
        const int idx = tid + 512 * i; const int r = idx >> 5, c4 = idx & 31;
        const v4f v = *(const v4f*)(src + (size_t)(k0 + r) * N + n0 + c4 * 4);
        LAS float* p = T + r * 129 + c4 * 4; p[0] = v.x; p[1] = v.y; p[2] = v.z; p[3] = v.w;
    }
    __syncthreads();
    {
        const int n = tid >> 2, kc = (tid & 3) * 16; unsigned w[4];
#pragma unroll
        for (int j = 0; j < 4; ++j) w[j] = pack4fp8(T[(kc + 4 * j) * 129 + n], T[(kc + 4 * j + 1) * 129 + n], T[(kc + 4 * j + 2) * 129 + n], T[(kc + 4 * j + 3) * 129 + n]);
        *(v4u*)(dst + (size_t)(n0 + n) * KD + k0 + kc) = make_v4u(w[0], w[1], w[2], w[3]);
    }
    __syncthreads();
}

struct TrDesc { const float* src; unsigned char* dst; int N, KD, k0, n0, fp8; };
__device__ __forceinline__ TrDesc p0_tile_desc(ARGS_REF a, int idx) {
    TrDesc d;
    if (idx < 2 * 9984) {
        const int l = idx / 9984; int j = idx - l * 9984; d.fp8 = 0; d.KD = 4096;
        if (j < 6912) { d.src = a.in[7] + (size_t)l * 4096 * INC; d.N = INC; d.dst = a.ws + WS_WIN + (size_t)l * INC * 4096 * 2; d.k0 = (j / 108) * 64; d.n0 = (j % 108) * 128; }
        else if (j < 8960) { j -= 6912; d.src = a.in[23] + (size_t)l * 4096 * 4096; d.N = 4096; d.dst = a.ws + WS_WOUT + (size_t)l * 4096 * 4096 * 2; d.k0 = (j / 32) * 64; d.n0 = (j % 32) * 128; }
        else { j -= 8960; d.src = a.in[25] + (size_t)l * 4096 * PQ; d.N = PQ; d.dst = a.ws + WS_WQ + (size_t)l * PQ * 4096 * 2; d.k0 = (j / 16) * 64; d.n0 = (j % 16) * 128; }
    } else {
        idx -= 2 * 9984; const int l = idx >> 13, j = idx & 8191; d.fp8 = 1; d.KD = PN;
        d.src = a.in[28] + (size_t)l * PN * 4096; d.N = 4096; d.dst = a.ws + WS_VT + (size_t)l * PN * 4096; d.k0 = (j >> 5) * 64; d.n0 = (j & 31) * 128;
    }
    return d;
}
__device__ __forceinline__ void p0_tile_load(const TrDesc& d, int tid, v4f (&r)[4]) {
#pragma unroll
    for (int i = 0; i < 4; ++i) { const int idx = tid + 512 * i; const int rr = idx >> 5, c4 = idx & 31; r[i] = *(const v4f*)(d.src + (size_t)(d.k0 + rr) * d.N + d.n0 + c4 * 4); }
}
__device__ __forceinline__ void p0_prologue(ARGS_REF a, LAS unsigned char* lds, int pmode = 0) {
    const int tid = fresh_tid(); const int G = gridDim.x, bx = blockIdx.x;
    if (pmode == 0 || pmode == 1) for (int it = bx; it < 384; it += G) p0_mod_item(a, it, lds);
    if (pmode == 0 || pmode == 2) for (int it = G - 1 - bx; it < 132; it += G) p0_filter_item(a, it, lds);
    if (pmode == 1 || pmode == 2) return;
    {
        constexpr int NP = (2 * 9984 + 16384) / 2;
        LAS float* T = (LAS float*)lds;
        volatile LAS int* slot = (volatile LAS int*)(lds + MISC_OFF + 64);
        unsigned* ctr = (unsigned*)(a.ws + WS_CTL) + CW_QUEUE + 64 * 40;
        v4f r[2][4], rn[2][4];
        int cur = bx, nxt = bx + G;
        TrDesc d0 = p0_tile_desc(a, cur < NP ? 2 * cur : 0), d1 = p0_tile_desc(a, cur < NP ? 2 * cur + 1 : 1);
        if (cur < NP) { p0_tile_load(d0, tid, r[0]); p0_tile_load(d1, tid, r[1]); }
#pragma unroll 1
        while (cur < NP) {
            TrDesc dn0 = d0, dn1 = d1;
            if (nxt < NP) { dn0 = p0_tile_desc(a, 2 * nxt); dn1 = p0_tile_desc(a, 2 * nxt + 1); p0_tile_load(dn0, tid, rn[0]); p0_tile_load(dn1, tid, rn[1]); }
            if (tid == 0) *slot = 2 * G + (int)atomicAdd(ctr, 1u);
#pragma unroll
            for (int h = 0; h < 2; ++h)
#pragma unroll
                for (int i = 0; i < 4; ++i) { const int idx = tid + 512 * i; const int rr = idx >> 5, c4 = idx & 31; LAS float* p = T + h * (64 * 129) + rr * 129 + c4 * 4; p[0] = r[h][i].x; p[1] = r[h][i].y; p[2] = r[h][i].z; p[3] = r[h][i].w; }
            __syncthreads();
            const int nn = __builtin_amdgcn_readfirstlane(*slot);
#pragma unroll
            for (int h = 0; h < 2; ++h) {
                const TrDesc& d = h ? d1 : d0; const LAS float* Th = T + h * (64 * 129);
                const int n = tid >> 2, kc = (tid & 3) * 16;
                if (d.fp8) {
                    unsigned w[4];
#pragma unroll
                    for (int j = 0; j < 4; ++j) w[j] = pack4fp8(Th[(kc + 4 * j) * 129 + n], Th[(kc + 4 * j + 1) * 129 + n], Th[(kc + 4 * j + 2) * 129 + n], Th[(kc + 4 * j + 3) * 129 + n]);
                    *(v4u*)(d.dst + (size_t)(d.n0 + n) * d.KD + d.k0 + kc) = make_v4u(w[0], w[1], w[2], w[3]);
                } else {
                    unsigned w[8];
#pragma unroll
                    for (int j = 0; j < 8; ++j) w[j] = pack2bf(Th[(kc + 2 * j) * 129 + n], Th[(kc + 2 * j + 1) * 129 + n]);
                    bf16_t* dd = (bf16_t*)d.dst + (size_t)(d.n0 + n) * d.KD + d.k0 + kc;
                    *(v4u*)dd = make_v4u(w[0], w[1], w[2], w[3]); *(v4u*)(dd + 8) = make_v4u(w[4], w[5], w[6], w[7]);
                }
            }
            __syncthreads();
#pragma unroll
            for (int h = 0; h < 2; ++h)
#pragma unroll
                for (int i = 0; i < 4; ++i) r[h][i] = rn[h][i];
            d0 = dn0; d1 = dn1; cur = nxt; nxt = nn;
        }
    }
    for (int it = bx; it < 32; it += G) {
        const float* kp = a.in[26] + (size_t)it * 128 * 128; bf16_t* kh = (bf16_t*)(a.ws + WS_KHL) + (size_t)it * 2 * 128 * 128; bf16_t* kl = kh + 128 * 128;
#pragma unroll
        for (int i = 0; i < 8; ++i) {
            const int idx4 = tid + 512 * i; const v4f x = *(const v4f*)(kp + idx4 * 4);
            const unsigned h01 = pack2bf(x.x, x.y), h23 = pack2bf(x.z, x.w);
            *(v2u*)(kh + idx4 * 4) = make_v2u(h01, h23);
            *(v2u*)(kl + idx4 * 4) = make_v2u(pack2bf(x.x - bflo(h01), x.y - bfhi(h01)), pack2bf(x.z - bflo(h23), x.w - bfhi(h23)));
        }
    }
    {
        const v4f* su = (const v4f*)a.in[27]; unsigned* du = (unsigned*)(a.ws + WS_UB);
        const size_t n4 = (size_t)2 * PN * 4096 / 4, stride = (size_t)G * NTHREADS;
        for (size_t i0 = (size_t)bx * NTHREADS + tid; i0 < n4; i0 += 8 * stride) {
            v4f x[8];
#pragma unroll
            for (int u = 0; u < 8; ++u) { const size_t i = i0 + u * stride; x[u] = su[i < n4 ? i : i0]; }
#pragma unroll
            for (int u = 0; u < 8; ++u) { const size_t i = i0 + u * stride; if (i < n4) du[i] = pack4fp8(x[u].x * U8_SCALE, x[u].y * U8_SCALE, x[u].z * U8_SCALE, x[u].w * U8_SCALE); }
        }
    }
}

__device__ __forceinline__ void norm_phase(ARGS_REF a, int l, int which, int nrows, int tmode = 0, const float* tgate = nullptr, float tsc = 1.0f) {
    const int tid = fresh_tid(), lane = tid & 63, wave = tid >> 6;
    const float* MOD = (const float*)(a.ws + WS_MOD);
    bf16_t* H = (bf16_t*)(a.ws + WS_H);
    const float* g = (which ? a.in[24] : a.in[6]) + l * 4096;
    const bool first = (l == 0 && which == 0);
    for (int row = blockIdx.x * 8 + wave; row < nrows; row += gridDim.x * 8) {
        const float* src; int r;
        if (row < TL) { src = (first ? a.in[0] : (const float*)a.out) + (size_t)row * 4096; r = row >> 12; }
        else { src = ((first || tmode == 1) ? a.in[2] : (const float*)(a.ws + WS_XC)) + (size_t)(row - TL) * 4096; r = 4; }
        const float* shift = MOD + (size_t)(l * 5 + r) * NMOD + (which ? 3 : 0) * 4096; const float* scale = shift + 4096;
        v4f v[16]; float ss = 0.f;
#pragma unroll
        for (int i = 0; i < 16; ++i) { v[i] = ((const v4f*)src)[i * 64 + lane]; ss += v[i].x * v[i].x + v[i].y * v[i].y + v[i].z * v[i].z + v[i].w * v[i].w; }
        if (tmode != 0 && row >= TL) {
            const float* part = (const float*)(a.ws + WS_PART) + (size_t)(row - TL) * 4096; ss = 0.f;
#pragma unroll
            for (int i = 0; i < 16; ++i) {
                const int j = (i * 64 + lane) * 4;
                v4f ps = *(const v4f*)(part + j);
#pragma unroll
                for (int s = 1; s < 4; ++s) ps += *(const v4f*)(part + (size_t)s * TC * 4096 + j);
                v[i] += *(const v4f*)(tgate + j) * tsc * ps;
                ss += v[i].x * v[i].x + v[i].y * v[i].y + v[i].z * v[i].z + v[i].w * v[i].w;
                if (tmode == 1) *(v4f*)((float*)(a.ws + WS_XC) + (size_t)(row - TL) * 4096 + j) = v[i];
            }
        }
        ss = wave_sum(ss);
        const float rs = rsqrtf(ss * (1.0f / 4096.0f) + EPS);
#pragma unroll
        for (int i = 0; i < 16; ++i) {
            const int j = (i * 64 + lane) * 4;
            const v4f gg = *(const v4f*)(g + j), sh = *(const v4f*)(shift + j), scl = *(const v4f*)(scale + j);
            const float o0 = v[i].x * rs * gg.x * (1.0f + scl.x) + sh.x, o1 = v[i].y * rs * gg.y * (1.0f + scl.y) + sh.y;
            const float o2 = v[i].z * rs * gg.z * (1.0f + scl.z) + sh.z, o3 = v[i].w * rs * gg.w * (1.0f + scl.w) + sh.w;
            *(v2u*)(H + (size_t)row * 4096 + j) = make_v2u(pack2bf(o0, o1), pack2bf(o2, o3));
            if (which) *(unsigned*)(a.ws + WS_HF8 + (size_t)row * 4096 + j) = pack4fp8(o0, o1, o2, o3);
        }
    }
}

struct EpiRes {
    static constexpr bool PERM = false, AFTER_DRAIN = false;
    const float* baseL; const float* baseC; float* outL; float* outC; const float* gate; float sc;
    __device__ __forceinline__ void operator()(const pg8::f32x4 (&acc)[2][2][4][2], const pg8::Unit& u, int wr, int wc, int fr, int fq) const {
        const int urow = u.pm * 256, row0 = urow + wr * 64 + fr, col0 = u.pn * 256 + wc * 32 + 4 * fq;
        const int r = urow < TL ? (urow >> 12) : 4;
        const float* bp0 = urow < TL ? baseL + (size_t)row0 * 4096 : baseC + (size_t)(row0 - TL) * 4096;
        float* op0 = urow < TL ? outL + (size_t)row0 * 4096 : outC + (size_t)(row0 - TL) * 4096;
        pg8::f32x4 gv[2][2];
#pragma unroll
        for (int bj = 0; bj < 2; ++bj)
#pragma unroll
            for (int n = 0; n < 2; ++n) gv[bj][n] = *(const pg8::f32x4*)(gate + (size_t)r * NMOD + col0 + bj * 128 + n * 16) * sc;
#pragma unroll
        for (int ai = 0; ai < 2; ++ai)
#pragma unroll
            for (int m2 = 0; m2 < 2; ++m2) {
                pg8::f32x4 bv[2][2][2];
#pragma unroll
                for (int mm = 0; mm < 2; ++mm)
#pragma unroll
                    for (int bj = 0; bj < 2; ++bj)
#pragma unroll
                        for (int n = 0; n < 2; ++n) bv[mm][bj][n] = *(const pg8::f32x4*)(bp0 + (size_t)(ai * 128 + (2 * m2 + mm) * 16) * 4096 + col0 + bj * 128 + n * 16);
                __builtin_amdgcn_sched_barrier(0);
#pragma unroll
                for (int mm = 0; mm < 2; ++mm)
#pragma unroll
                    for (int bj = 0; bj < 2; ++bj)
#pragma unroll
                        for (int n = 0; n < 2; ++n)
                            *(pg8::f32x4*)(op0 + (size_t)(ai * 128 + (2 * m2 + mm) * 16) * 4096 + col0 + bj * 128 + n * 16) = bv[mm][bj][n] + gv[bj][n] * acc[ai][bj][2 * m2 + mm][n];
                __builtin_amdgcn_sched_barrier(0);
            }
    }
};

struct EpiPart {
    static constexpr bool PERM = false, AFTER_DRAIN = false;
    float* P; int ldc, rows, kpb;
    __device__ __forceinline__ void operator()(const pg8::f32x4 (&acc)[2][2][4][2], const pg8::Unit& u, int wr, int wc, int fr, int fq) const {
        float* base = P + (size_t)(u.kb / kpb) * rows * ldc + (size_t)(u.pm * 256 + wr * 64 + fr) * ldc + u.pn * 256 + wc * 32 + 4 * fq;
#pragma unroll
        for (int ai = 0; ai < 2; ++ai)
#pragma unroll
            for (int m = 0; m < 4; ++m)
#pragma unroll
                for (int bj = 0; bj < 2; ++bj)
#pragma unroll
                    for (int n = 0; n < 2; ++n) *(pg8::f32x4*)(base + (size_t)(ai * 128 + m * 16) * ldc + bj * 128 + n * 16) = acc[ai][bj][m][n];
    }
};

struct EpiProj {
    static constexpr bool PERM = true, AFTER_DRAIN = false;
    bf16_t* O; bf16_t* UT;
    __device__ __forceinline__ void operator()(const pg8::f32x4 (&acc)[2][2][4][2], const pg8::Unit& u, int wr, int wc, int fr, int fq) const {
        const int row0 = u.pm * 256 + wr * 64 + fr, colt = u.pn * 256, col0 = colt + wc * 32 + 8 * fq;
        if (colt >= C_HY && colt < C_HY + 3072) {
#pragma unroll
            for (int ai = 0; ai < 2; ++ai)
#pragma unroll
                for (int m = 0; m < 4; ++m) {
                    const int row = row0 + ai * 128 + m * 16;
#pragma unroll
                    for (int bj = 0; bj < 2; ++bj) {
                        const pg8::f32x4 v0 = acc[ai][bj][m][0], v1 = acc[ai][bj][m][1];
                        const unsigned o = (unsigned)(col0 + bj * 128 - C_HY) * (unsigned)MT + (unsigned)row;
                        const unsigned w0 = pack2bf(v0[0], v0[1]), w1 = pack2bf(v0[2], v0[3]), w2 = pack2bf(v1[0], v1[1]), w3 = pack2bf(v1[2], v1[3]);
                        UT[o] = (bf16_t)(w0 & 0xffffu); UT[o + (unsigned)MT] = (bf16_t)(w0 >> 16); UT[o + 2u * (unsigned)MT] = (bf16_t)(w1 & 0xffffu); UT[o + 3u * (unsigned)MT] = (bf16_t)(w1 >> 16);
                        UT[o + 4u * (unsigned)MT] = (bf16_t)(w2 & 0xffffu); UT[o + 5u * (unsigned)MT] = (bf16_t)(w2 >> 16); UT[o + 6u * (unsigned)MT] = (bf16_t)(w3 & 0xffffu); UT[o + 7u * (unsigned)MT] = (bf16_t)(w3 >> 16);
                        __builtin_amdgcn_sched_barrier(0);
                    }
                }
        } else {
#pragma unroll
            for (int ai = 0; ai < 2; ++ai)
#pragma unroll
                for (int m = 0; m < 4; ++m) {
                    bf16_t* rowp = O + (size_t)(row0 + ai * 128 + m * 16) * INC + col0;
#pragma unroll
                    for (int bj = 0; bj < 2; ++bj) {
                        const pg8::f32x4 v0 = acc[ai][bj][m][0], v1 = acc[ai][bj][m][1];
                        *(v4u*)(rowp + bj * 128) = make_v4u(pack2bf(v0[0], v0[1]), pack2bf(v0[2], v0[3]), pack2bf(v1[0], v1[1]), pack2bf(v1[2], v1[3]));
                    }
                }
        }
    }
};

template <int NTN, int PER, int K, int LDA, int LDB, bool SWA = false, bool SWB = false>
__device__ __forceinline__ void mma_lds(const LAS bf16_t* A, const LAS bf16_t* Bt, f32x4_t (&acc)[PER], int wave, int fr, int fq) {
#pragma unroll
    for (int i = 0; i < PER; ++i) {
        const int tt = wave + 8 * i, tm = tt / NTN, tn = tt % NTN;
        const LAS bf16_t* ap = A + (tm * 16 + fr) * LDA + (SWA ? 0 : fq * 8); const LAS bf16_t* bp = Bt + (tn * 16 + fr) * LDB + (SWB ? 0 : fq * 8);
#pragma unroll
        for (int k0 = 0; k0 < K; k0 += 32) {
            const bf16x8_t av = *(const LAS bf16x8_t*)(ap + (SWA ? 8 * (fq ^ (tm & 3)) : 0) + k0);
            const bf16x8_t bv = *(const LAS bf16x8_t*)(bp + (SWB ? 8 * (fq ^ (tn & 3)) : 0) + k0);
            acc[i] = __builtin_amdgcn_mfma_f32_16x16x32_bf16(av, bv, acc[i], 0, 0, 0);
        }
        __builtin_amdgcn_sched_barrier(0);
    }
}

struct RetRaw { v2u qa[2], qb[2]; v2u ka[4], kb[4]; v2u vv[4]; };
__device__ __forceinline__ void ret_fetch(const bf16_t* P, int r0, int h, bool need_q, int tid, RetRaw& R) {
    if (need_q) {
#pragma unroll
        for (int it = 0; it < 2; ++it) {
            const int task = tid + 512 * it; const int t = task >> 4, half = (task >> 3) & 1, i0 = (task & 7) * 4;
            const bf16_t* src = P + (size_t)(r0 + t) * INC + C_RQ + h * 128 + half * 64 + i0;
            R.qa[it] = *(const v2u*)src; R.qb[it] = *(const v2u*)(src + 32);
        }
    }
    {
        const int s4 = tid >> 5, half = (tid >> 4) & 1, iq = (tid >> 1) & 7;
        const bf16_t* src = P + (size_t)(r0 + 4 * s4) * INC + C_RK + h * 128 + half * 64 + 4 * iq;
#pragma unroll
        for (int j = 0; j < 4; ++j) { R.ka[j] = *(const v2u*)(src + (size_t)j * INC); R.kb[j] = *(const v2u*)(src + (size_t)j * INC + 32); }
    }
    {
        const int s4 = tid >> 5, e4 = tid & 31;
        const bf16_t* src = P + (size_t)(r0 + 4 * s4) * INC + C_RV + h * 128 + 4 * e4;
#pragma unroll
        for (int j = 0; j < 4; ++j) R.vv[j] = *(const v2u*)(src + (size_t)j * INC);
    }
}
__device__ __forceinline__ void ret_stage(const RetRaw& R, int pos0, bool need_q, bool do_rope, int dir, float lg, int tid,
                                          LAS bf16_t* Qs, LAS bf16_t* Ks, LAS bf16_t* Ktd, LAS bf16_t* Vt, const LAS v2f* rope) {
    if (need_q) {
#pragma unroll
        for (int it = 0; it < 2; ++it) {
            const int task = tid + 512 * it; const int t = task >> 4, half = (task >> 3) & 1, i0 = (task & 7) * 4;
            const v2u wa = R.qa[it], wb = R.qb[it];
            const float av[4] = {bflo(wa.x), bfhi(wa.x), bflo(wa.y), bfhi(wa.y)}; const float bv[4] = {bflo(wb.x), bfhi(wb.x), bflo(wb.y), bfhi(wb.y)};
            float oa[4], ob[4];
            if (do_rope) {
                const int pos = half ? ((pos0 + t) & 63) : ((pos0 + t) >> 6);
#pragma unroll
                for (int q = 0; q < 4; ++q) { const v2f cs = rope[pos * 32 + i0 + q]; oa[q] = av[q] * cs.x - bv[q] * cs.y; ob[q] = av[q] * cs.y + bv[q] * cs.x; }
            } else {
#pragma unroll
                for (int q = 0; q < 4; ++q) { oa[q] = av[q]; ob[q] = bv[q]; }
            }
            *(LAS v2u*)(Qs + t * 136 + half * 64 + i0) = make_v2u(pack2bf(oa[0], oa[1]), pack2bf(oa[2], oa[3]));
            *(LAS v2u*)(Qs + t * 136 + half * 64 + 32 + i0) = make_v2u(pack2bf(ob[0], ob[1]), pack2bf(ob[2], ob[3]));
        }
    }
    {
        const int s4 = tid >> 5, half = (tid >> 4) & 1, iq = (tid >> 1) & 7, ab = tid & 1;
        float o[4][4];
#pragma unroll
        for (int j = 0; j < 4; ++j) {
            const int t = 4 * s4 + j; const v2u wa = R.ka[j], wb = R.kb[j];
            const float av[4] = {bflo(wa.x) * RET_SCALE, bfhi(wa.x) * RET_SCALE, bflo(wa.y) * RET_SCALE, bfhi(wa.y) * RET_SCALE};
            const float bv[4] = {bflo(wb.x) * RET_SCALE, bfhi(wb.x) * RET_SCALE, bflo(wb.y) * RET_SCALE, bfhi(wb.y) * RET_SCALE};
            if (do_rope) {
                const int pos = half ? ((pos0 + t) & 63) : ((pos0 + t) >> 6);
#pragma unroll
                for (int q = 0; q < 4; ++q) { const v2f cs = rope[pos * 32 + 4 * iq + q]; o[j][q] = ab ? (av[q] * cs.y + bv[q] * cs.x) : (av[q] * cs.x - bv[q] * cs.y); }
            } else {
#pragma unroll
                for (int q = 0; q < 4; ++q) o[j][q] = ab ? bv[q] : av[q];
            }
            if (need_q) *(LAS v2u*)(Ks + t * 136 + half * 64 + ab * 32 + 4 * iq) = make_v2u(pack2bf(o[j][0], o[j][1]), pack2bf(o[j][2], o[j][3]));
        }
        float kd[4];
#pragma unroll
        for (int j = 0; j < 4; ++j) { const int t = 4 * s4 + j; kd[j] = __expf(lg * (float)(dir ? t : 63 - t)); }
#pragma unroll
        for (int q = 0; q < 4; ++q)
            *(LAS v2u*)(Ktd + (half * 64 + ab * 32 + 4 * iq + q) * 72 + 4 * s4) = make_v2u(pack2bf(o[0][q] * kd[0], o[1][q] * kd[1]), pack2bf(o[2][q] * kd[2], o[3][q] * kd[3]));
    }
    {
        const int s4 = tid >> 5, e4 = tid & 31;
        const unsigned r0x = R.vv[0].x, r0y = R.vv[0].y, r1x = R.vv[1].x, r1y = R.vv[1].y, r2x = R.vv[2].x, r2y = R.vv[2].y, r3x = R.vv[3].x, r3y = R.vv[3].y;
        *(LAS v2u*)(Vt + (4 * e4 + 0) * 72 + 8 * ((s4 >> 1) ^ ((e4 >> 2) & 3)) + 4 * (s4 & 1)) = make_v2u((r0x & 0xffffu) | (r1x << 16), (r2x & 0xffffu) | (r3x << 16));
        *(LAS v2u*)(Vt + (4 * e4 + 1) * 72 + 8 * ((s4 >> 1) ^ ((e4 >> 2) & 3)) + 4 * (s4 & 1)) = make_v2u((r0x >> 16) | (r1x & 0xffff0000u), (r2x >> 16) | (r3x & 0xffff0000u));
        *(LAS v2u*)(Vt + (4 * e4 + 2) * 72 + 8 * ((s4 >> 1) ^ ((e4 >> 2) & 3)) + 4 * (s4 & 1)) = make_v2u((r0y & 0xffffu) | (r1y << 16), (r2y & 0xffffu) | (r3y << 16));
        *(LAS v2u*)(Vt + (4 * e4 + 3) * 72 + 8 * ((s4 >> 1) ^ ((e4 >> 2) & 3)) + 4 * (s4 & 1)) = make_v2u((r0y >> 16) | (r1y & 0xffff0000u), (r2y >> 16) | (r3y & 0xffff0000u));
    }
}

__device__ __forceinline__ void ret_item(ARGS_REF a, int l, int b, int h, int dir, bool cstream, LAS unsigned char* lds) {
    const int tid = fresh_tid(), lane = tid & 63, wave = tid >> 6, fr = lane & 15, fq = lane >> 4;
    LAS bf16_t* Qs  = (LAS bf16_t*)(lds);
    LAS bf16_t* Ks  = (LAS bf16_t*)(lds + 17408);
    LAS bf16_t* Ktd = (LAS bf16_t*)(lds + 34816);
    LAS bf16_t* Vt  = (LAS bf16_t*)(lds + 53248);
    LAS bf16_t* St  = (LAS bf16_t*)(lds + 71680);
    LAS float*  Af  = (LAS float*)(lds + 106496);
    LAS bf16_t* Pb  = (LAS bf16_t*)(lds + 123904);
    LAS v2f* rope = (LAS v2f*)(lds + 133120);
    volatile LAS int* slot = (volatile LAS int*)(lds + MISC_OFF + 128);
    const bf16_t* P = (const bf16_t*)(a.ws + WS_PROJ);
    float* OFd = (float*)(a.ws + WS_OF) + (size_t)dir * MT * 1536;
    const int L = cstream ? 256 : 4096, row0 = cstream ? TL + b * 256 : b * 4096, NCH = L / 64, crow0 = TL + b * 256;
    const int n_init = cstream ? 0 : 4, n_steps = n_init + NCH;
    __syncthreads();
    for (int i = tid; i < 2048; i += NTHREADS) {
        const int pos = i >> 5, fi = i & 31; const float inv = exp2f(-(float)fi * (13.287712379549449f / 32.0f));
        const float turns = ((float)pos * inv) * 0.15915494309189535f;
        rope[i] = make_v2f(cos_turns(turns), sin_turns(turns));
    }
    const float lg = -__expf(a.in[19][(l * 2 + dir) * 12 + h]);
    const float cdec = __expf(lg * 64.0f);
    f32x4_t Sacc[8];
#pragma unroll
    for (int i = 0; i < 8; ++i) Sacc[i] = (f32x4_t){0.f, 0.f, 0.f, 0.f};
#pragma unroll
    for (int i = 0; i < 8; ++i) *(LAS v2u*)(St + (wave * 16 + fr) * 136 + i * 16 + fq * 4) = make_v2u(0u, 0u);
    RetRaw R;
    {
        const bool init = 0 < n_init; const int ch = init ? (dir ? 3 : 0) : (dir ? NCH - 1 : 0);
        ret_fetch(P, init ? crow0 + ch * 64 : row0 + ch * 64, h, !init, tid, R);
    }
#pragma unroll 1
    for (int st = 0; st < n_steps; ++st) {
        const bool init = st < n_init; const int cc = init ? st : st - n_init;
        const int ch = init ? (dir ? 3 - cc : cc) : (dir ? NCH - 1 - cc : cc);
        const int r0 = init ? crow0 + ch * 64 : row0 + ch * 64, pos0 = ch * 64;
        __syncthreads();
        ret_stage(R, pos0, !init, !init && !cstream, dir, lg, tid, Qs, Ks, Ktd, Vt, rope);
        if (st + 1 < n_steps) {
            const bool ninit = st + 1 < n_init; const int ncc = ninit ? st + 1 : st + 1 - n_init;
            const int nch = ninit ? (dir ? 3 - ncc : ncc) : (dir ? NCH - 1 - ncc : ncc);
            ret_fetch(P, ninit ? crow0 + nch * 64 : row0 + nch * 64, h, !ninit, tid, R);
        }
        __syncthreads();
        if (init) {
#pragma unroll
            for (int i = 0; i < 8; ++i) Sacc[i] *= cdec;
            mma_lds<8, 8, 64, 72, 72, false, true>(Ktd, Vt, Sacc, wave, fr, fq);
            if (st + 1 == n_init) {
                __syncthreads();
#pragma unroll
                for (int i = 0; i < 8; ++i)
                    *(LAS v2u*)(St + (wave * 16 + fr) * 136 + i * 16 + fq * 4) = make_v2u(pack2bf(Sacc[i][0], Sacc[i][1]), pack2bf(Sacc[i][2], Sacc[i][3]));
            }
            continue;
        }
        {
            f32x4_t sa[2] = {(f32x4_t){0.f, 0.f, 0.f, 0.f}, (f32x4_t){0.f, 0.f, 0.f, 0.f}};
            mma_lds<4, 2, 128, 136, 136>(Qs, Ks, sa, wave, fr, fq);
#pragma unroll
            for (int i = 0; i < 2; ++i) { const int tt = wave + 8 * i, tm = tt >> 2, tn = tt & 3;
#pragma unroll
                for (int r = 0; r < 4; ++r) Af[(tm * 16 + fq * 4 + r) * 68 + tn * 16 + fr] = sa[i][r]; }
        }
        __syncthreads();
        for (int i = tid; i < 4096; i += NTHREADS) {
            const int ii = i >> 6, jj = i & 63; const int dd = dir ? jj - ii : ii - jj;
            const float val = dd >= 0 ? Af[ii * 68 + jj] * __expf(lg * (float)dd) : 0.f;
            Pb[ii * 72 + jj] = f2bf(val);
        }
        __syncthreads();
        f32x4_t o1[4];
#pragma unroll
        for (int i = 0; i < 4; ++i) o1[i] = (f32x4_t){0.f, 0.f, 0.f, 0.f};
        mma_lds<8, 4, 128, 136, 136>(Qs, St, o1, wave, fr, fq);
#pragma unroll
        for (int i = 0; i < 4; ++i) {
            const int tt = wave + 8 * i, tm = tt >> 3;
#pragma unroll
            for (int r = 0; r < 4; ++r) { const int il = tm * 16 + fq * 4 + r; o1[i][r] *= __expf(lg * (float)(dir ? 64 - il : il + 1)); }
        }
        mma_lds<8, 4, 64, 72, 72, false, true>(Pb, Vt, o1, wave, fr, fq);
#pragma unroll
        for (int i = 0; i < 8; ++i) Sacc[i] *= cdec;
        mma_lds<8, 8, 64, 72, 72, false, true>(Ktd, Vt, Sacc, wave, fr, fq);
        __syncthreads();
#pragma unroll
        for (int i = 0; i < 8; ++i)
            *(LAS v2u*)(St + (wave * 16 + fr) * 136 + i * 16 + fq * 4) = make_v2u(pack2bf(Sacc[i][0], Sacc[i][1]), pack2bf(Sacc[i][2], Sacc[i][3]));
#pragma unroll
        for (int i = 0; i < 4; ++i) {
            const int tt = wave + 8 * i, tm = tt >> 3, tn = tt & 7;
#pragma unroll
            for (int r = 0; r < 4; ++r) {
                const int il = tm * 16 + fq * 4 + r, e = tn * 16 + fr;
                __hip_atomic_store(OFd + (size_t)(r0 + il) * 1536 + h * 128 + e, o1[i][r], __ATOMIC_RELAXED, __HIP_MEMORY_SCOPE_AGENT);
            }
        }
    }
    asm volatile("s_waitcnt vmcnt(0)" ::: "memory");
    __syncthreads();
    if (tid == 0) {
        unsigned* cnt = (unsigned*)(a.ws + WS_CTL) + CW_RET + ((l * 2 + (cstream ? 1 : 0)) * 48 + b * 12 + h);
        *slot = (int)__hip_atomic_fetch_add(cnt, 1u, __ATOMIC_RELAXED, __HIP_MEMORY_SCOPE_AGENT);
    }
    __syncthreads();
    if (*slot == 1) {
        __builtin_amdgcn_fence(__ATOMIC_ACQUIRE, "agent");
        const float* OF0 = (const float*)(a.ws + WS_OF); const float* OF1 = OF0 + (size_t)MT * 1536;
        bf16_t* MIX = (bf16_t*)(a.ws + WS_MIX);
#pragma unroll 2
        for (int t = wave; t < L; t += 8) {
            const size_t row = (size_t)(row0 + t);
            const v2f x0 = *(const v2f*)(OF0 + row * 1536 + h * 128 + 2 * lane), x1 = *(const v2f*)(OF1 + row * 1536 + h * 128 + 2 * lane);
            const float y0 = x0.x + x1.x, y1 = x0.y + x1.y;
            const float ss = wave_sum(y0 * y0 + y1 * y1); const float rs = rsqrtf(ss * (1.0f / 128.0f) + EPS);
            const unsigned gw = *(const unsigned*)(P + row * INC + C_RG + h * 128 + 2 * lane);
            *(unsigned*)(MIX + row * 4096 + M_RO + h * 128 + 2 * lane) = pack2bf(y0 * rs * silu_f(bflo(gw)), y1 * rs * silu_f(bfhi(gw)));
        }
    }
    __syncthreads();
}

__device__ __forceinline__ void hy_conv8(const LAS float* U, const LAS float* G, int L, float (&y)[8]) {
    const int tb = 8 * fresh_tid();
#pragma unroll
    for (int j = 0; j < 8; ++j) y[j] = 0.f;
    if (tb < L) {
#pragma unroll 2
        for (int s0 = 0; s0 < L; s0 += 4) {
            const int base = tb - s0 + L;
            const v4f g0 = *(const LAS v4f*)(G + base - 4), g1 = *(const LAS v4f*)(G + base), g2 = *(const LAS v4f*)(G + base + 4);
            const v4f u = *(const LAS v4f*)(U + s0);
            const float g[12] = {g0.x, g0.y, g0.z, g0.w, g1.x, g1.y, g1.z, g1.w, g2.x, g2.y, g2.z, g2.w};
            const float uu[4] = {u.x, u.y, u.z, u.w};
#pragma unroll
            for (int j = 0; j < 8; ++j)
#pragma unroll
                for (int i = 0; i < 4; ++i) y[j] += g[4 + j - i] * uu[i];
        }
    }
}
__device__ __forceinline__ void hyena_item(ARGS_REF a, int l, int c, int b, bool cstream, LAS unsigned char* lds) {
    const int tid = fresh_tid();
    const int L = cstream ? 256 : 4096, row0 = cstream ? TL + b * 256 : b * 4096;
    LAS float* sv = (LAS float*)lds; LAS float* sx1 = sv + L; LAS float* sx2 = sx1 + L; LAS float* sz = sx2 + L; LAS float* G0 = sz + L; LAS float* G1 = G0 + 2 * L;
    const bf16_t* UT = (const bf16_t*)(a.ws + WS_UT);
    bf16_t* MIX = (bf16_t*)(a.ws + WS_MIX);
    const float* cw = a.in[8] + l * 3 * 3072; const float* cb = a.in[9] + l * 3072;
    const float* K = cstream ? (const float*)(a.ws + WS_KTC) : (const float*)(a.ws + WS_KT) + (size_t)l * 4096 * 4096;
    __syncthreads();
    for (int t = tid; t < L; t += NTHREADS) {
#pragma unroll
        for (int which = 0; which < 3; ++which) {
            const int chn = which * 1024 + c; float acc = cb[chn];
#pragma unroll
            for (int i = 0; i < 3; ++i) { const int tt = t + i - 1; if (tt >= 0 && tt < L) acc += cw[i * 3072 + chn] * bf2f(UT[(size_t)chn * MT + row0 + tt]); }
            (which == 0 ? sv : (which == 1 ? sx1 : sx2))[t] = acc;
        }
    }
    for (int i = tid; i < 2 * L; i += NTHREADS) {
        const int d = i - L;
        const size_t cf0 = (size_t)(0 * 1024 + c) * L, cb0 = (size_t)(1 * 1024 + c) * L, cf1 = (size_t)(2 * 1024 + c) * L, cb1 = (size_t)(3 * 1024 + c) * L;
        float v0 = 0.f, v1 = 0.f;
        if (d >= 0) { v0 = K[cf0 + d]; v1 = K[cf1 + d]; } else if (d > -L) { v0 = K[cb0 - d]; v1 = K[cb1 - d]; }
        G0[i] = v0; G1[i] = v1;
    }
    __syncthreads();
    const float skip0 = a.in[18][(l * 2 + 0) * 1024 + c], skip1 = a.in[18][(l * 2 + 1) * 1024 + c];
    float y[8];
    hy_conv8(sv, G0, L, y);
    if (8 * tid < L) {
#pragma unroll
        for (int j = 0; j < 8; ++j) { const int t = 8 * tid + j; sz[t] = sx1[t] * (y[j] + skip0 * sv[t]); }
    }
    __syncthreads();
    hy_conv8(sz, G1, L, y);
    if (8 * tid < L) {
#pragma unroll
        for (int j = 0; j < 8; ++j) { const int t = 8 * tid + j; MIX[(size_t)(row0 + t) * 4096 + M_HY + c] = f2bf(sx2[t] * (y[j] + skip1 * sz[t])); }
    }
    __syncthreads();
}


#define HY_DEV __device__ __forceinline__
#define HY_LDS LAS
__device__ __forceinline__ float hy_cos_turns(float t) { return __builtin_amdgcn_cosf(t); }
__device__ __forceinline__ float hy_sin_turns(float t) { return __builtin_amdgcn_sinf(t); }

#define HY_CPX_DEFINED
typedef float cpx __attribute__((ext_vector_type(2)));
__device__ __forceinline__ cpx cmk(float x, float y) { return (cpx){x, y}; }
#ifndef HY_CPX_DEFINED
struct __attribute__((aligned(8))) cpx { float x, y; };
HY_DEV cpx cmk(float x, float y) { cpx r; r.x = x; r.y = y; return r; }
#endif
HY_DEV cpx cadd(cpx a, cpx b) { return cmk(a.x + b.x, a.y + b.y); }
HY_DEV cpx csub(cpx a, cpx b) { return cmk(a.x - b.x, a.y - b.y); }
HY_DEV cpx cmul(cpx a, cpx b) { return cmk(a.x * b.x - a.y * b.y, a.x * b.y + a.y * b.x); }
HY_DEV cpx cmuli(cpx a, bool inv) { return inv ? cmk(-a.y, a.x) : cmk(a.y, -a.x); }
constexpr int HY_N = 8192, HY_BUFN = 8192 + 256;
HY_DEV int hy_pad(int p) { return p + (p >> 5); }
HY_DEV int hy_freq(int p) { return (p >> 9) | (((p >> 5) & 15) << 4) | (((p >> 1) & 15) << 8) | ((p & 1) << 12); }
HY_DEV int hy_pos(int w) { return ((w & 15) << 9) | (((w >> 4) & 15) << 5) | (((w >> 8) & 15) << 1) | (w >> 12); }

template <bool INV> HY_DEV void dft16(cpx (&x)[16]) {
    const float C1 = 0.92387953251128674f, S1 = 0.38268343236508977f, R2 = 0.70710678118654752f;
    cpx u[4][4];
#pragma unroll
    for (int b = 0; b < 4; ++b) {
        const cpx t0 = cadd(x[b], x[8 + b]), t1 = csub(x[b], x[8 + b]), t2 = cadd(x[4 + b], x[12 + b]), t3 = cmuli(csub(x[4 + b], x[12 + b]), INV);
        u[b][0] = cadd(t0, t2); u[b][2] = csub(t0, t2); u[b][1] = cadd(t1, t3); u[b][3] = csub(t1, t3);
    }
    const float sg = INV ? 1.0f : -1.0f;
    u[1][1] = cmul(u[1][1], cmk(C1, sg * S1));  u[1][2] = cmul(u[1][2], cmk(R2, sg * R2));  u[1][3] = cmul(u[1][3], cmk(S1, sg * C1));
    u[2][1] = cmul(u[2][1], cmk(R2, sg * R2));  u[2][2] = cmuli(u[2][2], INV);              u[2][3] = cmul(u[2][3], cmk(-R2, sg * R2));
    u[3][1] = cmul(u[3][1], cmk(S1, sg * C1));  u[3][2] = cmul(u[3][2], cmk(-R2, sg * R2)); u[3][3] = cmul(u[3][3], cmk(-C1, -sg * S1));
#pragma unroll
    for (int c = 0; c < 4; ++c) {
        const cpx t0 = cadd(u[0][c], u[2][c]), t1 = csub(u[0][c], u[2][c]), t2 = cadd(u[1][c], u[3][c]), t3 = cmuli(csub(u[1][c], u[3][c]), INV);
        x[c] = cadd(t0, t2); x[c + 8] = csub(t0, t2); x[c + 4] = cadd(t1, t3); x[c + 12] = csub(t1, t3);
    }
}
template <bool INV> HY_DEV void hy_twiddle(cpx (&x)[16], int j, int n) {
    const float turns = (float)j / (float)n;
    const cpx w1 = cmk(hy_cos_turns(turns), INV ? hy_sin_turns(turns) : -hy_sin_turns(turns));
    cpx w = w1;
#pragma unroll
    for (int q = 1; q < 16; ++q) { x[q] = cmul(x[q], w); w = cmul(w, w1); }
}
template <bool LOAD> HY_DEV void hy_fwd16(int tid, int n, HY_LDS cpx* Z, cpx (&x)[16]) {
    const int m = n >> 4, blk = tid / m, j = tid - blk * m, base = blk * n + j;
    const int bp = hy_pad(base), S = m + (m >> 5);
    if (LOAD) {
#pragma unroll
        for (int k = 0; k < 16; ++k) x[k] = Z[bp + k * S];
    }
    dft16<false>(x);
    hy_twiddle<false>(x, j, n);
#pragma unroll
    for (int q = 0; q < 16; ++q) Z[bp + q * S] = x[q];
}
template <bool STORE> HY_DEV void hy_inv16(int tid, int n, HY_LDS cpx* Z, cpx (&x)[16]) {
    const int m = n >> 4, blk = tid / m, j = tid - blk * m, base = blk * n + j;
    const int bp = hy_pad(base), S = m + (m >> 5);
#pragma unroll
    for (int q = 0; q < 16; ++q) x[q] = Z[bp + q * S];
    hy_twiddle<true>(x, j, n);
    dft16<true>(x);
    if (STORE) {
#pragma unroll
        for (int k = 0; k < 16; ++k) Z[bp + k * S] = x[k];
    }
}
HY_DEV void hy_fwd2(int tid, HY_LDS cpx* Z) {
#pragma unroll
    for (int i = 0; i < 8; ++i) { const int pp = 16 * tid + (tid >> 1) + 2 * i; const cpx a = Z[pp], b = Z[pp + 1]; Z[pp] = cadd(a, b); Z[pp + 1] = csub(a, b); }
}
HY_DEV cpx hy_kfilter(const HY_LDS cpx* F, int p, int order) {
    const int w = hy_freq(p); const cpx A = F[hy_pad(p)], B = F[hy_pad(hy_pos((HY_N - w) & (HY_N - 1)))];
    return order == 0 ? cmk(0.5f * (A.x + B.x), 0.5f * (A.y - B.y)) : cmk(0.5f * (A.y + B.y), -0.5f * (A.x - B.x));
}
HY_DEV void hy_mid(int tid, HY_LDS cpx* Z, const HY_LDS cpx* F, int order, float scale) {
#pragma unroll
    for (int i = 0; i < 8; ++i) {
        const int p0 = 16 * tid + 2 * i, pp = p0 + (tid >> 1); const cpx a = Z[pp], b = Z[pp + 1];
        cpx k0 = hy_kfilter(F, p0, order), k1 = hy_kfilter(F, p0 + 1, order);
        k0.x *= scale; k0.y *= scale; k1.x *= scale; k1.y *= scale;
        const cpx y0 = cmul(cadd(a, b), k0), y1 = cmul(csub(a, b), k1);
        Z[pp] = cadd(y0, y1); Z[pp + 1] = csub(y0, y1);
    }
}
__device__ __forceinline__ void hy_conv_fft(LAS cpx* Z, const LAS cpx* F, int order, cpx (&x)[16], int pmode = 0) {
    if (pmode == 1) return;
    hy_fwd16<false>(fresh_tid(), 8192, Z, x); __syncthreads();
    hy_fwd16<true>(fresh_tid(), 512, Z, x); __syncthreads();
    hy_fwd16<true>(fresh_tid(), 32, Z, x); __syncthreads();
    hy_mid(fresh_tid(), Z, F, order, 1.0f / 8192.0f); __syncthreads();
    hy_inv16<true>(fresh_tid(), 32, Z, x); __syncthreads();
    hy_inv16<true>(fresh_tid(), 512, Z, x); __syncthreads();
    hy_inv16<false>(fresh_tid(), 8192, Z, x);
}
__device__ __forceinline__ void hy_load_short(const bf16_t* U0, const bf16_t* U1, float w0, float w1, float w2, float bias, int tid, cpx (&o)[8]) {
    const int lane = tid & 63, tb = tid - lane;
    unsigned c0[8], c1[8], e0[8], e1[8];
#pragma unroll
    for (int k = 0; k < 8; ++k) {
        const int t = tid + 512 * k, ter = (lane < 32) ? (tb + 512 * k - 1) : (tb + 512 * k + 64), te = ter < 0 ? 0 : (ter > 4095 ? 4095 : ter);
        c0[k] = U0[t]; c1[k] = U1[t]; e0[k] = U0[te]; e1[k] = U1[te];
    }
#pragma unroll
    for (int k = 0; k < 8; ++k) {
        const int ter = (lane < 32) ? (tb + 512 * k - 1) : (tb + 512 * k + 64); const bool ev = (ter >= 0) && (ter <= 4095);
        const unsigned m0 = ev ? e0[k] : 0u, m1 = ev ? e1[k] : 0u;
        const unsigned l0 = (unsigned)__builtin_amdgcn_update_dpp((int)m0, (int)c0[k], 0x138, 0xf, 0xf, false), r0 = (unsigned)__builtin_amdgcn_update_dpp((int)m0, (int)c0[k], 0x130, 0xf, 0xf, false);
        const unsigned l1 = (unsigned)__builtin_amdgcn_update_dpp((int)m1, (int)c1[k], 0x138, 0xf, 0xf, false), r1 = (unsigned)__builtin_amdgcn_update_dpp((int)m1, (int)c1[k], 0x130, 0xf, 0xf, false);
        o[k] = cmk(bias + w0 * bf2f((bf16_t)l0) + w1 * bf2f((bf16_t)c0[k]) + w2 * bf2f((bf16_t)r0), bias + w0 * bf2f((bf16_t)l1) + w1 * bf2f((bf16_t)c1[k]) + w2 * bf2f((bf16_t)r1));
    }
}
__device__ __forceinline__ void hyena_fft_item(ARGS_REF a, int l, int c4, LAS unsigned char* lds, int pmode = 0) {
    LAS cpx* F = (LAS cpx*)lds; LAS cpx* Z = F + HY_BUFN;
    const bf16_t* UT = (const bf16_t*)(a.ws + WS_UT);
    bf16_t* MIX = (bf16_t*)(a.ws + WS_MIX);
    const float* cw = a.in[8] + l * 3 * 3072; const float* cb = a.in[9] + l * 3072;
    const float* K = (const float*)(a.ws + WS_KT) + (size_t)l * 4096 * 4096;
    unsigned olo[2][8][2], ohi[2][8][2];
#pragma unroll
    for (int i = 0; i < 2; ++i)
#pragma unroll
        for (int k = 0; k < 8; ++k) { olo[i][k][0] = 0u; olo[i][k][1] = 0u; ohi[i][k][0] = 0u; ohi[i][k][1] = 0u; }
#pragma unroll 1
    for (int ci = 0; ci < 4; ++ci) {
        const int c = 4 * c4 + ci;
        const float skip0 = a.in[18][(l * 2 + 0) * 1024 + c], skip1 = a.in[18][(l * 2 + 1) * 1024 + c];
        __syncthreads();
        cpx x[16];
        {
            const int tid = fresh_tid();
            const float* kf0 = K + (size_t)(0 * 1024 + c) * 4096; const float* kb0 = K + (size_t)(1 * 1024 + c) * 4096;
            const float* kf1 = K + (size_t)(2 * 1024 + c) * 4096; const float* kb1 = K + (size_t)(3 * 1024 + c) * 4096;
#pragma unroll
            for (int k = 0; k < 8; ++k) x[k] = cmk(kf0[tid + 512 * k], kf1[tid + 512 * k]);
#pragma unroll
            for (int k = 8; k < 16; ++k) { const int i = tid + 512 * k; const int ii = (i == 4096) ? 1 : 8192 - i; const cpx v = cmk(kb0[ii], kb1[ii]); x[k] = (i == 4096) ? cmk(0.f, 0.f) : v; }
            hy_fwd16<false>(fresh_tid(), 8192, F, x); __syncthreads();
            hy_fwd16<true>(fresh_tid(), 512, F, x); __syncthreads();
            hy_fwd16<true>(fresh_tid(), 32, F, x); __syncthreads();
            hy_fwd2(fresh_tid(), F); __syncthreads();
        }
#pragma unroll
        for (int bp = 0; bp < 2; ++bp) {
            const int rb0 = (2 * bp) * 4096, rb1 = (2 * bp + 1) * 4096;
            unsigned vvp[8], z1p[8];
            {
                cpx vv[8];
                const int chn = c; hy_load_short(UT + (size_t)chn * MT + rb0, UT + (size_t)chn * MT + rb1, cw[chn], cw[3072 + chn], cw[2 * 3072 + chn], cb[chn], fresh_tid(), vv);
#pragma unroll
                for (int k = 0; k < 8; ++k) { x[k] = vv[k]; x[k + 8] = cmk(0.f, 0.f); vvp[k] = pack2bf(vv[k].x, vv[k].y); }
            }
            hy_conv_fft(Z, F, 0, x, pmode);
            {
                cpx x1v[8];
                const int chn = 1024 + c; hy_load_short(UT + (size_t)chn * MT + rb0, UT + (size_t)chn * MT + rb1, cw[chn], cw[3072 + chn], cw[2 * 3072 + chn], cb[chn], fresh_tid(), x1v);
#pragma unroll
                for (int k = 0; k < 8; ++k) {
                    const cpx z = cmk(x1v[k].x * (x[k].x + skip0 * bflo(vvp[k])), x1v[k].y * (x[k].y + skip0 * bfhi(vvp[k])));
                    x[k] = z; x[k + 8] = cmk(0.f, 0.f); z1p[k] = pack2bf(z.x, z.y);
                }
            }
            __syncthreads();
            hy_conv_fft(Z, F, 1, x, pmode);
            {
                cpx x2v[8];
                const int chn = 2048 + c; hy_load_short(UT + (size_t)chn * MT + rb0, UT + (size_t)chn * MT + rb1, cw[chn], cw[3072 + chn], cw[2 * 3072 + chn], cb[chn], fresh_tid(), x2v);
                const unsigned sh = (ci & 1) ? 16u : 0u;
#pragma unroll
                for (int k = 0; k < 8; ++k) {
                    const unsigned w0 = (unsigned)f2bf(x2v[k].x * (x[k].x + skip1 * bflo(z1p[k]))) << sh, w1 = (unsigned)f2bf(x2v[k].y * (x[k].y + skip1 * bfhi(z1p[k]))) << sh;
                    if (ci < 2) { olo[bp][k][0] |= w0; olo[bp][k][1] |= w1; } else { ohi[bp][k][0] |= w0; ohi[bp][k][1] |= w1; }
                }
            }
            __syncthreads();
        }
    }
    if (pmode == 0 || pmode == 3) {
        const int tid = fresh_tid();
#pragma unroll
        for (int bp = 0; bp < 2; ++bp)
#pragma unroll
            for (int k = 0; k < 8; ++k) {
                const int t = tid + 512 * k;
                *(v2u*)(MIX + (size_t)((2 * bp) * 4096 + t) * 4096 + M_HY + 4 * c4) = make_v2u(olo[bp][k][0], ohi[bp][k][0]);
                *(v2u*)(MIX + (size_t)((2 * bp + 1) * 4096 + t) * 4096 + M_HY + 4 * c4) = make_v2u(olo[bp][k][1], ohi[bp][k][1]);
            }
    }
}

__device__ __forceinline__ void hy_ctx_conv2(const LAS float* U, const LAS float* G, int t2, float (&y)[2]) {
    y[0] = 0.f; y[1] = 0.f;
#pragma unroll 4
    for (int s0 = 0; s0 < 256; s0 += 4) {
        const int base = t2 - s0 + 256; const v4f u = *(const LAS v4f*)(U + s0);
        const float g0 = G[base - 3], g1 = G[base - 2], g2 = G[base - 1], g3 = G[base], g4 = G[base + 1];
        y[0] += g3 * u.x + g2 * u.y + g1 * u.z + g0 * u.w;
        y[1] += g4 * u.x + g3 * u.y + g2 * u.z + g1 * u.w;
    }
}
__device__ __forceinline__ void hyena_ctx_item(ARGS_REF a, int l, int c, LAS unsigned char* lds) {
    const int tid = fresh_tid();
    LAS float* G0 = (LAS float*)lds; LAS float* G1 = G0 + 512;
    LAS float* sv = G1 + 512; LAS float* sx1 = sv + 1024; LAS float* sx2 = sx1 + 1024; LAS float* sz = sx2 + 1024;
    const bf16_t* UT = (const bf16_t*)(a.ws + WS_UT);
    bf16_t* MIX = (bf16_t*)(a.ws + WS_MIX);
    const float* cw = a.in[8] + l * 3 * 3072; const float* cb = a.in[9] + l * 3072;
    const float* K = (const float*)(a.ws + WS_KTC);
    __syncthreads();
#pragma unroll
    for (int i = 0; i < 2; ++i) {
        const int idx = tid + 512 * i; const int b = idx >> 8, t = idx & 255, tm = t > 0 ? t - 1 : 0, tp = t < 255 ? t + 1 : 255;
        const float m0 = t > 0 ? 1.f : 0.f, m2 = t < 255 ? 1.f : 0.f;
#pragma unroll
        for (int which = 0; which < 3; ++which) {
            const int chn = which * 1024 + c; const bf16_t* U = UT + (size_t)chn * MT + TL + b * 256;
            const float val = cb[chn] + cw[chn] * m0 * bf2f(U[tm]) + cw[3072 + chn] * bf2f(U[t]) + cw[2 * 3072 + chn] * m2 * bf2f(U[tp]);
            (which == 0 ? sv : (which == 1 ? sx1 : sx2))[idx] = val;
        }
    }
    {
        const int d = tid - 256, dd = d >= 0 ? d : -d, ok = (d > -256) ? 1 : 0;
        const float f0 = K[(size_t)(0 * 1024 + c) * 256 + dd], b0 = K[(size_t)(1 * 1024 + c) * 256 + dd], f1 = K[(size_t)(2 * 1024 + c) * 256 + dd], b1 = K[(size_t)(3 * 1024 + c) * 256 + dd];
        G0[tid] = ok ? (d >= 0 ? f0 : b0) : 0.f; G1[tid] = ok ? (d >= 0 ? f1 : b1) : 0.f;
    }
    __syncthreads();
    const float skip0 = a.in[18][(l * 2 + 0) * 1024 + c], skip1 = a.in[18][(l * 2 + 1) * 1024 + c];
    const int b = tid >> 7, t2 = (tid & 127) * 2;
    float y[2];
    hy_ctx_conv2(sv + b * 256, G0, t2, y);
    sz[b * 256 + t2] = sx1[b * 256 + t2] * (y[0] + skip0 * sv[b * 256 + t2]); sz[b * 256 + t2 + 1] = sx1[b * 256 + t2 + 1] * (y[1] + skip0 * sv[b * 256 + t2 + 1]);
    __syncthreads();
    hy_ctx_conv2(sz + b * 256, G1, t2, y);
    MIX[(size_t)(TL + b * 256 + t2) * 4096 + M_HY + c] = f2bf(sx2[b * 256 + t2] * (y[0] + skip1 * sz[b * 256 + t2]));
    MIX[(size_t)(TL + b * 256 + t2 + 1) * 4096 + M_HY + c] = f2bf(sx2[b * 256 + t2 + 1] * (y[1] + skip1 * sz[b * 256 + t2 + 1]));
    __syncthreads();
}

struct NaRaw { v4u k[4]; v2u v[2][4]; };
__device__ __forceinline__ void na_fetch(const bf16_t* P, int krow0, int h, int tid, NaRaw& R) {
#pragma unroll
    for (int i = 0; i < 4; ++i) { const int idx = tid + 512 * i; const int kr = idx >> 4, c8 = idx & 15; R.k[i] = *(const v4u*)(P + (size_t)(krow0 + kr) * INC + C_NK + h * 128 + c8 * 8); }
#pragma unroll
    for (int it = 0; it < 2; ++it) {
        const int task = tid + 512 * it; const int s4 = task >> 5, e4 = task & 31;
        const bf16_t* src = P + (size_t)(krow0 + 4 * s4) * INC + C_NV + h * 128 + 4 * e4;
#pragma unroll
        for (int j = 0; j < 4; ++j) R.v[it][j] = *(const v2u*)(src + (size_t)j * INC);
    }
}
__device__ __forceinline__ void na_stage(const NaRaw& R, int tid, LAS bf16_t* Kb, LAS bf16_t* Vt) {
#pragma unroll
    for (int i = 0; i < 4; ++i) { const int idx = tid + 512 * i; const int kr = idx >> 4, c8 = idx & 15; *(LAS v4u*)(Kb + kr * 136 + c8 * 8) = R.k[i]; }
#pragma unroll
    for (int it = 0; it < 2; ++it) {
        const int task = tid + 512 * it; const int s4 = task >> 5, e4 = task & 31, sw = s4 ^ (e4 >> 2);
        const unsigned r0x = R.v[it][0].x, r0y = R.v[it][0].y, r1x = R.v[it][1].x, r1y = R.v[it][1].y, r2x = R.v[it][2].x, r2y = R.v[it][2].y, r3x = R.v[it][3].x, r3y = R.v[it][3].y;
        *(LAS v2u*)(Vt + (4 * e4 + 0) * 136 + 4 * sw) = make_v2u((r0x & 0xffffu) | (r1x << 16), (r2x & 0xffffu) | (r3x << 16));
        *(LAS v2u*)(Vt + (4 * e4 + 1) * 136 + 4 * sw) = make_v2u((r0x >> 16) | (r1x & 0xffff0000u), (r2x >> 16) | (r3x & 0xffff0000u));
        *(LAS v2u*)(Vt + (4 * e4 + 2) * 136 + 4 * sw) = make_v2u((r0y & 0xffffu) | (r1y << 16), (r2y & 0xffffu) | (r3y << 16));
        *(LAS v2u*)(Vt + (4 * e4 + 3) * 136 + 4 * sw) = make_v2u((r0y >> 16) | (r1y & 0xffff0000u), (r2y >> 16) | (r3y & 0xffff0000u));
    }
}
__device__ __forceinline__ void na_item(ARGS_REF a, int l, int b, int h, int r, bool cstream, LAS unsigned char* lds, int pmode = 0) {
    const int tid = fresh_tid(), lane = tid & 63, wave = tid >> 6, fr = lane & 15, fq = lane >> 4;
    LAS bf16_t* Qs = (LAS bf16_t*)lds;
    LAS bf16_t* Kb = (LAS bf16_t*)(lds + 17408);
    LAS bf16_t* Vt = (LAS bf16_t*)(lds + 52224);
    LAS float*  Sf = (LAS float*)(lds + 87040);
    LAS bf16_t* Pb = (LAS bf16_t*)(lds + 120832);
    LAS float*  rk = (LAS float*)(lds + 138240);
    LAS float*  st_m = rk + 128;
    LAS float*  st_l = st_m + 64;
    LAS float*  st_a = st_l + 64;
    LAS float*  rpbs = st_a + 64;
    const bf16_t* P = (const bf16_t*)(a.ws + WS_PROJ);
    bf16_t* MIX = (bf16_t*)(a.ws + WS_MIX);
    const int qrow0 = cstream ? TL + b * 256 + r * 64 : b * 4096 + r * 64;
    const float* gq = a.in[21] + l * 128; const float* gk = a.in[22] + l * 128;
    const float* rpb = a.in[20] + (size_t)(l * 12 + h) * 15 * 31;
    const int nloc = cstream ? 0 : 4, start = clampi(r - 4, 0, 56), nsteps = nloc + 2;
    NaRaw R;
    na_fetch(P, cstream ? TL + b * 256 : b * 4096 + start * 64, h, tid, R);
    __syncthreads();
#pragma unroll 1
    for (int qq = 0; qq < 8; ++qq) {
        const int q = wave * 8 + qq; const bf16_t* p = P + (size_t)(qrow0 + q) * INC + C_NQ + h * 128;
        const unsigned w = *(const unsigned*)(p + 2 * lane); const float x0 = bflo(w), x1 = bfhi(w);
        const float ss = wave_sum(x0 * x0 + x1 * x1); const float rs = rsqrtf(ss * (1.0f / 128.0f) + EPS) * RET_SCALE;
        *(LAS unsigned*)(Qs + q * 136 + 2 * lane) = pack2bf(x0 * rs * gq[2 * lane] * gk[2 * lane], x1 * rs * gq[2 * lane + 1] * gk[2 * lane + 1]);
    }
    if (tid < 64) { st_m[tid] = -1.0e30f; st_l[tid] = 0.f; }
    if (tid < 465) rpbs[tid] = rpb[tid];
    f32x4_t O[4];
#pragma unroll
    for (int i = 0; i < 4; ++i) O[i] = (f32x4_t){0.f, 0.f, 0.f, 0.f};
#pragma unroll 1
    for (int st = 0; st < nsteps; ++st) {
        const bool local = st < nloc;
        __syncthreads();
        na_stage(R, tid, Kb, Vt);
        if (st + 1 < nsteps) { const bool nl = st + 1 < nloc; na_fetch(P, nl ? b * 4096 + (start + 2 * (st + 1)) * 64 : TL + b * 256 + (st + 1 - nloc) * 128, h, tid, R); }
        __syncthreads();
        if (pmode == 4) continue;
        {
            const int key = tid >> 2, part = tid & 3; float ss = 0.f;
#pragma unroll
            for (int i = 0; i < 4; ++i) { const v4u w = *(const LAS v4u*)(Kb + key * 136 + part * 32 + i * 8);
                ss += bflo(w.x) * bflo(w.x) + bfhi(w.x) * bfhi(w.x) + bflo(w.y) * bflo(w.y) + bfhi(w.y) * bfhi(w.y) + bflo(w.z) * bflo(w.z) + bfhi(w.z) * bfhi(w.z) + bflo(w.w) * bflo(w.w) + bfhi(w.w) * bfhi(w.w); }
            ss += WAVE_DPP(ss, 0xB1); ss += WAVE_DPP(ss, 0x4E);
            if (part == 0) rk[key] = rsqrtf(ss * (1.0f / 128.0f) + EPS);
            f32x4_t sa[4];
#pragma unroll
            for (int i = 0; i < 4; ++i) sa[i] = (f32x4_t){0.f, 0.f, 0.f, 0.f};
            mma_lds<8, 4, 128, 136, 136>(Qs, Kb, sa, wave, fr, fq);
#pragma unroll
            for (int i = 0; i < 4; ++i)
#pragma unroll
                for (int rr = 0; rr < 4; ++rr) Sf[(i * 16 + fq * 4 + rr) * 132 + wave * 16 + fr] = sa[i][rr];
        }
        __syncthreads();
        if (pmode == 5) continue;
        {
            const int q = tid >> 3, part = tid & 7, col0 = part * 16;
            float s[16]; float mx = -1.0e30f;
            if (local) {
                const int cs = clampi(q - 8, 0, 48), kc0 = (part & 3) * 16, ridx = start + 2 * st + (part >> 2) - r + 7;
#pragma unroll
                for (int j4 = 0; j4 < 4; ++j4) {
                    const v4f sv = *(const LAS v4f*)(Sf + q * 132 + col0 + 4 * j4), kv = *(const LAS v4f*)(rk + col0 + 4 * j4);
#pragma unroll
                    for (int jj = 0; jj < 4; ++jj) {
                        const int kc = kc0 + 4 * j4 + jj; const bool ok = (kc >= cs) && (kc < cs + 16);
                        const float v = sv[jj] * kv[jj] + rpbs[ridx * 31 + clampi(kc - q + 15, 0, 30)];
                        s[4 * j4 + jj] = ok ? v : -1.0e30f; mx = fmaxf(mx, s[4 * j4 + jj]);
                    }
                }
            } else {
#pragma unroll
                for (int j4 = 0; j4 < 4; ++j4) {
                    const v4f sv = *(const LAS v4f*)(Sf + q * 132 + col0 + 4 * j4), kv = *(const LAS v4f*)(rk + col0 + 4 * j4);
#pragma unroll
                    for (int jj = 0; jj < 4; ++jj) { s[4 * j4 + jj] = sv[jj] * kv[jj]; mx = fmaxf(mx, s[4 * j4 + jj]); }
                }
            }
            mx = fmaxf(mx, WAVE_DPP(mx, 0xB1)); mx = fmaxf(mx, WAVE_DPP(mx, 0x4E)); mx = fmaxf(mx, WAVE_DPP(mx, 0x141));
            const float mo = st_m[q], mn = fmaxf(mo, mx);
            float sum = 0.f; unsigned pw[8];
#pragma unroll
            for (int j2 = 0; j2 < 8; ++j2) { const float p0 = __expf(s[2 * j2] - mn), p1 = __expf(s[2 * j2 + 1] - mn); sum += p0 + p1; pw[j2] = pack2bf(p0, p1); }
            *(LAS v4u*)(Pb + q * 136 + col0) = make_v4u(pw[0], pw[1], pw[2], pw[3]); *(LAS v4u*)(Pb + q * 136 + col0 + 8) = make_v4u(pw[4], pw[5], pw[6], pw[7]);
            sum += WAVE_DPP(sum, 0xB1); sum += WAVE_DPP(sum, 0x4E); sum += WAVE_DPP(sum, 0x141);
            const float al = __expf(mo - mn);
            if (part == 0) { st_m[q] = mn; st_l[q] = st_l[q] * al + sum; st_a[q] = al; }
        }
        __syncthreads();
        if (pmode == 6) continue;
#pragma unroll
        for (int i = 0; i < 4; ++i)
#pragma unroll
            for (int rr = 0; rr < 4; ++rr) O[i][rr] *= st_a[i * 16 + fq * 4 + rr];
        mma_lds<8, 4, 128, 136, 136>(Pb, Vt, O, wave, fr, fq);
    }
    __syncthreads();
    if (pmode >= 4) return;
#pragma unroll
    for (int i = 0; i < 4; ++i)
#pragma unroll
        for (int rr = 0; rr < 4; ++rr) { const int q = i * 16 + fq * 4 + rr; MIX[(size_t)(qrow0 + q) * 4096 + M_NO + h * 128 + wave * 16 + fr] = f2bf(O[i][rr] / st_l[q]); }
    __syncthreads();
}

__device__ __forceinline__ void na2_fetch(const bf16_t* P, int rowA, int rowB, int h, int tid, NaRaw& R) {
#pragma unroll
    for (int i = 0; i < 4; ++i) { const int idx = tid + 512 * i; const int kr = idx >> 4, c8 = idx & 15; const int row = kr < 64 ? rowA + kr : rowB + kr - 64;
        R.k[i] = *(const v4u*)(P + (size_t)row * INC + C_NK + h * 128 + c8 * 8); }
#pragma unroll
    for (int it = 0; it < 2; ++it) {
        const int task = tid + 512 * it; const int s4 = task >> 5, e4 = task & 31; const int r0 = 4 * s4, row = r0 < 64 ? rowA + r0 : rowB + r0 - 64;
        const bf16_t* src = P + (size_t)row * INC + C_NV + h * 128 + 4 * e4;
#pragma unroll
        for (int j = 0; j < 4; ++j) R.v[it][j] = *(const v2u*)(src + (size_t)j * INC);
    }
}
__device__ __forceinline__ void na2_item(ARGS_REF a, int l, int b, int h, int rp, bool cstream, LAS unsigned char* lds, int namode = 0) {
    const int tid = fresh_tid(), lane = tid & 63, wave = tid >> 6, fr = lane & 15, fq = lane >> 4;
    LAS bf16_t* Qs = (LAS bf16_t*)lds;
    LAS bf16_t* Kb = (LAS bf16_t*)(lds + 34816);
    LAS bf16_t* Vt = (LAS bf16_t*)(lds + 69632);
    LAS float*  rk = (LAS float*)(lds + 104448);
    LAS float*  rpbs = rk + 128;
    LAS float*  alx = rpbs + 480;
    const bf16_t* P = (const bf16_t*)(a.ws + WS_PROJ);
    bf16_t* MIX = (bf16_t*)(a.ws + WS_MIX);
    const float* gqp = a.in[21] + l * 128; const float* gkp = a.in[22] + l * 128;
    const float* rpb = a.in[20] + (size_t)(l * 12 + h) * 15 * 31;
    const int r0 = 2 * rp, start0 = clampi(r0 - 4, 0, 56), start1 = clampi(r0 - 3, 0, 56);
    const int nloc = cstream ? 0 : ((start1 + 9 - start0) >> 1), nsteps = nloc + 2;
    const int qb0 = cstream ? TL + b * 256 + rp * 128 + 16 * wave : b * 4096 + r0 * 64 + 8 * wave;
#define NA2_QTOK(j) (cstream ? qb0 + (j) : qb0 + ((j) >> 3) * 64 + ((j) & 7))
    const int rq = r0 + (fr >> 3), startq = (fr < 8) ? start0 : start1, qcol = 8 * wave + (fr & 7), cs = clampi(qcol - 8, 0, 48);
    const int wu = __builtin_amdgcn_readfirstlane(wave), tlo = wu <= 2 ? 0 : (wu <= 4 ? 1 : 2);
#define NA2_ROWA(s) ((s) < nloc ? b * 4096 + (start0 + 2 * (s) < 63 ? start0 + 2 * (s) : 63) * 64 : TL + b * 256 + ((s) - nloc) * 128)
#define NA2_ROWB(s) ((s) < nloc ? b * 4096 + (start0 + 2 * (s) + 1 < 63 ? start0 + 2 * (s) + 1 : 63) * 64 : TL + b * 256 + ((s) - nloc) * 128 + 64)
    NaRaw R;
    na2_fetch(P, NA2_ROWA(0), NA2_ROWB(0), h, tid, R);
    __syncthreads();
    if (tid < 465) rpbs[tid] = rpb[tid];
    {
        const v4f g0 = *(const v4f*)(gqp + 8 * fr), g1 = *(const v4f*)(gqp + 8 * fr + 4), k0 = *(const v4f*)(gkp + 8 * fr), k1 = *(const v4f*)(gkp + 8 * fr + 4);
#pragma unroll
        for (int it = 0; it < 4; ++it) {
            const int j = it * 4 + fq; const v4u w = *(const v4u*)(P + (size_t)NA2_QTOK(j) * INC + C_NQ + h * 128 + 8 * fr);
            const float x0 = bflo(w.x), x1 = bfhi(w.x), x2 = bflo(w.y), x3 = bfhi(w.y), x4 = bflo(w.z), x5 = bfhi(w.z), x6 = bflo(w.w), x7 = bfhi(w.w);
            float ss = (x0 * x0 + x1 * x1) + (x2 * x2 + x3 * x3) + (x4 * x4 + x5 * x5) + (x6 * x6 + x7 * x7);
            ss += WAVE_DPP(ss, 0xB1); ss += WAVE_DPP(ss, 0x4E); ss += WAVE_DPP(ss, 0x141); ss += WAVE_DPP(ss, 0x140);
            const float rs = rsqrtf(ss * (1.0f / 128.0f) + EPS) * RET_SCALE;
            *(LAS v4u*)(Qs + (16 * wave + j) * 136 + 8 * fr) = make_v4u(pack2bf(x0 * rs * g0.x * k0.x, x1 * rs * g0.y * k0.y), pack2bf(x2 * rs * g0.z * k0.z, x3 * rs * g0.w * k0.w),
                                                                          pack2bf(x4 * rs * g1.x * k1.x, x5 * rs * g1.y * k1.y), pack2bf(x6 * rs * g1.z * k1.z, x7 * rs * g1.w * k1.w));
        }
    }
    bf16x8_t qf[4];
#pragma unroll
    for (int ks = 0; ks < 4; ++ks) qf[ks] = *(const LAS bf16x8_t*)(Qs + (16 * wave + fr) * 136 + 8 * fq + 32 * ks);
    float m_run = -1.0e30f, l_run = 0.f;
    f32x4_t O[8];
#pragma unroll
    for (int i = 0; i < 8; ++i) O[i] = (f32x4_t){0.f, 0.f, 0.f, 0.f};
#pragma unroll 1
    for (int st = 0; st < nsteps; ++st) {
        const bool local = st < nloc; const int kra = start0 + 2 * st;
        __syncthreads();
        na_stage(R, tid, Kb, Vt);
#pragma unroll
        for (int i = 0; i < 4; ++i) {
            const v4u w = R.k[i];
            float ss = (bflo(w.x) * bflo(w.x) + bfhi(w.x) * bfhi(w.x)) + (bflo(w.y) * bflo(w.y) + bfhi(w.y) * bfhi(w.y)) + (bflo(w.z) * bflo(w.z) + bfhi(w.z) * bfhi(w.z)) + (bflo(w.w) * bflo(w.w) + bfhi(w.w) * bfhi(w.w));
            ss += WAVE_DPP(ss, 0xB1); ss += WAVE_DPP(ss, 0x4E); ss += WAVE_DPP(ss, 0x141); ss += WAVE_DPP(ss, 0x140);
            if (fr == 0) rk[(tid + 512 * i) >> 4] = rsqrtf(ss * (1.0f / 128.0f) + EPS);
        }
        if (st + 1 < nsteps && namode != 1) na2_fetch(P, NA2_ROWA(st + 1), NA2_ROWB(st + 1), h, tid, R);
        __syncthreads();
        if (namode == 3) continue;
        if (local) {
        f32x4_t sa[4];
#pragma unroll
        for (int u = 0; u < 4; ++u) {
            const int t = 4 * (u >> 1) + tlo + (u & 1);
            sa[u] = (f32x4_t){0.f, 0.f, 0.f, 0.f};
#pragma unroll
            for (int ks = 0; ks < 4; ++ks) sa[u] = __builtin_amdgcn_mfma_f32_16x16x32_bf16(*(const LAS bf16x8_t*)(Kb + (16 * t + fr) * 136 + 8 * fq + 32 * ks), qf[ks], sa[u], 0, 0, 0);
        }
        float mx = -1.0e30f;
#pragma unroll
        for (int u = 0; u < 4; ++u) {
            const int t = 4 * (u >> 1) + tlo + (u & 1);
            const v4f kv = *(const LAS v4f*)(rk + 16 * t + 4 * fq);
#pragma unroll
            for (int rr = 0; rr < 4; ++rr) {
                float v = sa[u][rr] * kv[rr];
                const int kr = kra + (u >> 1), kc = 16 * (tlo + (u & 1)) + 4 * fq + rr;
                const bool ok = (kr >= startq) && (kr <= startq + 7) && (kc >= cs) && (kc < cs + 16);
                v += rpbs[clampi(kr - rq + 7, 0, 14) * 31 + clampi(kc - qcol + 15, 0, 30)];
                v = ok ? v : -1.0e30f; sa[u][rr] = v; mx = fmaxf(mx, v);
            }
        }
        mx = fmaxf(mx, __shfl_xor(mx, 16)); mx = fmaxf(mx, __shfl_xor(mx, 32));
        const float mn = fmaxf(m_run, mx), al = __expf(m_run - mn); m_run = mn;
        float sum = 0.f; bf16x8_t pf[2];
#pragma unroll
        for (int s2 = 0; s2 < 2; ++s2) {
            const float p0 = __expf(sa[2 * s2][0] - mn), p1 = __expf(sa[2 * s2][1] - mn), p2 = __expf(sa[2 * s2][2] - mn), p3 = __expf(sa[2 * s2][3] - mn);
            const float p4 = __expf(sa[2 * s2 + 1][0] - mn), p5 = __expf(sa[2 * s2 + 1][1] - mn), p6 = __expf(sa[2 * s2 + 1][2] - mn), p7 = __expf(sa[2 * s2 + 1][3] - mn);
            sum += ((p0 + p1) + (p2 + p3)) + ((p4 + p5) + (p6 + p7));
            pf[s2] = __builtin_bit_cast(bf16x8_t, make_v4u(pack2bf(p0, p1), pack2bf(p2, p3), pack2bf(p4, p5), pack2bf(p6, p7)));
        }
        sum += __shfl_xor(sum, 16); sum += __shfl_xor(sum, 32);
        l_run = l_run * al + sum;
        if (fq == 0) alx[wave * 16 + fr] = al;
        const v4f a4 = *(const LAS v4f*)(alx + wave * 16 + 4 * fq);
#pragma unroll
        for (int te = 0; te < 8; ++te) {
#pragma unroll
            for (int rr = 0; rr < 4; ++rr) O[te][rr] *= a4[rr];
#pragma unroll
            for (int s2 = 0; s2 < 2; ++s2) {
                const v2u lo = *(const LAS v2u*)(Vt + (16 * te + fr) * 136 + 64 * s2 + 4 * ((4 * tlo + fq) ^ te)), hi = *(const LAS v2u*)(Vt + (16 * te + fr) * 136 + 64 * s2 + 4 * ((4 * tlo + 4 + fq) ^ te));
                O[te] = __builtin_amdgcn_mfma_f32_16x16x32_bf16(pf[s2], __builtin_bit_cast(bf16x8_t, make_v4u(lo.x, lo.y, hi.x, hi.y)), O[te], 0, 0, 0);
            }
        }
        } else {
        f32x4_t sa[8];
#pragma unroll
        for (int t = 0; t < 8; ++t) {
            sa[t] = (f32x4_t){0.f, 0.f, 0.f, 0.f};
#pragma unroll
            for (int ks = 0; ks < 4; ++ks) sa[t] = __builtin_amdgcn_mfma_f32_16x16x32_bf16(*(const LAS bf16x8_t*)(Kb + (16 * t + fr) * 136 + 8 * fq + 32 * ks), qf[ks], sa[t], 0, 0, 0);
        }
        float mx = -1.0e30f;
#pragma unroll
        for (int t = 0; t < 8; ++t) {
            const v4f kv = *(const LAS v4f*)(rk + 16 * t + 4 * fq);
#pragma unroll
            for (int rr = 0; rr < 4; ++rr) {
                const float v = sa[t][rr] * kv[rr];
                sa[t][rr] = v; mx = fmaxf(mx, v);
            }
        }
        mx = fmaxf(mx, __shfl_xor(mx, 16)); mx = fmaxf(mx, __shfl_xor(mx, 32));
        const float mn = fmaxf(m_run, mx), al = __expf(m_run - mn); m_run = mn;
        float sum = 0.f; bf16x8_t pf[4];
#pragma unroll
        for (int s4 = 0; s4 < 4; ++s4) {
            const float p0 = __expf(sa[2 * s4][0] - mn), p1 = __expf(sa[2 * s4][1] - mn), p2 = __expf(sa[2 * s4][2] - mn), p3 = __expf(sa[2 * s4][3] - mn);
            const float p4 = __expf(sa[2 * s4 + 1][0] - mn), p5 = __expf(sa[2 * s4 + 1][1] - mn), p6 = __expf(sa[2 * s4 + 1][2] - mn), p7 = __expf(sa[2 * s4 + 1][3] - mn);
            sum += ((p0 + p1) + (p2 + p3)) + ((p4 + p5) + (p6 + p7));
            pf[s4] = __builtin_bit_cast(bf16x8_t, make_v4u(pack2bf(p0, p1), pack2bf(p2, p3), pack2bf(p4, p5), pack2bf(p6, p7)));
        }
        sum += __shfl_xor(sum, 16); sum += __shfl_xor(sum, 32);
        l_run = l_run * al + sum;
        if (fq == 0) alx[wave * 16 + fr] = al;
        const v4f a4 = *(const LAS v4f*)(alx + wave * 16 + 4 * fq);
#pragma unroll
        for (int te = 0; te < 8; ++te) {
#pragma unroll
            for (int rr = 0; rr < 4; ++rr) O[te][rr] *= a4[rr];
#pragma unroll
            for (int s4 = 0; s4 < 4; ++s4) {
                const v2u lo = *(const LAS v2u*)(Vt + (16 * te + fr) * 136 + 32 * s4 + 4 * (fq ^ te)), hi = *(const LAS v2u*)(Vt + (16 * te + fr) * 136 + 32 * s4 + 4 * ((4 + fq) ^ te));
                O[te] = __builtin_amdgcn_mfma_f32_16x16x32_bf16(pf[s4], __builtin_bit_cast(bf16x8_t, make_v4u(lo.x, lo.y, hi.x, hi.y)), O[te], 0, 0, 0);
            }
        }

        }
    }
    if (fq == 0) alx[wave * 16 + fr] = l_run;
    {
        const v4f l4 = *(const LAS v4f*)(alx + wave * 16 + 4 * fq);
#pragma unroll
        for (int te = 0; te < 8; ++te)
#pragma unroll
            for (int rr = 0; rr < 4; ++rr) MIX[(size_t)NA2_QTOK(4 * fq + rr) * 4096 + M_NO + h * 128 + 16 * te + fr] = f2bf(O[te][rr] / l4[rr]);
    }
#undef NA2_ROWA
#undef NA2_ROWB
#undef NA2_QTOK
}

__device__ __forceinline__ void mixer_phase(ARGS_REF a, int l, LAS unsigned char* lds, unsigned* qctr, unsigned* nactr, int cls_mask = 7, int pmode = 0, int namode = 0) {
    volatile LAS int* slot = (volatile LAS int*)(lds + MISC_OFF + 64);
    const int n_ret = (l == 0) ? 192 : 96, n_hy = (l == 0) ? 256 + 1024 : 256;
    const int n_zero = (l == 0) ? MT / 32 : 0;
    const int total = n_ret + n_hy + n_zero;
    for (;;) {
        __syncthreads();
        if (fresh_tid() == 0) *slot = (int)atomicAdd(qctr, 1u);
        __syncthreads();
        int it = *slot;
        if (it >= total) break;
#ifndef NO_RET
        if (it < n_ret) { if (!(cls_mask & 1)) continue; const bool cs = it >= 96; const int j = cs ? it - 96 : it; ret_item(a, l, (j >> 1) / 12, (j >> 1) % 12, j & 1, cs, lds); continue; }
#endif
        it -= n_ret;
#ifndef NO_HY
        if (it < n_hy) { if (!(cls_mask & 2)) continue; if (it < 256) hyena_fft_item(a, l, it, lds, pmode); else { if (pmode) continue; hyena_ctx_item(a, l, it - 256, lds); } continue; }
#endif
        it -= n_hy;
        if (!(cls_mask & 4) || pmode) continue;
        {
            v4u* zp = (v4u*)(a.ws + WS_GA + (size_t)it * 32 * PN * 2); const v4u z = make_v4u(0u, 0u, 0u, 0u); const int t_ = fresh_tid();
#pragma unroll 8
            for (int i = 0; i < 128; ++i) zp[i * NTHREADS + t_] = z;
        }
    }
#ifndef NO_NA
    if (!(cls_mask & 4) || pmode) return;
    const int x0 = (int)(xb_xcc_id() & 7u), len = 192 + ((l == 0) ? 12 : 0);
#pragma unroll 1
    for (int k = 0; k < 8; ++k) {
        const int x = (x0 + k) & 7;
        for (;;) {
            __syncthreads();
            if (fresh_tid() == 0) *slot = (int)atomicAdd(nactr + 64 * x, 1u);
            __syncthreads();
            const int idx = *slot;
            if (idx >= len) break;
            const bool cs = idx >= 192; const int j = cs ? idx - 192 : idx;
            const int g = x + 8 * (cs ? (j >> 1) : (j >> 5)), rp = cs ? (j & 1) : (j & 31);
            na2_item(a, l, g / 12, g % 12, rp, cs, lds, namode);
        }
    }
#endif
}

__device__ __forceinline__ unsigned mono_key(float x) { const unsigned u = __float_as_uint(x); return (u & 0x80000000u) ? ~u : (u | 0x80000000u); }
__device__ __forceinline__ int lanes_below(unsigned long long m) { return (int)__builtin_amdgcn_mbcnt_hi((unsigned)(m >> 32), __builtin_amdgcn_mbcnt_lo((unsigned)m, 0u)); }
struct SelRaw { v4u kh[4], kl[4]; v4f q[2]; };
__device__ __forceinline__ void sel_fetch(ARGS_REF a, int l, int tile, int h, int p, int tid, SelRaw& R) {
    const bf16_t* kh = (const bf16_t*)(a.ws + WS_KHL) + (size_t)((l * 8 + h) * 2 + p) * 2 * 128 * 128; const bf16_t* kl = kh + 128 * 128;
    const float* Qb = (const float*)(a.ws + WS_Q);
    const int row0 = tile * 32;
#pragma unroll
    for (int i = 0; i < 4; ++i) { const int idx8 = tid + 512 * i; R.kh[i] = *(const v4u*)(kh + idx8 * 8); R.kl[i] = *(const v4u*)(kl + idx8 * 8); }
#pragma unroll
    for (int i = 0; i < 2; ++i) {
        const int idx4 = tid + 512 * i; const int t = idx4 >> 5, k4 = (idx4 & 31) * 4;
        v4f x;
        if (row0 < TL || l != 0) x = *(const v4f*)(Qb + (size_t)(row0 + t) * PQ + h * 256 + p * 128 + k4);
        else {
            const float* pp = (const float*)(a.ws + WS_PART) + (size_t)(row0 - TL + t) * PQ + h * 256 + p * 128 + k4;
            x = *(const v4f*)pp;
#pragma unroll
            for (int s = 1; s < 8; ++s) x += *(const v4f*)(pp + (size_t)s * TC * PQ);
        }
        R.q[i] = x;
    }
}
__device__ __forceinline__ void sel_stage(const SelRaw& R, int tid, LAS bf16_t* Qh, LAS bf16_t* Ql, LAS bf16_t* Kh, LAS bf16_t* Kl) {
#pragma unroll
    for (int i = 0; i < 4; ++i) { const int idx8 = tid + 512 * i; const int n = idx8 >> 4, k8 = (idx8 & 15) * 8; *(LAS v4u*)(Kh + n * 136 + k8) = R.kh[i]; *(LAS v4u*)(Kl + n * 136 + k8) = R.kl[i]; }
#pragma unroll
    for (int i = 0; i < 2; ++i) {
        const int idx4 = tid + 512 * i; const int t = idx4 >> 5, k4 = (idx4 & 31) * 4; const v4f x = R.q[i];
        const unsigned h01 = pack2bf(x.x, x.y), h23 = pack2bf(x.z, x.w);
        *(LAS v2u*)(Qh + t * 136 + k4) = make_v2u(h01, h23);
        *(LAS v2u*)(Ql + t * 136 + k4) = make_v2u(pack2bf(x.x - bflo(h01), x.y - bfhi(h01)), pack2bf(x.z - bflo(h23), x.w - bfhi(h23)));
    }
}
__device__ __forceinline__ void peer_select_phase(ARGS_REF a, int l, int nrows, LAS unsigned char* lds) {
    const int nit = (nrows / 32) * 8, G = gridDim.x;
    if ((int)blockIdx.x >= nit) return;
    SelRaw R;
    sel_fetch(a, l, (int)blockIdx.x >> 3, (int)blockIdx.x & 7, 0, fresh_tid(), R);
#pragma unroll 1
    for (int it = blockIdx.x; it < nit; it += G) {
    const int tile = it >> 3, h = it & 7;
    const int tid = fresh_tid(), lane = tid & 63, wave = tid >> 6, fr = lane & 15, fq = lane >> 4;
    LAS bf16_t* Qh = (LAS bf16_t*)lds;
    LAS bf16_t* Ql = Qh + 32 * 136;
    LAS bf16_t* Kh = Ql + 32 * 136;
    LAS bf16_t* Kl = Kh + 128 * 136;
    LAS float* Ss = (LAS float*)(Kl + 128 * 136);
    LAS float* tops = Ss + 64 * 129;
    LAS int* topi = (LAS int*)(tops + 64 * 16);
    LAS float* GL = (LAS float*)(topi + 64 * 16);
    LAS int* EL = (LAS int*)(GL + 32 * 16);
    const float* Qb = (const float*)(a.ws + WS_Q);
    unsigned* GA32 = (unsigned*)(a.ws + WS_GA);
    const int row0 = tile * 32;
#pragma unroll 1
    for (int p = 0; p < 2; ++p) {
        __syncthreads();
        sel_stage(R, tid, Qh, Ql, Kh, Kl);
        if (p == 0) sel_fetch(a, l, tile, h, 1, tid, R);
        else if (it + G < nit) sel_fetch(a, l, (it + G) >> 3, (it + G) & 7, 0, tid, R);
        __syncthreads();
        f32x4_t sa[2] = {(f32x4_t){0.f, 0.f, 0.f, 0.f}, (f32x4_t){0.f, 0.f, 0.f, 0.f}};
        mma_lds<8, 2, 128, 136, 136>(Ql, Kh, sa, wave, fr, fq);
        mma_lds<8, 2, 128, 136, 136>(Qh, Kl, sa, wave, fr, fq);
        mma_lds<8, 2, 128, 136, 136>(Qh, Kh, sa, wave, fr, fq);
#pragma unroll
        for (int i = 0; i < 2; ++i)
#pragma unroll
            for (int r = 0; r < 4; ++r) Ss[((i * 16 + fq * 4 + r) * 2 + p) * 129 + wave * 16 + fr] = sa[i][r];
    }
    __syncthreads();
    {
        float v0[8], v1[8]; unsigned k0[8], k1[8], T[8]; int ex[8];
#pragma unroll
        for (int rr = 0; rr < 8; ++rr) {
            const int row = wave * 8 + rr; v0[rr] = Ss[row * 129 + lane]; v1[rr] = Ss[row * 129 + lane + 64];
            k0[rr] = (mono_key(v0[rr]) & ~127u) | (unsigned)(127 - lane); k1[rr] = (mono_key(v1[rr]) & ~127u) | (unsigned)(63 - lane); T[rr] = 0u; ex[rr] = 0;
        }
#pragma unroll 1
        for (int bit = 31; bit >= 0; --bit) {
            int fin = 1;
#pragma unroll
            for (int g = 0; g < 2; ++g) {
                unsigned c[4]; unsigned long long ma[4], mb[4]; int cnt[4];
#pragma unroll
                for (int rr = 0; rr < 4; ++rr) c[rr] = T[4 * g + rr] | (1u << bit);
#pragma unroll
                for (int rr = 0; rr < 4; ++rr) { ma[rr] = __ballot(k0[4 * g + rr] >= c[rr]); mb[rr] = __ballot(k1[4 * g + rr] >= c[rr]); }
                __builtin_amdgcn_sched_barrier(0);
#pragma unroll
                for (int rr = 0; rr < 4; ++rr) cnt[rr] = __popcll(ma[rr]) + __popcll(mb[rr]);
                __builtin_amdgcn_sched_barrier(0);
#pragma unroll
                for (int rr = 0; rr < 4; ++rr) { T[4 * g + rr] = cnt[rr] >= 16 ? c[rr] : T[4 * g + rr]; ex[4 * g + rr] |= (cnt[rr] == 16) ? 1 : 0; fin &= ex[4 * g + rr]; }
                __builtin_amdgcn_sched_barrier(0);
            }
            if (fin) break;
        }
#pragma unroll
        for (int rr = 0; rr < 8; ++rr) {
            const int row = wave * 8 + rr; const bool s0 = k0[rr] >= T[rr], s1 = k1[rr] >= T[rr];
            const unsigned long long m0 = __ballot(s0), m1 = __ballot(s1);
            const int p0 = lanes_below(m0), p1 = __popcll(m0) + lanes_below(m1);
            if (s0 && p0 < 16) { tops[row * 16 + p0] = v0[rr]; topi[row * 16 + p0] = lane; }
            if (s1 && p1 < 16) { tops[row * 16 + p1] = v1[rr]; topi[row * 16 + p1] = lane + 64; }
        }
    }
    __syncthreads();
    {
        float cv[4][4]; unsigned ck[4][4], T[4]; int exb[4];
#pragma unroll
        for (int tt = 0; tt < 4; ++tt) {
            const int t = wave * 4 + tt; const int r0 = (t * 2) * 16, r1 = (t * 2 + 1) * 16;
#pragma unroll
            for (int j = 0; j < 4; ++j) { const int ci = lane * 4 + j; cv[tt][j] = tops[r0 + (ci >> 4)] + tops[r1 + (ci & 15)]; ck[tt][j] = (mono_key(cv[tt][j]) & ~255u) | (unsigned)(255 - ci); }
            T[tt] = 0u; exb[tt] = 0;
        }
#pragma unroll 1
        for (int bit = 31; bit >= 0; --bit) {
            int fin = 1;
#pragma unroll
            for (int g = 0; g < 2; ++g) {
                unsigned c[2]; unsigned long long mm[2][4]; int cnt[2];
#pragma unroll
                for (int tt = 0; tt < 2; ++tt) c[tt] = T[2 * g + tt] | (1u << bit);
#pragma unroll
                for (int tt = 0; tt < 2; ++tt)
#pragma unroll
                    for (int j = 0; j < 4; ++j) mm[tt][j] = __ballot(ck[2 * g + tt][j] >= c[tt]);
                __builtin_amdgcn_sched_barrier(0);
#pragma unroll
                for (int tt = 0; tt < 2; ++tt) cnt[tt] = (__popcll(mm[tt][0]) + __popcll(mm[tt][1])) + (__popcll(mm[tt][2]) + __popcll(mm[tt][3]));
                __builtin_amdgcn_sched_barrier(0);
#pragma unroll
                for (int tt = 0; tt < 2; ++tt) { T[2 * g + tt] = cnt[tt] >= 16 ? c[tt] : T[2 * g + tt]; exb[2 * g + tt] |= (cnt[tt] == 16) ? 1 : 0; fin &= exb[2 * g + tt]; }
                __builtin_amdgcn_sched_barrier(0);
            }
            if (fin) break;
        }
#pragma unroll
        for (int tt = 0; tt < 4; ++tt) {
            const int t = wave * 4 + tt; const int r0 = (t * 2) * 16, r1 = (t * 2 + 1) * 16; int base = 0;
#pragma unroll
            for (int j = 0; j < 4; ++j) {
                const bool sel = ck[tt][j] >= T[tt]; const unsigned long long m = __ballot(sel); const int pos = base + lanes_below(m); base += __popcll(m);
                if (sel && pos < 16) { const int ci = lane * 4 + j; EL[t * 16 + pos] = topi[r0 + (ci >> 4)] * 128 + topi[r1 + (ci & 15)]; GL[t * 16 + pos] = cv[tt][j]; }
            }
        }
        {
            const int t = wave * 4 + fq; const float sv = GL[t * 16 + fr]; const int eid = EL[t * 16 + fr];
            float m = sv;
#pragma unroll
            for (int o = 8; o >= 1; o >>= 1) m = fmaxf(m, __shfl_xor(m, o));
            const float e = __expf(sv - m); float s = e;
#pragma unroll
            for (int o = 8; o >= 1; o >>= 1) s += __shfl_xor(s, o);
            const unsigned gb = (unsigned)f2bf(e / s);
            typedef short s2v __attribute__((ext_vector_type(2)));
            const s2v val = __builtin_bit_cast(s2v, (eid & 1) ? (gb << 16) : gb);
            __builtin_amdgcn_global_atomic_fadd_v2bf16((__attribute__((address_space(1))) s2v*)(GA32 + (((size_t)(row0 + t) * PN + eid) >> 1)), val);
        }
    }
    }
}

struct EpiGate {
    static constexpr bool PERM = true, AFTER_DRAIN = false;
    bf16_t* GM; unsigned char* GA8; int ldc; float sc;
    __device__ __forceinline__ void operator()(const pg8::f32x4 (&acc)[2][2][4][2], const pg8::Unit& u, int wr, int wc, int fr, int fq) const {
        const int row0 = u.pm * 256 + wr * 64 + fr, col0 = u.pn * 256 + wc * 32 + 8 * fq;
#pragma unroll
        for (int ai = 0; ai < 2; ++ai) {
            v4u gm[4][2];
#pragma unroll
            for (int m = 0; m < 4; ++m)
#pragma unroll
                for (int bj = 0; bj < 2; ++bj) gm[m][bj] = *(const v4u*)(GM + (size_t)(row0 + ai * 128 + m * 16) * ldc + col0 + bj * 128);
            __builtin_amdgcn_sched_barrier(0);
#pragma unroll
            for (int m = 0; m < 4; ++m) {
                const size_t ro = (size_t)(row0 + ai * 128 + m * 16) * ldc + col0;
#pragma unroll
                for (int bj = 0; bj < 2; ++bj) {
                    const v4u g = gm[m][bj];
                    float o[8];
#pragma unroll
                    for (int e = 0; e < 8; ++e) {
                        const unsigned gw = (e >> 1) == 0 ? g.x : ((e >> 1) == 1 ? g.y : ((e >> 1) == 2 ? g.z : g.w));
                        const unsigned gb = (e & 1) ? (gw & 0xffff0000u) : (gw << 16);
                        o[e] = 0.f;
                        if (__ballot(gb != 0u) != 0ull) o[e] = A8_SCALE * __uint_as_float(gb) * gelu_tanh_f(acc[ai][bj][m][e >> 2][e & 3] * sc);
                    }
                    if ((g.x | g.y | g.z | g.w) != 0u) *(v4u*)(GM + ro + bj * 128) = make_v4u(0u, 0u, 0u, 0u);
                    *(v2u*)(GA8 + ro + bj * 128) = make_v2u(pack4fp8(o[0], o[1], o[2], o[3]), pack4fp8(o[4], o[5], o[6], o[7]));
                }
            }
        }
    }
};

constexpr int N_PHASES = 19;
__global__ void __launch_bounds__(NTHREADS, 2) fwd_kernel(Args a) {
    extern __shared__ __attribute__((aligned(16))) unsigned char lds_raw[];
    LAS unsigned char* lds = (LAS unsigned char*)lds_raw;
    const int tid = threadIdx.x;
    const KARG Args* ap0 = (const KARG Args*)__builtin_amdgcn_kernarg_segment_ptr();
#define FRESH(name) const KARG Args* name = ap0; asm volatile("" : "+s"(name))
    const int lo = ap0->ph_lo, hi = ap0->ph_hi;
    unsigned* ctl = (unsigned*)(ap0->ws + WS_CTL);
    const bool fused = (hi - lo) > 1;
    if (tid < 64) ((LAS unsigned*)(lds + MISC_OFF))[tid] = 0u;
    __syncthreads();
    XcdBarrier bar; bar.bar = ctl + CW_BAR; bar.x = 0; bar.st = (volatile LAS unsigned*)(lds + MISC_OFF);
    if (fused) bar = xcd_barrier_post(ctl + CW_BAR, (volatile LAS unsigned*)(lds + MISC_OFF));
#define IN(k) (lo <= (k) && (k) < hi)
#if defined(ONLY)
#define EN(x) ((ONLY) == (x))
#elif defined(DISABLE)
#define EN(x) (!(((DISABLE) >> (x)) & 1))
#else
#define EN(x) 1
#endif
#ifndef DUP
#define DUP 0
#endif
#ifndef DUPMIX
#define DUPMIX 7
#endif
#ifndef SELMODE
#define SELMODE 0
#endif
#ifndef NAMODE
#define NAMODE 0
#endif
#ifndef HYMODE
#define HYMODE 0
#endif
#ifndef P0MODE
#define P0MODE 0
#endif
#ifndef WGM_IN
#define WGM_IN 8
#endif
#ifndef WGM_OUT
#define WGM_OUT 4
#endif
#ifndef WGM_Q
#define WGM_Q 4
#endif
#ifndef WGM_P1
#define WGM_P1 4
#endif
#ifndef WGM_P2
#define WGM_P2 4
#endif
#define NREP(x) ((((DUP) >> (x)) & 1) ? 2 : 1)
#define REPBAR(x) do { if (rep + 1 < NREP(x)) xcd_barrier(bar); } while (0)
#define SEAM(k) do { if (IN(k) && IN((k) + 1)) xcd_barrier(bar); } while (0)

    if (EN(0) && IN(0)) for (int rep = 0; rep < NREP(0); ++rep) { FRESH(ap); p0_prologue(*ap, lds, rep ? P0MODE : 0); REPBAR(0); }
    SEAM(0);
#pragma unroll 1
    for (int l = 0; l < 2; ++l) {
        const int pb = 1 + 9 * l;
        const int nrows = (l == 0) ? MT : TL;
        if (EN(1) && IN(pb + 0)) for (int rep = 0; rep < NREP(1); ++rep) { FRESH(ap); if (l == 1) norm_phase(*ap, l, 0, MT, 2, (const float*)(ap->ws + WS_MOD) + (size_t)4 * NMOD + 5 * 4096, 1.0f / A8_SCALE); else norm_phase(*ap, l, 0, MT); REPBAR(1); }
        SEAM(pb + 0);
        if (EN(2) && IN(pb + 1)) for (int rep = 0; rep < NREP(2); ++rep) {
            FRESH(ap); ARGS_REF a = *ap;
            pg8::Gemm g{(const bf16_t*)(a.ws + WS_H), (const bf16_t*)(a.ws + WS_WIN) + (size_t)l * INC * 4096, MT, INC, D};
            pg8::TwoPartOrder S; S.init(TL, TC, INC, l == 0 ? INC / 256 : 6144 / 256, (int)gridDim.x, (int)blockIdx.x, WGM_IN);
            EpiProj E{(bf16_t*)(a.ws + WS_PROJ), (bf16_t*)(a.ws + WS_UT)};
            pg8::gemm_phase<EpiProj, pg8::TwoPartOrder, false>(lds, g, S, E, nullptr);
            REPBAR(2);
        }
        SEAM(pb + 1);
        if (EN(3) && IN(pb + 2)) for (int rep = 0; rep < NREP(3); ++rep) { FRESH(ap); mixer_phase(*ap, l, lds, (unsigned*)(ap->ws + WS_CTL) + CW_QUEUE + 64 * (l + 2 * rep), (unsigned*)(ap->ws + WS_CTL) + CW_QUEUE + 64 * (8 + 8 * (l + 2 * rep)), (NREP(3) == 2 && rep == 0) ? DUPMIX : 7, (NREP(3) == 2 && rep == 0) ? HYMODE : 0, (NREP(3) == 2 && rep == 0) ? NAMODE : 0); REPBAR(3); }
        SEAM(pb + 2);
        if (EN(4) && IN(pb + 3)) {
            FRESH(ap); ARGS_REF a = *ap;
            {
                pg8::Gemm g{(const bf16_t*)(a.ws + WS_MIX), (const bf16_t*)(a.ws + WS_WOUT) + (size_t)l * D * D, TL, D, D};
                pg8::StaticOrder S; S.init(TL, D, (int)gridDim.x, (int)blockIdx.x, WGM_OUT);
                EpiRes E{l == 0 ? a.in[0] : (const float*)a.out, (const float*)(a.ws + WS_XC), a.out, (float*)(a.ws + WS_XC), (const float*)(a.ws + WS_MOD) + (size_t)l * 5 * NMOD + 2 * 4096, 1.0f};
                pg8::gemm_phase<EpiRes, pg8::StaticOrder, false>(lds, g, S, E, nullptr);
            }
            if (l == 0) {
                pg8::Gemm g{(const bf16_t*)(a.ws + WS_MIX) + (size_t)TL * D, (const bf16_t*)(a.ws + WS_WOUT), TC, D, D / 4, D};
                pg8::SplitKOrder S; S.init(TC, D, 4, (D / 4) * 2, (int)gridDim.x, (int)blockIdx.x);
                EpiPart E{(float*)(a.ws + WS_PART), D, TC, (D / 4) * 2};
                pg8::gemm_phase<EpiPart, pg8::SplitKOrder, false>(lds, g, S, E, nullptr);
            }
        }
        SEAM(pb + 3);
        if (EN(1) && IN(pb + 4)) for (int rep = 0; rep < NREP(1); ++rep) { FRESH(ap); if (l == 0) norm_phase(*ap, l, 1, nrows, 1, (const float*)(ap->ws + WS_MOD) + (size_t)4 * NMOD + 2 * 4096, 1.0f); else norm_phase(*ap, l, 1, nrows); REPBAR(1); }
        SEAM(pb + 4);
        if (EN(5) && IN(pb + 5)) {
            FRESH(ap); ARGS_REF a = *ap;
            {
                pg8::Gemm g{(const bf16_t*)(a.ws + WS_H), (const bf16_t*)(a.ws + WS_WQ) + (size_t)l * PQ * D, TL, PQ, D};
                pg8::StaticOrder S; S.init(TL, PQ, (int)gridDim.x, (int)blockIdx.x, WGM_Q);
                pg8::EpiF32 E{(float*)(a.ws + WS_Q), PQ, nullptr};
                pg8::gemm_phase<pg8::EpiF32, pg8::StaticOrder, false>(lds, g, S, E, nullptr);
            }
            if (l == 0) {
                pg8::Gemm g{(const bf16_t*)(a.ws + WS_H) + (size_t)TL * D, (const bf16_t*)(a.ws + WS_WQ), TC, PQ, D / 8, D};
                pg8::SplitKOrder S; S.init(TC, PQ, 8, (D / 8) * 2, (int)gridDim.x, (int)blockIdx.x);
                EpiPart E{(float*)(a.ws + WS_PART), PQ, TC, (D / 8) * 2};
                pg8::gemm_phase<EpiPart, pg8::SplitKOrder, false>(lds, g, S, E, nullptr);
            }
        }
        SEAM(pb + 5);
        if (EN(6) && IN(pb + 6)) for (int rep = 0; rep < NREP(6); ++rep) { FRESH(ap); peer_select_phase(*ap, l, nrows, lds); REPBAR(6); }
        SEAM(pb + 6);
        if (EN(7) && IN(pb + 7)) for (int rep = 0; rep < NREP(7); ++rep) {
            FRESH(ap); ARGS_REF a = *ap;
            pg8::Gemm g{(const bf16_t*)(a.ws + WS_HF8), (const bf16_t*)(a.ws + WS_UB + (size_t)l * PN * D), nrows, PN, D / 2};
            pg8::StaticOrder S; S.init(nrows, PN, (int)gridDim.x, (int)blockIdx.x, WGM_P1);
            EpiGate E{(bf16_t*)(a.ws + WS_GA), a.ws + WS_GA8, PN, 1.0f / U8_SCALE};
            pg8::gemm_phase<EpiGate, pg8::StaticOrder, false, true>(lds, g, S, E, nullptr);
            REPBAR(7);
        }
        SEAM(pb + 7);
        if (EN(8) && IN(pb + 8)) {
            FRESH(ap); ARGS_REF a = *ap;
            {
                pg8::Gemm g{(const bf16_t*)(a.ws + WS_GA8), (const bf16_t*)(a.ws + WS_VT + (size_t)l * PN * D), TL, D, PN / 2};
                pg8::StaticOrder S; S.init(TL, D, (int)gridDim.x, (int)blockIdx.x, WGM_P2);
                EpiRes E{(const float*)a.out, (const float*)(a.ws + WS_XC), a.out, (float*)(a.ws + WS_XC), (const float*)(a.ws + WS_MOD) + (size_t)l * 5 * NMOD + 5 * 4096, 1.0f / A8_SCALE};
                pg8::gemm_phase<EpiRes, pg8::StaticOrder, false, true>(lds, g, S, E, nullptr);
            }
            if (l == 0) {
                pg8::Gemm g{(const bf16_t*)(a.ws + WS_GA8 + (size_t)TL * PN), (const bf16_t*)(a.ws + WS_VT), TC, D, PN / 8, PN / 2};
                pg8::SplitKOrder S; S.init(TC, D, 4, PN / 4, (int)gridDim.x, (int)blockIdx.x);
                EpiPart E{(float*)(a.ws + WS_PART), D, TC, PN / 4};
                pg8::gemm_phase<EpiPart, pg8::SplitKOrder, false, true>(lds, g, S, E, nullptr);
            }
        }
        SEAM(pb + 8);
    }
#undef IN
#undef SEAM
}

extern "C" void kernel_launch(void* const* d_in, const int* in_sizes, int n_in, void* d_out, int out_size, void* d_ws, size_t ws_size, hipStream_t stream) {
    static int grid = 0;
    if (grid == 0) {
        if (n_in != 29 || out_size != TL * D || ws_size < WS_END) {
            fprintf(stderr, "kernel_launch: expected 29 inputs, out %d floats, ws >= %zu bytes; got n_in %d out %d ws %zu; nothing launched\n", TL * D, (size_t)WS_END, n_in, out_size, ws_size);
            grid = -1; return;
        }
        int dev = 0, cus = 0, per_cu = 0;
        if (hipGetDevice(&dev) != hipSuccess || hipDeviceGetAttribute(&cus, hipDeviceAttributeMultiprocessorCount, dev) != hipSuccess) { fprintf(stderr, "kernel_launch: device query failed\n"); grid = -1; return; }
        if (hipFuncSetAttribute((const void*)fwd_kernel, hipFuncAttributeMaxDynamicSharedMemorySize, LDS_BYTES) != hipSuccess) { fprintf(stderr, "kernel_launch: hipFuncSetAttribute failed\n"); grid = -1; return; }
        if (hipOccupancyMaxActiveBlocksPerMultiprocessor(&per_cu, (const void*)fwd_kernel, NTHREADS, LDS_BYTES) != hipSuccess || per_cu < 1)
            fprintf(stderr, "kernel_launch: note: occupancy query reports %d workgroups per CU\n", per_cu);
        (void)hipGetLastError();
        grid = cus;
    }
    if (grid < 0) return;
    if (hipMemsetAsync((char*)d_ws + WS_CTL, 0, CTL_BYTES, stream) != hipSuccess) { fprintf(stderr, "kernel_launch: memset failed\n"); return; }
    Args a{};
    for (int i = 0; i < 29; ++i) a.in[i] = (const float*)d_in[i];
    a.out = (float*)d_out; a.ws = (unsigned char*)d_ws;
#if MK_ONE_LAUNCH
    a.ph_lo = 0; a.ph_hi = N_PHASES;
    hipLaunchKernelGGL(fwd_kernel, dim3(grid), dim3(NTHREADS), LDS_BYTES, stream, a);
#else
    for (int p = 0; p < N_PHASES; ++p) { a.ph_lo = p; a.ph_hi = p + 1; hipLaunchKernelGGL(fwd_kernel, dim3(grid), dim3(NTHREADS), LDS_BYTES, stream, a); }
#endif
    const hipError_t le = hipPeekAtLastError();
    if (le != hipSuccess) fprintf(stderr, "kernel_launch: launch failed: %s\n", hipGetErrorName(le));
}
```
